# Optimizing an MI355X kernel written in HIP

```python
import math
import jax, jax.numpy as jnp
from jax import lax
import numpy as np

D_MODEL = 2048
BATCH = 8
SEQ = 2048
DEPTH = 2

HEAD_DIM = 64
GROUP_WIDTH = D_MODEL // 4
D_MIX = 4 * GROUP_WIDTH
H_A = GROUP_WIDTH // HEAD_DIM
G_A = 2
CMP_BLK = 32
CMP_STRIDE = 16
CMP_HIDDEN = 128
SLC_BLK = 64
N_SEL = 8
WIN_A = 512
H_B = GROUP_WIDTH // HEAD_DIM
G_B = 2
WIN_B = 128
CONV_CH = GROUP_WIDTH
CONV_W = 3
H_D = GROUP_WIDTH // HEAD_DIM
DILATED = ((128, 1), (512, 4), (2048, 16))
NUM_BUCKETS = 32
MAX_DISTANCE = 2048
N_BIAS_HEADS = H_A + H_B + H_D
BLOCK = 128
RMS_EPS = 1e-6
NEG = -1e30
FORCE = 1e4

SEG_SIZES = (
    H_A * HEAD_DIM,
    G_A * HEAD_DIM, G_A * HEAD_DIM,
    G_A * HEAD_DIM, G_A * HEAD_DIM,
    G_A * HEAD_DIM, G_A * HEAD_DIM,
    3 * H_A,
    GROUP_WIDTH,
    H_B * HEAD_DIM, G_B * HEAD_DIM, G_B * HEAD_DIM, GROUP_WIDTH,
    CONV_CH, CONV_CH, CONV_CH, GROUP_WIDTH,
    H_D * HEAD_DIM, H_D * HEAD_DIM, H_D * HEAD_DIM, GROUP_WIDTH,
)
D_IN = sum(SEG_SIZES)

kernel_name = "hybrid_nsa_swa_conv_dilated_block"


def rms_norm(x, w):
    xf = x.astype(jnp.float32)
    y = xf * lax.rsqrt(jnp.mean(xf * xf, axis=-1, keepdims=True) + RMS_EPS)
    return (y * w.astype(jnp.float32)).astype(x.dtype)


def t5_bucket(dist):
    exact = NUM_BUCKETS // 2
    d = jnp.maximum(dist, 0)
    large = exact + (jnp.log(jnp.maximum(d, exact).astype(jnp.float32) / exact)
                     / math.log(MAX_DISTANCE / exact) * (NUM_BUCKETS - exact)).astype(jnp.int32)
    return jnp.where(d < exact, d, jnp.minimum(large, NUM_BUCKETS - 1))


def masked_softmax(s, mask):
    s = jnp.where(mask, s, NEG)
    e = jnp.where(mask, jnp.exp(s - jnp.max(s, axis=-1, keepdims=True)), 0.0)
    return e / jnp.maximum(jnp.sum(e, axis=-1, keepdims=True), 1e-30)


def to_heads(t, n):
    b, s, _ = t.shape
    return t.reshape(b, s, n, HEAD_DIM).transpose(0, 2, 1, 3)


def from_heads(t):
    b, n, s, hd = t.shape
    return t.transpose(0, 2, 1, 3).reshape(b, s, n * hd)


def banded_attention(q, k, v, max_dist, bias_tab, dist_scale=1, sink=None):
    b, h, s, hd = q.shape
    hkv = k.shape[1]
    r = h // hkv
    nprev = -(-max_dist // BLOCK)
    nb = -(-s // BLOCK)
    sp = nb * BLOCK
    pad = sp - s
    qp = jnp.pad(q, ((0, 0), (0, 0), (0, pad), (0, 0)))
    kp = jnp.pad(k, ((0, 0), (0, 0), (nprev * BLOCK, pad), (0, 0))).reshape(b, hkv, nb + nprev, BLOCK, hd)
    vp = jnp.pad(v, ((0, 0), (0, 0), (nprev * BLOCK, pad), (0, 0))).reshape(b, hkv, nb + nprev, BLOCK, hd)
    kw = jnp.concatenate([kp[:, :, j:j + nb] for j in range(nprev + 1)], axis=3)
    vw = jnp.concatenate([vp[:, :, j:j + nb] for j in range(nprev + 1)], axis=3)
    wlen = (nprev + 1) * BLOCK
    qb = qp.reshape(b, hkv, r, nb, BLOCK, hd)
    sc = jnp.einsum('bgrcqd,bgckd->bgrcqk', qb, kw).astype(jnp.float32) * (hd ** -0.5)
    qi = jnp.arange(BLOCK)[:, None]
    kj = jnp.arange(wlen)[None, :]
    dist = qi - kj + nprev * BLOCK
    kpos = jnp.arange(nb)[:, None, None] * BLOCK + kj[None] - nprev * BLOCK
    mask = (dist >= 0)[None] & (dist <= max_dist)[None] & (kpos >= 0)
    bias = bias_tab[t5_bucket(dist * dist_scale)].astype(jnp.float32)
    bias = bias.transpose(2, 0, 1).reshape(hkv, r, BLOCK, wlen)[None, :, :, None]
    sc = jnp.where(mask, sc + bias, NEG)
    lse = jax.nn.logsumexp(sc, axis=-1)
    if sink is not None:
        lse = jnp.logaddexp(lse, sink.astype(jnp.float32).reshape(hkv, r)[None, :, :, None, None])
    p = jnp.exp(sc - lse[..., None])
    o = jnp.einsum('bgrcqk,bgckd->bgrcqd', p, vw).reshape(b, h, sp, hd)[:, :, :s]
    return o, lse.reshape(b, h, sp)[:, :, :s]


def nsa_mixer(q, kc, vc, ks, vs, kw, vw, gates, cmp_pos, cmp_w1, cmp_w2, bias_tab):
    b, h, s, hd = q.shape
    g = kc.shape[1]
    r = h // g
    scale = hd ** -0.5
    t_pos = jnp.arange(s)
    qg = q.reshape(b, g, r, s, hd)

    n_cmp = (s - CMP_BLK) // CMP_STRIDE + 1
    cmp_start = jnp.arange(n_cmp) * CMP_STRIDE
    tok = cmp_start[:, None] + jnp.arange(CMP_BLK)[None]

    def compress(t, pos, w1, w2):
        blocks = t[:, :, tok] + pos
        flat = blocks.reshape(b, g, n_cmp, CMP_BLK * hd)
        return jax.nn.silu(flat @ w1) @ w2

    kcmp = compress(kc, cmp_pos[0], cmp_w1[0], cmp_w2[0])
    vcmp = compress(vc, cmp_pos[1], cmp_w1[1], cmp_w2[1])
    dist_c = t_pos[:, None] - (cmp_start + CMP_BLK - 1)[None]
    bias_c = bias_tab[t5_bucket(dist_c)].astype(jnp.float32).transpose(2, 0, 1).reshape(g, r, s, n_cmp)
    sc = jnp.einsum('bgrsd,bgcd->bgrsc', qg, kcmp).astype(jnp.float32) * scale + bias_c
    p_cmp = masked_softmax(sc, dist_c >= 0)
    o_cmp = jnp.einsum('bgrsc,bgcd->bgrsd', p_cmp, vcmp).reshape(b, h, s, hd)

    n_slc = s // SLC_BLK
    n_sel = min(N_SEL, n_slc)
    slc_start = jnp.arange(n_slc) * SLC_BLK
    overlap = ((cmp_start[:, None] < slc_start[None] + SLC_BLK)
               & (cmp_start[:, None] + CMP_BLK > slc_start[None])).astype(jnp.float32)
    imp = jnp.einsum('bgrsc,cn->bgsn', p_cmp, overlap)
    cur = (t_pos // SLC_BLK)[:, None]
    blk = jnp.arange(n_slc)[None]
    forced = (blk == 0) | (blk == cur) | (blk == cur - 1)
    imp = jnp.where(blk > cur, NEG, jnp.where(forced, FORCE, imp))
    _, sel = lax.top_k(imp, n_sel)
    ksb = ks.reshape(b, g, n_slc, SLC_BLK, hd)
    vsb = vs.reshape(b, g, n_slc, SLC_BLK, hd)
    tab_g = bias_tab.reshape(NUM_BUCKETS, g, r).transpose(1, 0, 2)
    gather = jax.vmap(jax.vmap(lambda blocks, ids: blocks[ids]))
    n_tok = n_sel * SLC_BLK

    def sel_chunk(args):
        qc, idc, tq = args
        nq = tq.shape[0]
        kg = gather(ksb, idc).reshape(b, g, nq, n_tok, hd)
        vg = gather(vsb, idc).reshape(b, g, nq, n_tok, hd)
        kpos = (idc[..., None] * SLC_BLK + jnp.arange(SLC_BLK)).reshape(b, g, nq, n_tok)
        dist = tq[:, None] - kpos
        bias = jax.vmap(lambda tb, bk: tb[bk], in_axes=(0, 1), out_axes=1)(tab_g, t5_bucket(dist))
        bias = jnp.moveaxis(bias, -1, 2).astype(jnp.float32)
        sc_s = jnp.einsum('bgrqd,bgqtd->bgrqt', qc, kg).astype(jnp.float32) * scale + bias
        p = masked_softmax(sc_s, (dist >= 0)[:, :, None])
        return jnp.einsum('bgrqt,bgqtd->bgrqd', p, vg)

    nchunk = s // BLOCK
    q_ch = jnp.moveaxis(qg.reshape(b, g, r, nchunk, BLOCK, hd), 3, 0)
    id_ch = jnp.moveaxis(sel.reshape(b, g, nchunk, BLOCK, n_sel), 2, 0)
    t_ch = t_pos.reshape(nchunk, BLOCK)
    o_slc = lax.map(sel_chunk, (q_ch, id_ch, t_ch))
    o_slc = jnp.moveaxis(o_slc, 0, 3).reshape(b, h, s, hd)

    o_win, _ = banded_attention(q, kw, vw, WIN_A - 1, bias_tab)

    gt = jax.nn.sigmoid(gates.astype(jnp.float32)).reshape(b, s, 3, h).transpose(2, 0, 3, 1)[..., None]
    return gt[0] * o_cmp + gt[1] * o_slc + gt[2] * o_win


def short_conv_mixer(bg, cg, hx, conv_w):
    u = cg * hx
    y = lax.conv_general_dilated(u, conv_w[:, None, :].astype(u.dtype), window_strides=(1,),
                                 padding=[(CONV_W - 1, 0)], dimension_numbers=('NWC', 'WIO', 'NWC'),
                                 feature_group_count=u.shape[-1])
    return bg * y


def dilated_mixer(q, k, v, bias_tab):
    b, h, s, hd = q.shape
    outs, lses = [], []
    for window, dil in DILATED:
        def split(t):
            return t.reshape(b, h, s // dil, dil, hd).transpose(0, 3, 1, 2, 4).reshape(b * dil, h, s // dil, hd)
        o, lse = banded_attention(split(q), split(k), split(v), window // dil, bias_tab, dist_scale=dil)
        outs.append(o.reshape(b, dil, h, s // dil, hd).transpose(0, 2, 3, 1, 4).reshape(b, h, s, hd))
        lses.append(lse.reshape(b, dil, h, s // dil).transpose(0, 2, 3, 1).reshape(b, h, s))
    wts = jax.nn.softmax(jnp.stack(lses), axis=0)
    return jnp.einsum('pbhs,pbhsd->bhsd', wts, jnp.stack(outs))


def hybrid_layer(x, norm_w, w_in, w_out, conv_w, sinks, cmp_pos, cmp_w1, cmp_w2, rel_bias):
    hn = rms_norm(x, norm_w)
    proj = hn @ w_in
    offs = np.cumsum(SEG_SIZES)[:-1].tolist()
    (aq, akc, avc, aks, avs, akw, avw, agates, agate,
     bq, bk, bv, bgate, cb, cc, ch, cgate, dq, dk, dv, dgate) = jnp.split(proj, offs, axis=-1)

    o_a = nsa_mixer(to_heads(aq, H_A), to_heads(akc, G_A), to_heads(avc, G_A), to_heads(aks, G_A),
                    to_heads(avs, G_A), to_heads(akw, G_A), to_heads(avw, G_A), agates,
                    cmp_pos, cmp_w1, cmp_w2, rel_bias[:, :H_A])
    o_b, _ = banded_attention(to_heads(bq, H_B), to_heads(bk, G_B), to_heads(bv, G_B), WIN_B - 1,
                              rel_bias[:, H_A:H_A + H_B], sink=sinks)
    o_c = short_conv_mixer(cb, cc, ch, conv_w)
    o_d = dilated_mixer(to_heads(dq, H_D), to_heads(dk, H_D), to_heads(dv, H_D), rel_bias[:, H_A + H_B:])

    mix = jnp.concatenate([
        from_heads(o_a).astype(x.dtype) * jax.nn.silu(agate),
        from_heads(o_b).astype(x.dtype) * jax.nn.silu(bgate),
        o_c.astype(x.dtype) * jax.nn.silu(cgate),
        from_heads(o_d).astype(x.dtype) * jax.nn.silu(dgate),
    ], axis=-1)
    return x + (mix @ w_out).astype(x.dtype)


def setup_inputs(seed: int = 0) -> dict:
    key = jax.random.key(seed)
    ks = jax.random.split(key, 12)
    f32 = jnp.float32
    x = jax.random.normal(ks[0], (BATCH, SEQ, D_MODEL), f32)
    norm_w = 1.0 + 0.02 * jax.random.normal(ks[1], (DEPTH, D_MODEL), f32)
    w_in = jax.random.normal(ks[2], (DEPTH, D_MODEL, D_IN), f32) * D_MODEL ** -0.5
    w_out = jax.random.normal(ks[3], (DEPTH, D_MIX, D_MODEL), f32) * D_MIX ** -0.5
    conv_w = jax.random.normal(ks[4], (DEPTH, CONV_W, CONV_CH), f32) * CONV_W ** -0.5
    sinks = 0.5 * jax.random.normal(ks[5], (DEPTH, H_B), f32)
    cmp_pos = 0.1 * jax.random.normal(ks[6], (DEPTH, 2, CMP_BLK, HEAD_DIM), f32)
    cmp_w1 = jax.random.normal(ks[7], (DEPTH, 2, CMP_BLK * HEAD_DIM, CMP_HIDDEN), f32) * (CMP_BLK * HEAD_DIM) ** -0.5
    cmp_w2 = jax.random.normal(ks[8], (DEPTH, 2, CMP_HIDDEN, HEAD_DIM), f32) * CMP_HIDDEN ** -0.5
    rel_bias = 0.5 * jax.random.normal(ks[9], (NUM_BUCKETS, N_BIAS_HEADS), f32)
    final_norm_w = 1.0 + 0.02 * jax.random.normal(ks[10], (D_MODEL,), f32)
    return {"x": x, "norm_w": norm_w, "w_in": w_in, "w_out": w_out, "conv_w": conv_w,
            "sinks": sinks, "cmp_pos": cmp_pos, "cmp_w1": cmp_w1, "cmp_w2": cmp_w2,
            "rel_bias": rel_bias, "final_norm_w": final_norm_w}


def reference(x, norm_w, w_in, w_out, conv_w, sinks, cmp_pos, cmp_w1, cmp_w2, rel_bias, final_norm_w):
    for layer in range(DEPTH):
        x = hybrid_layer(x, norm_w[layer], w_in[layer], w_out[layer], conv_w[layer], sinks[layer],
                         cmp_pos[layer], cmp_w1[layer], cmp_w2[layer], rel_bias)
    return rms_norm(x, final_norm_w)
```

```cpp
#include <hip/hip_runtime.h>
#include <hip/hip_cooperative_groups.h>
#include <cstdio>
#include <cstdint>
namespace cg = cooperative_groups;

typedef unsigned short bf16_t;
constexpr int DM = 2048, NB = 8, S = 2048, M = NB * S, DIN = 7192, DEPTH = 2;
constexpr int C_AQ = 0, C_AKC = 512, C_AVC = 640, C_AKS = 768, C_AVS = 896, C_AKW = 1024, C_AVW = 1152, C_AGATES = 1280, C_AGATE = 1304;
constexpr int C_BQ = 1816, C_BK = 2328, C_BV = 2456, C_BGATE = 2584;
constexpr int C_CB = 3096, C_CC = 3608, C_CH = 4120, C_CGATE = 4632;
constexpr int C_DQ = 5144, C_DK = 5656, C_DV = 6168, C_DGATE = 6680;
constexpr int NCMP = 127;

constexpr size_t MiB = 1u << 20;
constexpr size_t WS_BIASD = 0;
constexpr size_t WS_RS = 1 * MiB;
constexpr size_t WS_CMP = 2 * MiB;
constexpr size_t WS_P = 8 * MiB;
constexpr size_t WS_MIX = 240 * MiB;
constexpr size_t WS_END = 304 * MiB;

struct Params {
    const float* x; const float* norm_w; const float* w_in; const float* w_out; const float* conv_w; const float* sinks;
    const float* cmp_pos; const float* cmp_w1; const float* cmp_w2; const float* rel_bias; const float* final_norm_w;
    float* out; unsigned char* ws;
};

__device__ __forceinline__ float bf2f(bf16_t v) { return __uint_as_float(((unsigned)v) << 16); }
__device__ __forceinline__ bf16_t f2bf(float f) { unsigned u = __float_as_uint(f); return (bf16_t)((u + 0x7fffu + ((u >> 16) & 1u)) >> 16); }
__device__ __forceinline__ float wave_sum(float v) {
#pragma unroll
    for (int o = 32; o > 0; o >>= 1) v += __shfl_xor(v, o);
    return v;
}
__device__ __forceinline__ float wave_max(float v) {
#pragma unroll
    for (int o = 32; o > 0; o >>= 1) v = fmaxf(v, __shfl_xor(v, o));
    return v;
}
__device__ __forceinline__ float silu(float v) { return v / (1.f + __expf(-v)); }
__device__ __forceinline__ float sigmoidf(float v) { return 1.f / (1.f + __expf(-v)); }
#define LDS_FENCE() asm volatile("s_waitcnt lgkmcnt(0)" ::: "memory")

__device__ __forceinline__ int t5_bucket(int d) {
    if (d < 16) return d < 0 ? 0 : d;
    int b = 16;
    b += (d >= 22); b += (d >= 30); b += (d >= 40); b += (d >= 54); b += (d >= 73); b += (d >= 99); b += (d >= 134); b += (d >= 182);
    b += (d >= 246); b += (d >= 332); b += (d >= 450); b += (d >= 609); b += (d >= 825); b += (d >= 1117); b += (d >= 1513);
    return b;
}

struct ALoadX { const float* x; const float* rs; const float* nw; __device__ __forceinline__ float operator()(int row, int k) const { return x[(size_t)row * DM + k] * rs[row] * nw[k]; } };
struct ALoadMix { const bf16_t* mix; __device__ __forceinline__ float operator()(int row, int k) const { return bf2f(mix[(size_t)row * DM + k]); } };
struct EpiP { bf16_t* P; __device__ __forceinline__ void operator()(int row, int col, float v) const { P[(size_t)row * DIN + col] = f2bf(v); } };
struct EpiRes { const float* xin; float* xout; __device__ __forceinline__ void operator()(int row, int col, float v) const { xout[(size_t)row * DM + col] = xin[(size_t)row * DM + col] + v; } };
template <class ALoad, class Epi>
__device__ __forceinline__ void gemm_naive(float* lds, int Mr, int N, int K, const float* __restrict__ W, ALoad aload, Epi epi) {
    float (*As)[132] = (float (*)[132])lds;
    float (*Bs)[132] = (float (*)[132])(lds + 16 * 132);
    const int tid = threadIdx.x, tx = tid & 15, ty = tid >> 4;
    const int ntm = Mr / 128, ntn = (N + 127) / 128;
    for (int tile = blockIdx.x; tile < ntm * ntn; tile += gridDim.x) {
        const int tm = tile % ntm, tn = tile / ntm;
        float acc[8][8];
#pragma unroll
        for (int i = 0; i < 8; ++i)
#pragma unroll
            for (int j = 0; j < 8; ++j) acc[i][j] = 0.f;
        for (int k0 = 0; k0 < K; k0 += 16) {
#pragma unroll
            for (int i = 0; i < 8; ++i) { const int e = tid + i * 256, r = e >> 4, kk = e & 15; As[kk][r] = aload(tm * 128 + r, k0 + kk); }
#pragma unroll
            for (int i = 0; i < 8; ++i) { const int e = tid + i * 256, kk = e >> 7, c = e & 127, col = tn * 128 + c; Bs[kk][c] = col < N ? W[(size_t)(k0 + kk) * N + col] : 0.f; }
            __syncthreads();
#pragma unroll 2
            for (int kk = 0; kk < 16; ++kk) {
                float a[8], b[8];
#pragma unroll
                for (int i = 0; i < 8; ++i) { a[i] = As[kk][ty * 8 + i]; b[i] = Bs[kk][tx * 8 + i]; }
#pragma unroll
                for (int i = 0; i < 8; ++i)
#pragma unroll
                    for (int j = 0; j < 8; ++j) acc[i][j] += a[i] * b[j];
            }
            __syncthreads();
        }
#pragma unroll
        for (int i = 0; i < 8; ++i)
#pragma unroll
            for (int j = 0; j < 8; ++j) { const int row = tm * 128 + ty * 8 + i, col = tn * 128 + tx * 8 + j; if (col < N) epi(row, col, acc[i][j]); }
    }
}

__device__ __forceinline__ float ldval(const bf16_t* p) { return bf2f(*p); }
__device__ __forceinline__ float ldval(const float* p) { return *p; }
__device__ __forceinline__ void load8(const bf16_t* p, float (&k)[8]) {
    const uint4 w = *(const uint4*)p;
    k[0] = __uint_as_float(w.x << 16); k[1] = __uint_as_float(w.x & 0xffff0000u);
    k[2] = __uint_as_float(w.y << 16); k[3] = __uint_as_float(w.y & 0xffff0000u);
    k[4] = __uint_as_float(w.z << 16); k[5] = __uint_as_float(w.z & 0xffff0000u);
    k[6] = __uint_as_float(w.w << 16); k[7] = __uint_as_float(w.w & 0xffff0000u);
}
__device__ __forceinline__ void load8(const float* p, float (&k)[8]) {
    const float4 a = ((const float4*)p)[0], b = ((const float4*)p)[1];
    k[0] = a.x; k[1] = a.y; k[2] = a.z; k[3] = a.w; k[4] = b.x; k[5] = b.y; k[6] = b.z; k[7] = b.w;
}

template <int NH, typename KT>
__device__ __forceinline__ void score_chunk(const KT* kmat, size_t rstride, int krow, bool valid, int dist, const float* qs, const float* biasd, float (&s)[NH]) {
    float a[NH];
#pragma unroll
    for (int h = 0; h < NH; ++h) a[h] = 0.f;
    if (valid) {
        const KT* kr = kmat + (size_t)krow * rstride;
#pragma unroll 2
        for (int d8 = 0; d8 < 8; ++d8) {
            float k[8]; load8(kr + 8 * d8, k);
#pragma unroll
            for (int h = 0; h < NH; ++h) {
                const float4 q0 = ((const float4*)(qs + h * 64))[2 * d8], q1 = ((const float4*)(qs + h * 64))[2 * d8 + 1];
                a[h] += q0.x * k[0] + q0.y * k[1] + q0.z * k[2] + q0.w * k[3] + q1.x * k[4] + q1.y * k[5] + q1.z * k[6] + q1.w * k[7];
            }
        }
    }
#pragma unroll
    for (int h = 0; h < NH; ++h) s[h] = valid ? a[h] * 0.125f + biasd[h * 2048 + dist] : -INFINITY;
}
template <int NH, typename VT>
__device__ __forceinline__ void pv_chunk(const VT* vmat, size_t rstride, int rbase, int rstep, int j0, int j1, const float (&p)[NH], float (&o)[NH], int lane) {
    for (int jj = j0; jj < j1; ++jj) {
        const float vv = ldval(vmat + (size_t)(rbase + jj * rstep) * rstride + lane);
#pragma unroll
        for (int h = 0; h < NH; ++h) o[h] += __uint_as_float(__builtin_amdgcn_readlane(__float_as_uint(p[h]), jj)) * vv;
    }
}
template <int NH, typename KT>
__device__ __forceinline__ void attend_chunk(const KT* kmat, const KT* vmat, size_t rstride, int rbase, int rstep, int j0, int j1, int dbase, int dstep,
                                             const float* qs, const float* biasd, float (&m)[NH], float (&l)[NH], float (&o)[NH], int lane) {
    if (j1 <= j0) return;
    const bool valid = lane >= j0 && lane < j1;
    float s[NH], p[NH];
    score_chunk<NH, KT>(kmat, rstride, rbase + lane * rstep, valid, dbase + lane * dstep, qs, biasd, s);
#pragma unroll
    for (int h = 0; h < NH; ++h) {
        const float cm = wave_max(s[h]);
        const float mn = fmaxf(m[h], cm);
        const float sc = __expf(m[h] - mn);
        p[h] = valid ? __expf(s[h] - mn) : 0.f;
        l[h] = l[h] * sc + wave_sum(p[h]); o[h] *= sc; m[h] = mn;
    }
    pv_chunk<NH, KT>(vmat, rstride, rbase, rstep, j0, j1, p, o, lane);
}

__global__ void __launch_bounds__(256, 2) fwd_kernel(Params prm) {
    cg::grid_group grid = cg::this_grid();
    __shared__ __attribute__((aligned(16))) float lds[2 * 16 * 132];
    const int tid = threadIdx.x, lane = tid & 63, wib = tid >> 6;
    const int gthreads = gridDim.x * 256, gtid = blockIdx.x * 256 + tid;
    const int gwaves = gridDim.x * 4, gwave = blockIdx.x * 4 + wib;
    unsigned char* ws = prm.ws;
    float* biasd = (float*)(ws + WS_BIASD);
    float* rs = (float*)(ws + WS_RS);
    float* cmpkv = (float*)(ws + WS_CMP);
    bf16_t* P = (bf16_t*)(ws + WS_P);
    bf16_t* MIX = (bf16_t*)(ws + WS_MIX);

    for (int i = gtid; i < 24 * 2048; i += gthreads) { const int h = i >> 11, d = i & 2047; biasd[i] = prm.rel_bias[t5_bucket(d) * 24 + h]; }

    for (int layer = 0; layer < DEPTH; ++layer) {
        const float* xin = layer == 0 ? prm.x : prm.out;
        float* xout = prm.out;
        const float* nw = prm.norm_w + layer * DM;
        const float* Win = prm.w_in + (size_t)layer * DM * DIN;
        const float* Wout = prm.w_out + (size_t)layer * DM * DM;
        const float* convw = prm.conv_w + layer * 3 * 512;
        const float* sinks = prm.sinks + layer * 8;
        const float* cpos = prm.cmp_pos + layer * 2 * 32 * 64;
        const float* cw1 = prm.cmp_w1 + (size_t)layer * 2 * 2048 * 128;
        const float* cw2 = prm.cmp_w2 + (size_t)layer * 2 * 128 * 64;

        for (int row = gwave; row < M; row += gwaves) {
            const float4* xr = (const float4*)(xin + (size_t)row * DM);
            float s = 0.f;
#pragma unroll
            for (int j = 0; j < 8; ++j) { const float4 v = xr[lane + 64 * j]; s += v.x * v.x + v.y * v.y + v.z * v.z + v.w * v.w; }
            s = wave_sum(s);
            if (lane == 0) rs[row] = rsqrtf(s * (1.f / DM) + 1e-6f);
        }
        grid.sync();

        {
            ALoadX aload{xin, rs, nw}; EpiP epi{P};
            gemm_naive(lds, M, DIN, DM, Win, aload, epi);
        }
        grid.sync();

        for (int item = blockIdx.x; item < 2 * NB * 2 * NCMP; item += gridDim.x) {
            const int c = item % NCMP, g = (item / NCMP) & 1, b = (item / (NCMP * 2)) % NB, which = item / (NCMP * 2 * NB);
            const int j = tid & 127, half = tid >> 7;
            const bf16_t* src = P + (size_t)(b * S + 16 * c) * DIN + (which ? C_AVC : C_AKC) + g * 64;
            const float* pos = cpos + which * 32 * 64;
            const float* w1 = cw1 + (size_t)which * 2048 * 128;
            float a = 0.f;
            for (int l = half * 16; l < half * 16 + 16; ++l)
                for (int d = 0; d < 64; ++d) a += (bf2f(src[(size_t)l * DIN + d]) + pos[l * 64 + d]) * w1[(size_t)(l * 64 + d) * 128 + j];
            lds[half * 128 + j] = a;
            __syncthreads();
            if (tid < 128) lds[256 + tid] = silu(lds[tid] + lds[128 + tid]);
            __syncthreads();
            if (tid < 64) {
                const float* w2 = cw2 + which * 128 * 64;
                float o = 0.f;
                for (int jj = 0; jj < 128; ++jj) o += lds[256 + jj] * w2[jj * 64 + tid];
                cmpkv[(((size_t)which * NB + b) * 2 + g) * 128 * 64 + c * 64 + tid] = o;
            }
            __syncthreads();
        }
        grid.sync();

        {
            float* qs = lds + wib * 512;
            float* pc = qs + 256;
            constexpr int NA = NB * 2 * S, NBi = NB * 2 * S, ND = NB * 8 * S;
            for (int item = gwave; item < NA + NBi + ND; item += gwaves) {
                if (item < NA) {
                    const int t = item % S, g = (item / S) & 1, b = item / (2 * S);
                    const size_t row = (size_t)b * S + t;
                    const bf16_t* Pb = P + (size_t)b * S * DIN;
#pragma unroll
                    for (int h = 0; h < 4; ++h) qs[h * 64 + lane] = bf2f(P[row * DIN + C_AQ + (g * 4 + h) * 64 + lane]);
                    LDS_FENCE();
                    const float* bd = biasd + (g * 4) * 2048;
                    const float* kc = cmpkv + (((size_t)0 * NB + b) * 2 + g) * 128 * 64;
                    const float* vc = cmpkv + (((size_t)1 * NB + b) * 2 + g) * 128 * 64;
                    const int ncv = t >= 31 ? (t - 31) / 16 + 1 : 0;
                    float ocmp[4] = {0.f, 0.f, 0.f, 0.f};
                    float psum0 = 0.f, psum1 = 0.f;
                    if (ncv > 0) {
                        float s0[4], s1[4], p0[4], p1[4];
                        const bool v0 = lane < ncv, v1 = lane + 64 < ncv;
                        score_chunk<4, float>(kc, 64, lane, v0, v0 ? t - 31 - 16 * lane : 0, qs, bd, s0);
                        score_chunk<4, float>(kc, 64, lane + 64, v1, v1 ? t - 31 - 16 * (lane + 64) : 0, qs, bd, s1);
#pragma unroll
                        for (int h = 0; h < 4; ++h) {
                            const float mx = wave_max(fmaxf(s0[h], s1[h]));
                            const float e0 = v0 ? __expf(s0[h] - mx) : 0.f, e1 = v1 ? __expf(s1[h] - mx) : 0.f;
                            const float inv = 1.f / fmaxf(wave_sum(e0 + e1), 1e-30f);
                            p0[h] = e0 * inv; p1[h] = e1 * inv; psum0 += p0[h]; psum1 += p1[h];
                        }
                        pv_chunk<4, float>(vc, 64, 0, 1, 0, ncv < 64 ? ncv : 64, p0, ocmp, lane);
                        if (ncv > 64) pv_chunk<4, float>(vc, 64, 64, 1, 0, ncv - 64, p1, ocmp, lane);
                    }
                    pc[lane] = psum0; pc[64 + lane] = psum1;
                    LDS_FENCE();
                    const int cur = t >> 6;
                    float imp = -INFINITY;
                    if (lane < 32) {
                        float a = 0.f;
#pragma unroll
                        for (int c = -1; c <= 3; ++c) { const int cc = 4 * lane + c; if (cc >= 0 && cc < NCMP) a += pc[cc]; }
                        const bool forced = lane == 0 || lane == cur || lane == cur - 1;
                        imp = lane > cur ? -1e30f : (forced ? 1e4f : a);
                    }
                    unsigned selmask = 0u;
#pragma unroll 1
                    for (int r = 0; r < 8; ++r) {
                        const float mx = wave_max(imp);
                        const unsigned long long bal = __ballot(imp == mx);
                        const int win = __ffsll((long long)bal) - 1;
                        selmask |= 1u << win;
                        if (lane == win) imp = -INFINITY;
                    }
                    LDS_FENCE();
                    float m[4], l[4], osel[4];
#pragma unroll
                    for (int h = 0; h < 4; ++h) { m[h] = -INFINITY; l[h] = 0.f; osel[h] = 0.f; }
                    for (int n = 0; n <= cur; ++n) {
                        if (!((selmask >> n) & 1u)) continue;
                        const int j1 = (t - 64 * n + 1) < 64 ? (t - 64 * n + 1) : 64;
                        attend_chunk<4, bf16_t>(Pb + C_AKS + g * 64, Pb + C_AVS + g * 64, DIN, 64 * n, 1, 0, j1, t - 64 * n, -1, qs, bd, m, l, osel, lane);
                    }
#pragma unroll
                    for (int h = 0; h < 4; ++h) osel[h] = osel[h] / fmaxf(l[h], 1e-30f);
                    float owin[4];
#pragma unroll
                    for (int h = 0; h < 4; ++h) { m[h] = -INFINITY; l[h] = 0.f; owin[h] = 0.f; }
                    {
                        const int lo = t - 511 > 0 ? t - 511 : 0;
                        for (int k0 = lo; k0 <= t; k0 += 64) {
                            const int j1 = (t - k0 + 1) < 64 ? (t - k0 + 1) : 64;
                            attend_chunk<4, bf16_t>(Pb + C_AKW + g * 64, Pb + C_AVW + g * 64, DIN, k0, 1, 0, j1, t - k0, -1, qs, bd, m, l, owin, lane);
                        }
                    }
#pragma unroll
                    for (int h = 0; h < 4; ++h) {
                        const int hh = g * 4 + h;
                        const float g0 = sigmoidf(bf2f(P[row * DIN + C_AGATES + 0 * 8 + hh])), g1 = sigmoidf(bf2f(P[row * DIN + C_AGATES + 1 * 8 + hh])), g2 = sigmoidf(bf2f(P[row * DIN + C_AGATES + 2 * 8 + hh]));
                        const float oa = g0 * ocmp[h] + g1 * osel[h] + g2 * (owin[h] / l[h]);
                        const float gate = bf2f(P[row * DIN + C_AGATE + hh * 64 + lane]);
                        MIX[row * DM + hh * 64 + lane] = f2bf(oa * silu(gate));
                    }
                } else if (item < NA + NBi) {
                    const int it = item - NA;
                    const int t = it % S, g = (it / S) & 1, b = it / (2 * S);
                    const size_t row = (size_t)b * S + t;
                    const bf16_t* Pb = P + (size_t)b * S * DIN;
#pragma unroll
                    for (int h = 0; h < 4; ++h) qs[h * 64 + lane] = bf2f(P[row * DIN + C_BQ + (g * 4 + h) * 64 + lane]);
                    LDS_FENCE();
                    const float* bd = biasd + (8 + g * 4) * 2048;
                    float m[4], l[4], o[4];
#pragma unroll
                    for (int h = 0; h < 4; ++h) { m[h] = -INFINITY; l[h] = 0.f; o[h] = 0.f; }
                    const int lo = t - 127 > 0 ? t - 127 : 0;
                    for (int k0 = lo; k0 <= t; k0 += 64) {
                        const int j1 = (t - k0 + 1) < 64 ? (t - k0 + 1) : 64;
                        attend_chunk<4, bf16_t>(Pb + C_BK + g * 64, Pb + C_BV + g * 64, DIN, k0, 1, 0, j1, t - k0, -1, qs, bd, m, l, o, lane);
                    }
                    LDS_FENCE();
#pragma unroll
                    for (int h = 0; h < 4; ++h) {
                        const int hh = g * 4 + h;
                        const float den = l[h] + __expf(sinks[hh] - m[h]);
                        const float gate = bf2f(P[row * DIN + C_BGATE + hh * 64 + lane]);
                        MIX[row * DM + 512 + hh * 64 + lane] = f2bf(o[h] / den * silu(gate));
                    }
                } else {
                    const int it = item - NA - NBi;
                    const int t = it % S, hh = (it / S) & 7, b = it / (8 * S);
                    const size_t row = (size_t)b * S + t;
                    const bf16_t* Pb = P + (size_t)b * S * DIN;
                    qs[lane] = bf2f(P[row * DIN + C_DQ + hh * 64 + lane]);
                    LDS_FENCE();
                    const float* bd = biasd + (16 + hh) * 2048;
                    const bf16_t* kd = Pb + C_DK + hh * 64; const bf16_t* vd = Pb + C_DV + hh * 64;
                    float m[1] = {-INFINITY}, l[1] = {0.f}, o[1] = {0.f};
#pragma unroll 1
                    for (int pat = 0; pat < 3; ++pat) {
                        const int dil = pat == 0 ? 1 : (pat == 1 ? 4 : 16);
                        int nk = t / dil + 1;
                        if (nk > 129) nk = 129;
                        if (pat == 2 && nk > 128) nk = 128;
                        for (int m0 = 0; m0 < nk; m0 += 64) {
                            const int j1 = (nk - m0) < 64 ? (nk - m0) : 64;
                            attend_chunk<1, bf16_t>(kd, vd, DIN, t - dil * m0, -dil, 0, j1, dil * m0, dil, qs, bd, m, l, o, lane);
                        }
                    }
                    LDS_FENCE();
                    const float gate = bf2f(P[row * DIN + C_DGATE + hh * 64 + lane]);
                    MIX[row * DM + 1536 + hh * 64 + lane] = f2bf(o[0] / l[0] * silu(gate));
                }
            }
            for (int i = gtid; i < M * 512; i += gthreads) {
                const int c = i & 511, row = i >> 9, t = row & (S - 1);
                const bf16_t* pr = P + (size_t)row * DIN;
                float y = convw[2 * 512 + c] * bf2f(pr[C_CC + c]) * bf2f(pr[C_CH + c]);
                if (t >= 1) y += convw[1 * 512 + c] * bf2f(pr[C_CC + c - DIN]) * bf2f(pr[C_CH + c - DIN]);
                if (t >= 2) y += convw[0 * 512 + c] * bf2f(pr[C_CC + c - 2 * DIN]) * bf2f(pr[C_CH + c - 2 * DIN]);
                MIX[(size_t)row * DM + 1024 + c] = f2bf(bf2f(pr[C_CB + c]) * y * silu(bf2f(pr[C_CGATE + c])));
            }
        }
        grid.sync();

        {
            ALoadMix aload{MIX}; EpiRes epi{xin, xout};
            gemm_naive(lds, M, DM, DM, Wout, aload, epi);
        }
        grid.sync();
    }
    for (int row = gwave; row < M; row += gwaves) {
        float4* xr = (float4*)(prm.out + (size_t)row * DM);
        float4 v[8]; float s = 0.f;
#pragma unroll
        for (int j = 0; j < 8; ++j) { v[j] = xr[lane + 64 * j]; s += v[j].x * v[j].x + v[j].y * v[j].y + v[j].z * v[j].z + v[j].w * v[j].w; }
        s = wave_sum(s);
        const float r = rsqrtf(s * (1.f / DM) + 1e-6f);
#pragma unroll
        for (int j = 0; j < 8; ++j) { const float4 w = ((const float4*)prm.final_norm_w)[lane + 64 * j];
            xr[lane + 64 * j] = make_float4(v[j].x * r * w.x, v[j].y * r * w.y, v[j].z * r * w.z, v[j].w * r * w.w); }
    }
}

extern "C" void kernel_launch(void* const* d_in, const int* in_sizes, int n_in, void* d_out, int out_size, void* d_ws, size_t ws_size, hipStream_t stream) {
    static int grid_blocks = 0;
    if (!grid_blocks) {
        int dev = 0, cus = 0, per_cu = 0;
        hipGetDevice(&dev);
        hipDeviceGetAttribute(&cus, hipDeviceAttributeMultiprocessorCount, dev);
        hipOccupancyMaxActiveBlocksPerMultiprocessor(&per_cu, fwd_kernel, 256, 0);
        if (per_cu > 2) per_cu = 2;
        if (per_cu < 1) per_cu = 1;
        grid_blocks = cus * per_cu;
        if (ws_size < WS_END) fprintf(stderr, "kernel_launch: workspace too small: %zu < %zu\n", ws_size, (size_t)WS_END);
    }
    Params p{};
    p.x = (const float*)d_in[0]; p.norm_w = (const float*)d_in[1]; p.w_in = (const float*)d_in[2]; p.w_out = (const float*)d_in[3];
    p.conv_w = (const float*)d_in[4]; p.sinks = (const float*)d_in[5]; p.cmp_pos = (const float*)d_in[6]; p.cmp_w1 = (const float*)d_in[7];
    p.cmp_w2 = (const float*)d_in[8]; p.rel_bias = (const float*)d_in[9]; p.final_norm_w = (const float*)d_in[10];
    p.out = (float*)d_out; p.ws = (unsigned char*)d_ws;
    void* args[] = {&p};
    hipError_t e = hipLaunchCooperativeKernel((void*)fwd_kernel, dim3(grid_blocks), dim3(256), args, 0, stream);
    if (e != hipSuccess) fprintf(stderr, "cooperative launch failed: %s (grid %d)\n", hipGetErrorString(e), grid_blocks);
}
```

```cpp
#include <hip/hip_runtime.h>
#include <hip/hip_cooperative_groups.h>
#include <cstdio>
#include <cstdint>
namespace cg = cooperative_groups;

namespace pg8 {
#define PG8_LAS __attribute__((address_space(3)))
typedef unsigned short bf16_t;
typedef short bf16x8 __attribute__((ext_vector_type(8)));
typedef float f32x4 __attribute__((ext_vector_type(4)));
typedef unsigned u32x4 __attribute__((ext_vector_type(4)));
constexpr int BM = 256, BK = 64, HALF = 128, HTB = HALF * BK * 2  , STAGE_BYTES = 8 * HTB, NXCD = 8, WGM = 8;

__host__ __device__ __forceinline__ int lds_byte(int r, int c) { const int st = (r >> 4) * 2 + (c >> 5), rr = r & 15, cc = c & 31, ob = rr * 64 + cc * 2; return st * 1024 + (ob ^ (((ob >> 9) & 1) << 5)); }
__host__ __device__ __forceinline__ void stage_rc(int b, int& R, int& C) { const int st = b / 1024, sb = b % 1024, swz = sb ^ (((sb >> 9) & 1) << 5); R = (st >> 1) * 16 + swz / 64; C = (st & 1) * 32 + (swz % 64) / 2; }
__host__ __device__ __forceinline__ int perm32(int rho) { const int n = rho >> 4, i = rho & 15; return 8 * (i >> 2) + 4 * n + (i & 3); }

struct Unit { int pm, pn; };
struct Gemm { const bf16_t* A; const bf16_t* Bt; int M, N, K; };

struct StaticOrder {
    int nM, nN, nwg, G, c;
    __host__ __device__ void init(int M, int N, int G_, int c_) { nM = M / BM; nN = N / BM; nwg = nM * nN; G = G_; c = c_; }
    __host__ __device__ bool next(int i, Unit& u) const {
        const long L = (long)i * G + c; if (L >= nwg) return false;
        int wgid = (int)L; { const int q = nwg / NXCD, r = nwg % NXCD, xcd = wgid % NXCD, off = wgid / NXCD; wgid = (xcd < r ? xcd * (q + 1) : r * (q + 1) + (xcd - r) * q) + off; }
        const int nig = WGM * nN, gid = wgid / nig, fm = gid * WGM, gsz = (nM - fm) < WGM ? (nM - fm) : WGM;
        u.pm = fm + ((wgid % nig) % gsz); u.pn = (wgid % nig) / gsz; return true;
    }
    __device__ __forceinline__ void a_ready(const Unit&) const {}
    __device__ __forceinline__ void done(const Unit&) const {}
};


__device__ __forceinline__ unsigned cvt_pk_bf16(float lo, float hi) { unsigned r; asm volatile("v_cvt_pk_bf16_f32 %0, %1, %2" : "=v"(r) : "v"(lo), "v"(hi)); return r; }
struct EpiBf16 {
    static constexpr bool PERM = true, AFTER_DRAIN = false;
    bf16_t* O; int ldc;
    __device__ __forceinline__ void operator()(const f32x4 (&acc)[2][2][4][2], const Unit& u, int wr, int wc, int fr, int fq) const {
        const int row0 = u.pm * BM + wr * 64 + fr; const int col0 = u.pn * BM + wc * 32 + 8 * fq;
#pragma unroll
        for (int ai = 0; ai < 2; ++ai)
#pragma unroll
            for (int m = 0; m < 4; ++m) { bf16_t* rowp = O + (size_t)(row0 + ai * HALF + m * 16) * ldc + col0;
#pragma unroll
                for (int bj = 0; bj < 2; ++bj) { const f32x4 v0 = acc[ai][bj][m][0], v1 = acc[ai][bj][m][1];
                    u32x4 w; w.x = cvt_pk_bf16(v0[0], v0[1]); w.y = cvt_pk_bf16(v0[2], v0[3]); w.z = cvt_pk_bf16(v1[0], v1[1]); w.w = cvt_pk_bf16(v1[2], v1[3]);
                    *(u32x4*)(rowp + bj * HALF) = w; } }
    }
};
struct EpiResid {
    static constexpr bool PERM = false, AFTER_DRAIN = false;
    const float* base; float* out; int ldc;
    __device__ __forceinline__ void operator()(const f32x4 (&acc)[2][2][4][2], const Unit& u, int wr, int wc, int fr, int fq) const {
        const int col0 = u.pn * BM + wc * 32 + 4 * fq;
#pragma unroll
        for (int ai = 0; ai < 2; ++ai)
#pragma unroll
            for (int m = 0; m < 4; ++m) { const size_t off = (size_t)(u.pm * BM + ai * HALF + wr * 64 + m * 16 + fr) * ldc + col0;
#pragma unroll
                for (int bj = 0; bj < 2; ++bj)
#pragma unroll
                    for (int n = 0; n < 2; ++n) { const f32x4 bs = *(const f32x4*)(base + off + bj * HALF + n * 16); *(f32x4*)(out + off + bj * HALF + n * 16) = bs + acc[ai][bj][m][n]; } }
    }
};

template <class Epi, class Sched, bool ALIGN_EPI = false, bool SP2 = false>
__device__ __forceinline__ void gemm_phase(PG8_LAS unsigned char* lds, const Gemm g, const Sched& S, const Epi& E) {
    const int tid = threadIdx.x, wid = __builtin_amdgcn_readfirstlane(tid >> 6), lane = tid & 63, wr = wid >> 2, wc = wid & 3, fr = lane & 15, fq = lane >> 4;
    const int K = g.K, nt = K / BK;
    unsigned voffA[2], voffB[2];
#pragma unroll
    for (int i = 0; i < 2; ++i) { int R, C; stage_rc(tid * 16 + i * 8192, R, C); const int Rb = Epi::PERM ? ((R & ~31) + perm32(R & 31)) : R;
        voffA[i] = (unsigned)(R * K + C) * 2u; voffB[i] = (unsigned)(Rb * K + C) * 2u; }
    const size_t kstep = (size_t)(BK * 2);
    const size_t hstep = (size_t)HALF * K * 2;
    const size_t tstep = 2 * hstep;
    const unsigned ldsw = (unsigned)wid * 1024u;
    const int aoff = lds_byte(wr * 64 + fr, fq * 8), boff = lds_byte(wc * 32 + fr, fq * 8);
#define PG8_SA(b, h) (((b) * 2 + (h)) * HTB)
#define PG8_SB(b, h) ((4 + (b) * 2 + (h)) * HTB)
#define PG8_STAGE(bufoff, gbase, voff) do { _Pragma("unroll") for (int _i = 0; _i < 2; ++_i) \
        __builtin_amdgcn_global_load_lds((const unsigned*)((const char*)(gbase) + (voff)[_i]), (PG8_LAS unsigned*)(lds + (bufoff) + ldsw + _i * 8192), 16, 0, 0); } while (0)
#define PG8_LDA(dst, b, h) do { _Pragma("unroll") for (int m = 0; m < 4; ++m) _Pragma("unroll") for (int k = 0; k < 2; ++k) dst[m][k] = *(const PG8_LAS bf16x8*)(lds + PG8_SA(b, h) + aoff + m * 2048 + k * 1024); } while (0)
#define PG8_LDB(dst, b, h) do { _Pragma("unroll") for (int n = 0; n < 2; ++n) _Pragma("unroll") for (int k = 0; k < 2; ++k) dst[n][k] = *(const PG8_LAS bf16x8*)(lds + PG8_SB(b, h) + boff + n * 2048 + k * 1024); } while (0)
#define PG8_MMA(ai, bj, At, Bt) do { __builtin_amdgcn_s_setprio(1); _Pragma("unroll") for (int m = 0; m < 4; ++m) _Pragma("unroll") for (int n = 0; n < 2; ++n) _Pragma("unroll") for (int k = 0; k < 2; ++k) \
        acc[ai][bj][m][n] = __builtin_amdgcn_mfma_f32_16x16x32_bf16(Bt[n][k], At[m][k], acc[ai][bj][m][n], 0, 0, 0); __builtin_amdgcn_s_setprio(0); } while (0)
#define PG8_WAIT_V(n) asm volatile("s_waitcnt vmcnt(" #n ")" ::: "memory")
#define PG8_WAIT_L(n) asm volatile("s_waitcnt lgkmcnt(" #n ")" ::: "memory")
#define PG8_BAR __builtin_amdgcn_s_barrier()
#define PG8_SCHED __builtin_amdgcn_sched_barrier(0)
    Unit cur, nxt; int ui = 0;
    if (!S.next(0, cur)) return;
    f32x4 acc[2][2][4][2];
#pragma unroll
    for (int a = 0; a < 2; ++a)
#pragma unroll
        for (int b = 0; b < 2; ++b)
#pragma unroll
            for (int m = 0; m < 4; ++m)
#pragma unroll
                for (int n = 0; n < 2; ++n) acc[a][b][m][n] = (f32x4){0.f, 0.f, 0.f, 0.f};
    bf16x8 At[4][2], B0[2][2], B1[2][2];
    const char* cA = (const char*)g.A + (size_t)cur.pm * tstep; const char* cB = (const char*)g.Bt + (size_t)cur.pn * tstep;
    S.a_ready(cur);
    if constexpr (SP2) {
        PG8_STAGE(PG8_SB(0, 0), cB, voffB); PG8_STAGE(PG8_SB(0, 1), cB + hstep, voffB); PG8_STAGE(PG8_SA(0, 0), cA, voffA); PG8_STAGE(PG8_SA(0, 1), cA + hstep, voffA);
        if (wr == 1) PG8_BAR;
        PG8_WAIT_V(2); PG8_BAR;
        PG8_STAGE(PG8_SB(1, 0), cB + kstep, voffB); PG8_STAGE(PG8_SA(1, 0), cA + kstep, voffA); PG8_STAGE(PG8_SB(1, 1), cB + hstep + kstep, voffB);
        PG8_WAIT_V(6); PG8_BAR;
    } else {
        PG8_STAGE(PG8_SB(0, 0), cB, voffB); PG8_STAGE(PG8_SA(0, 0), cA, voffA); PG8_STAGE(PG8_SB(0, 1), cB + hstep, voffB); PG8_STAGE(PG8_SA(0, 1), cA + hstep, voffA);
        if (wr == 1) PG8_BAR;
        PG8_WAIT_V(4); PG8_BAR;
        PG8_STAGE(PG8_SB(1, 0), cB + kstep, voffB); PG8_STAGE(PG8_SA(1, 0), cA + kstep, voffA); PG8_STAGE(PG8_SB(1, 1), cB + hstep + kstep, voffB);
        PG8_WAIT_V(6); PG8_BAR;
    }
    for (;;) {
        const bool has_next = S.next(ui + 1, nxt);
        const char* nA = has_next ? (const char*)g.A + (size_t)nxt.pm * tstep : cA; const char* nB = has_next ? (const char*)g.Bt + (size_t)nxt.pn * tstep : cB;
        for (int t = 0; t < nt; t += 2) {
            const bool last = (t == nt - 2);
            const char* a1 = cA + (size_t)(t + 1) * kstep;
            const char* a2 = last ? nA : cA + (size_t)(t + 2) * kstep; const char* b2 = last ? nB : cB + (size_t)(t + 2) * kstep;
            const char* a3 = a2 + kstep; const char* b3 = b2 + kstep;
            if (last && has_next) S.a_ready(nxt);
            if constexpr (SP2) {
            PG8_LDB(B0, 0, 0); PG8_LDB(B1, 0, 1); PG8_SCHED; PG8_LDA(At, 0, 0); PG8_STAGE(PG8_SA(1, 1), a1 + hstep, voffA);
            PG8_WAIT_V(8); PG8_WAIT_L(0); PG8_BAR; PG8_MMA(0, 0, At, B0); PG8_MMA(0, 1, At, B1); PG8_BAR; PG8_SCHED;
            PG8_LDA(At, 0, 1); PG8_STAGE(PG8_SB(0, 0), b2, voffB); PG8_STAGE(PG8_SB(0, 1), b2 + hstep, voffB); PG8_STAGE(PG8_SA(0, 0), a2, voffA);
            PG8_WAIT_V(8); PG8_WAIT_L(0); PG8_BAR; PG8_MMA(1, 0, At, B0); PG8_MMA(1, 1, At, B1); PG8_BAR; PG8_SCHED;
            PG8_LDB(B0, 1, 0); PG8_LDB(B1, 1, 1); PG8_SCHED; PG8_LDA(At, 1, 0); PG8_STAGE(PG8_SA(0, 1), a2 + hstep, voffA);
            PG8_WAIT_V(8); PG8_WAIT_L(0); PG8_BAR; PG8_MMA(0, 0, At, B0); PG8_MMA(0, 1, At, B1); PG8_BAR; PG8_SCHED;
            PG8_LDA(At, 1, 1); PG8_STAGE(PG8_SB(1, 0), b3, voffB); PG8_STAGE(PG8_SB(1, 1), b3 + hstep, voffB); PG8_STAGE(PG8_SA(1, 0), a3, voffA);
            PG8_WAIT_V(8); PG8_WAIT_L(0); PG8_BAR; PG8_MMA(1, 0, At, B0); PG8_MMA(1, 1, At, B1); PG8_BAR; PG8_SCHED;
            } else {
            PG8_LDB(B0, 0, 0); PG8_SCHED; PG8_LDA(At, 0, 0); PG8_STAGE(PG8_SA(1, 1), a1 + hstep, voffA);
            PG8_WAIT_L(8); PG8_BAR; PG8_WAIT_L(0); PG8_MMA(0, 0, At, B0); PG8_BAR; PG8_SCHED;
            PG8_LDB(B1, 0, 1); PG8_STAGE(PG8_SB(0, 0), b2, voffB);
            PG8_BAR; PG8_WAIT_L(0); PG8_MMA(0, 1, At, B1); PG8_BAR;
            PG8_LDA(At, 0, 1); PG8_STAGE(PG8_SA(0, 0), a2, voffA);
            PG8_BAR; PG8_WAIT_L(0); PG8_MMA(1, 0, At, B0); PG8_BAR; PG8_SCHED;
            PG8_STAGE(PG8_SB(0, 1), b2 + hstep, voffB);
            PG8_WAIT_V(6); PG8_BAR; PG8_MMA(1, 1, At, B1); PG8_BAR;
            PG8_LDB(B0, 1, 0); PG8_SCHED; PG8_LDA(At, 1, 0); PG8_STAGE(PG8_SA(0, 1), a2 + hstep, voffA);
            PG8_WAIT_L(8); PG8_BAR; PG8_WAIT_L(0); PG8_MMA(0, 0, At, B0); PG8_BAR; PG8_SCHED;
            PG8_LDB(B1, 1, 1); PG8_STAGE(PG8_SB(1, 0), b3, voffB);
            PG8_BAR; PG8_WAIT_L(0); PG8_MMA(0, 1, At, B1); PG8_BAR;
            PG8_LDA(At, 1, 1); PG8_STAGE(PG8_SA(1, 0), a3, voffA);
            PG8_BAR; PG8_WAIT_L(0); PG8_MMA(1, 0, At, B0); PG8_BAR; PG8_SCHED;
            PG8_STAGE(PG8_SB(1, 1), b3 + hstep, voffB);
            PG8_WAIT_V(6); PG8_BAR; PG8_MMA(1, 1, At, B1); PG8_BAR;
            }
        }
        if constexpr (ALIGN_EPI) { if (wr == 0) PG8_BAR; }
        if constexpr (!Epi::AFTER_DRAIN) { E(acc, cur, wr, wc, fr, fq); S.done(cur); }
        if (!has_next) break;
#pragma unroll
        for (int a = 0; a < 2; ++a)
#pragma unroll
            for (int b = 0; b < 2; ++b)
#pragma unroll
                for (int m = 0; m < 4; ++m)
#pragma unroll
                    for (int n = 0; n < 2; ++n) acc[a][b][m][n] = (f32x4){0.f, 0.f, 0.f, 0.f};
        cur = nxt; cA = nA; cB = nB; ++ui;
        if constexpr (ALIGN_EPI) { if (wr == 1) PG8_BAR; }
    }
    PG8_WAIT_V(0);
    if constexpr (!ALIGN_EPI) { if (wr == 0) PG8_BAR; }
    PG8_BAR;
    if constexpr (Epi::AFTER_DRAIN) { E.fused(acc, cur, wr, wc, fr, fq, lds, wid, lane); S.done(cur); }
#undef PG8_SA
#undef PG8_SB
#undef PG8_STAGE
#undef PG8_LDA
#undef PG8_LDB
#undef PG8_MMA
#undef PG8_WAIT_V
#undef PG8_WAIT_L
#undef PG8_BAR
#undef PG8_SCHED
}
}

typedef unsigned short bf16_t;
#define LAS __attribute__((address_space(3)))
constexpr int DM = 2048, NB = 8, S = 2048, M = NB * S, DIN = 7192, DEPTH = 2, LDP = 7168;
constexpr int NWAVES = 8, NT = NWAVES * 64;
constexpr int C_AQ = 0, C_AKC = 512, C_AVC = 640, C_AKS = 768, C_AVS = 896, C_AKW = 1024, C_AVW = 1152, C_AGATE = 1280;
constexpr int C_BQ = 1792, C_BK = 2304, C_BV = 2432, C_BGATE = 2560;
constexpr int C_CB = 3072, C_CC = 3584, C_CH = 4096, C_CGATE = 4608;
constexpr int C_DQ = 5120, C_DK = 5632, C_DV = 6144, C_DGATE = 6656;
constexpr int SRC_GATES = 1280;
constexpr int NCMP = 127;

constexpr size_t MiB = 1u << 20;
constexpr size_t WS_BIASD = 1 * MiB;
constexpr size_t WS_G = 2 * MiB;
constexpr size_t WS_WG = 4 * MiB;
constexpr size_t WS_CMP = 5 * MiB;
constexpr size_t WS_WIN = 8 * MiB;
constexpr size_t WS_WOUT = 64 * MiB;
constexpr size_t WS_XB = 80 * MiB;
constexpr size_t WS_MIX = 144 * MiB;
constexpr size_t WS_P = 208 * MiB;
constexpr size_t WS_END = 432 * MiB;
constexpr int LDS_BYTES = 147456;

struct Params {
    const float* x; const float* norm_w; const float* w_in; const float* w_out; const float* conv_w; const float* sinks;
    const float* cmp_pos; const float* cmp_w1; const float* cmp_w2; const float* rel_bias; const float* final_norm_w;
    float* out; unsigned char* ws;
};

__device__ __forceinline__ float bf2f(bf16_t v) { return __uint_as_float(((unsigned)v) << 16); }
__device__ __forceinline__ unsigned f2bfu(float f) { unsigned u = __float_as_uint(f); return (u + 0x7fffu + ((u >> 16) & 1u)) >> 16; }
__device__ __forceinline__ bf16_t f2bf(float f) { return (bf16_t)f2bfu(f); }
__device__ __forceinline__ unsigned pk2(float lo, float hi) { return f2bfu(lo) | (f2bfu(hi) << 16); }
__device__ __forceinline__ float wave_sum(float v) {
#pragma unroll
    for (int o = 32; o > 0; o >>= 1) v += __shfl_xor(v, o);
    return v;
}
__device__ __forceinline__ float wave_max(float v) {
#pragma unroll
    for (int o = 32; o > 0; o >>= 1) v = fmaxf(v, __shfl_xor(v, o));
    return v;
}
__device__ __forceinline__ float silu(float v) { return v / (1.f + __expf(-v)); }
__device__ __forceinline__ float sigmoidf(float v) { return 1.f / (1.f + __expf(-v)); }
#define LDS_FENCE() asm volatile("s_waitcnt lgkmcnt(0)" ::: "memory")

__device__ __forceinline__ int t5_bucket(int d) {
    if (d < 16) return d < 0 ? 0 : d;
    int b = 16;
    b += (d >= 22); b += (d >= 30); b += (d >= 40); b += (d >= 54); b += (d >= 73); b += (d >= 99); b += (d >= 134); b += (d >= 182);
    b += (d >= 246); b += (d >= 332); b += (d >= 450); b += (d >= 609); b += (d >= 825); b += (d >= 1117); b += (d >= 1513);
    return b;
}

__device__ __forceinline__ void transpose_item(const float* W, int K, int srcld, int src_n0, const float* ksc, bf16_t* WT, LAS float* scr, int kb, int nb, int lane) {
    const int k0 = 64 * kb, n0 = 32 * nb;
#pragma unroll 8
    for (int i = 0; i < 32; ++i) { const int kk = 2 * i + (lane >> 5); const float sc = ksc ? ksc[k0 + kk] : 1.f; scr[kk * 33 + (lane & 31)] = W[(size_t)(k0 + kk) * srcld + src_n0 + n0 + (lane & 31)] * sc; }
    LDS_FENCE();
    const int c = lane & 7;
#pragma unroll
    for (int j = 0; j < 4; ++j) { const int n = (lane >> 3) + 8 * j; const LAS float* s = scr + (8 * c) * 33 + n;
        uint4 o; o.x = pk2(s[0 * 33], s[1 * 33]); o.y = pk2(s[2 * 33], s[3 * 33]); o.z = pk2(s[4 * 33], s[5 * 33]); o.w = pk2(s[6 * 33], s[7 * 33]);
        *(uint4*)(WT + (size_t)(n0 + n) * K + k0 + 8 * c) = o; }
    LDS_FENCE();
}
__device__ __forceinline__ void rms_row_to_bf16(const float* xrow, bf16_t* orow, int lane) {
    const float4* xr = (const float4*)xrow + lane;
    float4 v[8]; float s = 0.f;
#pragma unroll
    for (int j = 0; j < 8; ++j) { v[j] = xr[64 * j]; s += (v[j].x * v[j].x + v[j].y * v[j].y) + (v[j].z * v[j].z + v[j].w * v[j].w); }
    const float r = rsqrtf(wave_sum(s) * (1.f / DM) + 1e-6f);
    uint2* o8 = (uint2*)orow + lane;
#pragma unroll
    for (int j = 0; j < 8; ++j) o8[64 * j] = make_uint2(pk2(v[j].x * r, v[j].y * r), pk2(v[j].z * r, v[j].w * r));
}

__device__ __forceinline__ float ldval(const bf16_t* p) { return bf2f(*p); }
__device__ __forceinline__ float ldval(const float* p) { return *p; }
__device__ __forceinline__ void load8(const bf16_t* p, float (&k)[8]) {
    const uint4 w = *(const uint4*)p;
    k[0] = __uint_as_float(w.x << 16); k[1] = __uint_as_float(w.x & 0xffff0000u);
    k[2] = __uint_as_float(w.y << 16); k[3] = __uint_as_float(w.y & 0xffff0000u);
    k[4] = __uint_as_float(w.z << 16); k[5] = __uint_as_float(w.z & 0xffff0000u);
    k[6] = __uint_as_float(w.w << 16); k[7] = __uint_as_float(w.w & 0xffff0000u);
}
__device__ __forceinline__ void load8(const float* p, float (&k)[8]) {
    const float4 a = ((const float4*)p)[0], b = ((const float4*)p)[1];
    k[0] = a.x; k[1] = a.y; k[2] = a.z; k[3] = a.w; k[4] = b.x; k[5] = b.y; k[6] = b.z; k[7] = b.w;
}

template <int NH, typename KT>
__device__ __forceinline__ void score_chunk(const KT* kmat, size_t rstride, int krow, bool valid, int dist, const float* qs, const float* biasd, float (&s)[NH]) {
    float a[NH];
#pragma unroll
    for (int h = 0; h < NH; ++h) a[h] = 0.f;
    if (valid) {
        const KT* kr = kmat + (size_t)krow * rstride;
#pragma unroll 2
        for (int d8 = 0; d8 < 8; ++d8) {
            float k[8]; load8(kr + 8 * d8, k);
#pragma unroll
            for (int h = 0; h < NH; ++h) {
                const float4 q0 = ((const float4*)(qs + h * 64))[2 * d8], q1 = ((const float4*)(qs + h * 64))[2 * d8 + 1];
                a[h] += q0.x * k[0] + q0.y * k[1] + q0.z * k[2] + q0.w * k[3] + q1.x * k[4] + q1.y * k[5] + q1.z * k[6] + q1.w * k[7];
            }
        }
    }
#pragma unroll
    for (int h = 0; h < NH; ++h) s[h] = valid ? a[h] * 0.125f + biasd[h * 2048 + dist] : -INFINITY;
}
template <int NH, typename VT>
__device__ __forceinline__ void pv_chunk(const VT* vmat, size_t rstride, int rbase, int rstep, int j0, int j1, const float (&p)[NH], float (&o)[NH], int lane) {
    for (int jj = j0; jj < j1; ++jj) {
        const float vv = ldval(vmat + (size_t)(rbase + jj * rstep) * rstride + lane);
#pragma unroll
        for (int h = 0; h < NH; ++h) o[h] += __uint_as_float(__builtin_amdgcn_readlane(__float_as_uint(p[h]), jj)) * vv;
    }
}
template <int NH, typename KT>
__device__ __forceinline__ void attend_chunk(const KT* kmat, const KT* vmat, size_t rstride, int rbase, int rstep, int j0, int j1, int dbase, int dstep,
                                             const float* qs, const float* biasd, float (&m)[NH], float (&l)[NH], float (&o)[NH], int lane) {
    if (j1 <= j0) return;
    const bool valid = lane >= j0 && lane < j1;
    float s[NH], p[NH];
    score_chunk<NH, KT>(kmat, rstride, rbase + lane * rstep, valid, dbase + lane * dstep, qs, biasd, s);
#pragma unroll
    for (int h = 0; h < NH; ++h) {
        const float cm = wave_max(s[h]);
        const float mn = fmaxf(m[h], cm);
        const float sc = __expf(m[h] - mn);
        p[h] = valid ? __expf(s[h] - mn) : 0.f;
        l[h] = l[h] * sc + wave_sum(p[h]); o[h] *= sc; m[h] = mn;
    }
    pv_chunk<NH, KT>(vmat, rstride, rbase, rstep, j0, j1, p, o, lane);
}

#define LAUNDER_S(x)
#define PH_COMMON \
    int tid_ = threadIdx.x; asm volatile("" : "+v"(tid_)); const int tid = tid_, lane = tid & 63, wib = __builtin_amdgcn_readfirstlane(tid >> 6); \
    const int G = gridDim.x; const int gthreads = G * NT, gtid = blockIdx.x * NT + tid; const int gwaves = G * NWAVES, gwave = blockIdx.x * NWAVES + wib; \
    unsigned char* ws = prm.ws; (void)lane; (void)gthreads; (void)gtid; (void)gwaves; (void)gwave; (void)ws;

__device__ __forceinline__ void phase_prologue(const Params& prm, LAS unsigned char* ldsb) {
    PH_COMMON
    float* biasd = (float*)(ws + WS_BIASD); float* WG = (float*)(ws + WS_WG);
    bf16_t* WINT = (bf16_t*)(ws + WS_WIN); bf16_t* WOUTT = (bf16_t*)(ws + WS_WOUT); bf16_t* XB = (bf16_t*)(ws + WS_XB);
    for (int i = gtid; i < 24 * 2048; i += gthreads) { const int h = i >> 11, d = i & 2047; biasd[i] = prm.rel_bias[t5_bucket(d) * 24 + h]; }
    for (int i = gtid; i < DEPTH * 24 * 2048; i += gthreads) { const int k = i & 2047, j = (i >> 11) % 24, l = i / (24 * 2048); WG[i] = prm.w_in[(size_t)l * DM * DIN + (size_t)k * DIN + SRC_GATES + j] * prm.norm_w[l * DM + k]; }
    {
        LAS float* scr = (LAS float*)(ldsb + wib * 16384);
        constexpr int I_IN = 32 * (LDP / 32), I_OUT = 32 * (DM / 32);
        for (int it = gwave; it < DEPTH * (I_IN + I_OUT); it += gwaves) {
            const int l = it / (I_IN + I_OUT); int r = it % (I_IN + I_OUT);
            if (r < I_IN) { const int nb = r % (LDP / 32), kb = r / (LDP / 32);
                transpose_item(prm.w_in + (size_t)l * DM * DIN, DM, DIN, (32 * nb >= SRC_GATES) ? 24 : 0, prm.norm_w + l * DM, WINT + (size_t)l * LDP * DM, scr, kb, nb, lane); }
            else { r -= I_IN; const int nb = r % (DM / 32), kb = r / (DM / 32);
                transpose_item(prm.w_out + (size_t)l * DM * DM, DM, DM, 0, nullptr, WOUTT + (size_t)l * DM * DM, scr, kb, nb, lane); }
        }
    }
    for (int row = gwave; row < M; row += gwaves) rms_row_to_bf16(prm.x + (size_t)row * DM, XB + (size_t)row * DM, lane);
}

__device__ __forceinline__ void phase_inproj(const Params& prm, int layer, LAS unsigned char* ldsb) {
    LAUNDER_S(layer);
    unsigned char* ws = prm.ws;
    pg8::Gemm g{(const bf16_t*)(ws + WS_XB), (const bf16_t*)(ws + WS_WIN) + (size_t)layer * LDP * DM, M, LDP, DM}; pg8::StaticOrder So; So.init(M, LDP, (int)gridDim.x, (int)blockIdx.x);
    pg8::EpiBf16 E{(bf16_t*)(ws + WS_P), LDP};
    pg8::gemm_phase<pg8::EpiBf16, pg8::StaticOrder, true, true>(ldsb, g, So, E);
}
__device__ __forceinline__ void phase_outproj(const Params& prm, int layer, LAS unsigned char* ldsb) {
    LAUNDER_S(layer);
    unsigned char* ws = prm.ws;
    const float* xin = layer == 0 ? prm.x : prm.out;
    pg8::Gemm g{(const bf16_t*)(ws + WS_MIX), (const bf16_t*)(ws + WS_WOUT) + (size_t)layer * DM * DM, M, DM, DM}; pg8::StaticOrder So; So.init(M, DM, (int)gridDim.x, (int)blockIdx.x);
    pg8::EpiResid E{xin, prm.out, DM};
    pg8::gemm_phase<pg8::EpiResid, pg8::StaticOrder, true, true>(ldsb, g, So, E);
}
__device__ __forceinline__ void phase_gates(const Params& prm, int layer) {
    LAUNDER_S(layer);
    PH_COMMON
    const bf16_t* XB = (const bf16_t*)(ws + WS_XB); float* GT = (float*)(ws + WS_G);
    const float* wg = (const float*)(ws + WS_WG) + (size_t)layer * 24 * 2048;
    for (int row = gwave; row < M; row += gwaves) {
        float xv[32];
#pragma unroll
        for (int i = 0; i < 32; ++i) xv[i] = bf2f(XB[(size_t)row * DM + lane + 64 * i]);
#pragma unroll 1
        for (int j = 0; j < 24; ++j) {
            float a = 0.f;
#pragma unroll
            for (int i = 0; i < 32; ++i) a += xv[i] * wg[j * 2048 + lane + 64 * i];
            a = wave_sum(a);
            if (lane == 0) GT[(size_t)row * 24 + j] = a;
        }
    }
}
__device__ __forceinline__ void phase_compress(const Params& prm, int layer, float* lds) {
    LAUNDER_S(layer);
    PH_COMMON
    const bf16_t* P = (const bf16_t*)(ws + WS_P); float* cmpkv = (float*)(ws + WS_CMP);
    const float* cpos = prm.cmp_pos + layer * 2 * 32 * 64;
    const float* cw1 = prm.cmp_w1 + (size_t)layer * 2 * 2048 * 128;
    const float* cw2 = prm.cmp_w2 + (size_t)layer * 2 * 128 * 64;
    for (int item = blockIdx.x; item < 2 * NB * 2 * NCMP; item += G) {
        const int c = item % NCMP, g = (item / NCMP) & 1, b = (item / (NCMP * 2)) % NB, which = item / (NCMP * 2 * NB);
        const int j = tid & 127, part = tid >> 7;
        const bf16_t* src = P + (size_t)(b * S + 16 * c) * LDP + (which ? C_AVC : C_AKC) + g * 64;
        const float* pos = cpos + which * 32 * 64;
        const float* w1 = cw1 + (size_t)which * 2048 * 128;
        float a = 0.f;
        for (int l = part * 8; l < part * 8 + 8; ++l)
            for (int d = 0; d < 64; ++d) a += (bf2f(src[(size_t)l * LDP + d]) + pos[l * 64 + d]) * w1[(size_t)(l * 64 + d) * 128 + j];
        lds[part * 128 + j] = a;
        __syncthreads();
        if (tid < 128) lds[512 + tid] = silu((lds[tid] + lds[128 + tid]) + (lds[256 + tid] + lds[384 + tid]));
        __syncthreads();
        if (tid < 64) {
            const float* w2 = cw2 + which * 128 * 64;
            float o = 0.f;
            for (int jj = 0; jj < 128; ++jj) o += lds[512 + jj] * w2[jj * 64 + tid];
            cmpkv[(((size_t)which * NB + b) * 2 + g) * 128 * 64 + c * 64 + tid] = o;
        }
        __syncthreads();
    }
}
__device__ __forceinline__ void phase_mixers(const Params& prm, int layer, float* lds) {
    LAUNDER_S(layer);
    PH_COMMON
    const float* biasd = (const float*)(ws + WS_BIASD); const float* GT = (const float*)(ws + WS_G); const float* cmpkv = (const float*)(ws + WS_CMP);
    const bf16_t* P = (const bf16_t*)(ws + WS_P); bf16_t* MIX = (bf16_t*)(ws + WS_MIX);
    const float* convw = prm.conv_w + layer * 3 * 512;
    const float* sinks = prm.sinks + layer * 8;
        {
            float* qs = lds + wib * 512;
            float* pc = qs + 256;
            constexpr int NA = NB * 2 * S, NBi = NB * 2 * S, ND = NB * 8 * S;
            for (int item = gwave; item < NA + NBi + ND; item += gwaves) {
                if (item < NA) {
                    const int t = item % S, g = (item / S) & 1, b = item / (2 * S);
                    const size_t row = (size_t)b * S + t;
                    const bf16_t* Pb = P + (size_t)b * S * LDP;
#pragma unroll
                    for (int h = 0; h < 4; ++h) qs[h * 64 + lane] = bf2f(P[row * LDP + C_AQ + (g * 4 + h) * 64 + lane]);
                    LDS_FENCE();
                    const float* bd = biasd + (g * 4) * 2048;
                    const float* kc = cmpkv + (((size_t)0 * NB + b) * 2 + g) * 128 * 64;
                    const float* vc = cmpkv + (((size_t)1 * NB + b) * 2 + g) * 128 * 64;
                    const int ncv = t >= 31 ? (t - 31) / 16 + 1 : 0;
                    float ocmp[4] = {0.f, 0.f, 0.f, 0.f};
                    float psum0 = 0.f, psum1 = 0.f;
                    if (ncv > 0) {
                        float s0[4], s1[4], p0[4], p1[4];
                        const bool v0 = lane < ncv, v1 = lane + 64 < ncv;
                        score_chunk<4, float>(kc, 64, lane, v0, v0 ? t - 31 - 16 * lane : 0, qs, bd, s0);
                        score_chunk<4, float>(kc, 64, lane + 64, v1, v1 ? t - 31 - 16 * (lane + 64) : 0, qs, bd, s1);
#pragma unroll
                        for (int h = 0; h < 4; ++h) {
                            const float mx = wave_max(fmaxf(s0[h], s1[h]));
                            const float e0 = v0 ? __expf(s0[h] - mx) : 0.f, e1 = v1 ? __expf(s1[h] - mx) : 0.f;
                            const float inv = 1.f / fmaxf(wave_sum(e0 + e1), 1e-30f);
                            p0[h] = e0 * inv; p1[h] = e1 * inv; psum0 += p0[h]; psum1 += p1[h];
                        }
                        pv_chunk<4, float>(vc, 64, 0, 1, 0, ncv < 64 ? ncv : 64, p0, ocmp, lane);
                        if (ncv > 64) pv_chunk<4, float>(vc, 64, 64, 1, 0, ncv - 64, p1, ocmp, lane);
                    }
                    pc[lane] = psum0; pc[64 + lane] = psum1;
                    LDS_FENCE();
                    const int cur = t >> 6;
                    float imp = -INFINITY;
                    if (lane < 32) {
                        float a = 0.f;
#pragma unroll
                        for (int c = -1; c <= 3; ++c) { const int cc = 4 * lane + c; if (cc >= 0 && cc < NCMP) a += pc[cc]; }
                        const bool forced = lane == 0 || lane == cur || lane == cur - 1;
                        imp = lane > cur ? -1e30f : (forced ? 1e4f : a);
                    }
                    unsigned selmask = 0u;
#pragma unroll 1
                    for (int r = 0; r < 8; ++r) {
                        const float mx = wave_max(imp);
                        const unsigned long long bal = __ballot(imp == mx);
                        const int win = __ffsll((long long)bal) - 1;
                        selmask |= 1u << win;
                        if (lane == win) imp = -INFINITY;
                    }
                    LDS_FENCE();
                    float m[4], l[4], osel[4];
#pragma unroll
                    for (int h = 0; h < 4; ++h) { m[h] = -INFINITY; l[h] = 0.f; osel[h] = 0.f; }
                    for (int n = 0; n <= cur; ++n) {
                        if (!((selmask >> n) & 1u)) continue;
                        const int j1 = (t - 64 * n + 1) < 64 ? (t - 64 * n + 1) : 64;
                        attend_chunk<4, bf16_t>(Pb + C_AKS + g * 64, Pb + C_AVS + g * 64, LDP, 64 * n, 1, 0, j1, t - 64 * n, -1, qs, bd, m, l, osel, lane);
                    }
#pragma unroll
                    for (int h = 0; h < 4; ++h) osel[h] = osel[h] / fmaxf(l[h], 1e-30f);
                    float owin[4];
#pragma unroll
                    for (int h = 0; h < 4; ++h) { m[h] = -INFINITY; l[h] = 0.f; owin[h] = 0.f; }
                    {
                        const int lo = t - 511 > 0 ? t - 511 : 0;
                        for (int k0 = lo; k0 <= t; k0 += 64) {
                            const int j1 = (t - k0 + 1) < 64 ? (t - k0 + 1) : 64;
                            attend_chunk<4, bf16_t>(Pb + C_AKW + g * 64, Pb + C_AVW + g * 64, LDP, k0, 1, 0, j1, t - k0, -1, qs, bd, m, l, owin, lane);
                        }
                    }
#pragma unroll
                    for (int h = 0; h < 4; ++h) {
                        const int hh = g * 4 + h;
                        const float g0 = sigmoidf(GT[row * 24 + 0 * 8 + hh]), g1 = sigmoidf(GT[row * 24 + 1 * 8 + hh]), g2 = sigmoidf(GT[row * 24 + 2 * 8 + hh]);
                        const float oa = g0 * ocmp[h] + g1 * osel[h] + g2 * (owin[h] / l[h]);
                        const float gate = bf2f(P[row * LDP + C_AGATE + hh * 64 + lane]);
                        MIX[row * DM + hh * 64 + lane] = f2bf(oa * silu(gate));
                    }
                } else if (item < NA + NBi) {
                    const int it = item - NA;
                    const int t = it % S, g = (it / S) & 1, b = it / (2 * S);
                    const size_t row = (size_t)b * S + t;
                    const bf16_t* Pb = P + (size_t)b * S * LDP;
#pragma unroll
                    for (int h = 0; h < 4; ++h) qs[h * 64 + lane] = bf2f(P[row * LDP + C_BQ + (g * 4 + h) * 64 + lane]);
                    LDS_FENCE();
                    const float* bd = biasd + (8 + g * 4) * 2048;
                    float m[4], l[4], o[4];
#pragma unroll
                    for (int h = 0; h < 4; ++h) { m[h] = -INFINITY; l[h] = 0.f; o[h] = 0.f; }
                    const int lo = t - 127 > 0 ? t - 127 : 0;
                    for (int k0 = lo; k0 <= t; k0 += 64) {
                        const int j1 = (t - k0 + 1) < 64 ? (t - k0 + 1) : 64;
                        attend_chunk<4, bf16_t>(Pb + C_BK + g * 64, Pb + C_BV + g * 64, LDP, k0, 1, 0, j1, t - k0, -1, qs, bd, m, l, o, lane);
                    }
                    LDS_FENCE();
#pragma unroll
                    for (int h = 0; h < 4; ++h) {
                        const int hh = g * 4 + h;
                        const float den = l[h] + __expf(sinks[hh] - m[h]);
                        const float gate = bf2f(P[row * LDP + C_BGATE + hh * 64 + lane]);
                        MIX[row * DM + 512 + hh * 64 + lane] = f2bf(o[h] / den * silu(gate));
                    }
                } else {
                    const int it = item - NA - NBi;
                    const int t = it % S, hh = (it / S) & 7, b = it / (8 * S);
                    const size_t row = (size_t)b * S + t;
                    const bf16_t* Pb = P + (size_t)b * S * LDP;
                    qs[lane] = bf2f(P[row * LDP + C_DQ + hh * 64 + lane]);
                    LDS_FENCE();
                    const float* bd = biasd + (16 + hh) * 2048;
                    const bf16_t* kd = Pb + C_DK + hh * 64; const bf16_t* vd = Pb + C_DV + hh * 64;
                    float m[1] = {-INFINITY}, l[1] = {0.f}, o[1] = {0.f};
#pragma unroll 1
                    for (int pat = 0; pat < 3; ++pat) {
                        const int dil = pat == 0 ? 1 : (pat == 1 ? 4 : 16);
                        int nk = t / dil + 1;
                        if (nk > 129) nk = 129;
                        if (pat == 2 && nk > 128) nk = 128;
                        for (int m0 = 0; m0 < nk; m0 += 64) {
                            const int j1 = (nk - m0) < 64 ? (nk - m0) : 64;
                            attend_chunk<1, bf16_t>(kd, vd, LDP, t - dil * m0, -dil, 0, j1, dil * m0, dil, qs, bd, m, l, o, lane);
                        }
                    }
                    LDS_FENCE();
                    const float gate = bf2f(P[row * LDP + C_DGATE + hh * 64 + lane]);
                    MIX[row * DM + 1536 + hh * 64 + lane] = f2bf(o[0] / l[0] * silu(gate));
                }
            }
            for (int i = gtid; i < M * 512; i += gthreads) {
                const int c = i & 511, row = i >> 9, t = row & (S - 1);
                const bf16_t* pr = P + (size_t)row * LDP;
                float y = convw[2 * 512 + c] * bf2f(pr[C_CC + c]) * bf2f(pr[C_CH + c]);
                if (t >= 1) y += convw[1 * 512 + c] * bf2f(pr[C_CC + c - LDP]) * bf2f(pr[C_CH + c - LDP]);
                if (t >= 2) y += convw[0 * 512 + c] * bf2f(pr[C_CC + c - 2 * LDP]) * bf2f(pr[C_CH + c - 2 * LDP]);
                MIX[(size_t)row * DM + 1024 + c] = f2bf(bf2f(pr[C_CB + c]) * y * silu(bf2f(pr[C_CGATE + c])));
            }
        }

}
__device__ __forceinline__ void phase_xb(const Params& prm) {
    PH_COMMON
    bf16_t* XB = (bf16_t*)(ws + WS_XB);
    for (int row = gwave; row < M; row += gwaves) rms_row_to_bf16(prm.out + (size_t)row * DM, XB + (size_t)row * DM, lane);
}
__device__ __forceinline__ void phase_final(const Params& prm) {
    PH_COMMON
    for (int row = gwave; row < M; row += gwaves) {
        float4* xr = (float4*)(prm.out + (size_t)row * DM);
        float4 v[8]; float s = 0.f;
#pragma unroll
        for (int j = 0; j < 8; ++j) { v[j] = xr[lane + 64 * j]; s += v[j].x * v[j].x + v[j].y * v[j].y + v[j].z * v[j].z + v[j].w * v[j].w; }
        s = wave_sum(s);
        const float r = rsqrtf(s * (1.f / DM) + 1e-6f);
#pragma unroll
        for (int j = 0; j < 8; ++j) { const float4 w = ((const float4*)prm.final_norm_w)[lane + 64 * j];
            xr[lane + 64 * j] = make_float4(v[j].x * r * w.x, v[j].y * r * w.y, v[j].z * r * w.z, v[j].w * r * w.w); }
    }
}

__global__ void __launch_bounds__(NT, 2) fwd_kernel(Params prm) {
    cg::grid_group grid = cg::this_grid();
    extern __shared__ __attribute__((aligned(16))) unsigned char lds_raw[];
    LAS unsigned char* ldsb = (LAS unsigned char*)lds_raw;
    float* lds = (float*)lds_raw;
    phase_prologue(prm, ldsb);
    grid.sync();
#pragma unroll
    for (int layer = 0; layer < DEPTH; ++layer) {
        phase_inproj(prm, layer, ldsb);
        phase_gates(prm, layer);
        grid.sync();
        phase_compress(prm, layer, lds);
        grid.sync();
        phase_mixers(prm, layer, lds);
        grid.sync();
        phase_outproj(prm, layer, ldsb);
        grid.sync();
        if (layer + 1 < DEPTH) { phase_xb(prm); grid.sync(); }
    }
    phase_final(prm);
}

extern "C" void kernel_launch(void* const* d_in, const int* in_sizes, int n_in, void* d_out, int out_size, void* d_ws, size_t ws_size, hipStream_t stream) {
    static int grid_blocks = 0;
    if (!grid_blocks) {
        int dev = 0, cus = 0, per_cu = 0;
        (void)hipGetDevice(&dev);
        (void)hipDeviceGetAttribute(&cus, hipDeviceAttributeMultiprocessorCount, dev);
        if (hipFuncSetAttribute((const void*)fwd_kernel, hipFuncAttributeMaxDynamicSharedMemorySize, LDS_BYTES) != hipSuccess) fprintf(stderr, "kernel_launch: hipFuncSetAttribute failed\n");
        (void)hipOccupancyMaxActiveBlocksPerMultiprocessor(&per_cu, fwd_kernel, NT, LDS_BYTES);
        if (per_cu < 1) fprintf(stderr, "kernel_launch: occupancy query says %d blocks per CU\n", per_cu);
        grid_blocks = cus;
        if (ws_size < WS_END) fprintf(stderr, "kernel_launch: workspace too small: %zu < %zu\n", ws_size, (size_t)WS_END);
    }
    Params p{};
    p.x = (const float*)d_in[0]; p.norm_w = (const float*)d_in[1]; p.w_in = (const float*)d_in[2]; p.w_out = (const float*)d_in[3];
    p.conv_w = (const float*)d_in[4]; p.sinks = (const float*)d_in[5]; p.cmp_pos = (const float*)d_in[6]; p.cmp_w1 = (const float*)d_in[7];
    p.cmp_w2 = (const float*)d_in[8]; p.rel_bias = (const float*)d_in[9]; p.final_norm_w = (const float*)d_in[10];
    p.out = (float*)d_out; p.ws = (unsigned char*)d_ws;
    void* args[] = {&p};
    hipError_t e = hipLaunchCooperativeKernel((void*)fwd_kernel, dim3(grid_blocks), dim3(NT), args, LDS_BYTES, stream);
    if (e != hipSuccess) fprintf(stderr, "cooperative launch failed: %s (grid %d)\n", hipGetErrorString(e), grid_blocks);
}
```

```cpp
#include <hip/hip_runtime.h>
#include <hip/hip_cooperative_groups.h>
#include <cstdio>
#include <cstdint>
namespace cg = cooperative_groups;

namespace pg8 {
#define PG8_LAS __attribute__((address_space(3)))
typedef unsigned short bf16_t;
typedef short bf16x8 __attribute__((ext_vector_type(8)));
typedef float f32x4 __attribute__((ext_vector_type(4)));
typedef unsigned u32x4 __attribute__((ext_vector_type(4)));
constexpr int BM = 256, BK = 64, HALF = 128, HTB = HALF * BK * 2  , STAGE_BYTES = 8 * HTB, NXCD = 8, WGM = 8;

__host__ __device__ __forceinline__ int lds_byte(int r, int c) { const int st = (r >> 4) * 2 + (c >> 5), rr = r & 15, cc = c & 31, ob = rr * 64 + cc * 2; return st * 1024 + (ob ^ (((ob >> 9) & 1) << 5)); }
__host__ __device__ __forceinline__ void stage_rc(int b, int& R, int& C) { const int st = b / 1024, sb = b % 1024, swz = sb ^ (((sb >> 9) & 1) << 5); R = (st >> 1) * 16 + swz / 64; C = (st & 1) * 32 + (swz % 64) / 2; }
__host__ __device__ __forceinline__ int perm32(int rho) { const int n = rho >> 4, i = rho & 15; return 8 * (i >> 2) + 4 * n + (i & 3); }

struct Unit { int pm, pn; };
struct Gemm { const bf16_t* A; const bf16_t* Bt; int M, N, K; };

struct StaticOrder {
    int nM, nN, nwg, G, c;
    __host__ __device__ void init(int M, int N, int G_, int c_) { nM = M / BM; nN = N / BM; nwg = nM * nN; G = G_; c = c_; }
    __host__ __device__ bool next(int i, Unit& u) const {
        const long L = (long)i * G + c; if (L >= nwg) return false;
        int wgid = (int)L; { const int q = nwg / NXCD, r = nwg % NXCD, xcd = wgid % NXCD, off = wgid / NXCD; wgid = (xcd < r ? xcd * (q + 1) : r * (q + 1) + (xcd - r) * q) + off; }
        const int nig = WGM * nN, gid = wgid / nig, fm = gid * WGM, gsz = (nM - fm) < WGM ? (nM - fm) : WGM;
        u.pm = fm + ((wgid % nig) % gsz); u.pn = (wgid % nig) / gsz; return true;
    }
    __device__ __forceinline__ void a_ready(const Unit&) const {}
    __device__ __forceinline__ void done(const Unit&) const {}
};


__device__ __forceinline__ unsigned cvt_pk_bf16(float lo, float hi) { unsigned r; asm volatile("v_cvt_pk_bf16_f32 %0, %1, %2" : "=v"(r) : "v"(lo), "v"(hi)); return r; }
struct EpiBf16 {
    static constexpr bool PERM = true, AFTER_DRAIN = false;
    bf16_t* O; int ldc;
    __device__ __forceinline__ void operator()(const f32x4 (&acc)[2][2][4][2], const Unit& u, int wr, int wc, int fr, int fq) const {
        const int row0 = u.pm * BM + wr * 64 + fr; const int col0 = u.pn * BM + wc * 32 + 8 * fq;
#pragma unroll
        for (int ai = 0; ai < 2; ++ai)
#pragma unroll
            for (int m = 0; m < 4; ++m) { bf16_t* rowp = O + (size_t)(row0 + ai * HALF + m * 16) * ldc + col0;
#pragma unroll
                for (int bj = 0; bj < 2; ++bj) { const f32x4 v0 = acc[ai][bj][m][0], v1 = acc[ai][bj][m][1];
                    u32x4 w; w.x = cvt_pk_bf16(v0[0], v0[1]); w.y = cvt_pk_bf16(v0[2], v0[3]); w.z = cvt_pk_bf16(v1[0], v1[1]); w.w = cvt_pk_bf16(v1[2], v1[3]);
                    *(u32x4*)(rowp + bj * HALF) = w; } }
    }
};
struct EpiResid {
    static constexpr bool PERM = false, AFTER_DRAIN = false;
    const float* base; float* out; int ldc;
    __device__ __forceinline__ void operator()(const f32x4 (&acc)[2][2][4][2], const Unit& u, int wr, int wc, int fr, int fq) const {
        const int col0 = u.pn * BM + wc * 32 + 4 * fq;
#pragma unroll
        for (int ai = 0; ai < 2; ++ai)
#pragma unroll
            for (int m = 0; m < 4; ++m) { const size_t off = (size_t)(u.pm * BM + ai * HALF + wr * 64 + m * 16 + fr) * ldc + col0;
#pragma unroll
                for (int bj = 0; bj < 2; ++bj)
#pragma unroll
                    for (int n = 0; n < 2; ++n) { const f32x4 bs = *(const f32x4*)(base + off + bj * HALF + n * 16); *(f32x4*)(out + off + bj * HALF + n * 16) = bs + acc[ai][bj][m][n]; } }
    }
};

template <class Epi, class Sched, bool ALIGN_EPI = false, bool SP2 = false>
__device__ __forceinline__ void gemm_phase(PG8_LAS unsigned char* lds, const Gemm g, const Sched& S, const Epi& E) {
    const int tid = threadIdx.x, wid = __builtin_amdgcn_readfirstlane(tid >> 6), lane = tid & 63, wr = wid >> 2, wc = wid & 3, fr = lane & 15, fq = lane >> 4;
    const int K = g.K, nt = K / BK;
    unsigned voffA[2], voffB[2];
#pragma unroll
    for (int i = 0; i < 2; ++i) { int R, C; stage_rc(tid * 16 + i * 8192, R, C); const int Rb = Epi::PERM ? ((R & ~31) + perm32(R & 31)) : R;
        voffA[i] = (unsigned)(R * K + C) * 2u; voffB[i] = (unsigned)(Rb * K + C) * 2u; }
    const size_t kstep = (size_t)(BK * 2);
    const size_t hstep = (size_t)HALF * K * 2;
    const size_t tstep = 2 * hstep;
    const unsigned ldsw = (unsigned)wid * 1024u;
    const int aoff = lds_byte(wr * 64 + fr, fq * 8), boff = lds_byte(wc * 32 + fr, fq * 8);
#define PG8_SA(b, h) (((b) * 2 + (h)) * HTB)
#define PG8_SB(b, h) ((4 + (b) * 2 + (h)) * HTB)
#define PG8_STAGE(bufoff, gbase, voff) do { _Pragma("unroll") for (int _i = 0; _i < 2; ++_i) \
        __builtin_amdgcn_global_load_lds((const unsigned*)((const char*)(gbase) + (voff)[_i]), (PG8_LAS unsigned*)(lds + (bufoff) + ldsw + _i * 8192), 16, 0, 0); } while (0)
#define PG8_LDA(dst, b, h) do { _Pragma("unroll") for (int m = 0; m < 4; ++m) _Pragma("unroll") for (int k = 0; k < 2; ++k) dst[m][k] = *(const PG8_LAS bf16x8*)(lds + PG8_SA(b, h) + aoff + m * 2048 + k * 1024); } while (0)
#define PG8_LDB(dst, b, h) do { _Pragma("unroll") for (int n = 0; n < 2; ++n) _Pragma("unroll") for (int k = 0; k < 2; ++k) dst[n][k] = *(const PG8_LAS bf16x8*)(lds + PG8_SB(b, h) + boff + n * 2048 + k * 1024); } while (0)
#define PG8_MMA(ai, bj, At, Bt) do { __builtin_amdgcn_s_setprio(1); _Pragma("unroll") for (int m = 0; m < 4; ++m) _Pragma("unroll") for (int n = 0; n < 2; ++n) _Pragma("unroll") for (int k = 0; k < 2; ++k) \
        acc[ai][bj][m][n] = __builtin_amdgcn_mfma_f32_16x16x32_bf16(Bt[n][k], At[m][k], acc[ai][bj][m][n], 0, 0, 0); __builtin_amdgcn_s_setprio(0); } while (0)
#define PG8_WAIT_V(n) asm volatile("s_waitcnt vmcnt(" #n ")" ::: "memory")
#define PG8_WAIT_L(n) asm volatile("s_waitcnt lgkmcnt(" #n ")" ::: "memory")
#define PG8_BAR __builtin_amdgcn_s_barrier()
#define PG8_SCHED __builtin_amdgcn_sched_barrier(0)
    Unit cur, nxt; int ui = 0;
    if (!S.next(0, cur)) return;
    f32x4 acc[2][2][4][2];
#pragma unroll
    for (int a = 0; a < 2; ++a)
#pragma unroll
        for (int b = 0; b < 2; ++b)
#pragma unroll
            for (int m = 0; m < 4; ++m)
#pragma unroll
                for (int n = 0; n < 2; ++n) acc[a][b][m][n] = (f32x4){0.f, 0.f, 0.f, 0.f};
    bf16x8 At[4][2], B0[2][2], B1[2][2];
    const char* cA = (const char*)g.A + (size_t)cur.pm * tstep; const char* cB = (const char*)g.Bt + (size_t)cur.pn * tstep;
    S.a_ready(cur);
    if constexpr (SP2) {
        PG8_STAGE(PG8_SB(0, 0), cB, voffB); PG8_STAGE(PG8_SB(0, 1), cB + hstep, voffB); PG8_STAGE(PG8_SA(0, 0), cA, voffA); PG8_STAGE(PG8_SA(0, 1), cA + hstep, voffA);
        if (wr == 1) PG8_BAR;
        PG8_WAIT_V(2); PG8_BAR;
        PG8_STAGE(PG8_SB(1, 0), cB + kstep, voffB); PG8_STAGE(PG8_SA(1, 0), cA + kstep, voffA); PG8_STAGE(PG8_SB(1, 1), cB + hstep + kstep, voffB);
        PG8_WAIT_V(6); PG8_BAR;
    } else {
        PG8_STAGE(PG8_SB(0, 0), cB, voffB); PG8_STAGE(PG8_SA(0, 0), cA, voffA); PG8_STAGE(PG8_SB(0, 1), cB + hstep, voffB); PG8_STAGE(PG8_SA(0, 1), cA + hstep, voffA);
        if (wr == 1) PG8_BAR;
        PG8_WAIT_V(4); PG8_BAR;
        PG8_STAGE(PG8_SB(1, 0), cB + kstep, voffB); PG8_STAGE(PG8_SA(1, 0), cA + kstep, voffA); PG8_STAGE(PG8_SB(1, 1), cB + hstep + kstep, voffB);
        PG8_WAIT_V(6); PG8_BAR;
    }
    for (;;) {
        const bool has_next = S.next(ui + 1, nxt);
        const char* nA = has_next ? (const char*)g.A + (size_t)nxt.pm * tstep : cA; const char* nB = has_next ? (const char*)g.Bt + (size_t)nxt.pn * tstep : cB;
        for (int t = 0; t < nt; t += 2) {
            const bool last = (t == nt - 2);
            const char* a1 = cA + (size_t)(t + 1) * kstep;
            const char* a2 = last ? nA : cA + (size_t)(t + 2) * kstep; const char* b2 = last ? nB : cB + (size_t)(t + 2) * kstep;
            const char* a3 = a2 + kstep; const char* b3 = b2 + kstep;
            if (last && has_next) S.a_ready(nxt);
            if constexpr (SP2) {
            PG8_LDB(B0, 0, 0); PG8_LDB(B1, 0, 1); PG8_SCHED; PG8_LDA(At, 0, 0); PG8_STAGE(PG8_SA(1, 1), a1 + hstep, voffA);
            PG8_WAIT_V(8); PG8_WAIT_L(0); PG8_BAR; PG8_MMA(0, 0, At, B0); PG8_MMA(0, 1, At, B1); PG8_BAR; PG8_SCHED;
            PG8_LDA(At, 0, 1); PG8_STAGE(PG8_SB(0, 0), b2, voffB); PG8_STAGE(PG8_SB(0, 1), b2 + hstep, voffB); PG8_STAGE(PG8_SA(0, 0), a2, voffA);
            PG8_WAIT_V(8); PG8_WAIT_L(0); PG8_BAR; PG8_MMA(1, 0, At, B0); PG8_MMA(1, 1, At, B1); PG8_BAR; PG8_SCHED;
            PG8_LDB(B0, 1, 0); PG8_LDB(B1, 1, 1); PG8_SCHED; PG8_LDA(At, 1, 0); PG8_STAGE(PG8_SA(0, 1), a2 + hstep, voffA);
            PG8_WAIT_V(8); PG8_WAIT_L(0); PG8_BAR; PG8_MMA(0, 0, At, B0); PG8_MMA(0, 1, At, B1); PG8_BAR; PG8_SCHED;
            PG8_LDA(At, 1, 1); PG8_STAGE(PG8_SB(1, 0), b3, voffB); PG8_STAGE(PG8_SB(1, 1), b3 + hstep, voffB); PG8_STAGE(PG8_SA(1, 0), a3, voffA);
            PG8_WAIT_V(8); PG8_WAIT_L(0); PG8_BAR; PG8_MMA(1, 0, At, B0); PG8_MMA(1, 1, At, B1); PG8_BAR; PG8_SCHED;
            } else {
            PG8_LDB(B0, 0, 0); PG8_SCHED; PG8_LDA(At, 0, 0); PG8_STAGE(PG8_SA(1, 1), a1 + hstep, voffA);
            PG8_WAIT_L(8); PG8_BAR; PG8_WAIT_L(0); PG8_MMA(0, 0, At, B0); PG8_BAR; PG8_SCHED;
            PG8_LDB(B1, 0, 1); PG8_STAGE(PG8_SB(0, 0), b2, voffB);
            PG8_BAR; PG8_WAIT_L(0); PG8_MMA(0, 1, At, B1); PG8_BAR;
            PG8_LDA(At, 0, 1); PG8_STAGE(PG8_SA(0, 0), a2, voffA);
            PG8_BAR; PG8_WAIT_L(0); PG8_MMA(1, 0, At, B0); PG8_BAR; PG8_SCHED;
            PG8_STAGE(PG8_SB(0, 1), b2 + hstep, voffB);
            PG8_WAIT_V(6); PG8_BAR; PG8_MMA(1, 1, At, B1); PG8_BAR;
            PG8_LDB(B0, 1, 0); PG8_SCHED; PG8_LDA(At, 1, 0); PG8_STAGE(PG8_SA(0, 1), a2 + hstep, voffA);
            PG8_WAIT_L(8); PG8_BAR; PG8_WAIT_L(0); PG8_MMA(0, 0, At, B0); PG8_BAR; PG8_SCHED;
            PG8_LDB(B1, 1, 1); PG8_STAGE(PG8_SB(1, 0), b3, voffB);
            PG8_BAR; PG8_WAIT_L(0); PG8_MMA(0, 1, At, B1); PG8_BAR;
            PG8_LDA(At, 1, 1); PG8_STAGE(PG8_SA(1, 0), a3, voffA);
            PG8_BAR; PG8_WAIT_L(0); PG8_MMA(1, 0, At, B0); PG8_BAR; PG8_SCHED;
            PG8_STAGE(PG8_SB(1, 1), b3 + hstep, voffB);
            PG8_WAIT_V(6); PG8_BAR; PG8_MMA(1, 1, At, B1); PG8_BAR;
            }
        }
        if constexpr (ALIGN_EPI) { if (wr == 0) PG8_BAR; }
        if constexpr (!Epi::AFTER_DRAIN) { E(acc, cur, wr, wc, fr, fq); S.done(cur); }
        if (!has_next) break;
#pragma unroll
        for (int a = 0; a < 2; ++a)
#pragma unroll
            for (int b = 0; b < 2; ++b)
#pragma unroll
                for (int m = 0; m < 4; ++m)
#pragma unroll
                    for (int n = 0; n < 2; ++n) acc[a][b][m][n] = (f32x4){0.f, 0.f, 0.f, 0.f};
        cur = nxt; cA = nA; cB = nB; ++ui;
        if constexpr (ALIGN_EPI) { if (wr == 1) PG8_BAR; }
    }
    PG8_WAIT_V(0);
    if constexpr (!ALIGN_EPI) { if (wr == 0) PG8_BAR; }
    PG8_BAR;
    if constexpr (Epi::AFTER_DRAIN) { E.fused(acc, cur, wr, wc, fr, fq, lds, wid, lane); S.done(cur); }
#undef PG8_SA
#undef PG8_SB
#undef PG8_STAGE
#undef PG8_LDA
#undef PG8_LDB
#undef PG8_MMA
#undef PG8_WAIT_V
#undef PG8_WAIT_L
#undef PG8_BAR
#undef PG8_SCHED
}
}

typedef unsigned short bf16_t;
#define LAS __attribute__((address_space(3)))
constexpr int DM = 2048, NB = 8, S = 2048, M = NB * S, DIN = 7192, DEPTH = 2, LDP = 6144, NVT = 1024, NW_IN = LDP + NVT;
constexpr int NWAVES = 8, NT = NWAVES * 64;
constexpr int C_AQ = 0, C_AKC = 512, C_AKS = 640, C_AKW = 768, C_AGATE = 896;
constexpr int C_BQ = 1408, C_BK = 1920, C_BGATE = 2048;
constexpr int C_CB = 2560, C_CC = 3072, C_CH = 3584, C_CGATE = 4096;
constexpr int C_DQ = 4608, C_DK = 5120, C_DGATE = 5632;
constexpr int VR_AVC = 0, VR_AVS = 128, VR_AVW = 256, VR_BV = 384, VR_DV = 512;
__host__ __device__ __forceinline__ int src_col_of(int n) {
    if (n < 640) return n;
    if (n < 768) return n - 640 + 768;
    if (n < 896) return n - 768 + 1024;
    if (n < 1408) return n - 896 + 1304;
    if (n < 1920) return n - 1408 + 1816;
    if (n < 2048) return n - 1920 + 2328;
    if (n < 2560) return n - 2048 + 2584;
    if (n < 4608) return n - 2560 + 3096;
    if (n < 5120) return n - 4608 + 5144;
    if (n < 5632) return n - 5120 + 5656;
    if (n < 6144) return n - 5632 + 6680;
    if (n < 6272) return n - 6144 + 640;
    if (n < 6400) return n - 6272 + 896;
    if (n < 6528) return n - 6400 + 1152;
    if (n < 6656) return n - 6528 + 2456;
    return n - 6656 + 6168;
}
constexpr int SRC_GATES = 1280;
constexpr int NCMP = 127;

constexpr size_t MiB = 1u << 20;
constexpr size_t WS_BIASD = 1 * MiB;
constexpr size_t WS_G = 2 * MiB;
constexpr size_t WS_WG = 4 * MiB;
constexpr size_t WS_CMP = 5 * MiB;
constexpr size_t WS_WIN = 8 * MiB;
constexpr size_t WS_WOUT = 64 * MiB;
constexpr size_t WS_XB = 80 * MiB;
constexpr size_t WS_MIX = 144 * MiB;
constexpr size_t WS_P = 208 * MiB;
constexpr size_t WS_VT = 400 * MiB;
constexpr size_t WS_END = 432 * MiB;
constexpr int LDS_BYTES = 147456;

struct Params {
    const float* x; const float* norm_w; const float* w_in; const float* w_out; const float* conv_w; const float* sinks;
    const float* cmp_pos; const float* cmp_w1; const float* cmp_w2; const float* rel_bias; const float* final_norm_w;
    float* out; unsigned char* ws;
};

__device__ __forceinline__ float bf2f(bf16_t v) { return __uint_as_float(((unsigned)v) << 16); }
__device__ __forceinline__ unsigned f2bfu(float f) { unsigned u = __float_as_uint(f); return (u + 0x7fffu + ((u >> 16) & 1u)) >> 16; }
__device__ __forceinline__ bf16_t f2bf(float f) { return (bf16_t)f2bfu(f); }
__device__ __forceinline__ unsigned pk2(float lo, float hi) { return f2bfu(lo) | (f2bfu(hi) << 16); }
__device__ __forceinline__ float wave_sum(float v) {
#pragma unroll
    for (int o = 32; o > 0; o >>= 1) v += __shfl_xor(v, o);
    return v;
}
__device__ __forceinline__ float wave_max(float v) {
#pragma unroll
    for (int o = 32; o > 0; o >>= 1) v = fmaxf(v, __shfl_xor(v, o));
    return v;
}
__device__ __forceinline__ float silu(float v) { return v / (1.f + __expf(-v)); }
__device__ __forceinline__ float sigmoidf(float v) { return 1.f / (1.f + __expf(-v)); }
#define LDS_FENCE() asm volatile("s_waitcnt lgkmcnt(0)" ::: "memory")

__device__ __forceinline__ int t5_bucket(int d) {
    if (d < 16) return d < 0 ? 0 : d;
    int b = 16;
    b += (d >= 22); b += (d >= 30); b += (d >= 40); b += (d >= 54); b += (d >= 73); b += (d >= 99); b += (d >= 134); b += (d >= 182);
    b += (d >= 246); b += (d >= 332); b += (d >= 450); b += (d >= 609); b += (d >= 825); b += (d >= 1117); b += (d >= 1513);
    return b;
}

__device__ __forceinline__ void transpose_item(const float* W, int K, int srcld, int src_n0, const float* ksc, bf16_t* WT, LAS float* scr, int kb, int nb, int lane) {
    const int k0 = 64 * kb, n0 = 32 * nb;
#pragma unroll 8
    for (int i = 0; i < 32; ++i) { const int kk = 2 * i + (lane >> 5); const float sc = ksc ? ksc[k0 + kk] : 1.f; scr[kk * 33 + (lane & 31)] = W[(size_t)(k0 + kk) * srcld + src_n0 + n0 + (lane & 31)] * sc; }
    LDS_FENCE();
    const int c = lane & 7;
#pragma unroll
    for (int j = 0; j < 4; ++j) { const int n = (lane >> 3) + 8 * j; const LAS float* s = scr + (8 * c) * 33 + n;
        uint4 o; o.x = pk2(s[0 * 33], s[1 * 33]); o.y = pk2(s[2 * 33], s[3 * 33]); o.z = pk2(s[4 * 33], s[5 * 33]); o.w = pk2(s[6 * 33], s[7 * 33]);
        *(uint4*)(WT + (size_t)(n0 + n) * K + k0 + 8 * c) = o; }
    LDS_FENCE();
}
__device__ __forceinline__ void rms_row_to_bf16(const float* xrow, bf16_t* orow, int lane) {
    const float4* xr = (const float4*)xrow + lane;
    float4 v[8]; float s = 0.f;
#pragma unroll
    for (int j = 0; j < 8; ++j) { v[j] = xr[64 * j]; s += (v[j].x * v[j].x + v[j].y * v[j].y) + (v[j].z * v[j].z + v[j].w * v[j].w); }
    const float r = rsqrtf(wave_sum(s) * (1.f / DM) + 1e-6f);
    uint2* o8 = (uint2*)orow + lane;
#pragma unroll
    for (int j = 0; j < 8; ++j) o8[64 * j] = make_uint2(pk2(v[j].x * r, v[j].y * r), pk2(v[j].z * r, v[j].w * r));
}

__device__ __forceinline__ float ldval(const bf16_t* p) { return bf2f(*p); }
__device__ __forceinline__ float ldval(const float* p) { return *p; }
__device__ __forceinline__ void load8(const bf16_t* p, float (&k)[8]) {
    const uint4 w = *(const uint4*)p;
    k[0] = __uint_as_float(w.x << 16); k[1] = __uint_as_float(w.x & 0xffff0000u);
    k[2] = __uint_as_float(w.y << 16); k[3] = __uint_as_float(w.y & 0xffff0000u);
    k[4] = __uint_as_float(w.z << 16); k[5] = __uint_as_float(w.z & 0xffff0000u);
    k[6] = __uint_as_float(w.w << 16); k[7] = __uint_as_float(w.w & 0xffff0000u);
}
__device__ __forceinline__ void load8(const float* p, float (&k)[8]) {
    const float4 a = ((const float4*)p)[0], b = ((const float4*)p)[1];
    k[0] = a.x; k[1] = a.y; k[2] = a.z; k[3] = a.w; k[4] = b.x; k[5] = b.y; k[6] = b.z; k[7] = b.w;
}

template <int NH, typename KT>
__device__ __forceinline__ void score_chunk(const KT* kmat, size_t rstride, int krow, bool valid, int dist, const float* qs, const float* biasd, float (&s)[NH]) {
    float a[NH];
#pragma unroll
    for (int h = 0; h < NH; ++h) a[h] = 0.f;
    if (valid) {
        const KT* kr = kmat + (size_t)krow * rstride;
#pragma unroll 2
        for (int d8 = 0; d8 < 8; ++d8) {
            float k[8]; load8(kr + 8 * d8, k);
#pragma unroll
            for (int h = 0; h < NH; ++h) {
                const float4 q0 = ((const float4*)(qs + h * 64))[2 * d8], q1 = ((const float4*)(qs + h * 64))[2 * d8 + 1];
                a[h] += q0.x * k[0] + q0.y * k[1] + q0.z * k[2] + q0.w * k[3] + q1.x * k[4] + q1.y * k[5] + q1.z * k[6] + q1.w * k[7];
            }
        }
    }
#pragma unroll
    for (int h = 0; h < NH; ++h) s[h] = valid ? a[h] * 0.125f + biasd[h * 2048 + dist] : -INFINITY;
}
template <int NH, typename VT>
__device__ __forceinline__ void pv_chunk(const VT* vmat, size_t rstride, size_t dstride, int rbase, int rstep, int j0, int j1, const float (&p)[NH], float (&o)[NH], int lane) {
    for (int jj = j0; jj < j1; ++jj) {
        const float vv = ldval(vmat + (size_t)(rbase + jj * rstep) * rstride + (size_t)lane * dstride);
#pragma unroll
        for (int h = 0; h < NH; ++h) o[h] += __uint_as_float(__builtin_amdgcn_readlane(__float_as_uint(p[h]), jj)) * vv;
    }
}
template <int NH, typename KT>
__device__ __forceinline__ void attend_chunk(const KT* kmat, const KT* vmat  , size_t rstride, int rbase, int rstep, int j0, int j1, int dbase, int dstep,
                                             const float* qs, const float* biasd, float (&m)[NH], float (&l)[NH], float (&o)[NH], int lane) {
    if (j1 <= j0) return;
    const bool valid = lane >= j0 && lane < j1;
    float s[NH], p[NH];
    score_chunk<NH, KT>(kmat, rstride, rbase + lane * rstep, valid, dbase + lane * dstep, qs, biasd, s);
#pragma unroll
    for (int h = 0; h < NH; ++h) {
        const float cm = wave_max(s[h]);
        const float mn = fmaxf(m[h], cm);
        const float sc = __expf(m[h] - mn);
        p[h] = valid ? __expf(s[h] - mn) : 0.f;
        l[h] = l[h] * sc + wave_sum(p[h]); o[h] *= sc; m[h] = mn;
    }
    pv_chunk<NH, KT>(vmat, 1, (size_t)M, rbase, rstep, j0, j1, p, o, lane);
}

#define LAUNDER_S(x)
#define PH_COMMON \
    int tid_ = threadIdx.x; asm volatile("" : "+v"(tid_)); const int tid = tid_, lane = tid & 63, wib = __builtin_amdgcn_readfirstlane(tid >> 6); \
    const int G = gridDim.x; const int gthreads = G * NT, gtid = blockIdx.x * NT + tid; const int gwaves = G * NWAVES, gwave = blockIdx.x * NWAVES + wib; \
    unsigned char* ws = prm.ws; (void)lane; (void)gthreads; (void)gtid; (void)gwaves; (void)gwave; (void)ws;

__device__ __forceinline__ void phase_prologue(const Params& prm, LAS unsigned char* ldsb) {
    PH_COMMON
    float* biasd = (float*)(ws + WS_BIASD); float* WG = (float*)(ws + WS_WG);
    bf16_t* WINT = (bf16_t*)(ws + WS_WIN); bf16_t* WOUTT = (bf16_t*)(ws + WS_WOUT); bf16_t* XB = (bf16_t*)(ws + WS_XB);
    for (int i = gtid; i < 24 * 2048; i += gthreads) { const int h = i >> 11, d = i & 2047; biasd[i] = prm.rel_bias[t5_bucket(d) * 24 + h]; }
    for (int i = gtid; i < DEPTH * 24 * 2048; i += gthreads) { const int k = i & 2047, j = (i >> 11) % 24, l = i / (24 * 2048); WG[i] = prm.w_in[(size_t)l * DM * DIN + (size_t)k * DIN + SRC_GATES + j] * prm.norm_w[l * DM + k]; }
    {
        LAS float* scr = (LAS float*)(ldsb + wib * 16384);
        constexpr int I_IN = 32 * (NW_IN / 32), I_OUT = 32 * (DM / 32);
        for (int it = gwave; it < DEPTH * (I_IN + I_OUT); it += gwaves) {
            const int l = it / (I_IN + I_OUT); int r = it % (I_IN + I_OUT);
            if (r < I_IN) { const int nb = r % (NW_IN / 32), kb = r / (NW_IN / 32);
                transpose_item(prm.w_in + (size_t)l * DM * DIN, DM, DIN, src_col_of(32 * nb) - 32 * nb, prm.norm_w + l * DM, WINT + (size_t)l * NW_IN * DM, scr, kb, nb, lane); }
            else { r -= I_IN; const int nb = r % (DM / 32), kb = r / (DM / 32);
                transpose_item(prm.w_out + (size_t)l * DM * DM, DM, DM, 0, nullptr, WOUTT + (size_t)l * DM * DM, scr, kb, nb, lane); }
        }
    }
    for (int row = gwave; row < M; row += gwaves) rms_row_to_bf16(prm.x + (size_t)row * DM, XB + (size_t)row * DM, lane);
}

__device__ __forceinline__ void phase_inproj(const Params& prm, int layer, LAS unsigned char* ldsb) {
    LAUNDER_S(layer);
    unsigned char* ws = prm.ws;
    const bf16_t* W = (const bf16_t*)(ws + WS_WIN) + (size_t)layer * NW_IN * DM;
    {
        pg8::Gemm g{(const bf16_t*)(ws + WS_XB), W, M, LDP, DM}; pg8::StaticOrder So; So.init(M, LDP, (int)gridDim.x, (int)blockIdx.x);
        pg8::EpiBf16 E{(bf16_t*)(ws + WS_P), LDP};
        pg8::gemm_phase<pg8::EpiBf16, pg8::StaticOrder, true, true>(ldsb, g, So, E);
    }
    {
        pg8::Gemm g{W + (size_t)LDP * DM, (const bf16_t*)(ws + WS_XB), NVT, M, DM}; pg8::StaticOrder So; So.init(NVT, M, (int)gridDim.x, (int)blockIdx.x);
        pg8::EpiBf16 E{(bf16_t*)(ws + WS_VT), M};
        pg8::gemm_phase<pg8::EpiBf16, pg8::StaticOrder, true, true>(ldsb, g, So, E);
    }
}
__device__ __forceinline__ void phase_outproj(const Params& prm, int layer, LAS unsigned char* ldsb) {
    LAUNDER_S(layer);
    unsigned char* ws = prm.ws;
    const float* xin = layer == 0 ? prm.x : prm.out;
    pg8::Gemm g{(const bf16_t*)(ws + WS_MIX), (const bf16_t*)(ws + WS_WOUT) + (size_t)layer * DM * DM, M, DM, DM}; pg8::StaticOrder So; So.init(M, DM, (int)gridDim.x, (int)blockIdx.x);
    pg8::EpiResid E{xin, prm.out, DM};
    pg8::gemm_phase<pg8::EpiResid, pg8::StaticOrder, true, true>(ldsb, g, So, E);
}
__device__ __forceinline__ void phase_gates(const Params& prm, int layer) {
    LAUNDER_S(layer);
    PH_COMMON
    const bf16_t* XB = (const bf16_t*)(ws + WS_XB); float* GT = (float*)(ws + WS_G);
    const float* wg = (const float*)(ws + WS_WG) + (size_t)layer * 24 * 2048;
    for (int row = gwave; row < M; row += gwaves) {
        float xv[32];
#pragma unroll
        for (int i = 0; i < 32; ++i) xv[i] = bf2f(XB[(size_t)row * DM + lane + 64 * i]);
#pragma unroll 1
        for (int j = 0; j < 24; ++j) {
            float a = 0.f;
#pragma unroll
            for (int i = 0; i < 32; ++i) a += xv[i] * wg[j * 2048 + lane + 64 * i];
            a = wave_sum(a);
            if (lane == 0) GT[(size_t)row * 24 + j] = a;
        }
    }
}
__device__ __forceinline__ void phase_compress(const Params& prm, int layer, float* lds) {
    LAUNDER_S(layer);
    PH_COMMON
    const bf16_t* P = (const bf16_t*)(ws + WS_P); float* cmpkv = (float*)(ws + WS_CMP);
    const float* cpos = prm.cmp_pos + layer * 2 * 32 * 64;
    const float* cw1 = prm.cmp_w1 + (size_t)layer * 2 * 2048 * 128;
    const float* cw2 = prm.cmp_w2 + (size_t)layer * 2 * 128 * 64;
    for (int item = blockIdx.x; item < 2 * NB * 2 * NCMP; item += G) {
        const int c = item % NCMP, g = (item / NCMP) & 1, b = (item / (NCMP * 2)) % NB, which = item / (NCMP * 2 * NB);
        const int j = tid & 127, part = tid >> 7;
        const bf16_t* VT = (const bf16_t*)(ws + WS_VT);
        const bf16_t* src = which ? VT + (size_t)(VR_AVC + g * 64) * M + (size_t)(b * S + 16 * c) : P + (size_t)(b * S + 16 * c) * LDP + C_AKC + g * 64;
        const size_t sl = which ? 1 : LDP, sd = which ? M : 1;
        const float* pos = cpos + which * 32 * 64;
        const float* w1 = cw1 + (size_t)which * 2048 * 128;
        float a = 0.f;
        for (int l = part * 8; l < part * 8 + 8; ++l)
            for (int d = 0; d < 64; ++d) a += (bf2f(src[(size_t)l * sl + (size_t)d * sd]) + pos[l * 64 + d]) * w1[(size_t)(l * 64 + d) * 128 + j];
        lds[part * 128 + j] = a;
        __syncthreads();
        if (tid < 128) lds[512 + tid] = silu((lds[tid] + lds[128 + tid]) + (lds[256 + tid] + lds[384 + tid]));
        __syncthreads();
        if (tid < 64) {
            const float* w2 = cw2 + which * 128 * 64;
            float o = 0.f;
            for (int jj = 0; jj < 128; ++jj) o += lds[512 + jj] * w2[jj * 64 + tid];
            cmpkv[(((size_t)which * NB + b) * 2 + g) * 128 * 64 + c * 64 + tid] = o;
        }
        __syncthreads();
    }
}
__device__ __forceinline__ void phase_mixers(const Params& prm, int layer, float* lds) {
    LAUNDER_S(layer);
    PH_COMMON
    const float* biasd = (const float*)(ws + WS_BIASD); const float* GT = (const float*)(ws + WS_G); const float* cmpkv = (const float*)(ws + WS_CMP);
    const bf16_t* P = (const bf16_t*)(ws + WS_P); bf16_t* MIX = (bf16_t*)(ws + WS_MIX); const bf16_t* VT = (const bf16_t*)(ws + WS_VT);
    const float* convw = prm.conv_w + layer * 3 * 512;
    const float* sinks = prm.sinks + layer * 8;
        {
            float* qs = lds + wib * 512;
            float* pc = qs + 256;
            constexpr int NA = NB * 2 * S, NBi = NB * 2 * S, ND = NB * 8 * S;
            for (int item = gwave; item < NA + NBi + ND; item += gwaves) {
                if (item < NA) {
                    const int t = item % S, g = (item / S) & 1, b = item / (2 * S);
                    const size_t row = (size_t)b * S + t;
                    const bf16_t* Pb = P + (size_t)b * S * LDP;
#pragma unroll
                    for (int h = 0; h < 4; ++h) qs[h * 64 + lane] = bf2f(P[row * LDP + C_AQ + (g * 4 + h) * 64 + lane]);
                    LDS_FENCE();
                    const float* bd = biasd + (g * 4) * 2048;
                    const float* kc = cmpkv + (((size_t)0 * NB + b) * 2 + g) * 128 * 64;
                    const float* vc = cmpkv + (((size_t)1 * NB + b) * 2 + g) * 128 * 64;
                    const int ncv = t >= 31 ? (t - 31) / 16 + 1 : 0;
                    float ocmp[4] = {0.f, 0.f, 0.f, 0.f};
                    float psum0 = 0.f, psum1 = 0.f;
                    if (ncv > 0) {
                        float s0[4], s1[4], p0[4], p1[4];
                        const bool v0 = lane < ncv, v1 = lane + 64 < ncv;
                        score_chunk<4, float>(kc, 64, lane, v0, v0 ? t - 31 - 16 * lane : 0, qs, bd, s0);
                        score_chunk<4, float>(kc, 64, lane + 64, v1, v1 ? t - 31 - 16 * (lane + 64) : 0, qs, bd, s1);
#pragma unroll
                        for (int h = 0; h < 4; ++h) {
                            const float mx = wave_max(fmaxf(s0[h], s1[h]));
                            const float e0 = v0 ? __expf(s0[h] - mx) : 0.f, e1 = v1 ? __expf(s1[h] - mx) : 0.f;
                            const float inv = 1.f / fmaxf(wave_sum(e0 + e1), 1e-30f);
                            p0[h] = e0 * inv; p1[h] = e1 * inv; psum0 += p0[h]; psum1 += p1[h];
                        }
                        pv_chunk<4, float>(vc, 64, 1, 0, 1, 0, ncv < 64 ? ncv : 64, p0, ocmp, lane);
                        if (ncv > 64) pv_chunk<4, float>(vc, 64, 1, 64, 1, 0, ncv - 64, p1, ocmp, lane);
                    }
                    pc[lane] = psum0; pc[64 + lane] = psum1;
                    LDS_FENCE();
                    const int cur = t >> 6;
                    float imp = -INFINITY;
                    if (lane < 32) {
                        float a = 0.f;
#pragma unroll
                        for (int c = -1; c <= 3; ++c) { const int cc = 4 * lane + c; if (cc >= 0 && cc < NCMP) a += pc[cc]; }
                        const bool forced = lane == 0 || lane == cur || lane == cur - 1;
                        imp = lane > cur ? -1e30f : (forced ? 1e4f : a);
                    }
                    unsigned selmask = 0u;
#pragma unroll 1
                    for (int r = 0; r < 8; ++r) {
                        const float mx = wave_max(imp);
                        const unsigned long long bal = __ballot(imp == mx);
                        const int win = __ffsll((long long)bal) - 1;
                        selmask |= 1u << win;
                        if (lane == win) imp = -INFINITY;
                    }
                    LDS_FENCE();
                    float m[4], l[4], osel[4];
#pragma unroll
                    for (int h = 0; h < 4; ++h) { m[h] = -INFINITY; l[h] = 0.f; osel[h] = 0.f; }
                    for (int n = 0; n <= cur; ++n) {
                        if (!((selmask >> n) & 1u)) continue;
                        const int j1 = (t - 64 * n + 1) < 64 ? (t - 64 * n + 1) : 64;
                        attend_chunk<4, bf16_t>(Pb + C_AKS + g * 64, VT + (size_t)(VR_AVS + g * 64) * M + (size_t)b * S, LDP, 64 * n, 1, 0, j1, t - 64 * n, -1, qs, bd, m, l, osel, lane);
                    }
#pragma unroll
                    for (int h = 0; h < 4; ++h) osel[h] = osel[h] / fmaxf(l[h], 1e-30f);
                    float owin[4];
#pragma unroll
                    for (int h = 0; h < 4; ++h) { m[h] = -INFINITY; l[h] = 0.f; owin[h] = 0.f; }
                    {
                        const int lo = t - 511 > 0 ? t - 511 : 0;
                        for (int k0 = lo; k0 <= t; k0 += 64) {
                            const int j1 = (t - k0 + 1) < 64 ? (t - k0 + 1) : 64;
                            attend_chunk<4, bf16_t>(Pb + C_AKW + g * 64, VT + (size_t)(VR_AVW + g * 64) * M + (size_t)b * S, LDP, k0, 1, 0, j1, t - k0, -1, qs, bd, m, l, owin, lane);
                        }
                    }
#pragma unroll
                    for (int h = 0; h < 4; ++h) {
                        const int hh = g * 4 + h;
                        const float g0 = sigmoidf(GT[row * 24 + 0 * 8 + hh]), g1 = sigmoidf(GT[row * 24 + 1 * 8 + hh]), g2 = sigmoidf(GT[row * 24 + 2 * 8 + hh]);
                        const float oa = g0 * ocmp[h] + g1 * osel[h] + g2 * (owin[h] / l[h]);
                        const float gate = bf2f(P[row * LDP + C_AGATE + hh * 64 + lane]);
                        MIX[row * DM + hh * 64 + lane] = f2bf(oa * silu(gate));
                    }
                } else if (item < NA + NBi) {
                    const int it = item - NA;
                    const int t = it % S, g = (it / S) & 1, b = it / (2 * S);
                    const size_t row = (size_t)b * S + t;
                    const bf16_t* Pb = P + (size_t)b * S * LDP;
#pragma unroll
                    for (int h = 0; h < 4; ++h) qs[h * 64 + lane] = bf2f(P[row * LDP + C_BQ + (g * 4 + h) * 64 + lane]);
                    LDS_FENCE();
                    const float* bd = biasd + (8 + g * 4) * 2048;
                    float m[4], l[4], o[4];
#pragma unroll
                    for (int h = 0; h < 4; ++h) { m[h] = -INFINITY; l[h] = 0.f; o[h] = 0.f; }
                    const int lo = t - 127 > 0 ? t - 127 : 0;
                    for (int k0 = lo; k0 <= t; k0 += 64) {
                        const int j1 = (t - k0 + 1) < 64 ? (t - k0 + 1) : 64;
                        attend_chunk<4, bf16_t>(Pb + C_BK + g * 64, VT + (size_t)(VR_BV + g * 64) * M + (size_t)b * S, LDP, k0, 1, 0, j1, t - k0, -1, qs, bd, m, l, o, lane);
                    }
                    LDS_FENCE();
#pragma unroll
                    for (int h = 0; h < 4; ++h) {
                        const int hh = g * 4 + h;
                        const float den = l[h] + __expf(sinks[hh] - m[h]);
                        const float gate = bf2f(P[row * LDP + C_BGATE + hh * 64 + lane]);
                        MIX[row * DM + 512 + hh * 64 + lane] = f2bf(o[h] / den * silu(gate));
                    }
                } else {
                    const int it = item - NA - NBi;
                    const int t = it % S, hh = (it / S) & 7, b = it / (8 * S);
                    const size_t row = (size_t)b * S + t;
                    const bf16_t* Pb = P + (size_t)b * S * LDP;
                    qs[lane] = bf2f(P[row * LDP + C_DQ + hh * 64 + lane]);
                    LDS_FENCE();
                    const float* bd = biasd + (16 + hh) * 2048;
                    const bf16_t* kd = Pb + C_DK + hh * 64; const bf16_t* vd = VT + (size_t)(VR_DV + hh * 64) * M + (size_t)b * S;
                    float m[1] = {-INFINITY}, l[1] = {0.f}, o[1] = {0.f};
#pragma unroll 1
                    for (int pat = 0; pat < 3; ++pat) {
                        const int dil = pat == 0 ? 1 : (pat == 1 ? 4 : 16);
                        int nk = t / dil + 1;
                        if (nk > 129) nk = 129;
                        if (pat == 2 && nk > 128) nk = 128;
                        for (int m0 = 0; m0 < nk; m0 += 64) {
                            const int j1 = (nk - m0) < 64 ? (nk - m0) : 64;
                            attend_chunk<1, bf16_t>(kd, vd, LDP, t - dil * m0, -dil, 0, j1, dil * m0, dil, qs, bd, m, l, o, lane);
                        }
                    }
                    LDS_FENCE();
                    const float gate = bf2f(P[row * LDP + C_DGATE + hh * 64 + lane]);
                    MIX[row * DM + 1536 + hh * 64 + lane] = f2bf(o[0] / l[0] * silu(gate));
                }
            }
            for (int i = gtid; i < M * 512; i += gthreads) {
                const int c = i & 511, row = i >> 9, t = row & (S - 1);
                const bf16_t* pr = P + (size_t)row * LDP;
                float y = convw[2 * 512 + c] * bf2f(pr[C_CC + c]) * bf2f(pr[C_CH + c]);
                if (t >= 1) y += convw[1 * 512 + c] * bf2f(pr[C_CC + c - LDP]) * bf2f(pr[C_CH + c - LDP]);
                if (t >= 2) y += convw[0 * 512 + c] * bf2f(pr[C_CC + c - 2 * LDP]) * bf2f(pr[C_CH + c - 2 * LDP]);
                MIX[(size_t)row * DM + 1024 + c] = f2bf(bf2f(pr[C_CB + c]) * y * silu(bf2f(pr[C_CGATE + c])));
            }
        }

}
__device__ __forceinline__ void phase_xb(const Params& prm) {
    PH_COMMON
    bf16_t* XB = (bf16_t*)(ws + WS_XB);
    for (int row = gwave; row < M; row += gwaves) rms_row_to_bf16(prm.out + (size_t)row * DM, XB + (size_t)row * DM, lane);
}
__device__ __forceinline__ void phase_final(const Params& prm) {
    PH_COMMON
    for (int row = gwave; row < M; row += gwaves) {
        float4* xr = (float4*)(prm.out + (size_t)row * DM);
        float4 v[8]; float s = 0.f;
#pragma unroll
        for (int j = 0; j < 8; ++j) { v[j] = xr[lane + 64 * j]; s += v[j].x * v[j].x + v[j].y * v[j].y + v[j].z * v[j].z + v[j].w * v[j].w; }
        s = wave_sum(s);
        const float r = rsqrtf(s * (1.f / DM) + 1e-6f);
#pragma unroll
        for (int j = 0; j < 8; ++j) { const float4 w = ((const float4*)prm.final_norm_w)[lane + 64 * j];
            xr[lane + 64 * j] = make_float4(v[j].x * r * w.x, v[j].y * r * w.y, v[j].z * r * w.z, v[j].w * r * w.w); }
    }
}

__global__ void __launch_bounds__(NT, 2) fwd_kernel(Params prm) {
    cg::grid_group grid = cg::this_grid();
    extern __shared__ __attribute__((aligned(16))) unsigned char lds_raw[];
    LAS unsigned char* ldsb = (LAS unsigned char*)lds_raw;
    float* lds = (float*)lds_raw;
    phase_prologue(prm, ldsb);
    grid.sync();
#pragma unroll
    for (int layer = 0; layer < DEPTH; ++layer) {
        phase_inproj(prm, layer, ldsb);
        phase_gates(prm, layer);
        grid.sync();
        phase_compress(prm, layer, lds);
        grid.sync();
        phase_mixers(prm, layer, lds);
        grid.sync();
        phase_outproj(prm, layer, ldsb);
        grid.sync();
        if (layer + 1 < DEPTH) { phase_xb(prm); grid.sync(); }
    }
    phase_final(prm);
}

extern "C" void kernel_launch(void* const* d_in, const int* in_sizes, int n_in, void* d_out, int out_size, void* d_ws, size_t ws_size, hipStream_t stream) {
    static int grid_blocks = 0;
    if (!grid_blocks) {
        int dev = 0, cus = 0, per_cu = 0;
        (void)hipGetDevice(&dev);
        (void)hipDeviceGetAttribute(&cus, hipDeviceAttributeMultiprocessorCount, dev);
        if (hipFuncSetAttribute((const void*)fwd_kernel, hipFuncAttributeMaxDynamicSharedMemorySize, LDS_BYTES) != hipSuccess) fprintf(stderr, "kernel_launch: hipFuncSetAttribute failed\n");
        (void)hipOccupancyMaxActiveBlocksPerMultiprocessor(&per_cu, fwd_kernel, NT, LDS_BYTES);
        if (per_cu < 1) fprintf(stderr, "kernel_launch: occupancy query says %d blocks per CU\n", per_cu);
        grid_blocks = cus;
        if (ws_size < WS_END) fprintf(stderr, "kernel_launch: workspace too small: %zu < %zu\n", ws_size, (size_t)WS_END);
    }
    Params p{};
    p.x = (const float*)d_in[0]; p.norm_w = (const float*)d_in[1]; p.w_in = (const float*)d_in[2]; p.w_out = (const float*)d_in[3];
    p.conv_w = (const float*)d_in[4]; p.sinks = (const float*)d_in[5]; p.cmp_pos = (const float*)d_in[6]; p.cmp_w1 = (const float*)d_in[7];
    p.cmp_w2 = (const float*)d_in[8]; p.rel_bias = (const float*)d_in[9]; p.final_norm_w = (const float*)d_in[10];
    p.out = (float*)d_out; p.ws = (unsigned char*)d_ws;
    void* args[] = {&p};
    hipError_t e = hipLaunchCooperativeKernel((void*)fwd_kernel, dim3(grid_blocks), dim3(NT), args, LDS_BYTES, stream);
    if (e != hipSuccess) fprintf(stderr, "cooperative launch failed: %s (grid %d)\n", hipGetErrorString(e), grid_blocks);
}
```

```cpp
#include <hip/hip_runtime.h>
#include <hip/hip_cooperative_groups.h>
#include <cstdio>
#include <cstdint>
namespace cg = cooperative_groups;

namespace pg8 {
#define PG8_LAS __attribute__((address_space(3)))
typedef unsigned short bf16_t;
typedef short bf16x8 __attribute__((ext_vector_type(8)));
typedef float f32x4 __attribute__((ext_vector_type(4)));
typedef unsigned u32x4 __attribute__((ext_vector_type(4)));
constexpr int BM = 256, BK = 64, HALF = 128, HTB = HALF * BK * 2  , STAGE_BYTES = 8 * HTB, NXCD = 8, WGM = 8;

__host__ __device__ __forceinline__ int lds_byte(int r, int c) { const int st = (r >> 4) * 2 + (c >> 5), rr = r & 15, cc = c & 31, ob = rr * 64 + cc * 2; return st * 1024 + (ob ^ (((ob >> 9) & 1) << 5)); }
__host__ __device__ __forceinline__ void stage_rc(int b, int& R, int& C) { const int st = b / 1024, sb = b % 1024, swz = sb ^ (((sb >> 9) & 1) << 5); R = (st >> 1) * 16 + swz / 64; C = (st & 1) * 32 + (swz % 64) / 2; }
__host__ __device__ __forceinline__ int perm32(int rho) { const int n = rho >> 4, i = rho & 15; return 8 * (i >> 2) + 4 * n + (i & 3); }

struct Unit { int pm, pn; };
struct Gemm { const bf16_t* A; const bf16_t* Bt; int M, N, K; };

struct StaticOrder {
    int nM, nN, nwg, G, c;
    __host__ __device__ void init(int M, int N, int G_, int c_) { nM = M / BM; nN = N / BM; nwg = nM * nN; G = G_; c = c_; }
    __host__ __device__ bool next(int i, Unit& u) const {
        const long L = (long)i * G + c; if (L >= nwg) return false;
        int wgid = (int)L; { const int q = nwg / NXCD, r = nwg % NXCD, xcd = wgid % NXCD, off = wgid / NXCD; wgid = (xcd < r ? xcd * (q + 1) : r * (q + 1) + (xcd - r) * q) + off; }
        const int nig = WGM * nN, gid = wgid / nig, fm = gid * WGM, gsz = (nM - fm) < WGM ? (nM - fm) : WGM;
        u.pm = fm + ((wgid % nig) % gsz); u.pn = (wgid % nig) / gsz; return true;
    }
    __device__ __forceinline__ void a_ready(const Unit&) const {}
    __device__ __forceinline__ void done(const Unit&) const {}
};


__device__ __forceinline__ unsigned cvt_pk_bf16(float lo, float hi) { unsigned r; asm volatile("v_cvt_pk_bf16_f32 %0, %1, %2" : "=v"(r) : "v"(lo), "v"(hi)); return r; }
struct EpiBf16 {
    static constexpr bool PERM = true, AFTER_DRAIN = false;
    bf16_t* O; int ldc;
    __device__ __forceinline__ void operator()(const f32x4 (&acc)[2][2][4][2], const Unit& u, int wr, int wc, int fr, int fq) const {
        const int row0 = u.pm * BM + wr * 64 + fr; const int col0 = u.pn * BM + wc * 32 + 8 * fq;
#pragma unroll
        for (int ai = 0; ai < 2; ++ai)
#pragma unroll
            for (int m = 0; m < 4; ++m) { bf16_t* rowp = O + (size_t)(row0 + ai * HALF + m * 16) * ldc + col0;
#pragma unroll
                for (int bj = 0; bj < 2; ++bj) { const f32x4 v0 = acc[ai][bj][m][0], v1 = acc[ai][bj][m][1];
                    u32x4 w; w.x = cvt_pk_bf16(v0[0], v0[1]); w.y = cvt_pk_bf16(v0[2], v0[3]); w.z = cvt_pk_bf16(v1[0], v1[1]); w.w = cvt_pk_bf16(v1[2], v1[3]);
                    *(u32x4*)(rowp + bj * HALF) = w; } }
    }
};
struct EpiResid {
    static constexpr bool PERM = false, AFTER_DRAIN = false;
    const float* base; float* out; int ldc;
    __device__ __forceinline__ void operator()(const f32x4 (&acc)[2][2][4][2], const Unit& u, int wr, int wc, int fr, int fq) const {
        const int col0 = u.pn * BM + wc * 32 + 4 * fq;
#pragma unroll
        for (int ai = 0; ai < 2; ++ai)
#pragma unroll
            for (int m = 0; m < 4; ++m) { const size_t off = (size_t)(u.pm * BM + ai * HALF + wr * 64 + m * 16 + fr) * ldc + col0;
#pragma unroll
                for (int bj = 0; bj < 2; ++bj)
#pragma unroll
                    for (int n = 0; n < 2; ++n) { const f32x4 bs = *(const f32x4*)(base + off + bj * HALF + n * 16); *(f32x4*)(out + off + bj * HALF + n * 16) = bs + acc[ai][bj][m][n]; } }
    }
};

template <class Epi, class Sched, bool ALIGN_EPI = false, bool SP2 = false>
__device__ __forceinline__ void gemm_phase(PG8_LAS unsigned char* lds, const Gemm g, const Sched& S, const Epi& E) {
    const int tid = threadIdx.x, wid = __builtin_amdgcn_readfirstlane(tid >> 6), lane = tid & 63, wr = wid >> 2, wc = wid & 3, fr = lane & 15, fq = lane >> 4;
    const int K = g.K, nt = K / BK;
    unsigned voffA[2], voffB[2];
#pragma unroll
    for (int i = 0; i < 2; ++i) { int R, C; stage_rc(tid * 16 + i * 8192, R, C); const int Rb = Epi::PERM ? ((R & ~31) + perm32(R & 31)) : R;
        voffA[i] = (unsigned)(R * K + C) * 2u; voffB[i] = (unsigned)(Rb * K + C) * 2u; }
    const size_t kstep = (size_t)(BK * 2);
    const size_t hstep = (size_t)HALF * K * 2;
    const size_t tstep = 2 * hstep;
    const unsigned ldsw = (unsigned)wid * 1024u;
    const int aoff = lds_byte(wr * 64 + fr, fq * 8), boff = lds_byte(wc * 32 + fr, fq * 8);
#define PG8_SA(b, h) (((b) * 2 + (h)) * HTB)
#define PG8_SB(b, h) ((4 + (b) * 2 + (h)) * HTB)
#define PG8_STAGE(bufoff, gbase, voff) do { _Pragma("unroll") for (int _i = 0; _i < 2; ++_i) \
        __builtin_amdgcn_global_load_lds((const unsigned*)((const char*)(gbase) + (voff)[_i]), (PG8_LAS unsigned*)(lds + (bufoff) + ldsw + _i * 8192), 16, 0, 0); } while (0)
#define PG8_LDA(dst, b, h) do { _Pragma("unroll") for (int m = 0; m < 4; ++m) _Pragma("unroll") for (int k = 0; k < 2; ++k) dst[m][k] = *(const PG8_LAS bf16x8*)(lds + PG8_SA(b, h) + aoff + m * 2048 + k * 1024); } while (0)
#define PG8_LDB(dst, b, h) do { _Pragma("unroll") for (int n = 0; n < 2; ++n) _Pragma("unroll") for (int k = 0; k < 2; ++k) dst[n][k] = *(const PG8_LAS bf16x8*)(lds + PG8_SB(b, h) + boff + n * 2048 + k * 1024); } while (0)
#define PG8_MMA(ai, bj, At, Bt) do { __builtin_amdgcn_s_setprio(1); _Pragma("unroll") for (int m = 0; m < 4; ++m) _Pragma("unroll") for (int n = 0; n < 2; ++n) _Pragma("unroll") for (int k = 0; k < 2; ++k) \
        acc[ai][bj][m][n] = __builtin_amdgcn_mfma_f32_16x16x32_bf16(Bt[n][k], At[m][k], acc[ai][bj][m][n], 0, 0, 0); __builtin_amdgcn_s_setprio(0); } while (0)
#define PG8_WAIT_V(n) asm volatile("s_waitcnt vmcnt(" #n ")" ::: "memory")
#define PG8_WAIT_L(n) asm volatile("s_waitcnt lgkmcnt(" #n ")" ::: "memory")
#define PG8_BAR __builtin_amdgcn_s_barrier()
#define PG8_SCHED __builtin_amdgcn_sched_barrier(0)
    Unit cur, nxt; int ui = 0;
    if (!S.next(0, cur)) return;
    f32x4 acc[2][2][4][2];
#pragma unroll
    for (int a = 0; a < 2; ++a)
#pragma unroll
        for (int b = 0; b < 2; ++b)
#pragma unroll
            for (int m = 0; m < 4; ++m)
#pragma unroll
                for (int n = 0; n < 2; ++n) acc[a][b][m][n] = (f32x4){0.f, 0.f, 0.f, 0.f};
    bf16x8 At[4][2], B0[2][2], B1[2][2];
    const char* cA = (const char*)g.A + (size_t)cur.pm * tstep; const char* cB = (const char*)g.Bt + (size_t)cur.pn * tstep;
    S.a_ready(cur);
    if constexpr (SP2) {
        PG8_STAGE(PG8_SB(0, 0), cB, voffB); PG8_STAGE(PG8_SB(0, 1), cB + hstep, voffB); PG8_STAGE(PG8_SA(0, 0), cA, voffA); PG8_STAGE(PG8_SA(0, 1), cA + hstep, voffA);
        if (wr == 1) PG8_BAR;
        PG8_WAIT_V(2); PG8_BAR;
        PG8_STAGE(PG8_SB(1, 0), cB + kstep, voffB); PG8_STAGE(PG8_SA(1, 0), cA + kstep, voffA); PG8_STAGE(PG8_SB(1, 1), cB + hstep + kstep, voffB);
        PG8_WAIT_V(6); PG8_BAR;
    } else {
        PG8_STAGE(PG8_SB(0, 0), cB, voffB); PG8_STAGE(PG8_SA(0, 0), cA, voffA); PG8_STAGE(PG8_SB(0, 1), cB + hstep, voffB); PG8_STAGE(PG8_SA(0, 1), cA + hstep, voffA);
        if (wr == 1) PG8_BAR;
        PG8_WAIT_V(4); PG8_BAR;
        PG8_STAGE(PG8_SB(1, 0), cB + kstep, voffB); PG8_STAGE(PG8_SA(1, 0), cA + kstep, voffA); PG8_STAGE(PG8_SB(1, 1), cB + hstep + kstep, voffB);
        PG8_WAIT_V(6); PG8_BAR;
    }
    for (;;) {
        const bool has_next = S.next(ui + 1, nxt);
        const char* nA = has_next ? (const char*)g.A + (size_t)nxt.pm * tstep : cA; const char* nB = has_next ? (const char*)g.Bt + (size_t)nxt.pn * tstep : cB;
        for (int t = 0; t < nt; t += 2) {
            const bool last = (t == nt - 2);
            const char* a1 = cA + (size_t)(t + 1) * kstep;
            const char* a2 = last ? nA : cA + (size_t)(t + 2) * kstep; const char* b2 = last ? nB : cB + (size_t)(t + 2) * kstep;
            const char* a3 = a2 + kstep; const char* b3 = b2 + kstep;
            if (last && has_next) S.a_ready(nxt);
            if constexpr (SP2) {
            PG8_LDB(B0, 0, 0); PG8_LDB(B1, 0, 1); PG8_SCHED; PG8_LDA(At, 0, 0); PG8_STAGE(PG8_SA(1, 1), a1 + hstep, voffA);
            PG8_WAIT_V(8); PG8_WAIT_L(0); PG8_BAR; PG8_MMA(0, 0, At, B0); PG8_MMA(0, 1, At, B1); PG8_BAR; PG8_SCHED;
            PG8_LDA(At, 0, 1); PG8_STAGE(PG8_SB(0, 0), b2, voffB); PG8_STAGE(PG8_SB(0, 1), b2 + hstep, voffB); PG8_STAGE(PG8_SA(0, 0), a2, voffA);
            PG8_WAIT_V(8); PG8_WAIT_L(0); PG8_BAR; PG8_MMA(1, 0, At, B0); PG8_MMA(1, 1, At, B1); PG8_BAR; PG8_SCHED;
            PG8_LDB(B0, 1, 0); PG8_LDB(B1, 1, 1); PG8_SCHED; PG8_LDA(At, 1, 0); PG8_STAGE(PG8_SA(0, 1), a2 + hstep, voffA);
            PG8_WAIT_V(8); PG8_WAIT_L(0); PG8_BAR; PG8_MMA(0, 0, At, B0); PG8_MMA(0, 1, At, B1); PG8_BAR; PG8_SCHED;
            PG8_LDA(At, 1, 1); PG8_STAGE(PG8_SB(1, 0), b3, voffB); PG8_STAGE(PG8_SB(1, 1), b3 + hstep, voffB); PG8_STAGE(PG8_SA(1, 0), a3, voffA);
            PG8_WAIT_V(8); PG8_WAIT_L(0); PG8_BAR; PG8_MMA(1, 0, At, B0); PG8_MMA(1, 1, At, B1); PG8_BAR; PG8_SCHED;
            } else {
            PG8_LDB(B0, 0, 0); PG8_SCHED; PG8_LDA(At, 0, 0); PG8_STAGE(PG8_SA(1, 1), a1 + hstep, voffA);
            PG8_WAIT_L(8); PG8_BAR; PG8_WAIT_L(0); PG8_MMA(0, 0, At, B0); PG8_BAR; PG8_SCHED;
            PG8_LDB(B1, 0, 1); PG8_STAGE(PG8_SB(0, 0), b2, voffB);
            PG8_BAR; PG8_WAIT_L(0); PG8_MMA(0, 1, At, B1); PG8_BAR;
            PG8_LDA(At, 0, 1); PG8_STAGE(PG8_SA(0, 0), a2, voffA);
            PG8_BAR; PG8_WAIT_L(0); PG8_MMA(1, 0, At, B0); PG8_BAR; PG8_SCHED;
            PG8_STAGE(PG8_SB(0, 1), b2 + hstep, voffB);
            PG8_WAIT_V(6); PG8_BAR; PG8_MMA(1, 1, At, B1); PG8_BAR;
            PG8_LDB(B0, 1, 0); PG8_SCHED; PG8_LDA(At, 1, 0); PG8_STAGE(PG8_SA(0, 1), a2 + hstep, voffA);
            PG8_WAIT_L(8); PG8_BAR; PG8_WAIT_L(0); PG8_MMA(0, 0, At, B0); PG8_BAR; PG8_SCHED;
            PG8_LDB(B1, 1, 1); PG8_STAGE(PG8_SB(1, 0), b3, voffB);
            PG8_BAR; PG8_WAIT_L(0); PG8_MMA(0, 1, At, B1); PG8_BAR;
            PG8_LDA(At, 1, 1); PG8_STAGE(PG8_SA(1, 0), a3, voffA);
            PG8_BAR; PG8_WAIT_L(0); PG8_MMA(1, 0, At, B0); PG8_BAR; PG8_SCHED;
            PG8_STAGE(PG8_SB(1, 1), b3 + hstep, voffB);
            PG8_WAIT_V(6); PG8_BAR; PG8_MMA(1, 1, At, B1); PG8_BAR;
            }
        }
        if constexpr (ALIGN_EPI) { if (wr == 0) PG8_BAR; }
        if constexpr (!Epi::AFTER_DRAIN) { E(acc, cur, wr, wc, fr, fq); S.done(cur); }
        if (!has_next) break;
#pragma unroll
        for (int a = 0; a < 2; ++a)
#pragma unroll
            for (int b = 0; b < 2; ++b)
#pragma unroll
                for (int m = 0; m < 4; ++m)
#pragma unroll
                    for (int n = 0; n < 2; ++n) acc[a][b][m][n] = (f32x4){0.f, 0.f, 0.f, 0.f};
        cur = nxt; cA = nA; cB = nB; ++ui;
        if constexpr (ALIGN_EPI) { if (wr == 1) PG8_BAR; }
    }
    PG8_WAIT_V(0);
    if constexpr (!ALIGN_EPI) { if (wr == 0) PG8_BAR; }
    PG8_BAR;
    if constexpr (Epi::AFTER_DRAIN) { E.fused(acc, cur, wr, wc, fr, fq, lds, wid, lane); S.done(cur); }
#undef PG8_SA
#undef PG8_SB
#undef PG8_STAGE
#undef PG8_LDA
#undef PG8_LDB
#undef PG8_MMA
#undef PG8_WAIT_V
#undef PG8_WAIT_L
#undef PG8_BAR
#undef PG8_SCHED
}
}

typedef unsigned short bf16_t;
#define LAS __attribute__((address_space(3)))
constexpr int DM = 2048, NB = 8, S = 2048, M = NB * S, DIN = 7192, DEPTH = 2, LDP = 6144, NVT = 1024, NW_IN = LDP + NVT;
constexpr int NWAVES = 8, NT = NWAVES * 64;
constexpr int C_AQ = 0, C_AKC = 512, C_AKS = 640, C_AKW = 768, C_AGATE = 896;
constexpr int C_BQ = 1408, C_BK = 1920, C_BGATE = 2048;
constexpr int C_CB = 2560, C_CC = 3072, C_CH = 3584, C_CGATE = 4096;
constexpr int C_DQ = 4608, C_DK = 5120, C_DGATE = 5632;
constexpr int VR_AVC = 0, VR_AVS = 128, VR_AVW = 256, VR_BV = 384, VR_DV = 512;
__host__ __device__ __forceinline__ int src_col_of(int n) {
    if (n < 640) return n;
    if (n < 768) return n - 640 + 768;
    if (n < 896) return n - 768 + 1024;
    if (n < 1408) return n - 896 + 1304;
    if (n < 1920) return n - 1408 + 1816;
    if (n < 2048) return n - 1920 + 2328;
    if (n < 2560) return n - 2048 + 2584;
    if (n < 4608) return n - 2560 + 3096;
    if (n < 5120) return n - 4608 + 5144;
    if (n < 5632) return n - 5120 + 5656;
    if (n < 6144) return n - 5632 + 6680;
    if (n < 6272) return n - 6144 + 640;
    if (n < 6400) return n - 6272 + 896;
    if (n < 6528) return n - 6400 + 1152;
    if (n < 6656) return n - 6528 + 2456;
    return n - 6656 + 6168;
}
constexpr int SRC_GATES = 1280;
constexpr int NCMP = 127;

constexpr size_t MiB = 1u << 20;
constexpr size_t WS_BIASD = 1 * MiB;
constexpr size_t WS_IMG = 1 * MiB + 512 * 1024;
constexpr size_t WS_G = 2 * MiB;
constexpr size_t WS_WG = 4 * MiB;
constexpr size_t WS_CMP = 5 * MiB;
constexpr size_t WS_WIN = 8 * MiB;
constexpr size_t WS_WOUT = 64 * MiB;
constexpr size_t WS_XB = 80 * MiB;
constexpr size_t WS_MIX = 144 * MiB;
constexpr size_t WS_P = 208 * MiB;
constexpr size_t WS_VT = 400 * MiB;
constexpr size_t WS_END = 432 * MiB;
constexpr int LDS_BYTES = 147456;

struct Params {
    const float* x; const float* norm_w; const float* w_in; const float* w_out; const float* conv_w; const float* sinks;
    const float* cmp_pos; const float* cmp_w1; const float* cmp_w2; const float* rel_bias; const float* final_norm_w;
    float* out; unsigned char* ws;
};

__device__ __forceinline__ float bf2f(bf16_t v) { return __uint_as_float(((unsigned)v) << 16); }
__device__ __forceinline__ unsigned f2bfu(float f) { unsigned u = __float_as_uint(f); return (u + 0x7fffu + ((u >> 16) & 1u)) >> 16; }
__device__ __forceinline__ bf16_t f2bf(float f) { return (bf16_t)f2bfu(f); }
__device__ __forceinline__ unsigned pk2(float lo, float hi) { return f2bfu(lo) | (f2bfu(hi) << 16); }
__device__ __forceinline__ float wave_sum(float v) {
#pragma unroll
    for (int o = 32; o > 0; o >>= 1) v += __shfl_xor(v, o);
    return v;
}
__device__ __forceinline__ float wave_max(float v) {
#pragma unroll
    for (int o = 32; o > 0; o >>= 1) v = fmaxf(v, __shfl_xor(v, o));
    return v;
}
__device__ __forceinline__ float silu(float v) { return v / (1.f + __expf(-v)); }
__device__ __forceinline__ float sigmoidf(float v) { return 1.f / (1.f + __expf(-v)); }
#define LDS_FENCE() asm volatile("s_waitcnt lgkmcnt(0)" ::: "memory")

__device__ __forceinline__ int t5_bucket(int d) {
    if (d < 16) return d < 0 ? 0 : d;
    int b = 16;
    b += (d >= 22); b += (d >= 30); b += (d >= 40); b += (d >= 54); b += (d >= 73); b += (d >= 99); b += (d >= 134); b += (d >= 182);
    b += (d >= 246); b += (d >= 332); b += (d >= 450); b += (d >= 609); b += (d >= 825); b += (d >= 1117); b += (d >= 1513);
    return b;
}

__device__ __forceinline__ void transpose_item(const float* W, int K, int srcld, int src_n0, const float* ksc, bf16_t* WT, LAS float* scr, int kb, int nb, int lane) {
    const int k0 = 64 * kb, n0 = 32 * nb;
#pragma unroll 8
    for (int i = 0; i < 32; ++i) { const int kk = 2 * i + (lane >> 5); const float sc = ksc ? ksc[k0 + kk] : 1.f; scr[kk * 33 + (lane & 31)] = W[(size_t)(k0 + kk) * srcld + src_n0 + n0 + (lane & 31)] * sc; }
    LDS_FENCE();
    const int c = lane & 7;
#pragma unroll
    for (int j = 0; j < 4; ++j) { const int n = (lane >> 3) + 8 * j; const LAS float* s = scr + (8 * c) * 33 + n;
        uint4 o; o.x = pk2(s[0 * 33], s[1 * 33]); o.y = pk2(s[2 * 33], s[3 * 33]); o.z = pk2(s[4 * 33], s[5 * 33]); o.w = pk2(s[6 * 33], s[7 * 33]);
        *(uint4*)(WT + (size_t)(n0 + n) * K + k0 + 8 * c) = o; }
    LDS_FENCE();
}
__device__ __forceinline__ void rms_row_to_bf16(const float* xrow, bf16_t* orow, int lane) {
    const float4* xr = (const float4*)xrow + lane;
    float4 v[8]; float s = 0.f;
#pragma unroll
    for (int j = 0; j < 8; ++j) { v[j] = xr[64 * j]; s += (v[j].x * v[j].x + v[j].y * v[j].y) + (v[j].z * v[j].z + v[j].w * v[j].w); }
    const float r = rsqrtf(wave_sum(s) * (1.f / DM) + 1e-6f);
    uint2* o8 = (uint2*)orow + lane;
#pragma unroll
    for (int j = 0; j < 8; ++j) o8[64 * j] = make_uint2(pk2(v[j].x * r, v[j].y * r), pk2(v[j].z * r, v[j].w * r));
}

__device__ __forceinline__ float ldval(const bf16_t* p) { return bf2f(*p); }
__device__ __forceinline__ float ldval(const float* p) { return *p; }
__device__ __forceinline__ void load8(const bf16_t* p, float (&k)[8]) {
    const uint4 w = *(const uint4*)p;
    k[0] = __uint_as_float(w.x << 16); k[1] = __uint_as_float(w.x & 0xffff0000u);
    k[2] = __uint_as_float(w.y << 16); k[3] = __uint_as_float(w.y & 0xffff0000u);
    k[4] = __uint_as_float(w.z << 16); k[5] = __uint_as_float(w.z & 0xffff0000u);
    k[6] = __uint_as_float(w.w << 16); k[7] = __uint_as_float(w.w & 0xffff0000u);
}
__device__ __forceinline__ void load8(const float* p, float (&k)[8]) {
    const float4 a = ((const float4*)p)[0], b = ((const float4*)p)[1];
    k[0] = a.x; k[1] = a.y; k[2] = a.z; k[3] = a.w; k[4] = b.x; k[5] = b.y; k[6] = b.z; k[7] = b.w;
}

template <int NH, typename KT>
__device__ __forceinline__ void score_chunk(const KT* kmat, size_t rstride, int krow, bool valid, int dist, const float* qs, const float* biasd, float (&s)[NH]) {
    float a[NH];
#pragma unroll
    for (int h = 0; h < NH; ++h) a[h] = 0.f;
    if (valid) {
        const KT* kr = kmat + (size_t)krow * rstride;
#pragma unroll 2
        for (int d8 = 0; d8 < 8; ++d8) {
            float k[8]; load8(kr + 8 * d8, k);
#pragma unroll
            for (int h = 0; h < NH; ++h) {
                const float4 q0 = ((const float4*)(qs + h * 64))[2 * d8], q1 = ((const float4*)(qs + h * 64))[2 * d8 + 1];
                a[h] += q0.x * k[0] + q0.y * k[1] + q0.z * k[2] + q0.w * k[3] + q1.x * k[4] + q1.y * k[5] + q1.z * k[6] + q1.w * k[7];
            }
        }
    }
#pragma unroll
    for (int h = 0; h < NH; ++h) s[h] = valid ? a[h] * 0.125f + biasd[h * 2048 + dist] : -INFINITY;
}
template <int NH, typename VT>
__device__ __forceinline__ void pv_chunk(const VT* vmat, size_t rstride, size_t dstride, int rbase, int rstep, int j0, int j1, const float (&p)[NH], float (&o)[NH], int lane) {
    for (int jj = j0; jj < j1; ++jj) {
        const float vv = ldval(vmat + (size_t)(rbase + jj * rstep) * rstride + (size_t)lane * dstride);
#pragma unroll
        for (int h = 0; h < NH; ++h) o[h] += __uint_as_float(__builtin_amdgcn_readlane(__float_as_uint(p[h]), jj)) * vv;
    }
}
template <int NH, typename KT>
__device__ __forceinline__ void attend_chunk(const KT* kmat, const KT* vmat  , size_t rstride, int rbase, int rstep, int j0, int j1, int dbase, int dstep,
                                             const float* qs, const float* biasd, float (&m)[NH], float (&l)[NH], float (&o)[NH], int lane) {
    if (j1 <= j0) return;
    const bool valid = lane >= j0 && lane < j1;
    float s[NH], p[NH];
    score_chunk<NH, KT>(kmat, rstride, rbase + lane * rstep, valid, dbase + lane * dstep, qs, biasd, s);
#pragma unroll
    for (int h = 0; h < NH; ++h) {
        const float cm = wave_max(s[h]);
        const float mn = fmaxf(m[h], cm);
        const float sc = __expf(m[h] - mn);
        p[h] = valid ? __expf(s[h] - mn) : 0.f;
        l[h] = l[h] * sc + wave_sum(p[h]); o[h] *= sc; m[h] = mn;
    }
    pv_chunk<NH, KT>(vmat, 1, (size_t)M, rbase, rstep, j0, j1, p, o, lane);
}


typedef short abf16x8 __attribute__((ext_vector_type(8)));
typedef float f32x16 __attribute__((ext_vector_type(16)));
constexpr float LOG2E = 1.4426950408889634f, SCL = 0.125f * 1.4426950408889634f;
constexpr int OFF_SCR = 0, OFF_TD = 16384, OFF_TA = 16384 + 65536, OFF_TB = 16384 + 131072;
__device__ __forceinline__ int pi32(int i) { return (i & 19) | ((i & 4) << 1) | ((i & 8) >> 1); }
__device__ __forceinline__ unsigned cvtpk(float lo, float hi) { unsigned r; asm volatile("v_cvt_pk_bf16_f32 %0, %1, %2" : "=v"(r) : "v"(lo), "v"(hi)); return r; }
struct KVF { abf16x8 k[4]; abf16x8 v[4]; };
struct Soft { float m, l; f32x16 o[2]; };
__device__ __forceinline__ void soft_init(Soft& st) {
    st.m = -INFINITY; st.l = 0.f;
#pragma unroll
    for (int r = 0; r < 16; ++r) { st.o[0][r] = 0.f; st.o[1][r] = 0.f; }
}
__device__ __forceinline__ void load_kv(KVF& f, const bf16_t* kp, size_t krs, const bf16_t* vp, size_t vhalf, int key0) {
    const bf16_t* k = kp + (size_t)key0 * krs;
#pragma unroll
    for (int s = 0; s < 4; ++s) f.k[s] = *(const abf16x8*)(k + 16 * s);
    const bf16_t* v = vp + key0;
    f.v[0] = *(const abf16x8*)(v); f.v[1] = *(const abf16x8*)(v + 16); f.v[2] = *(const abf16x8*)(v + vhalf); f.v[3] = *(const abf16x8*)(v + vhalf + 16);
}
template <bool CAUSAL, bool WIN, bool ROWSEL>
__device__ __forceinline__ void tile_step(Soft& st, const KVF& f, const abf16x8 (&qf)[4], const LAS float* tabp, int key0, int D0, int W, bool rowsel) {
    f32x16 acc;
#pragma unroll
    for (int r = 0; r < 16; ++r) acc[r] = 0.f;
#pragma unroll
    for (int s = 0; s < 4; ++s) acc = __builtin_amdgcn_mfma_f32_32x32x16_bf16(f.k[s], qf[s], acc, 0, 0, 0);
    float sv[16]; float tm = -INFINITY;
#pragma unroll
    for (int r = 0; r < 16; ++r) {
        const int ko = (r & 7) + 16 * (r >> 3);
        float x = fmaf(acc[r], SCL, tabp[key0 + ko]);
        bool ok = true;
        if (CAUSAL) ok = ok && (ko <= D0);
        if (WIN) ok = ok && (ko >= D0 - W);
        if (ROWSEL) ok = ok && rowsel;
        if (CAUSAL || WIN || ROWSEL) x = ok ? x : -INFINITY;
        sv[r] = x; tm = fmaxf(tm, x);
    }
    tm = fmaxf(tm, __shfl_xor(tm, 32));
    const float mn = fmaxf(st.m, tm);
    const float alpha = __builtin_amdgcn_exp2f(st.m - mn);
    float rs = 0.f;
#pragma unroll
    for (int r = 0; r < 16; ++r) { sv[r] = __builtin_amdgcn_exp2f(sv[r] - mn); rs += sv[r]; }
    st.l = st.l * alpha + rs; st.m = mn;
    if (__any(alpha != 1.f)) {
#pragma unroll
        for (int r = 0; r < 16; ++r) { st.o[0][r] *= alpha; st.o[1][r] *= alpha; }
    }
    abf16x8 pf[2];
#pragma unroll
    for (int s2 = 0; s2 < 2; ++s2) {
        typedef unsigned u32x4_t __attribute__((ext_vector_type(4)));
        u32x4_t w; w.x = cvtpk(sv[8 * s2 + 0], sv[8 * s2 + 1]); w.y = cvtpk(sv[8 * s2 + 2], sv[8 * s2 + 3]); w.z = cvtpk(sv[8 * s2 + 4], sv[8 * s2 + 5]); w.w = cvtpk(sv[8 * s2 + 6], sv[8 * s2 + 7]);
        pf[s2] = __builtin_bit_cast(abf16x8, w);
    }
#pragma unroll
    for (int dh = 0; dh < 2; ++dh)
#pragma unroll
        for (int s2 = 0; s2 < 2; ++s2) st.o[dh] = __builtin_amdgcn_mfma_f32_32x32x16_bf16(f.v[dh * 2 + s2], pf[s2], st.o[dh], 0, 0, 0);
}
__device__ __forceinline__ void store_rows(const f32x16 (&o)[2], float scale, const bf16_t* gp, bf16_t* op, int h) {
#pragma unroll
    for (int dh = 0; dh < 2; ++dh)
#pragma unroll
        for (int rg = 0; rg < 4; ++rg) {
            const int dim0 = 32 * dh + 8 * rg + 4 * h;
            const uint2 gw = *(const uint2*)(gp + dim0);
            const float g0 = __uint_as_float(gw.x << 16), g1 = __uint_as_float(gw.x & 0xffff0000u), g2 = __uint_as_float(gw.y << 16), g3 = __uint_as_float(gw.y & 0xffff0000u);
            uint2 w; w.x = cvtpk(o[dh][4 * rg + 0] * scale * silu(g0), o[dh][4 * rg + 1] * scale * silu(g1)); w.y = cvtpk(o[dh][4 * rg + 2] * scale * silu(g2), o[dh][4 * rg + 3] * scale * silu(g3));
            *(uint2*)(op + dim0) = w;
        }
}
__device__ __forceinline__ void unit_D(const bf16_t* P, const bf16_t* VT, bf16_t* MIX, const LAS float* tabD, int b, int head, int qt, int lane) {
    const int c = lane & 31, h = lane >> 5, tc = qt * 32 + c;
    const size_t rowq = (size_t)b * S + tc;
    abf16x8 qf[4];
#pragma unroll
    for (int s = 0; s < 4; ++s) qf[s] = *(const abf16x8*)(P + rowq * LDP + C_DQ + head * 64 + 16 * s + 8 * h);
    const bf16_t* kp = P + ((size_t)b * S + pi32(c)) * LDP + C_DK + head * 64 + 8 * h;
    const bf16_t* vp = VT + (size_t)(VR_DV + head * 64 + c) * M + (size_t)b * S + 8 * h;
    const LAS float* tabp = tabD + head * 2048 + (2047 - tc + 8 * h);
    Soft st; soft_init(st);
    KVF cur, nxt;
    load_kv(cur, kp, LDP, vp, (size_t)32 * M, 32 * qt);
    for (int kt = qt; kt >= 0; --kt) {
        if (kt > 0) load_kv(nxt, kp, LDP, vp, (size_t)32 * M, 32 * (kt - 1));
        const int D0 = tc - 32 * kt - 8 * h;
        if (kt == qt) tile_step<true, false, false>(st, cur, qf, tabp, 32 * kt, D0, 0, true);
        else tile_step<false, false, false>(st, cur, qf, tabp, 32 * kt, D0, 0, true);
        if (kt > 0) cur = nxt;
    }
    const float l = st.l + __shfl_xor(st.l, 32);
    store_rows(st.o, 1.f / l, P + rowq * LDP + C_DGATE + head * 64, MIX + rowq * DM + 1536 + head * 64, h);
}

#define LAUNDER_S(x)
#define PH_COMMON \
    int tid_ = threadIdx.x; asm volatile("" : "+v"(tid_)); const int tid = tid_, lane = tid & 63, wib = __builtin_amdgcn_readfirstlane(tid >> 6); \
    const int G = gridDim.x; const int gthreads = G * NT, gtid = blockIdx.x * NT + tid; const int gwaves = G * NWAVES, gwave = blockIdx.x * NWAVES + wib; \
    unsigned char* ws = prm.ws; asm volatile("" : "+s"(ws)); (void)lane; (void)gthreads; (void)gtid; (void)gwaves; (void)gwave; (void)ws;

__device__ __forceinline__ void phase_prologue(const Params& prm, LAS unsigned char* ldsb) {
    PH_COMMON
    float* biasd = (float*)(ws + WS_BIASD); float* WG = (float*)(ws + WS_WG);
    bf16_t* WINT = (bf16_t*)(ws + WS_WIN); bf16_t* WOUTT = (bf16_t*)(ws + WS_WOUT); bf16_t* XB = (bf16_t*)(ws + WS_XB);
    for (int i = gtid; i < 24 * 2048; i += gthreads) { const int h = i >> 11, d = i & 2047; biasd[i] = prm.rel_bias[t5_bucket(d) * 24 + h]; }
    {
        float* img = (float*)(ws + WS_IMG);
        for (int i = gtid; i < 8 * 2048; i += gthreads) { const int h = i >> 11, d = 2047 - (i & 2047);
            img[i] = prm.rel_bias[t5_bucket(d) * 24 + h] * LOG2E;
            const int mult = (d <= 128 ? 1 : 0) + (((d & 3) == 0 && d <= 512) ? 1 : 0) + ((d & 15) == 0 ? 1 : 0);
            img[8 * 2048 + i] = mult == 0 ? -INFINITY : prm.rel_bias[t5_bucket(d) * 24 + 16 + h] * LOG2E + (mult == 1 ? 0.f : (mult == 2 ? 1.f : 1.5849625007211562f)); }
        for (int i = gtid; i < 8 * 256; i += gthreads) { const int h = i >> 8, d = 255 - (i & 255); img[16 * 2048 + i] = prm.rel_bias[t5_bucket(d) * 24 + 8 + h] * LOG2E; }
    }
    for (int i = gtid; i < DEPTH * 24 * 2048; i += gthreads) { const int k = i & 2047, j = (i >> 11) % 24, l = i / (24 * 2048); WG[i] = prm.w_in[(size_t)l * DM * DIN + (size_t)k * DIN + SRC_GATES + j] * prm.norm_w[l * DM + k]; }
    {
        LAS float* scr = (LAS float*)(ldsb + wib * 16384);
        constexpr int I_IN = 32 * (NW_IN / 32), I_OUT = 32 * (DM / 32);
        for (int it = gwave; it < DEPTH * (I_IN + I_OUT); it += gwaves) {
            const int l = it / (I_IN + I_OUT); int r = it % (I_IN + I_OUT);
            if (r < I_IN) { const int nb = r % (NW_IN / 32), kb = r / (NW_IN / 32);
                transpose_item(prm.w_in + (size_t)l * DM * DIN, DM, DIN, src_col_of(32 * nb) - 32 * nb, prm.norm_w + l * DM, WINT + (size_t)l * NW_IN * DM, scr, kb, nb, lane); }
            else { r -= I_IN; const int nb = r % (DM / 32), kb = r / (DM / 32);
                transpose_item(prm.w_out + (size_t)l * DM * DM, DM, DM, 0, nullptr, WOUTT + (size_t)l * DM * DM, scr, kb, nb, lane); }
        }
    }
    for (int row = gwave; row < M; row += gwaves) rms_row_to_bf16(prm.x + (size_t)row * DM, XB + (size_t)row * DM, lane);
}

__device__ __forceinline__ void phase_inproj(const Params& prm, int layer, LAS unsigned char* ldsb) {
    LAUNDER_S(layer);
    unsigned char* ws = prm.ws; asm volatile("" : "+s"(ws));
    const bf16_t* W = (const bf16_t*)(ws + WS_WIN) + (size_t)layer * NW_IN * DM;
    {
        pg8::Gemm g{(const bf16_t*)(ws + WS_XB), W, M, LDP, DM}; pg8::StaticOrder So; So.init(M, LDP, (int)gridDim.x, (int)blockIdx.x);
        pg8::EpiBf16 E{(bf16_t*)(ws + WS_P), LDP};
        pg8::gemm_phase<pg8::EpiBf16, pg8::StaticOrder, true, true>(ldsb, g, So, E);
    }
    {
        pg8::Gemm g{W + (size_t)LDP * DM, (const bf16_t*)(ws + WS_XB), NVT, M, DM}; pg8::StaticOrder So; So.init(NVT, M, (int)gridDim.x, (int)blockIdx.x);
        pg8::EpiBf16 E{(bf16_t*)(ws + WS_VT), M};
        pg8::gemm_phase<pg8::EpiBf16, pg8::StaticOrder, true, true>(ldsb, g, So, E);
    }
}
__device__ __forceinline__ void phase_outproj(const Params& prm, int layer, LAS unsigned char* ldsb) {
    LAUNDER_S(layer);
    unsigned char* ws = prm.ws; asm volatile("" : "+s"(ws));
    const float* xin = layer == 0 ? prm.x : prm.out;
    pg8::Gemm g{(const bf16_t*)(ws + WS_MIX), (const bf16_t*)(ws + WS_WOUT) + (size_t)layer * DM * DM, M, DM, DM}; pg8::StaticOrder So; So.init(M, DM, (int)gridDim.x, (int)blockIdx.x);
    pg8::EpiResid E{xin, prm.out, DM};
    pg8::gemm_phase<pg8::EpiResid, pg8::StaticOrder, true, true>(ldsb, g, So, E);
}
__device__ __forceinline__ void phase_gates(const Params& prm, int layer) {
    LAUNDER_S(layer);
    PH_COMMON
    const bf16_t* XB = (const bf16_t*)(ws + WS_XB); float* GT = (float*)(ws + WS_G);
    const float* wg = (const float*)(ws + WS_WG) + (size_t)layer * 24 * 2048;
    for (int row = gwave; row < M; row += gwaves) {
        float xv[32];
#pragma unroll
        for (int i = 0; i < 32; ++i) xv[i] = bf2f(XB[(size_t)row * DM + lane + 64 * i]);
#pragma unroll 1
        for (int j = 0; j < 24; ++j) {
            float a = 0.f;
#pragma unroll
            for (int i = 0; i < 32; ++i) a += xv[i] * wg[j * 2048 + lane + 64 * i];
            a = wave_sum(a);
            if (lane == 0) GT[(size_t)row * 24 + j] = a;
        }
    }
}
__device__ __forceinline__ void phase_compress(const Params& prm, int layer, float* lds) {
    LAUNDER_S(layer);
    PH_COMMON
    const bf16_t* P = (const bf16_t*)(ws + WS_P); float* cmpkv = (float*)(ws + WS_CMP);
    const float* cpos = prm.cmp_pos + layer * 2 * 32 * 64;
    const float* cw1 = prm.cmp_w1 + (size_t)layer * 2 * 2048 * 128;
    const float* cw2 = prm.cmp_w2 + (size_t)layer * 2 * 128 * 64;
    for (int item = blockIdx.x; item < 2 * NB * 2 * NCMP; item += G) {
        const int c = item % NCMP, g = (item / NCMP) & 1, b = (item / (NCMP * 2)) % NB, which = item / (NCMP * 2 * NB);
        const int j = tid & 127, part = tid >> 7;
        const bf16_t* VT = (const bf16_t*)(ws + WS_VT);
        const bf16_t* src = which ? VT + (size_t)(VR_AVC + g * 64) * M + (size_t)(b * S + 16 * c) : P + (size_t)(b * S + 16 * c) * LDP + C_AKC + g * 64;
        const size_t sl = which ? 1 : LDP, sd = which ? M : 1;
        const float* pos = cpos + which * 32 * 64;
        const float* w1 = cw1 + (size_t)which * 2048 * 128;
        float a = 0.f;
        for (int l = part * 8; l < part * 8 + 8; ++l)
            for (int d = 0; d < 64; ++d) a += (bf2f(src[(size_t)l * sl + (size_t)d * sd]) + pos[l * 64 + d]) * w1[(size_t)(l * 64 + d) * 128 + j];
        lds[part * 128 + j] = a;
        __syncthreads();
        if (tid < 128) lds[512 + tid] = silu((lds[tid] + lds[128 + tid]) + (lds[256 + tid] + lds[384 + tid]));
        __syncthreads();
        if (tid < 64) {
            const float* w2 = cw2 + which * 128 * 64;
            float o = 0.f;
            for (int jj = 0; jj < 128; ++jj) o += lds[512 + jj] * w2[jj * 64 + tid];
            cmpkv[(((size_t)which * NB + b) * 2 + g) * 128 * 64 + c * 64 + tid] = o;
        }
        __syncthreads();
    }
}
__device__ __forceinline__ void phase_mixers(const Params& prm, int layer, float* lds) {
    LAUNDER_S(layer);
    PH_COMMON
    const float* biasd = (const float*)(ws + WS_BIASD); const float* GT = (const float*)(ws + WS_G); const float* cmpkv = (const float*)(ws + WS_CMP);
    const bf16_t* P = (const bf16_t*)(ws + WS_P); bf16_t* MIX = (bf16_t*)(ws + WS_MIX); const bf16_t* VT = (const bf16_t*)(ws + WS_VT);
    const float* convw = prm.conv_w + layer * 3 * 512;
    const float* sinks = prm.sinks + layer * 8;
        {
            {
                typedef unsigned u32x4_t __attribute__((ext_vector_type(4)));
                const u32x4_t* src = (const u32x4_t*)(ws + WS_IMG + 8 * 2048 * 4); LAS u32x4_t* dst = (LAS u32x4_t*)((LAS unsigned char*)lds + OFF_TD);
                for (int i = tid; i < 65536 / 16; i += NT) dst[i] = src[i];
                __syncthreads();
            }
            float* qs = lds + wib * 512;
            float* pc = qs + 256;
            constexpr int NA = NB * 2 * S, NBi = NB * 2 * S, ND = NB * 8 * S;
            (void)ND;
            for (int pr = gwave; pr < NB * 8 * 32; pr += gwaves) {
                const int bh = pr >> 5, qa = pr & 31;
                unit_D(P, VT, MIX, (const LAS float*)((LAS unsigned char*)lds + OFF_TD), bh >> 3, bh & 7, qa, lane);
                unit_D(P, VT, MIX, (const LAS float*)((LAS unsigned char*)lds + OFF_TD), bh >> 3, bh & 7, 63 - qa, lane);
            }
            for (int item = gwave; item < NA + NBi; item += gwaves) {
                if (item < NA) {
                    const int t = item % S, g = (item / S) & 1, b = item / (2 * S);
                    const size_t row = (size_t)b * S + t;
                    const bf16_t* Pb = P + (size_t)b * S * LDP;
#pragma unroll
                    for (int h = 0; h < 4; ++h) qs[h * 64 + lane] = bf2f(P[row * LDP + C_AQ + (g * 4 + h) * 64 + lane]);
                    LDS_FENCE();
                    const float* bd = biasd + (g * 4) * 2048;
                    const float* kc = cmpkv + (((size_t)0 * NB + b) * 2 + g) * 128 * 64;
                    const float* vc = cmpkv + (((size_t)1 * NB + b) * 2 + g) * 128 * 64;
                    const int ncv = t >= 31 ? (t - 31) / 16 + 1 : 0;
                    float ocmp[4] = {0.f, 0.f, 0.f, 0.f};
                    float psum0 = 0.f, psum1 = 0.f;
                    if (ncv > 0) {
                        float s0[4], s1[4], p0[4], p1[4];
                        const bool v0 = lane < ncv, v1 = lane + 64 < ncv;
                        score_chunk<4, float>(kc, 64, lane, v0, v0 ? t - 31 - 16 * lane : 0, qs, bd, s0);
                        score_chunk<4, float>(kc, 64, lane + 64, v1, v1 ? t - 31 - 16 * (lane + 64) : 0, qs, bd, s1);
#pragma unroll
                        for (int h = 0; h < 4; ++h) {
                            const float mx = wave_max(fmaxf(s0[h], s1[h]));
                            const float e0 = v0 ? __expf(s0[h] - mx) : 0.f, e1 = v1 ? __expf(s1[h] - mx) : 0.f;
                            const float inv = 1.f / fmaxf(wave_sum(e0 + e1), 1e-30f);
                            p0[h] = e0 * inv; p1[h] = e1 * inv; psum0 += p0[h]; psum1 += p1[h];
                        }
                        pv_chunk<4, float>(vc, 64, 1, 0, 1, 0, ncv < 64 ? ncv : 64, p0, ocmp, lane);
                        if (ncv > 64) pv_chunk<4, float>(vc, 64, 1, 64, 1, 0, ncv - 64, p1, ocmp, lane);
                    }
                    pc[lane] = psum0; pc[64 + lane] = psum1;
                    LDS_FENCE();
                    const int cur = t >> 6;
                    float imp = -INFINITY;
                    if (lane < 32) {
                        float a = 0.f;
#pragma unroll
                        for (int c = -1; c <= 3; ++c) { const int cc = 4 * lane + c; if (cc >= 0 && cc < NCMP) a += pc[cc]; }
                        const bool forced = lane == 0 || lane == cur || lane == cur - 1;
                        imp = lane > cur ? -1e30f : (forced ? 1e4f : a);
                    }
                    unsigned selmask = 0u;
#pragma unroll 1
                    for (int r = 0; r < 8; ++r) {
                        const float mx = wave_max(imp);
                        const unsigned long long bal = __ballot(imp == mx);
                        const int win = __ffsll((long long)bal) - 1;
                        selmask |= 1u << win;
                        if (lane == win) imp = -INFINITY;
                    }
                    LDS_FENCE();
                    float m[4], l[4], osel[4];
#pragma unroll
                    for (int h = 0; h < 4; ++h) { m[h] = -INFINITY; l[h] = 0.f; osel[h] = 0.f; }
                    for (int n = 0; n <= cur; ++n) {
                        if (!((selmask >> n) & 1u)) continue;
                        const int j1 = (t - 64 * n + 1) < 64 ? (t - 64 * n + 1) : 64;
                        attend_chunk<4, bf16_t>(Pb + C_AKS + g * 64, VT + (size_t)(VR_AVS + g * 64) * M + (size_t)b * S, LDP, 64 * n, 1, 0, j1, t - 64 * n, -1, qs, bd, m, l, osel, lane);
                    }
#pragma unroll
                    for (int h = 0; h < 4; ++h) osel[h] = osel[h] / fmaxf(l[h], 1e-30f);
                    float owin[4];
#pragma unroll
                    for (int h = 0; h < 4; ++h) { m[h] = -INFINITY; l[h] = 0.f; owin[h] = 0.f; }
                    {
                        const int lo = t - 511 > 0 ? t - 511 : 0;
                        for (int k0 = lo; k0 <= t; k0 += 64) {
                            const int j1 = (t - k0 + 1) < 64 ? (t - k0 + 1) : 64;
                            attend_chunk<4, bf16_t>(Pb + C_AKW + g * 64, VT + (size_t)(VR_AVW + g * 64) * M + (size_t)b * S, LDP, k0, 1, 0, j1, t - k0, -1, qs, bd, m, l, owin, lane);
                        }
                    }
#pragma unroll
                    for (int h = 0; h < 4; ++h) {
                        const int hh = g * 4 + h;
                        const float g0 = sigmoidf(GT[row * 24 + 0 * 8 + hh]), g1 = sigmoidf(GT[row * 24 + 1 * 8 + hh]), g2 = sigmoidf(GT[row * 24 + 2 * 8 + hh]);
                        const float oa = g0 * ocmp[h] + g1 * osel[h] + g2 * (owin[h] / l[h]);
                        const float gate = bf2f(P[row * LDP + C_AGATE + hh * 64 + lane]);
                        MIX[row * DM + hh * 64 + lane] = f2bf(oa * silu(gate));
                    }
                } else if (item < NA + NBi) {
                    const int it = item - NA;
                    const int t = it % S, g = (it / S) & 1, b = it / (2 * S);
                    const size_t row = (size_t)b * S + t;
                    const bf16_t* Pb = P + (size_t)b * S * LDP;
#pragma unroll
                    for (int h = 0; h < 4; ++h) qs[h * 64 + lane] = bf2f(P[row * LDP + C_BQ + (g * 4 + h) * 64 + lane]);
                    LDS_FENCE();
                    const float* bd = biasd + (8 + g * 4) * 2048;
                    float m[4], l[4], o[4];
#pragma unroll
                    for (int h = 0; h < 4; ++h) { m[h] = -INFINITY; l[h] = 0.f; o[h] = 0.f; }
                    const int lo = t - 127 > 0 ? t - 127 : 0;
                    for (int k0 = lo; k0 <= t; k0 += 64) {
                        const int j1 = (t - k0 + 1) < 64 ? (t - k0 + 1) : 64;
                        attend_chunk<4, bf16_t>(Pb + C_BK + g * 64, VT + (size_t)(VR_BV + g * 64) * M + (size_t)b * S, LDP, k0, 1, 0, j1, t - k0, -1, qs, bd, m, l, o, lane);
                    }
                    LDS_FENCE();
#pragma unroll
                    for (int h = 0; h < 4; ++h) {
                        const int hh = g * 4 + h;
                        const float den = l[h] + __expf(sinks[hh] - m[h]);
                        const float gate = bf2f(P[row * LDP + C_BGATE + hh * 64 + lane]);
                        MIX[row * DM + 512 + hh * 64 + lane] = f2bf(o[h] / den * silu(gate));
                    }
                }
            }
            for (int i = gtid; i < M * 512; i += gthreads) {
                const int c = i & 511, row = i >> 9, t = row & (S - 1);
                const bf16_t* pr = P + (size_t)row * LDP;
                float y = convw[2 * 512 + c] * bf2f(pr[C_CC + c]) * bf2f(pr[C_CH + c]);
                if (t >= 1) y += convw[1 * 512 + c] * bf2f(pr[C_CC + c - LDP]) * bf2f(pr[C_CH + c - LDP]);
                if (t >= 2) y += convw[0 * 512 + c] * bf2f(pr[C_CC + c - 2 * LDP]) * bf2f(pr[C_CH + c - 2 * LDP]);
                MIX[(size_t)row * DM + 1024 + c] = f2bf(bf2f(pr[C_CB + c]) * y * silu(bf2f(pr[C_CGATE + c])));
            }
        }

}
__device__ __forceinline__ void phase_xb(const Params& prm) {
    PH_COMMON
    bf16_t* XB = (bf16_t*)(ws + WS_XB);
    for (int row = gwave; row < M; row += gwaves) rms_row_to_bf16(prm.out + (size_t)row * DM, XB + (size_t)row * DM, lane);
}
__device__ __forceinline__ void phase_final(const Params& prm) {
    PH_COMMON
    for (int row = gwave; row < M; row += gwaves) {
        float4* xr = (float4*)(prm.out + (size_t)row * DM);
        float4 v[8]; float s = 0.f;
#pragma unroll
        for (int j = 0; j < 8; ++j) { v[j] = xr[lane + 64 * j]; s += v[j].x * v[j].x + v[j].y * v[j].y + v[j].z * v[j].z + v[j].w * v[j].w; }
        s = wave_sum(s);
        const float r = rsqrtf(s * (1.f / DM) + 1e-6f);
#pragma unroll
        for (int j = 0; j < 8; ++j) { const float4 w = ((const float4*)prm.final_norm_w)[lane + 64 * j];
            xr[lane + 64 * j] = make_float4(v[j].x * r * w.x, v[j].y * r * w.y, v[j].z * r * w.z, v[j].w * r * w.w); }
    }
}

__global__ void __launch_bounds__(NT, 2) fwd_kernel(Params prm) {
    cg::grid_group grid = cg::this_grid();
    extern __shared__ __attribute__((aligned(16))) unsigned char lds_raw[];
    LAS unsigned char* ldsb = (LAS unsigned char*)lds_raw;
    float* lds = (float*)lds_raw;
    phase_prologue(prm, ldsb);
    grid.sync();
#pragma unroll
    for (int layer = 0; layer < DEPTH; ++layer) {
        phase_inproj(prm, layer, ldsb);
        phase_gates(prm, layer);
        grid.sync();
        phase_compress(prm, layer, lds);
        grid.sync();
        phase_mixers(prm, layer, lds);
        grid.sync();
        phase_outproj(prm, layer, ldsb);
        grid.sync();
        if (layer + 1 < DEPTH) { phase_xb(prm); grid.sync(); }
    }
    phase_final(prm);
}

extern "C" void kernel_launch(void* const* d_in, const int* in_sizes, int n_in, void* d_out, int out_size, void* d_ws, size_t ws_size, hipStream_t stream) {
    static int grid_blocks = 0;
    if (!grid_blocks) {
        int dev = 0, cus = 0, per_cu = 0;
        (void)hipGetDevice(&dev);
        (void)hipDeviceGetAttribute(&cus, hipDeviceAttributeMultiprocessorCount, dev);
        if (hipFuncSetAttribute((const void*)fwd_kernel, hipFuncAttributeMaxDynamicSharedMemorySize, LDS_BYTES) != hipSuccess) fprintf(stderr, "kernel_launch: hipFuncSetAttribute failed\n");
        (void)hipOccupancyMaxActiveBlocksPerMultiprocessor(&per_cu, fwd_kernel, NT, LDS_BYTES);
        if (per_cu < 1) fprintf(stderr, "kernel_launch: occupancy query says %d blocks per CU\n", per_cu);
        grid_blocks = cus;
        if (ws_size < WS_END) fprintf(stderr, "kernel_launch: workspace too small: %zu < %zu\n", ws_size, (size_t)WS_END);
    }
    Params p{};
    p.x = (const float*)d_in[0]; p.norm_w = (const float*)d_in[1]; p.w_in = (const float*)d_in[2]; p.w_out = (const float*)d_in[3];
    p.conv_w = (const float*)d_in[4]; p.sinks = (const float*)d_in[5]; p.cmp_pos = (const float*)d_in[6]; p.cmp_w1 = (const float*)d_in[7];
    p.cmp_w2 = (const float*)d_in[8]; p.rel_bias = (const float*)d_in[9]; p.final_norm_w = (const float*)d_in[10];
    p.out = (float*)d_out; p.ws = (unsigned char*)d_ws;
    void* args[] = {&p};
    hipError_t e = hipLaunchCooperativeKernel((void*)fwd_kernel, dim3(grid_blocks), dim3(NT), args, LDS_BYTES, stream);
    if (e != hipSuccess) fprintf(stderr, "cooperative launch failed: %s (grid %d)\n", hipGetErrorString(e), grid_blocks);
}
```

```cpp
#include <hip/hip_runtime.h>
#include <hip/hip_cooperative_groups.h>
#include <cstdio>
#include <cstdint>
namespace cg = cooperative_groups;

namespace pg8 {
#define PG8_LAS __attribute__((address_space(3)))
typedef unsigned short bf16_t;
typedef short bf16x8 __attribute__((ext_vector_type(8)));
typedef float f32x4 __attribute__((ext_vector_type(4)));
typedef unsigned u32x4 __attribute__((ext_vector_type(4)));
constexpr int BM = 256, BK = 64, HALF = 128, HTB = HALF * BK * 2  , STAGE_BYTES = 8 * HTB, NXCD = 8, WGM = 8;

__host__ __device__ __forceinline__ int lds_byte(int r, int c) { const int st = (r >> 4) * 2 + (c >> 5), rr = r & 15, cc = c & 31, ob = rr * 64 + cc * 2; return st * 1024 + (ob ^ (((ob >> 9) & 1) << 5)); }
__host__ __device__ __forceinline__ void stage_rc(int b, int& R, int& C) { const int st = b / 1024, sb = b % 1024, swz = sb ^ (((sb >> 9) & 1) << 5); R = (st >> 1) * 16 + swz / 64; C = (st & 1) * 32 + (swz % 64) / 2; }
__host__ __device__ __forceinline__ int perm32(int rho) { const int n = rho >> 4, i = rho & 15; return 8 * (i >> 2) + 4 * n + (i & 3); }

struct Unit { int pm, pn; };
struct Gemm { const bf16_t* A; const bf16_t* Bt; int M, N, K; };

struct StaticOrder {
    int nM, nN, nwg, G, c;
    __host__ __device__ void init(int M, int N, int G_, int c_) { nM = M / BM; nN = N / BM; nwg = nM * nN; G = G_; c = c_; }
    __host__ __device__ bool next(int i, Unit& u) const {
        const long L = (long)i * G + c; if (L >= nwg) return false;
        int wgid = (int)L; { const int q = nwg / NXCD, r = nwg % NXCD, xcd = wgid % NXCD, off = wgid / NXCD; wgid = (xcd < r ? xcd * (q + 1) : r * (q + 1) + (xcd - r) * q) + off; }
        const int nig = WGM * nN, gid = wgid / nig, fm = gid * WGM, gsz = (nM - fm) < WGM ? (nM - fm) : WGM;
        u.pm = fm + ((wgid % nig) % gsz); u.pn = (wgid % nig) / gsz; return true;
    }
    __device__ __forceinline__ void a_ready(const Unit&) const {}
    __device__ __forceinline__ void done(const Unit&) const {}
};


__device__ __forceinline__ unsigned cvt_pk_bf16(float lo, float hi) { unsigned r; asm volatile("v_cvt_pk_bf16_f32 %0, %1, %2" : "=v"(r) : "v"(lo), "v"(hi)); return r; }
struct EpiBf16 {
    static constexpr bool PERM = true, AFTER_DRAIN = false;
    bf16_t* O; int ldc;
    __device__ __forceinline__ void operator()(const f32x4 (&acc)[2][2][4][2], const Unit& u, int wr, int wc, int fr, int fq) const {
        const int row0 = u.pm * BM + wr * 64 + fr; const int col0 = u.pn * BM + wc * 32 + 8 * fq;
#pragma unroll
        for (int ai = 0; ai < 2; ++ai)
#pragma unroll
            for (int m = 0; m < 4; ++m) { bf16_t* rowp = O + (size_t)(row0 + ai * HALF + m * 16) * ldc + col0;
#pragma unroll
                for (int bj = 0; bj < 2; ++bj) { const f32x4 v0 = acc[ai][bj][m][0], v1 = acc[ai][bj][m][1];
                    u32x4 w; w.x = cvt_pk_bf16(v0[0], v0[1]); w.y = cvt_pk_bf16(v0[2], v0[3]); w.z = cvt_pk_bf16(v1[0], v1[1]); w.w = cvt_pk_bf16(v1[2], v1[3]);
                    *(u32x4*)(rowp + bj * HALF) = w; } }
    }
};
struct EpiResid {
    static constexpr bool PERM = false, AFTER_DRAIN = false;
    const float* base; float* out; int ldc;
    __device__ __forceinline__ void operator()(const f32x4 (&acc)[2][2][4][2], const Unit& u, int wr, int wc, int fr, int fq) const {
        const int col0 = u.pn * BM + wc * 32 + 4 * fq;
#pragma unroll
        for (int ai = 0; ai < 2; ++ai)
#pragma unroll
            for (int m = 0; m < 4; ++m) { const size_t off = (size_t)(u.pm * BM + ai * HALF + wr * 64 + m * 16 + fr) * ldc + col0;
#pragma unroll
                for (int bj = 0; bj < 2; ++bj)
#pragma unroll
                    for (int n = 0; n < 2; ++n) { const f32x4 bs = *(const f32x4*)(base + off + bj * HALF + n * 16); *(f32x4*)(out + off + bj * HALF + n * 16) = bs + acc[ai][bj][m][n]; } }
    }
};

template <class Epi, class Sched, bool ALIGN_EPI = false, bool SP2 = false>
__device__ __forceinline__ void gemm_phase(PG8_LAS unsigned char* lds, const Gemm g, const Sched& S, const Epi& E) {
    int tid_ = threadIdx.x; asm volatile("" : "+v"(tid_));
    const int tid = tid_, wid = __builtin_amdgcn_readfirstlane(tid >> 6), lane = tid & 63, wr = wid >> 2, wc = wid & 3, fr = lane & 15, fq = lane >> 4;
    const int K = g.K, nt = K / BK;
    unsigned voffA[2], voffB[2];
#pragma unroll
    for (int i = 0; i < 2; ++i) { int R, C; stage_rc(tid * 16 + i * 8192, R, C); const int Rb = Epi::PERM ? ((R & ~31) + perm32(R & 31)) : R;
        voffA[i] = (unsigned)(R * K + C) * 2u; voffB[i] = (unsigned)(Rb * K + C) * 2u; }
    const size_t kstep = (size_t)(BK * 2);
    const size_t hstep = (size_t)HALF * K * 2;
    const size_t tstep = 2 * hstep;
    const unsigned ldsw = (unsigned)wid * 1024u;
    const unsigned ldsm0 = __builtin_amdgcn_readfirstlane((unsigned)(unsigned long long)lds + ldsw);
    const int aoff = lds_byte(wr * 64 + fr, fq * 8), boff = lds_byte(wc * 32 + fr, fq * 8);
#define PG8_SA(b, h) (((b) * 2 + (h)) * HTB)
#define PG8_SB(b, h) ((4 + (b) * 2 + (h)) * HTB)
#define PG8_STAGE(bufoff, gbase, voff) do { _Pragma("unroll") for (int _i = 0; _i < 2; ++_i) \
        asm volatile("s_mov_b32 m0, %0\n\ts_nop 0\n\tglobal_load_lds_dwordx4 %1, %2" :: "s"(ldsm0 + (unsigned)((bufoff) + _i * 8192)), "v"((voff)[_i]), "s"((const char*)(gbase)) : "m0", "memory"); } while (0)
#define PG8_LDA(dst, b, h) do { _Pragma("unroll") for (int m = 0; m < 4; ++m) _Pragma("unroll") for (int k = 0; k < 2; ++k) dst[m][k] = *(const PG8_LAS bf16x8*)(lds + PG8_SA(b, h) + aoff + m * 2048 + k * 1024); } while (0)
#define PG8_LDB(dst, b, h) do { _Pragma("unroll") for (int n = 0; n < 2; ++n) _Pragma("unroll") for (int k = 0; k < 2; ++k) dst[n][k] = *(const PG8_LAS bf16x8*)(lds + PG8_SB(b, h) + boff + n * 2048 + k * 1024); } while (0)
#define PG8_MMA(ai, bj, At, Bt) do { __builtin_amdgcn_s_setprio(1); _Pragma("unroll") for (int m = 0; m < 4; ++m) _Pragma("unroll") for (int n = 0; n < 2; ++n) _Pragma("unroll") for (int k = 0; k < 2; ++k) \
        acc[ai][bj][m][n] = __builtin_amdgcn_mfma_f32_16x16x32_bf16(Bt[n][k], At[m][k], acc[ai][bj][m][n], 0, 0, 0); __builtin_amdgcn_s_setprio(0); } while (0)
#define PG8_WAIT_V(n) asm volatile("s_waitcnt vmcnt(" #n ")" ::: "memory")
#define PG8_WAIT_L(n) asm volatile("s_waitcnt lgkmcnt(" #n ")" ::: "memory")
#define PG8_BAR __builtin_amdgcn_s_barrier()
#define PG8_SCHED __builtin_amdgcn_sched_barrier(0)
    Unit cur, nxt; int ui = 0;
    if (!S.next(0, cur)) return;
    f32x4 acc[2][2][4][2];
#pragma unroll
    for (int a = 0; a < 2; ++a)
#pragma unroll
        for (int b = 0; b < 2; ++b)
#pragma unroll
            for (int m = 0; m < 4; ++m)
#pragma unroll
                for (int n = 0; n < 2; ++n) acc[a][b][m][n] = (f32x4){0.f, 0.f, 0.f, 0.f};
    bf16x8 At[4][2], B0[2][2], B1[2][2];
    const char* cA = (const char*)g.A + (size_t)cur.pm * tstep; const char* cB = (const char*)g.Bt + (size_t)cur.pn * tstep;
    S.a_ready(cur);
    if constexpr (SP2) {
        PG8_STAGE(PG8_SB(0, 0), cB, voffB); PG8_STAGE(PG8_SB(0, 1), cB + hstep, voffB); PG8_STAGE(PG8_SA(0, 0), cA, voffA); PG8_STAGE(PG8_SA(0, 1), cA + hstep, voffA);
        if (wr == 1) PG8_BAR;
        PG8_WAIT_V(2); PG8_BAR;
        PG8_STAGE(PG8_SB(1, 0), cB + kstep, voffB); PG8_STAGE(PG8_SA(1, 0), cA + kstep, voffA); PG8_STAGE(PG8_SB(1, 1), cB + hstep + kstep, voffB);
        PG8_WAIT_V(6); PG8_BAR;
    } else {
        PG8_STAGE(PG8_SB(0, 0), cB, voffB); PG8_STAGE(PG8_SA(0, 0), cA, voffA); PG8_STAGE(PG8_SB(0, 1), cB + hstep, voffB); PG8_STAGE(PG8_SA(0, 1), cA + hstep, voffA);
        if (wr == 1) PG8_BAR;
        PG8_WAIT_V(4); PG8_BAR;
        PG8_STAGE(PG8_SB(1, 0), cB + kstep, voffB); PG8_STAGE(PG8_SA(1, 0), cA + kstep, voffA); PG8_STAGE(PG8_SB(1, 1), cB + hstep + kstep, voffB);
        PG8_WAIT_V(6); PG8_BAR;
    }
    for (;;) {
        const bool has_next = S.next(ui + 1, nxt);
        const char* nA = has_next ? (const char*)g.A + (size_t)nxt.pm * tstep : cA; const char* nB = has_next ? (const char*)g.Bt + (size_t)nxt.pn * tstep : cB;
        for (int t = 0; t < nt; t += 2) {
            const bool last = (t == nt - 2);
            const char* a1 = cA + (size_t)(t + 1) * kstep;
            const char* a2 = last ? nA : cA + (size_t)(t + 2) * kstep; const char* b2 = last ? nB : cB + (size_t)(t + 2) * kstep;
            const char* a3 = a2 + kstep; const char* b3 = b2 + kstep;
            if (last && has_next) S.a_ready(nxt);
            if constexpr (SP2) {
            PG8_LDB(B0, 0, 0); PG8_LDB(B1, 0, 1); PG8_SCHED; PG8_LDA(At, 0, 0); PG8_STAGE(PG8_SA(1, 1), a1 + hstep, voffA);
            PG8_WAIT_V(8); PG8_WAIT_L(0); PG8_BAR; PG8_MMA(0, 0, At, B0); PG8_MMA(0, 1, At, B1); PG8_BAR; PG8_SCHED;
            PG8_LDA(At, 0, 1); PG8_STAGE(PG8_SB(0, 0), b2, voffB); PG8_STAGE(PG8_SB(0, 1), b2 + hstep, voffB); PG8_STAGE(PG8_SA(0, 0), a2, voffA);
            PG8_WAIT_V(8); PG8_WAIT_L(0); PG8_BAR; PG8_MMA(1, 0, At, B0); PG8_MMA(1, 1, At, B1); PG8_BAR; PG8_SCHED;
            PG8_LDB(B0, 1, 0); PG8_LDB(B1, 1, 1); PG8_SCHED; PG8_LDA(At, 1, 0); PG8_STAGE(PG8_SA(0, 1), a2 + hstep, voffA);
            PG8_WAIT_V(8); PG8_WAIT_L(0); PG8_BAR; PG8_MMA(0, 0, At, B0); PG8_MMA(0, 1, At, B1); PG8_BAR; PG8_SCHED;
            PG8_LDA(At, 1, 1); PG8_STAGE(PG8_SB(1, 0), b3, voffB); PG8_STAGE(PG8_SB(1, 1), b3 + hstep, voffB); PG8_STAGE(PG8_SA(1, 0), a3, voffA);
            PG8_WAIT_V(8); PG8_WAIT_L(0); PG8_BAR; PG8_MMA(1, 0, At, B0); PG8_MMA(1, 1, At, B1); PG8_BAR; PG8_SCHED;
            } else {
            PG8_LDB(B0, 0, 0); PG8_SCHED; PG8_LDA(At, 0, 0); PG8_STAGE(PG8_SA(1, 1), a1 + hstep, voffA);
            PG8_WAIT_L(8); PG8_BAR; PG8_WAIT_L(0); PG8_MMA(0, 0, At, B0); PG8_BAR; PG8_SCHED;
            PG8_LDB(B1, 0, 1); PG8_STAGE(PG8_SB(0, 0), b2, voffB);
            PG8_BAR; PG8_WAIT_L(0); PG8_MMA(0, 1, At, B1); PG8_BAR;
            PG8_LDA(At, 0, 1); PG8_STAGE(PG8_SA(0, 0), a2, voffA);
            PG8_BAR; PG8_WAIT_L(0); PG8_MMA(1, 0, At, B0); PG8_BAR; PG8_SCHED;
            PG8_STAGE(PG8_SB(0, 1), b2 + hstep, voffB);
            PG8_WAIT_V(6); PG8_BAR; PG8_MMA(1, 1, At, B1); PG8_BAR;
            PG8_LDB(B0, 1, 0); PG8_SCHED; PG8_LDA(At, 1, 0); PG8_STAGE(PG8_SA(0, 1), a2 + hstep, voffA);
            PG8_WAIT_L(8); PG8_BAR; PG8_WAIT_L(0); PG8_MMA(0, 0, At, B0); PG8_BAR; PG8_SCHED;
            PG8_LDB(B1, 1, 1); PG8_STAGE(PG8_SB(1, 0), b3, voffB);
            PG8_BAR; PG8_WAIT_L(0); PG8_MMA(0, 1, At, B1); PG8_BAR;
            PG8_LDA(At, 1, 1); PG8_STAGE(PG8_SA(1, 0), a3, voffA);
            PG8_BAR; PG8_WAIT_L(0); PG8_MMA(1, 0, At, B0); PG8_BAR; PG8_SCHED;
            PG8_STAGE(PG8_SB(1, 1), b3 + hstep, voffB);
            PG8_WAIT_V(6); PG8_BAR; PG8_MMA(1, 1, At, B1); PG8_BAR;
            }
        }
        if constexpr (ALIGN_EPI) { if (wr == 0) PG8_BAR; }
        if constexpr (!Epi::AFTER_DRAIN) { E(acc, cur, wr, wc, fr, fq); S.done(cur); }
        if (!has_next) break;
#pragma unroll
        for (int a = 0; a < 2; ++a)
#pragma unroll
            for (int b = 0; b < 2; ++b)
#pragma unroll
                for (int m = 0; m < 4; ++m)
#pragma unroll
                    for (int n = 0; n < 2; ++n) acc[a][b][m][n] = (f32x4){0.f, 0.f, 0.f, 0.f};
        cur = nxt; cA = nA; cB = nB; ++ui;
        if constexpr (ALIGN_EPI) { if (wr == 1) PG8_BAR; }
    }
    PG8_WAIT_V(0);
    if constexpr (!ALIGN_EPI) { if (wr == 0) PG8_BAR; }
    PG8_BAR;
    if constexpr (Epi::AFTER_DRAIN) { E.fused(acc, cur, wr, wc, fr, fq, lds, wid, lane); S.done(cur); }
#undef PG8_SA
#undef PG8_SB
#undef PG8_STAGE
#undef PG8_LDA
#undef PG8_LDB
#undef PG8_MMA
#undef PG8_WAIT_V
#undef PG8_WAIT_L
#undef PG8_BAR
#undef PG8_SCHED
}
}

typedef unsigned short bf16_t;
#define LAS __attribute__((address_space(3)))
constexpr int DM = 2048, NB = 8, S = 2048, M = NB * S, DIN = 7192, DEPTH = 2, LDP = 6144, NVT = 1024, NW_IN = LDP + NVT;
constexpr int NWAVES = 8, NT = NWAVES * 64;
constexpr int C_AQ = 0, C_AKC = 512, C_AKS = 640, C_AKW = 768, C_AGATE = 896;
constexpr int C_BQ = 1408, C_BK = 1920, C_BGATE = 2048;
constexpr int C_CB = 2560, C_CC = 3072, C_CH = 3584, C_CGATE = 4096;
constexpr int C_DQ = 4608, C_DK = 5120, C_DGATE = 5632;
constexpr int VR_AVC = 0, VR_AVS = 128, VR_AVW = 256, VR_BV = 384, VR_DV = 512;
__host__ __device__ __forceinline__ int src_col_of(int n) {
    if (n < 640) return n;
    if (n < 768) return n - 640 + 768;
    if (n < 896) return n - 768 + 1024;
    if (n < 1408) return n - 896 + 1304;
    if (n < 1920) return n - 1408 + 1816;
    if (n < 2048) return n - 1920 + 2328;
    if (n < 2560) return n - 2048 + 2584;
    if (n < 4608) return n - 2560 + 3096;
    if (n < 5120) return n - 4608 + 5144;
    if (n < 5632) return n - 5120 + 5656;
    if (n < 6144) return n - 5632 + 6680;
    if (n < 6272) return n - 6144 + 640;
    if (n < 6400) return n - 6272 + 896;
    if (n < 6528) return n - 6400 + 1152;
    if (n < 6656) return n - 6528 + 2456;
    return n - 6656 + 6168;
}
constexpr int SRC_GATES = 1280;
constexpr int NCMP = 127;

constexpr size_t MiB = 1u << 20;
constexpr size_t WS_BIASD = 1 * MiB;
constexpr size_t WS_IMG = 1 * MiB + 512 * 1024;
constexpr size_t WS_G = 2 * MiB;
constexpr size_t WS_WG = 4 * MiB;
constexpr size_t WS_CMP = 5 * MiB;
constexpr size_t WS_WIN = 8 * MiB;
constexpr size_t WS_WOUT = 64 * MiB;
constexpr size_t WS_XB = 80 * MiB;
constexpr size_t WS_MIX = 144 * MiB;
constexpr size_t WS_P = 208 * MiB;
constexpr size_t WS_VT = 400 * MiB;
constexpr size_t WS_END = 432 * MiB;
constexpr int LDS_BYTES = 147456;

struct Params {
    const float* x; const float* norm_w; const float* w_in; const float* w_out; const float* conv_w; const float* sinks;
    const float* cmp_pos; const float* cmp_w1; const float* cmp_w2; const float* rel_bias; const float* final_norm_w;
    float* out; unsigned char* ws;
};

__device__ __forceinline__ float bf2f(bf16_t v) { return __uint_as_float(((unsigned)v) << 16); }
__device__ __forceinline__ unsigned f2bfu(float f) { unsigned u = __float_as_uint(f); return (u + 0x7fffu + ((u >> 16) & 1u)) >> 16; }
__device__ __forceinline__ bf16_t f2bf(float f) { return (bf16_t)f2bfu(f); }
__device__ __forceinline__ unsigned pk2(float lo, float hi) { return f2bfu(lo) | (f2bfu(hi) << 16); }
__device__ __forceinline__ float wave_sum(float v) {
#pragma unroll
    for (int o = 32; o > 0; o >>= 1) v += __shfl_xor(v, o);
    return v;
}
__device__ __forceinline__ float wave_max(float v) {
#pragma unroll
    for (int o = 32; o > 0; o >>= 1) v = fmaxf(v, __shfl_xor(v, o));
    return v;
}
__device__ __forceinline__ float silu(float v) { return v / (1.f + __expf(-v)); }
__device__ __forceinline__ float sigmoidf(float v) { return 1.f / (1.f + __expf(-v)); }
#define LDS_FENCE() asm volatile("s_waitcnt lgkmcnt(0)" ::: "memory")

__device__ __forceinline__ int t5_bucket(int d) {
    if (d < 16) return d < 0 ? 0 : d;
    int b = 16;
    b += (d >= 22); b += (d >= 30); b += (d >= 40); b += (d >= 54); b += (d >= 73); b += (d >= 99); b += (d >= 134); b += (d >= 182);
    b += (d >= 246); b += (d >= 332); b += (d >= 450); b += (d >= 609); b += (d >= 825); b += (d >= 1117); b += (d >= 1513);
    return b;
}

__device__ __forceinline__ void transpose_item(const float* W, int K, int srcld, int src_n0, const float* ksc, bf16_t* WT, LAS float* scr, int kb, int nb, int lane) {
    const int k0 = 64 * kb, n0 = 32 * nb;
#pragma unroll 8
    for (int i = 0; i < 32; ++i) { const int kk = 2 * i + (lane >> 5); const float sc = ksc ? ksc[k0 + kk] : 1.f; scr[kk * 33 + (lane & 31)] = W[(size_t)(k0 + kk) * srcld + src_n0 + n0 + (lane & 31)] * sc; }
    LDS_FENCE();
    const int c = lane & 7;
#pragma unroll
    for (int j = 0; j < 4; ++j) { const int n = (lane >> 3) + 8 * j; const LAS float* s = scr + (8 * c) * 33 + n;
        uint4 o; o.x = pk2(s[0 * 33], s[1 * 33]); o.y = pk2(s[2 * 33], s[3 * 33]); o.z = pk2(s[4 * 33], s[5 * 33]); o.w = pk2(s[6 * 33], s[7 * 33]);
        *(uint4*)(WT + (size_t)(n0 + n) * K + k0 + 8 * c) = o; }
    LDS_FENCE();
}
__device__ __forceinline__ void rms_row_to_bf16(const float* xrow, bf16_t* orow, int lane) {
    const float4* xr = (const float4*)xrow + lane;
    float4 v[8]; float s = 0.f;
#pragma unroll
    for (int j = 0; j < 8; ++j) { v[j] = xr[64 * j]; s += (v[j].x * v[j].x + v[j].y * v[j].y) + (v[j].z * v[j].z + v[j].w * v[j].w); }
    const float r = rsqrtf(wave_sum(s) * (1.f / DM) + 1e-6f);
    uint2* o8 = (uint2*)orow + lane;
#pragma unroll
    for (int j = 0; j < 8; ++j) o8[64 * j] = make_uint2(pk2(v[j].x * r, v[j].y * r), pk2(v[j].z * r, v[j].w * r));
}

__device__ __forceinline__ float ldval(const bf16_t* p) { return bf2f(*p); }
__device__ __forceinline__ float ldval(const float* p) { return *p; }
__device__ __forceinline__ void load8(const bf16_t* p, float (&k)[8]) {
    const uint4 w = *(const uint4*)p;
    k[0] = __uint_as_float(w.x << 16); k[1] = __uint_as_float(w.x & 0xffff0000u);
    k[2] = __uint_as_float(w.y << 16); k[3] = __uint_as_float(w.y & 0xffff0000u);
    k[4] = __uint_as_float(w.z << 16); k[5] = __uint_as_float(w.z & 0xffff0000u);
    k[6] = __uint_as_float(w.w << 16); k[7] = __uint_as_float(w.w & 0xffff0000u);
}
__device__ __forceinline__ void load8(const float* p, float (&k)[8]) {
    const float4 a = ((const float4*)p)[0], b = ((const float4*)p)[1];
    k[0] = a.x; k[1] = a.y; k[2] = a.z; k[3] = a.w; k[4] = b.x; k[5] = b.y; k[6] = b.z; k[7] = b.w;
}

template <int NH, typename KT>
__device__ __forceinline__ void score_chunk(const KT* kmat, size_t rstride, int krow, bool valid, int dist, const float* qs, const float* biasd, float (&s)[NH]) {
    float a[NH];
#pragma unroll
    for (int h = 0; h < NH; ++h) a[h] = 0.f;
    if (valid) {
        const KT* kr = kmat + (size_t)krow * rstride;
#pragma unroll 2
        for (int d8 = 0; d8 < 8; ++d8) {
            float k[8]; load8(kr + 8 * d8, k);
#pragma unroll
            for (int h = 0; h < NH; ++h) {
                const float4 q0 = ((const float4*)(qs + h * 64))[2 * d8], q1 = ((const float4*)(qs + h * 64))[2 * d8 + 1];
                a[h] += q0.x * k[0] + q0.y * k[1] + q0.z * k[2] + q0.w * k[3] + q1.x * k[4] + q1.y * k[5] + q1.z * k[6] + q1.w * k[7];
            }
        }
    }
#pragma unroll
    for (int h = 0; h < NH; ++h) s[h] = valid ? a[h] * 0.125f + biasd[h * 2048 + dist] : -INFINITY;
}
template <int NH, typename VT>
__device__ __forceinline__ void pv_chunk(const VT* vmat, size_t rstride, size_t dstride, int rbase, int rstep, int j0, int j1, const float (&p)[NH], float (&o)[NH], int lane) {
    for (int jj = j0; jj < j1; ++jj) {
        const float vv = ldval(vmat + (size_t)(rbase + jj * rstep) * rstride + (size_t)lane * dstride);
#pragma unroll
        for (int h = 0; h < NH; ++h) o[h] += __uint_as_float(__builtin_amdgcn_readlane(__float_as_uint(p[h]), jj)) * vv;
    }
}
template <int NH, typename KT>
__device__ __forceinline__ void attend_chunk(const KT* kmat, const KT* vmat  , size_t rstride, int rbase, int rstep, int j0, int j1, int dbase, int dstep,
                                             const float* qs, const float* biasd, float (&m)[NH], float (&l)[NH], float (&o)[NH], int lane) {
    if (j1 <= j0) return;
    const bool valid = lane >= j0 && lane < j1;
    float s[NH], p[NH];
    score_chunk<NH, KT>(kmat, rstride, rbase + lane * rstep, valid, dbase + lane * dstep, qs, biasd, s);
#pragma unroll
    for (int h = 0; h < NH; ++h) {
        const float cm = wave_max(s[h]);
        const float mn = fmaxf(m[h], cm);
        const float sc = __expf(m[h] - mn);
        p[h] = valid ? __expf(s[h] - mn) : 0.f;
        l[h] = l[h] * sc + wave_sum(p[h]); o[h] *= sc; m[h] = mn;
    }
    pv_chunk<NH, KT>(vmat, 1, (size_t)M, rbase, rstep, j0, j1, p, o, lane);
}


typedef short abf16x8 __attribute__((ext_vector_type(8)));
typedef float f32x16 __attribute__((ext_vector_type(16)));
constexpr float LOG2E = 1.4426950408889634f, SCL = 0.125f * 1.4426950408889634f;
constexpr int OFF_TA = 0, OFF_TB = 65536, OFF_OSC = 65536 + 8192, OFF_TD = 0;
__device__ __forceinline__ int pi32(int i) { return (i & 19) | ((i & 4) << 1) | ((i & 8) >> 1); }
__device__ __forceinline__ unsigned cvtpk(float lo, float hi) { unsigned r; asm volatile("v_cvt_pk_bf16_f32 %0, %1, %2" : "=v"(r) : "v"(lo), "v"(hi)); return r; }
struct KVF { abf16x8 k[4]; abf16x8 v[4]; };
struct Soft { float m, l; f32x16 o[2]; };
__device__ __forceinline__ void soft_init(Soft& st) {
    st.m = -INFINITY; st.l = 0.f;
#pragma unroll
    for (int r = 0; r < 16; ++r) { st.o[0][r] = 0.f; st.o[1][r] = 0.f; }
}
__device__ __forceinline__ void load_kv(KVF& f, const bf16_t* kp, size_t krs, const bf16_t* vp, size_t vhalf, int key0) {
    const bf16_t* k = kp + (size_t)key0 * krs;
#pragma unroll
    for (int s = 0; s < 4; ++s) f.k[s] = *(const abf16x8*)(k + 16 * s);
    const bf16_t* v = vp + key0;
    f.v[0] = *(const abf16x8*)(v); f.v[1] = *(const abf16x8*)(v + 16); f.v[2] = *(const abf16x8*)(v + vhalf); f.v[3] = *(const abf16x8*)(v + vhalf + 16);
}
template <bool CAUSAL, bool WIN, bool ROWSEL>
__device__ __forceinline__ void tile_step(Soft& st, const KVF& f, const abf16x8 (&qf)[4], const LAS float* tabp, int key0, int D0, int W, bool rowsel) {
    f32x16 acc;
#pragma unroll
    for (int r = 0; r < 16; ++r) acc[r] = 0.f;
#pragma unroll
    for (int s = 0; s < 4; ++s) acc = __builtin_amdgcn_mfma_f32_32x32x16_bf16(f.k[s], qf[s], acc, 0, 0, 0);
    float sv[16]; float tm = -INFINITY;
#pragma unroll
    for (int r = 0; r < 16; ++r) {
        const int ko = (r & 7) + 16 * (r >> 3);
        float x = fmaf(acc[r], SCL, tabp[key0 + ko]);
        bool ok = true;
        if (CAUSAL) ok = ok && (ko <= D0);
        if (WIN) ok = ok && (ko >= D0 - W);
        if (ROWSEL) ok = ok && rowsel;
        if (CAUSAL || WIN || ROWSEL) x = ok ? x : -INFINITY;
        sv[r] = x; tm = fmaxf(tm, x);
    }
    tm = fmaxf(tm, __shfl_xor(tm, 32));
    const float mn = fmaxf(st.m, tm);
    const float alpha = __builtin_amdgcn_exp2f(st.m - mn);
    float rs = 0.f;
#pragma unroll
    for (int r = 0; r < 16; ++r) { sv[r] = __builtin_amdgcn_exp2f(sv[r] - mn); rs += sv[r]; }
    st.l = st.l * alpha + rs; st.m = mn;
    if (__any(alpha != 1.f)) {
#pragma unroll
        for (int r = 0; r < 16; ++r) { st.o[0][r] *= alpha; st.o[1][r] *= alpha; }
    }
    abf16x8 pf[2];
#pragma unroll
    for (int s2 = 0; s2 < 2; ++s2) {
        typedef unsigned u32x4_t __attribute__((ext_vector_type(4)));
        u32x4_t w; w.x = cvtpk(sv[8 * s2 + 0], sv[8 * s2 + 1]); w.y = cvtpk(sv[8 * s2 + 2], sv[8 * s2 + 3]); w.z = cvtpk(sv[8 * s2 + 4], sv[8 * s2 + 5]); w.w = cvtpk(sv[8 * s2 + 6], sv[8 * s2 + 7]);
        pf[s2] = __builtin_bit_cast(abf16x8, w);
    }
#pragma unroll
    for (int dh = 0; dh < 2; ++dh)
#pragma unroll
        for (int s2 = 0; s2 < 2; ++s2) st.o[dh] = __builtin_amdgcn_mfma_f32_32x32x16_bf16(f.v[dh * 2 + s2], pf[s2], st.o[dh], 0, 0, 0);
}
__device__ __forceinline__ void store_rows(const f32x16 (&o)[2], float scale, const bf16_t* gp, bf16_t* op, int h) {
#pragma unroll
    for (int dh = 0; dh < 2; ++dh)
#pragma unroll
        for (int rg = 0; rg < 4; ++rg) {
            const int dim0 = 32 * dh + 8 * rg + 4 * h;
            const uint2 gw = *(const uint2*)(gp + dim0);
            const float g0 = __uint_as_float(gw.x << 16), g1 = __uint_as_float(gw.x & 0xffff0000u), g2 = __uint_as_float(gw.y << 16), g3 = __uint_as_float(gw.y & 0xffff0000u);
            uint2 w; w.x = cvtpk(o[dh][4 * rg + 0] * scale * silu(g0), o[dh][4 * rg + 1] * scale * silu(g1)); w.y = cvtpk(o[dh][4 * rg + 2] * scale * silu(g2), o[dh][4 * rg + 3] * scale * silu(g3));
            *(uint2*)(op + dim0) = w;
        }
}
__device__ __forceinline__ void unit_D(const bf16_t* P, const bf16_t* VT, bf16_t* MIX, const LAS float* tabD, int b, int head, int qt, int lane) {
    asm volatile("" : "+v"(lane));
    const int c = lane & 31, h = lane >> 5, tc = qt * 32 + c;
    const size_t rowq = (size_t)b * S + tc;
    abf16x8 qf[4];
#pragma unroll
    for (int s = 0; s < 4; ++s) qf[s] = *(const abf16x8*)(P + rowq * LDP + C_DQ + head * 64 + 16 * s + 8 * h);
    const bf16_t* kp = P + ((size_t)b * S + pi32(c)) * LDP + C_DK + head * 64 + 8 * h;
    const bf16_t* vp = VT + (size_t)(VR_DV + head * 64 + c) * M + (size_t)b * S + 8 * h;
    const LAS float* tabp = tabD + head * 2048 + (2047 - tc + 8 * h);
    Soft st; soft_init(st);
    KVF cur, nxt;
    load_kv(cur, kp, LDP, vp, (size_t)32 * M, 32 * qt);
    for (int kt = qt; kt >= 0; --kt) {
        if (kt > 0) load_kv(nxt, kp, LDP, vp, (size_t)32 * M, 32 * (kt - 1));
        const int D0 = tc - 32 * kt - 8 * h;
        if (kt == qt) tile_step<true, false, false>(st, cur, qf, tabp, 32 * kt, D0, 0, true);
        else tile_step<false, false, false>(st, cur, qf, tabp, 32 * kt, D0, 0, true);
        if (kt > 0) cur = nxt;
    }
    const float l = st.l + __shfl_xor(st.l, 32);
    store_rows(st.o, 1.f / l, P + rowq * LDP + C_DGATE + head * 64, MIX + rowq * DM + 1536 + head * 64, h);
}

__device__ __forceinline__ void unit_B(const bf16_t* P, const bf16_t* VT, bf16_t* MIX, const LAS float* tabB, const float* sinks, int b, int g, int q8, int lane) {
    asm volatile("" : "+v"(lane));
    const int c = lane & 31, h = lane >> 5, hh = c >> 3, qi = c & 7, t0 = q8 * 8, tc = t0 + qi, head = g * 4 + hh;
    const size_t rowq = (size_t)b * S + tc;
    abf16x8 qf[4];
#pragma unroll
    for (int s = 0; s < 4; ++s) qf[s] = *(const abf16x8*)(P + rowq * LDP + C_BQ + head * 64 + 16 * s + 8 * h);
    const bf16_t* kp = P + ((size_t)b * S + pi32(c)) * LDP + C_BK + g * 64 + 8 * h;
    const bf16_t* vp = VT + (size_t)(VR_BV + g * 64 + c) * M + (size_t)b * S + 8 * h;
    const LAS float* tabp = tabB + head * 256 + (255 - tc + 8 * h);
    Soft st; soft_init(st);
    const int ktd = t0 >> 5, ktlo = (t0 - 127 > 0 ? t0 - 127 : 0) >> 5;
    KVF cur, nxt;
    load_kv(cur, kp, LDP, vp, (size_t)32 * M, 32 * ktd);
    for (int kt = ktd; kt >= ktlo; --kt) {
        if (kt > ktlo) load_kv(nxt, kp, LDP, vp, (size_t)32 * M, 32 * (kt - 1));
        const int D0 = tc - 32 * kt - 8 * h;
        if (kt == ktd) tile_step<true, false, false>(st, cur, qf, tabp, 32 * kt, D0, 0, true);
        else tile_step<false, true, false>(st, cur, qf, tabp, 32 * kt, D0, 127, true);
        if (kt > ktlo) cur = nxt;
    }
    const float l = st.l + __shfl_xor(st.l, 32) + __builtin_amdgcn_exp2f(sinks[head] * LOG2E - st.m);
    store_rows(st.o, 1.f / l, P + rowq * LDP + C_BGATE + head * 64, MIX + rowq * DM + 512 + head * 64, h);
}

__device__ __forceinline__ void unit_A(const bf16_t* P, const bf16_t* VT, const bf16_t* KCMP, const bf16_t* VCMPT, const float* GT, bf16_t* MIX, const LAS float* tabA, LAS float* osc  , int b, int g, int q8, int lane) {
    asm volatile("" : "+v"(lane));
    const int c = lane & 31, h = lane >> 5, hh = c >> 3, qi = c & 7, t0 = q8 * 8, tc = t0 + qi, head = g * 4 + hh;
    const size_t rowq = (size_t)b * S + tc;
    abf16x8 qf[4];
#pragma unroll
    for (int s = 0; s < 4; ++s) qf[s] = *(const abf16x8*)(P + rowq * LDP + C_AQ + head * 64 + 16 * s + 8 * h);
    const LAS float* tabh = tabA + head * 2048;
    unsigned selmask = 0u;
    {
        const int ncv = tc >= 31 ? ((tc - 31) >> 4) + 1 : 0;
        const bf16_t* kp = KCMP + ((size_t)(b * 2 + g) * 128 + pi32(c)) * 64 + 8 * h;
        const bf16_t* vp = VCMPT + ((size_t)(b * 2 + g) * 64 + c) * 128 + 8 * h;
        const LAS float* tabp = tabh + (2047 - tc + 31 + 128 * h);
        float sc[4][16]; float mx = -INFINITY;
#pragma unroll
        for (int kt = 0; kt < 4; ++kt) {
            f32x16 acc;
#pragma unroll
            for (int r = 0; r < 16; ++r) acc[r] = 0.f;
#pragma unroll
            for (int s = 0; s < 4; ++s) acc = __builtin_amdgcn_mfma_f32_32x32x16_bf16(*(const abf16x8*)(kp + (size_t)(32 * kt) * 64 + 16 * s), qf[s], acc, 0, 0, 0);
#pragma unroll
            for (int r = 0; r < 16; ++r) {
                const int ko = (r & 7) + 16 * (r >> 3);
                const bool ok = 32 * kt + 8 * h + ko < ncv;
                const float tb = tabp[512 * kt + 16 * ko];
                const float x = ok ? fmaf(acc[r], SCL, tb) : -INFINITY;
                sc[kt][r] = x; mx = fmaxf(mx, x);
            }
            asm volatile("" ::: "memory");
        }
        mx = fmaxf(mx, __shfl_xor(mx, 32)); mx = fmaxf(mx, -1e30f);
        float sum = 0.f;
#pragma unroll
        for (int kt = 0; kt < 4; ++kt)
#pragma unroll
            for (int r = 0; r < 16; ++r) { sc[kt][r] = __builtin_amdgcn_exp2f(sc[kt][r] - mx); sum += sc[kt][r]; }
        sum += __shfl_xor(sum, 32);
        const float inv = 1.f / fmaxf(sum, 1e-30f);
        f32x16 oc[2];
#pragma unroll
        for (int r = 0; r < 16; ++r) { oc[0][r] = 0.f; oc[1][r] = 0.f; }
#pragma unroll
        for (int kt = 0; kt < 4; ++kt) {
#pragma unroll
            for (int r = 0; r < 16; ++r) sc[kt][r] *= inv;
            abf16x8 pf[2];
#pragma unroll
            for (int s2 = 0; s2 < 2; ++s2) {
                typedef unsigned u32x4_t __attribute__((ext_vector_type(4)));
                u32x4_t w; w.x = cvtpk(sc[kt][8 * s2 + 0], sc[kt][8 * s2 + 1]); w.y = cvtpk(sc[kt][8 * s2 + 2], sc[kt][8 * s2 + 3]); w.z = cvtpk(sc[kt][8 * s2 + 4], sc[kt][8 * s2 + 5]); w.w = cvtpk(sc[kt][8 * s2 + 6], sc[kt][8 * s2 + 7]);
                pf[s2] = __builtin_bit_cast(abf16x8, w);
            }
#pragma unroll
            for (int dh = 0; dh < 2; ++dh)
#pragma unroll
                for (int s2 = 0; s2 < 2; ++s2) oc[dh] = __builtin_amdgcn_mfma_f32_32x32x16_bf16(*(const abf16x8*)(vp + (size_t)dh * 32 * 128 + 32 * kt + 16 * s2), pf[s2], oc[dh], 0, 0, 0);
            asm volatile("" ::: "memory");
        }
        float x7[4], x15[4];
#pragma unroll
        for (int kt = 0; kt < 4; ++kt) { x7[kt] = __shfl_xor(sc[kt][7], 32); x15[kt] = __shfl_xor(sc[kt][15], 32); }
        unsigned key[16];
        const int cur = tc >> 6;
#pragma unroll
        for (int kt = 0; kt < 4; ++kt)
#pragma unroll
            for (int gb = 0; gb < 2; ++gb) {
                const float pl0 = gb == 0 ? (kt > 0 ? x15[kt > 0 ? kt - 1 : 0] : 0.f) : x7[kt];
                const float pl1 = gb == 0 ? x7[kt] : x15[kt];
                const float prevlast = h ? pl1 : pl0;
                float ie = prevlast + sc[kt][8 * gb + 0] + sc[kt][8 * gb + 1] + sc[kt][8 * gb + 2] + sc[kt][8 * gb + 3];
                float io = sc[kt][8 * gb + 3] + sc[kt][8 * gb + 4] + sc[kt][8 * gb + 5] + sc[kt][8 * gb + 6] + sc[kt][8 * gb + 7];
                ie += __shfl_xor(ie, 8); ie += __shfl_xor(ie, 16);
                io += __shfl_xor(io, 8); io += __shfl_xor(io, 16);
#pragma unroll
                for (int eo = 0; eo < 2; ++eo) {
                    const int n = 8 * kt + 2 * h + 4 * gb + eo;
                    const bool forced = n == 0 || n == cur || n == cur - 1;
                    const float v = forced ? 1e4f : (eo ? io : ie);
                    key[(kt * 2 + gb) * 2 + eo] = n > cur ? (unsigned)(31 - n) : ((((__float_as_uint(v) >> 5) + 1u) << 5) | (unsigned)(31 - n));
                }
            }
#pragma unroll 1
        for (int round = 0; round < 8; ++round) {
            unsigned lm = key[0];
#pragma unroll
            for (int i = 1; i < 16; ++i) lm = lm > key[i] ? lm : key[i];
            const unsigned pm = (unsigned)__shfl_xor((int)lm, 32);
            const unsigned best = lm > pm ? lm : pm;
            selmask |= 1u << (31 - (best & 31u));
#pragma unroll
            for (int i = 0; i < 16; ++i) key[i] = key[i] == best ? 0u : key[i];
        }
        const float g0 = sigmoidf(GT[rowq * 24 + 0 * 8 + head]);
#pragma unroll
        for (int r = 0; r < 16; ++r) { osc[r * 64 + lane] = oc[0][r] * g0; osc[(16 + r) * 64 + lane] = oc[1][r] * g0; }
    }
    const int ktd = t0 >> 5;
    const LAS float* tabp = tabh + (2047 - tc + 8 * h);
    {
        unsigned umask = selmask;
#pragma unroll
        for (int o = 1; o < 64; o <<= 1) umask |= (unsigned)__shfl_xor((int)umask, o);
        umask = __builtin_amdgcn_readfirstlane(umask);
        int c2 = lane & 31, h2 = lane >> 5; asm volatile("" : "+v"(c2), "+v"(h2));
        const bf16_t* kp = P + ((size_t)b * S + pi32(c2)) * LDP + C_AKS + g * 64 + 8 * h2;
        const bf16_t* vp = VT + (size_t)(VR_AVS + g * 64 + c2) * M + (size_t)b * S + 8 * h2;
        Soft st; soft_init(st);
        KVF cur, nxt;
        load_kv(cur, kp, LDP, vp, (size_t)32 * M, 32 * ktd);
        int kt = ktd;
        while (kt >= 0) {
            int nk = kt - 1;
            while (nk >= 0 && !((umask >> (nk >> 1)) & 1u)) --nk;
            if (nk >= 0) load_kv(nxt, kp, LDP, vp, (size_t)32 * M, 32 * nk);
            const int D0 = tc - 32 * kt - 8 * h;
            const bool rowsel = (selmask >> (kt >> 1)) & 1u;
            if (kt == ktd) tile_step<true, false, true>(st, cur, qf, tabp, 32 * kt, D0, 0, rowsel);
            else tile_step<false, false, true>(st, cur, qf, tabp, 32 * kt, D0, 0, rowsel);
            if (nk >= 0) cur = nxt;
            kt = nk;
        }
        const float l = st.l + __shfl_xor(st.l, 32);
        const float g1 = sigmoidf(GT[rowq * 24 + 1 * 8 + head]) / l;
#pragma unroll
        for (int r = 0; r < 16; ++r) { osc[r * 64 + lane] += st.o[0][r] * g1; osc[(16 + r) * 64 + lane] += st.o[1][r] * g1; }
    }
    {
        int c2 = lane & 31, h2 = lane >> 5; asm volatile("" : "+v"(c2), "+v"(h2));
        const bf16_t* kp = P + ((size_t)b * S + pi32(c2)) * LDP + C_AKW + g * 64 + 8 * h2;
        const bf16_t* vp = VT + (size_t)(VR_AVW + g * 64 + c2) * M + (size_t)b * S + 8 * h2;
        Soft st; soft_init(st);
        const int ktlo = (t0 - 511 > 0 ? t0 - 511 : 0) >> 5;
        KVF cur, nxt;
        load_kv(cur, kp, LDP, vp, (size_t)32 * M, 32 * ktd);
        for (int kt = ktd; kt >= ktlo; --kt) {
            if (kt > ktlo) load_kv(nxt, kp, LDP, vp, (size_t)32 * M, 32 * (kt - 1));
            const int D0 = tc - 32 * kt - 8 * h;
            if (kt == ktd) tile_step<true, false, false>(st, cur, qf, tabp, 32 * kt, D0, 0, true);
            else if (32 * kt < t0 + 7 - 511) tile_step<false, true, false>(st, cur, qf, tabp, 32 * kt, D0, 511, true);
            else tile_step<false, false, false>(st, cur, qf, tabp, 32 * kt, D0, 0, true);
            if (kt > ktlo) cur = nxt;
        }
        const float l = st.l + __shfl_xor(st.l, 32);
        const float g2 = sigmoidf(GT[rowq * 24 + 2 * 8 + head]) / l;
#pragma unroll
        for (int r = 0; r < 16; ++r) { st.o[0][r] = osc[r * 64 + lane] + st.o[0][r] * g2; st.o[1][r] = osc[(16 + r) * 64 + lane] + st.o[1][r] * g2; }
        int c3 = lane & 31; asm volatile("" : "+v"(c3));
        const size_t rowq3 = (size_t)b * S + t0 + (c3 & 7); const int head3 = g * 4 + (c3 >> 3);
        store_rows(st.o, 1.f, P + rowq3 * LDP + C_AGATE + head3 * 64, MIX + rowq3 * DM + head3 * 64, h2);
    }
}

#define LAUNDER_S(x)
#define PH_COMMON \
    int tid_ = threadIdx.x; asm volatile("" : "+v"(tid_)); const int tid = tid_, lane = tid & 63, wib = __builtin_amdgcn_readfirstlane(tid >> 6); \
    const int G = gridDim.x; const int gthreads = G * NT, gtid = blockIdx.x * NT + tid; const int gwaves = G * NWAVES, gwave = blockIdx.x * NWAVES + wib; \
    unsigned char* ws = prm.ws; asm volatile("" : "+s"(ws)); (void)lane; (void)gthreads; (void)gtid; (void)gwaves; (void)gwave; (void)ws;

__device__ __forceinline__ void phase_prologue(const Params& prm, LAS unsigned char* ldsb) {
    PH_COMMON
    float* biasd = (float*)(ws + WS_BIASD); float* WG = (float*)(ws + WS_WG);
    bf16_t* WINT = (bf16_t*)(ws + WS_WIN); bf16_t* WOUTT = (bf16_t*)(ws + WS_WOUT); bf16_t* XB = (bf16_t*)(ws + WS_XB);
    for (int i = gtid; i < 24 * 2048; i += gthreads) { const int h = i >> 11, d = i & 2047; biasd[i] = prm.rel_bias[t5_bucket(d) * 24 + h]; }
    {
        float* img = (float*)(ws + WS_IMG);
        for (int i = gtid; i < 8 * 2048; i += gthreads) { const int h = i >> 11, d = 2047 - (i & 2047);
            img[i] = prm.rel_bias[t5_bucket(d) * 24 + h] * LOG2E;
            const int mult = (d <= 128 ? 1 : 0) + (((d & 3) == 0 && d <= 512) ? 1 : 0) + ((d & 15) == 0 ? 1 : 0);
            img[8 * 2048 + i] = mult == 0 ? -INFINITY : prm.rel_bias[t5_bucket(d) * 24 + 16 + h] * LOG2E + (mult == 1 ? 0.f : (mult == 2 ? 1.f : 1.5849625007211562f)); }
        for (int i = gtid; i < 8 * 256; i += gthreads) { const int h = i >> 8, d = 255 - (i & 255); img[16 * 2048 + i] = prm.rel_bias[t5_bucket(d) * 24 + 8 + h] * LOG2E; }
    }
    for (int i = gtid; i < DEPTH * 24 * 2048; i += gthreads) { const int k = i & 2047, j = (i >> 11) % 24, l = i / (24 * 2048); WG[i] = prm.w_in[(size_t)l * DM * DIN + (size_t)k * DIN + SRC_GATES + j] * prm.norm_w[l * DM + k]; }
    {
        LAS float* scr = (LAS float*)(ldsb + wib * 16384);
        constexpr int I_IN = 32 * (NW_IN / 32), I_OUT = 32 * (DM / 32);
        for (int it = gwave; it < DEPTH * (I_IN + I_OUT); it += gwaves) {
            const int l = it / (I_IN + I_OUT); int r = it % (I_IN + I_OUT);
            if (r < I_IN) { const int nb = r % (NW_IN / 32), kb = r / (NW_IN / 32);
                transpose_item(prm.w_in + (size_t)l * DM * DIN, DM, DIN, src_col_of(32 * nb) - 32 * nb, prm.norm_w + l * DM, WINT + (size_t)l * NW_IN * DM, scr, kb, nb, lane); }
            else { r -= I_IN; const int nb = r % (DM / 32), kb = r / (DM / 32);
                transpose_item(prm.w_out + (size_t)l * DM * DM, DM, DM, 0, nullptr, WOUTT + (size_t)l * DM * DM, scr, kb, nb, lane); }
        }
    }
    for (int row = gwave; row < M; row += gwaves) rms_row_to_bf16(prm.x + (size_t)row * DM, XB + (size_t)row * DM, lane);
}

__device__ __forceinline__ void phase_inproj(const Params& prm, int layer, LAS unsigned char* ldsb) {
    LAUNDER_S(layer);
    unsigned char* ws = prm.ws; asm volatile("" : "+s"(ws));
    const bf16_t* W = (const bf16_t*)(ws + WS_WIN) + (size_t)layer * NW_IN * DM;
    {
        pg8::Gemm g{(const bf16_t*)(ws + WS_XB), W, M, LDP, DM}; pg8::StaticOrder So; So.init(M, LDP, (int)gridDim.x, (int)blockIdx.x);
        pg8::EpiBf16 E{(bf16_t*)(ws + WS_P), LDP};
        pg8::gemm_phase<pg8::EpiBf16, pg8::StaticOrder, true, true>(ldsb, g, So, E);
    }
    {
        pg8::Gemm g{W + (size_t)LDP * DM, (const bf16_t*)(ws + WS_XB), NVT, M, DM}; pg8::StaticOrder So; So.init(NVT, M, (int)gridDim.x, (int)blockIdx.x);
        pg8::EpiBf16 E{(bf16_t*)(ws + WS_VT), M};
        pg8::gemm_phase<pg8::EpiBf16, pg8::StaticOrder, true, true>(ldsb, g, So, E);
    }
}
__device__ __forceinline__ void phase_outproj(const Params& prm, int layer, LAS unsigned char* ldsb) {
    LAUNDER_S(layer);
    unsigned char* ws = prm.ws; asm volatile("" : "+s"(ws));
    const float* xin = layer == 0 ? prm.x : prm.out;
    pg8::Gemm g{(const bf16_t*)(ws + WS_MIX), (const bf16_t*)(ws + WS_WOUT) + (size_t)layer * DM * DM, M, DM, DM}; pg8::StaticOrder So; So.init(M, DM, (int)gridDim.x, (int)blockIdx.x);
    pg8::EpiResid E{xin, prm.out, DM};
    pg8::gemm_phase<pg8::EpiResid, pg8::StaticOrder, true, true>(ldsb, g, So, E);
}
__device__ __forceinline__ void phase_gates(const Params& prm, int layer) {
    LAUNDER_S(layer);
    PH_COMMON
    const bf16_t* XB = (const bf16_t*)(ws + WS_XB); float* GT = (float*)(ws + WS_G);
    const float* wg = (const float*)(ws + WS_WG) + (size_t)layer * 24 * 2048;
    for (int row = gwave; row < M; row += gwaves) {
        float xv[32];
#pragma unroll
        for (int i = 0; i < 32; ++i) xv[i] = bf2f(XB[(size_t)row * DM + lane + 64 * i]);
#pragma unroll 1
        for (int j = 0; j < 24; ++j) {
            float a = 0.f;
#pragma unroll
            for (int i = 0; i < 32; ++i) a += xv[i] * wg[j * 2048 + lane + 64 * i];
            a = wave_sum(a);
            if (lane == 0) GT[(size_t)row * 24 + j] = a;
        }
    }
}
__device__ __forceinline__ void phase_compress(const Params& prm, int layer, float* lds) {
    LAUNDER_S(layer);
    PH_COMMON
    const bf16_t* P = (const bf16_t*)(ws + WS_P); bf16_t* cmpkv = (bf16_t*)(ws + WS_CMP);
    const float* cpos = prm.cmp_pos + layer * 2 * 32 * 64;
    const float* cw1 = prm.cmp_w1 + (size_t)layer * 2 * 2048 * 128;
    const float* cw2 = prm.cmp_w2 + (size_t)layer * 2 * 128 * 64;
    for (int item = blockIdx.x; item < 2 * NB * 2 * NCMP; item += G) {
        const int c = item % NCMP, g = (item / NCMP) & 1, b = (item / (NCMP * 2)) % NB, which = item / (NCMP * 2 * NB);
        const int j = tid & 127, part = tid >> 7;
        const bf16_t* VT = (const bf16_t*)(ws + WS_VT);
        const bf16_t* src = which ? VT + (size_t)(VR_AVC + g * 64) * M + (size_t)(b * S + 16 * c) : P + (size_t)(b * S + 16 * c) * LDP + C_AKC + g * 64;
        const size_t sl = which ? 1 : LDP, sd = which ? M : 1;
        const float* pos = cpos + which * 32 * 64;
        const float* w1 = cw1 + (size_t)which * 2048 * 128;
        float a = 0.f;
        for (int l = part * 8; l < part * 8 + 8; ++l)
            for (int d = 0; d < 64; ++d) a += (bf2f(src[(size_t)l * sl + (size_t)d * sd]) + pos[l * 64 + d]) * w1[(size_t)(l * 64 + d) * 128 + j];
        lds[part * 128 + j] = a;
        __syncthreads();
        if (tid < 128) lds[512 + tid] = silu((lds[tid] + lds[128 + tid]) + (lds[256 + tid] + lds[384 + tid]));
        __syncthreads();
        if (tid < 64) {
            const float* w2 = cw2 + which * 128 * 64;
            float o = 0.f;
            for (int jj = 0; jj < 128; ++jj) o += lds[512 + jj] * w2[jj * 64 + tid];
            if (which == 0) cmpkv[((size_t)(b * 2 + g) * 128 + c) * 64 + tid] = f2bf(o);
            else cmpkv[(size_t)NB * 2 * 128 * 64 + ((size_t)(b * 2 + g) * 64 + tid) * 128 + c] = f2bf(o);
        }
        __syncthreads();
    }
}
typedef unsigned u32x4_t __attribute__((ext_vector_type(4)));
__device__ __forceinline__ void phase_mix_ab(const Params& prm, int layer, LAS unsigned char* ldsb) {
    LAUNDER_S(layer);
    PH_COMMON
    {
        const u32x4_t* src = (const u32x4_t*)(ws + WS_IMG); LAS u32x4_t* dst = (LAS u32x4_t*)ldsb;
        for (int i = tid; i < 65536 / 16; i += NT) dst[i] = src[i];
        for (int i = tid; i < 8192 / 16; i += NT) dst[65536 / 16 + i] = src[131072 / 16 + i];
        __syncthreads();
    }
    const float* GT = (const float*)(ws + WS_G); const bf16_t* KCMP = (const bf16_t*)(ws + WS_CMP); const bf16_t* VCMPT = KCMP + (size_t)NB * 2 * 128 * 64;
    const bf16_t* P = (const bf16_t*)(ws + WS_P); bf16_t* MIX = (bf16_t*)(ws + WS_MIX); const bf16_t* VT = (const bf16_t*)(ws + WS_VT);
    const LAS float* tabA = (const LAS float*)(ldsb + OFF_TA);
    LAS float* osc = (LAS float*)(ldsb + OFF_OSC + wib * 8192);
    for (int pr = gwave; pr < NB * 2 * 128; pr += gwaves) {
        const int bg = pr >> 7, qa = pr & 127;
#pragma unroll 1
        for (int k = 0; k < 2; ++k) unit_A(P, VT, KCMP, VCMPT, GT, MIX, tabA, osc, bg >> 1, bg & 1, k ? 255 - qa : qa, lane);
    }
}
__device__ __forceinline__ void phase_mix_b(const Params& prm, int layer, LAS unsigned char* ldsb) {
    LAUNDER_S(layer);
    PH_COMMON
    const bf16_t* P = (const bf16_t*)(ws + WS_P); bf16_t* MIX = (bf16_t*)(ws + WS_MIX); const bf16_t* VT = (const bf16_t*)(ws + WS_VT);
    const float* sinks = prm.sinks + layer * 8;
    const LAS float* tabB = (const LAS float*)(ldsb + OFF_TB);
#pragma unroll 1
    for (int u = gwave; u < NB * 2 * 256; u += gwaves) unit_B(P, VT, MIX, tabB, sinks, u >> 9, (u >> 8) & 1, u & 255, lane);
}
__device__ __forceinline__ void phase_mix_d(const Params& prm, LAS unsigned char* ldsb) {
    PH_COMMON
    {
        const u32x4_t* src = (const u32x4_t*)(ws + WS_IMG + 65536); LAS u32x4_t* dst = (LAS u32x4_t*)(ldsb + OFF_TD);
        for (int i = tid; i < 65536 / 16; i += NT) dst[i] = src[i];
        __syncthreads();
    }
    const bf16_t* P = (const bf16_t*)(ws + WS_P); bf16_t* MIX = (bf16_t*)(ws + WS_MIX); const bf16_t* VT = (const bf16_t*)(ws + WS_VT);
    const LAS float* tabD = (const LAS float*)(ldsb + OFF_TD);
    for (int pr = gwave; pr < NB * 8 * 32; pr += gwaves) {
        const int bh = pr >> 5, qa = pr & 31;
#pragma unroll 1
        for (int k = 0; k < 2; ++k) unit_D(P, VT, MIX, tabD, bh >> 3, bh & 7, k ? 63 - qa : qa, lane);
    }
}
__device__ __forceinline__ void phase_conv(const Params& prm, int layer) {
    LAUNDER_S(layer);
    PH_COMMON
    const bf16_t* P = (const bf16_t*)(ws + WS_P); bf16_t* MIX = (bf16_t*)(ws + WS_MIX);
    const float* convw = prm.conv_w + layer * 3 * 512;
    for (int i = gtid; i < M * 512; i += gthreads) {
        const int c = i & 511, row = i >> 9, t = row & (S - 1);
        const bf16_t* pr = P + (size_t)row * LDP;
        float y = convw[2 * 512 + c] * bf2f(pr[C_CC + c]) * bf2f(pr[C_CH + c]);
        if (t >= 1) y += convw[1 * 512 + c] * bf2f(pr[C_CC + c - LDP]) * bf2f(pr[C_CH + c - LDP]);
        if (t >= 2) y += convw[0 * 512 + c] * bf2f(pr[C_CC + c - 2 * LDP]) * bf2f(pr[C_CH + c - 2 * LDP]);
        MIX[(size_t)row * DM + 1024 + c] = f2bf(bf2f(pr[C_CB + c]) * y * silu(bf2f(pr[C_CGATE + c])));
    }
}
__device__ __forceinline__ void phase_xb(const Params& prm) {
    PH_COMMON
    bf16_t* XB = (bf16_t*)(ws + WS_XB);
    for (int row = gwave; row < M; row += gwaves) rms_row_to_bf16(prm.out + (size_t)row * DM, XB + (size_t)row * DM, lane);
}
__device__ __forceinline__ void phase_final(const Params& prm) {
    PH_COMMON
    for (int row = gwave; row < M; row += gwaves) {
        float4* xr = (float4*)(prm.out + (size_t)row * DM);
        float4 v[8]; float s = 0.f;
#pragma unroll
        for (int j = 0; j < 8; ++j) { v[j] = xr[lane + 64 * j]; s += v[j].x * v[j].x + v[j].y * v[j].y + v[j].z * v[j].z + v[j].w * v[j].w; }
        s = wave_sum(s);
        const float r = rsqrtf(s * (1.f / DM) + 1e-6f);
#pragma unroll
        for (int j = 0; j < 8; ++j) { const float4 w = ((const float4*)prm.final_norm_w)[lane + 64 * j];
            xr[lane + 64 * j] = make_float4(v[j].x * r * w.x, v[j].y * r * w.y, v[j].z * r * w.z, v[j].w * r * w.w); }
    }
}

__global__ void __launch_bounds__(NT, 2) fwd_kernel(Params prm) {
    cg::grid_group grid = cg::this_grid();
    extern __shared__ __attribute__((aligned(16))) unsigned char lds_raw[];
    LAS unsigned char* ldsb = (LAS unsigned char*)lds_raw;
    float* lds = (float*)lds_raw;
    phase_prologue(prm, ldsb);
    grid.sync();
#pragma unroll
    for (int layer = 0; layer < DEPTH; ++layer) {
        phase_inproj(prm, layer, ldsb);
        phase_gates(prm, layer);
        grid.sync();
        phase_compress(prm, layer, lds);
        grid.sync();
        phase_mix_ab(prm, layer, ldsb);
        phase_mix_b(prm, layer, ldsb);
        __syncthreads();
        phase_mix_d(prm, ldsb);
        phase_conv(prm, layer);
        grid.sync();
        phase_outproj(prm, layer, ldsb);
        grid.sync();
        if (layer + 1 < DEPTH) { phase_xb(prm); grid.sync(); }
    }
    phase_final(prm);
}

extern "C" void kernel_launch(void* const* d_in, const int* in_sizes, int n_in, void* d_out, int out_size, void* d_ws, size_t ws_size, hipStream_t stream) {
    static int grid_blocks = 0;
    if (!grid_blocks) {
        int dev = 0, cus = 0, per_cu = 0;
        (void)hipGetDevice(&dev);
        (void)hipDeviceGetAttribute(&cus, hipDeviceAttributeMultiprocessorCount, dev);
        if (hipFuncSetAttribute((const void*)fwd_kernel, hipFuncAttributeMaxDynamicSharedMemorySize, LDS_BYTES) != hipSuccess) fprintf(stderr, "kernel_launch: hipFuncSetAttribute failed\n");
        (void)hipOccupancyMaxActiveBlocksPerMultiprocessor(&per_cu, fwd_kernel, NT, LDS_BYTES);
        if (per_cu < 1) fprintf(stderr, "kernel_launch: occupancy query says %d blocks per CU\n", per_cu);
        grid_blocks = cus;
        if (ws_size < WS_END) fprintf(stderr, "kernel_launch: workspace too small: %zu < %zu\n", ws_size, (size_t)WS_END);
    }
    Params p{};
    p.x = (const float*)d_in[0]; p.norm_w = (const float*)d_in[1]; p.w_in = (const float*)d_in[2]; p.w_out = (const float*)d_in[3];
    p.conv_w = (const float*)d_in[4]; p.sinks = (const float*)d_in[5]; p.cmp_pos = (const float*)d_in[6]; p.cmp_w1 = (const float*)d_in[7];
    p.cmp_w2 = (const float*)d_in[8]; p.rel_bias = (const float*)d_in[9]; p.final_norm_w = (const float*)d_in[10];
    p.out = (float*)d_out; p.ws = (unsigned char*)d_ws;
    void* args[] = {&p};
    hipError_t e = hipLaunchCooperativeKernel((void*)fwd_kernel, dim3(grid_blocks), dim3(NT), args, LDS_BYTES, stream);
    if (e != hipSuccess) fprintf(stderr, "cooperative launch failed: %s (grid %d)\n", hipGetErrorString(e), grid_blocks);
}
```

```cpp
#include <hip/hip_runtime.h>
#include <hip/hip_cooperative_groups.h>
#include <cstdio>
#include <cstdint>
namespace cg = cooperative_groups;

namespace pg8 {
#define PG8_LAS __attribute__((address_space(3)))
typedef unsigned short bf16_t;
typedef short bf16x8 __attribute__((ext_vector_type(8)));
typedef float f32x4 __attribute__((ext_vector_type(4)));
typedef unsigned u32x4 __attribute__((ext_vector_type(4)));
constexpr int BM = 256, BK = 64, HALF = 128, HTB = HALF * BK * 2  , STAGE_BYTES = 8 * HTB, NXCD = 8, WGM = 8;

__host__ __device__ __forceinline__ int lds_byte(int r, int c) { const int st = (r >> 4) * 2 + (c >> 5), rr = r & 15, cc = c & 31, ob = rr * 64 + cc * 2; return st * 1024 + (ob ^ (((ob >> 9) & 1) << 5)); }
__host__ __device__ __forceinline__ void stage_rc(int b, int& R, int& C) { const int st = b / 1024, sb = b % 1024, swz = sb ^ (((sb >> 9) & 1) << 5); R = (st >> 1) * 16 + swz / 64; C = (st & 1) * 32 + (swz % 64) / 2; }
__host__ __device__ __forceinline__ int perm32(int rho) { const int n = rho >> 4, i = rho & 15; return 8 * (i >> 2) + 4 * n + (i & 3); }

struct Unit { int pm, pn; };
struct Gemm { const bf16_t* A; const bf16_t* Bt; int M, N, K; };

struct StaticOrder {
    int nM, nN, nwg, G, c;
    __host__ __device__ void init(int M, int N, int G_, int c_) { nM = M / BM; nN = N / BM; nwg = nM * nN; G = G_; c = c_; }
    __host__ __device__ bool next(int i, Unit& u) const {
        const long L = (long)i * G + c; if (L >= nwg) return false;
        int wgid = (int)L; { const int q = nwg / NXCD, r = nwg % NXCD, xcd = wgid % NXCD, off = wgid / NXCD; wgid = (xcd < r ? xcd * (q + 1) : r * (q + 1) + (xcd - r) * q) + off; }
        const int nig = WGM * nN, gid = wgid / nig, fm = gid * WGM, gsz = (nM - fm) < WGM ? (nM - fm) : WGM;
        u.pm = fm + ((wgid % nig) % gsz); u.pn = (wgid % nig) / gsz; return true;
    }
    __device__ __forceinline__ void a_ready(const Unit&) const {}
    __device__ __forceinline__ void done(const Unit&) const {}
};


__device__ __forceinline__ unsigned cvt_pk_bf16(float lo, float hi) { unsigned r; asm volatile("v_cvt_pk_bf16_f32 %0, %1, %2" : "=v"(r) : "v"(lo), "v"(hi)); return r; }
struct EpiBf16 {
    static constexpr bool PERM = true, AFTER_DRAIN = false;
    bf16_t* O; int ldc;
    __device__ __forceinline__ void operator()(const f32x4 (&acc)[2][2][4][2], const Unit& u, int wr, int wc, int fr, int fq) const {
        const int row0 = u.pm * BM + wr * 64 + fr; const int col0 = u.pn * BM + wc * 32 + 8 * fq;
#pragma unroll
        for (int ai = 0; ai < 2; ++ai)
#pragma unroll
            for (int m = 0; m < 4; ++m) { bf16_t* rowp = O + (size_t)(row0 + ai * HALF + m * 16) * ldc + col0;
#pragma unroll
                for (int bj = 0; bj < 2; ++bj) { const f32x4 v0 = acc[ai][bj][m][0], v1 = acc[ai][bj][m][1];
                    u32x4 w; w.x = cvt_pk_bf16(v0[0], v0[1]); w.y = cvt_pk_bf16(v0[2], v0[3]); w.z = cvt_pk_bf16(v1[0], v1[1]); w.w = cvt_pk_bf16(v1[2], v1[3]);
                    *(u32x4*)(rowp + bj * HALF) = w; } }
    }
};
struct EpiResid {
    static constexpr bool PERM = false, AFTER_DRAIN = false;
    const float* base; float* out; int ldc;
    __device__ __forceinline__ void operator()(const f32x4 (&acc)[2][2][4][2], const Unit& u, int wr, int wc, int fr, int fq) const {
        const int col0 = u.pn * BM + wc * 32 + 4 * fq;
#pragma unroll
        for (int ai = 0; ai < 2; ++ai)
#pragma unroll
            for (int m = 0; m < 4; ++m) { const size_t off = (size_t)(u.pm * BM + ai * HALF + wr * 64 + m * 16 + fr) * ldc + col0;
#pragma unroll
                for (int bj = 0; bj < 2; ++bj)
#pragma unroll
                    for (int n = 0; n < 2; ++n) { const f32x4 bs = *(const f32x4*)(base + off + bj * HALF + n * 16); *(f32x4*)(out + off + bj * HALF + n * 16) = bs + acc[ai][bj][m][n]; } }
    }
};

template <class Epi, class Sched, bool ALIGN_EPI = false, bool SP2 = false>
__device__ __forceinline__ void gemm_phase(PG8_LAS unsigned char* lds, const Gemm g, const Sched& S, const Epi& E) {
    int tid_ = threadIdx.x; asm volatile("" : "+v"(tid_));
    const int tid = tid_, wid = __builtin_amdgcn_readfirstlane(tid >> 6), lane = tid & 63, wr = wid >> 2, wc = wid & 3, fr = lane & 15, fq = lane >> 4;
    const int K = g.K, nt = K / BK;
    unsigned voffA[2], voffB[2];
#pragma unroll
    for (int i = 0; i < 2; ++i) { int R, C; stage_rc(tid * 16 + i * 8192, R, C); const int Rb = Epi::PERM ? ((R & ~31) + perm32(R & 31)) : R;
        voffA[i] = (unsigned)(R * K + C) * 2u; voffB[i] = (unsigned)(Rb * K + C) * 2u; }
    const size_t kstep = (size_t)(BK * 2);
    const size_t hstep = (size_t)HALF * K * 2;
    const size_t tstep = 2 * hstep;
    const unsigned ldsw = (unsigned)wid * 1024u;
    const unsigned ldsm0 = __builtin_amdgcn_readfirstlane((unsigned)(unsigned long long)lds + ldsw);
    const int aoff = lds_byte(wr * 64 + fr, fq * 8), boff = lds_byte(wc * 32 + fr, fq * 8);
#define PG8_SA(b, h) (((b) * 2 + (h)) * HTB)
#define PG8_SB(b, h) ((4 + (b) * 2 + (h)) * HTB)
#define PG8_STAGE(bufoff, gbase, voff) do { _Pragma("unroll") for (int _i = 0; _i < 2; ++_i) \
        asm volatile("s_mov_b32 m0, %0\n\ts_nop 0\n\tglobal_load_lds_dwordx4 %1, %2" :: "s"(ldsm0 + (unsigned)((bufoff) + _i * 8192)), "v"((voff)[_i]), "s"((const char*)(gbase)) : "m0", "memory"); } while (0)
#define PG8_LDA(dst, b, h) do { _Pragma("unroll") for (int m = 0; m < 4; ++m) _Pragma("unroll") for (int k = 0; k < 2; ++k) dst[m][k] = *(const PG8_LAS bf16x8*)(lds + PG8_SA(b, h) + aoff + m * 2048 + k * 1024); } while (0)
#define PG8_LDB(dst, b, h) do { _Pragma("unroll") for (int n = 0; n < 2; ++n) _Pragma("unroll") for (int k = 0; k < 2; ++k) dst[n][k] = *(const PG8_LAS bf16x8*)(lds + PG8_SB(b, h) + boff + n * 2048 + k * 1024); } while (0)
#define PG8_MMA(ai, bj, At, Bt) do { __builtin_amdgcn_s_setprio(1); _Pragma("unroll") for (int m = 0; m < 4; ++m) _Pragma("unroll") for (int n = 0; n < 2; ++n) _Pragma("unroll") for (int k = 0; k < 2; ++k) \
        acc[ai][bj][m][n] = __builtin_amdgcn_mfma_f32_16x16x32_bf16(Bt[n][k], At[m][k], acc[ai][bj][m][n], 0, 0, 0); __builtin_amdgcn_s_setprio(0); } while (0)
#define PG8_WAIT_V(n) asm volatile("s_waitcnt vmcnt(" #n ")" ::: "memory")
#define PG8_WAIT_L(n) asm volatile("s_waitcnt lgkmcnt(" #n ")" ::: "memory")
#define PG8_BAR __builtin_amdgcn_s_barrier()
#define PG8_SCHED __builtin_amdgcn_sched_barrier(0)
    Unit cur, nxt; int ui = 0;
    if (!S.next(0, cur)) return;
    f32x4 acc[2][2][4][2];
#pragma unroll
    for (int a = 0; a < 2; ++a)
#pragma unroll
        for (int b = 0; b < 2; ++b)
#pragma unroll
            for (int m = 0; m < 4; ++m)
#pragma unroll
                for (int n = 0; n < 2; ++n) acc[a][b][m][n] = (f32x4){0.f, 0.f, 0.f, 0.f};
    bf16x8 At[4][2], B0[2][2], B1[2][2];
    const char* cA = (const char*)g.A + (size_t)cur.pm * tstep; const char* cB = (const char*)g.Bt + (size_t)cur.pn * tstep;
    S.a_ready(cur);
    if constexpr (SP2) {
        PG8_STAGE(PG8_SB(0, 0), cB, voffB); PG8_STAGE(PG8_SB(0, 1), cB + hstep, voffB); PG8_STAGE(PG8_SA(0, 0), cA, voffA); PG8_STAGE(PG8_SA(0, 1), cA + hstep, voffA);
        if (wr == 1) PG8_BAR;
        PG8_WAIT_V(2); PG8_BAR;
        PG8_STAGE(PG8_SB(1, 0), cB + kstep, voffB); PG8_STAGE(PG8_SA(1, 0), cA + kstep, voffA); PG8_STAGE(PG8_SB(1, 1), cB + hstep + kstep, voffB);
        PG8_WAIT_V(6); PG8_BAR;
    } else {
        PG8_STAGE(PG8_SB(0, 0), cB, voffB); PG8_STAGE(PG8_SA(0, 0), cA, voffA); PG8_STAGE(PG8_SB(0, 1), cB + hstep, voffB); PG8_STAGE(PG8_SA(0, 1), cA + hstep, voffA);
        if (wr == 1) PG8_BAR;
        PG8_WAIT_V(4); PG8_BAR;
        PG8_STAGE(PG8_SB(1, 0), cB + kstep, voffB); PG8_STAGE(PG8_SA(1, 0), cA + kstep, voffA); PG8_STAGE(PG8_SB(1, 1), cB + hstep + kstep, voffB);
        PG8_WAIT_V(6); PG8_BAR;
    }
    for (;;) {
        const bool has_next = S.next(ui + 1, nxt);
        const char* nA = has_next ? (const char*)g.A + (size_t)nxt.pm * tstep : cA; const char* nB = has_next ? (const char*)g.Bt + (size_t)nxt.pn * tstep : cB;
        for (int t = 0; t < nt; t += 2) {
            const bool last = (t == nt - 2);
            const char* a1 = cA + (size_t)(t + 1) * kstep;
            const char* a2 = last ? nA : cA + (size_t)(t + 2) * kstep; const char* b2 = last ? nB : cB + (size_t)(t + 2) * kstep;
            const char* a3 = a2 + kstep; const char* b3 = b2 + kstep;
            if (last && has_next) S.a_ready(nxt);
            if constexpr (SP2) {
            PG8_LDB(B0, 0, 0); PG8_LDB(B1, 0, 1); PG8_SCHED; PG8_LDA(At, 0, 0); PG8_STAGE(PG8_SA(1, 1), a1 + hstep, voffA);
            PG8_WAIT_V(8); PG8_WAIT_L(0); PG8_BAR; PG8_MMA(0, 0, At, B0); PG8_MMA(0, 1, At, B1); PG8_BAR; PG8_SCHED;
            PG8_LDA(At, 0, 1); PG8_STAGE(PG8_SB(0, 0), b2, voffB); PG8_STAGE(PG8_SB(0, 1), b2 + hstep, voffB); PG8_STAGE(PG8_SA(0, 0), a2, voffA);
            PG8_WAIT_V(8); PG8_WAIT_L(0); PG8_BAR; PG8_MMA(1, 0, At, B0); PG8_MMA(1, 1, At, B1); PG8_BAR; PG8_SCHED;
            PG8_LDB(B0, 1, 0); PG8_LDB(B1, 1, 1); PG8_SCHED; PG8_LDA(At, 1, 0); PG8_STAGE(PG8_SA(0, 1), a2 + hstep, voffA);
            PG8_WAIT_V(8); PG8_WAIT_L(0); PG8_BAR; PG8_MMA(0, 0, At, B0); PG8_MMA(0, 1, At, B1); PG8_BAR; PG8_SCHED;
            PG8_LDA(At, 1, 1); PG8_STAGE(PG8_SB(1, 0), b3, voffB); PG8_STAGE(PG8_SB(1, 1), b3 + hstep, voffB); PG8_STAGE(PG8_SA(1, 0), a3, voffA);
            PG8_WAIT_V(8); PG8_WAIT_L(0); PG8_BAR; PG8_MMA(1, 0, At, B0); PG8_MMA(1, 1, At, B1); PG8_BAR; PG8_SCHED;
            } else {
            PG8_LDB(B0, 0, 0); PG8_SCHED; PG8_LDA(At, 0, 0); PG8_STAGE(PG8_SA(1, 1), a1 + hstep, voffA);
            PG8_WAIT_L(8); PG8_BAR; PG8_WAIT_L(0); PG8_MMA(0, 0, At, B0); PG8_BAR; PG8_SCHED;
            PG8_LDB(B1, 0, 1); PG8_STAGE(PG8_SB(0, 0), b2, voffB);
            PG8_BAR; PG8_WAIT_L(0); PG8_MMA(0, 1, At, B1); PG8_BAR;
            PG8_LDA(At, 0, 1); PG8_STAGE(PG8_SA(0, 0), a2, voffA);
            PG8_BAR; PG8_WAIT_L(0); PG8_MMA(1, 0, At, B0); PG8_BAR; PG8_SCHED;
            PG8_STAGE(PG8_SB(0, 1), b2 + hstep, voffB);
            PG8_WAIT_V(6); PG8_BAR; PG8_MMA(1, 1, At, B1); PG8_BAR;
            PG8_LDB(B0, 1, 0); PG8_SCHED; PG8_LDA(At, 1, 0); PG8_STAGE(PG8_SA(0, 1), a2 + hstep, voffA);
            PG8_WAIT_L(8); PG8_BAR; PG8_WAIT_L(0); PG8_MMA(0, 0, At, B0); PG8_BAR; PG8_SCHED;
            PG8_LDB(B1, 1, 1); PG8_STAGE(PG8_SB(1, 0), b3, voffB);
            PG8_BAR; PG8_WAIT_L(0); PG8_MMA(0, 1, At, B1); PG8_BAR;
            PG8_LDA(At, 1, 1); PG8_STAGE(PG8_SA(1, 0), a3, voffA);
            PG8_BAR; PG8_WAIT_L(0); PG8_MMA(1, 0, At, B0); PG8_BAR; PG8_SCHED;
            PG8_STAGE(PG8_SB(1, 1), b3 + hstep, voffB);
            PG8_WAIT_V(6); PG8_BAR; PG8_MMA(1, 1, At, B1); PG8_BAR;
            }
        }
        if constexpr (ALIGN_EPI) { if (wr == 0) PG8_BAR; }
        if constexpr (!Epi::AFTER_DRAIN) { E(acc, cur, wr, wc, fr, fq); S.done(cur); }
        if (!has_next) break;
#pragma unroll
        for (int a = 0; a < 2; ++a)
#pragma unroll
            for (int b = 0; b < 2; ++b)
#pragma unroll
                for (int m = 0; m < 4; ++m)
#pragma unroll
                    for (int n = 0; n < 2; ++n) acc[a][b][m][n] = (f32x4){0.f, 0.f, 0.f, 0.f};
        cur = nxt; cA = nA; cB = nB; ++ui;
        if constexpr (ALIGN_EPI) { if (wr == 1) PG8_BAR; }
    }
    PG8_WAIT_V(0);
    if constexpr (!ALIGN_EPI) { if (wr == 0) PG8_BAR; }
    PG8_BAR;
    if constexpr (Epi::AFTER_DRAIN) { E.fused(acc, cur, wr, wc, fr, fq, lds, wid, lane); S.done(cur); }
#undef PG8_SA
#undef PG8_SB
#undef PG8_STAGE
#undef PG8_LDA
#undef PG8_LDB
#undef PG8_MMA
#undef PG8_WAIT_V
#undef PG8_WAIT_L
#undef PG8_BAR
#undef PG8_SCHED
}
}

typedef unsigned short bf16_t;
#define LAS __attribute__((address_space(3)))
constexpr int DM = 2048, NB = 8, S = 2048, M = NB * S, DIN = 7192, DEPTH = 2, LDP = 6144, NVT = 1024, NW_IN = LDP + NVT;
constexpr int NWAVES = 8, NT = NWAVES * 64;
constexpr int C_AQ = 0, C_AKC = 512, C_AKS = 640, C_AKW = 768, C_AGATE = 896;
constexpr int C_BQ = 1408, C_BK = 1920, C_BGATE = 2048;
constexpr int C_CB = 2560, C_CC = 3072, C_CH = 3584, C_CGATE = 4096;
constexpr int C_DQ = 4608, C_DK = 5120, C_DGATE = 5632;
constexpr int VR_AVC = 0, VR_AVS = 128, VR_AVW = 256, VR_BV = 384, VR_DV = 512;
__host__ __device__ __forceinline__ int src_col_of(int n) {
    if (n < 640) return n;
    if (n < 768) return n - 640 + 768;
    if (n < 896) return n - 768 + 1024;
    if (n < 1408) return n - 896 + 1304;
    if (n < 1920) return n - 1408 + 1816;
    if (n < 2048) return n - 1920 + 2328;
    if (n < 2560) return n - 2048 + 2584;
    if (n < 4608) return n - 2560 + 3096;
    if (n < 5120) return n - 4608 + 5144;
    if (n < 5632) return n - 5120 + 5656;
    if (n < 6144) return n - 5632 + 6680;
    if (n < 6272) return n - 6144 + 640;
    if (n < 6400) return n - 6272 + 896;
    if (n < 6528) return n - 6400 + 1152;
    if (n < 6656) return n - 6528 + 2456;
    return n - 6656 + 6168;
}
constexpr int SRC_GATES = 1280;
constexpr int NCMP = 127;

constexpr size_t MiB = 1u << 20;
constexpr size_t WS_BIASD = 1 * MiB;
constexpr size_t WS_IMG = 1 * MiB + 512 * 1024;
constexpr size_t WS_G = 2 * MiB;
constexpr size_t WS_WG = 4 * MiB;
constexpr size_t WS_PB = 4 * MiB + 512 * 1024;
constexpr size_t WS_W2T = 4 * MiB + 768 * 1024;
constexpr size_t WS_W1T = 6 * MiB;
constexpr size_t WS_CMP = 5 * MiB;
constexpr size_t WS_WIN = 8 * MiB;
constexpr size_t WS_WOUT = 64 * MiB;
constexpr size_t WS_XB = 80 * MiB;
constexpr size_t WS_MIX = 144 * MiB;
constexpr size_t WS_P = 208 * MiB;
constexpr size_t WS_VT = 400 * MiB;
constexpr size_t WS_END = 432 * MiB;
constexpr int LDS_BYTES = 147456;

struct Params {
    const float* x; const float* norm_w; const float* w_in; const float* w_out; const float* conv_w; const float* sinks;
    const float* cmp_pos; const float* cmp_w1; const float* cmp_w2; const float* rel_bias; const float* final_norm_w;
    float* out; unsigned char* ws;
};

__device__ __forceinline__ float bf2f(bf16_t v) { return __uint_as_float(((unsigned)v) << 16); }
__device__ __forceinline__ unsigned f2bfu(float f) { unsigned u = __float_as_uint(f); return (u + 0x7fffu + ((u >> 16) & 1u)) >> 16; }
__device__ __forceinline__ bf16_t f2bf(float f) { return (bf16_t)f2bfu(f); }
__device__ __forceinline__ unsigned pk2(float lo, float hi) { return f2bfu(lo) | (f2bfu(hi) << 16); }
__device__ __forceinline__ float wave_sum(float v) {
#pragma unroll
    for (int o = 32; o > 0; o >>= 1) v += __shfl_xor(v, o);
    return v;
}
__device__ __forceinline__ float wave_max(float v) {
#pragma unroll
    for (int o = 32; o > 0; o >>= 1) v = fmaxf(v, __shfl_xor(v, o));
    return v;
}
__device__ __forceinline__ float silu(float v) { return v / (1.f + __expf(-v)); }
__device__ __forceinline__ float sigmoidf(float v) { return 1.f / (1.f + __expf(-v)); }
#define LDS_FENCE() asm volatile("s_waitcnt lgkmcnt(0)" ::: "memory")

__device__ __forceinline__ int t5_bucket(int d) {
    if (d < 16) return d < 0 ? 0 : d;
    int b = 16;
    b += (d >= 22); b += (d >= 30); b += (d >= 40); b += (d >= 54); b += (d >= 73); b += (d >= 99); b += (d >= 134); b += (d >= 182);
    b += (d >= 246); b += (d >= 332); b += (d >= 450); b += (d >= 609); b += (d >= 825); b += (d >= 1117); b += (d >= 1513);
    return b;
}

__device__ __forceinline__ void transpose_item(const float* W, int K, int srcld, int src_n0, const float* ksc, bf16_t* WT, LAS float* scr, int kb, int nb, int lane) {
    const int k0 = 64 * kb, n0 = 32 * nb;
#pragma unroll 8
    for (int i = 0; i < 32; ++i) { const int kk = 2 * i + (lane >> 5); const float sc = ksc ? ksc[k0 + kk] : 1.f; scr[kk * 33 + (lane & 31)] = W[(size_t)(k0 + kk) * srcld + src_n0 + n0 + (lane & 31)] * sc; }
    LDS_FENCE();
    const int c = lane & 7;
#pragma unroll
    for (int j = 0; j < 4; ++j) { const int n = (lane >> 3) + 8 * j; const LAS float* s = scr + (8 * c) * 33 + n;
        uint4 o; o.x = pk2(s[0 * 33], s[1 * 33]); o.y = pk2(s[2 * 33], s[3 * 33]); o.z = pk2(s[4 * 33], s[5 * 33]); o.w = pk2(s[6 * 33], s[7 * 33]);
        *(uint4*)(WT + (size_t)(n0 + n) * K + k0 + 8 * c) = o; }
    LDS_FENCE();
}
__device__ __forceinline__ void rms_row_to_bf16(const float* xrow, bf16_t* orow, int lane) {
    const float4* xr = (const float4*)xrow + lane;
    float4 v[8]; float s = 0.f;
#pragma unroll
    for (int j = 0; j < 8; ++j) { v[j] = xr[64 * j]; s += (v[j].x * v[j].x + v[j].y * v[j].y) + (v[j].z * v[j].z + v[j].w * v[j].w); }
    const float r = rsqrtf(wave_sum(s) * (1.f / DM) + 1e-6f);
    uint2* o8 = (uint2*)orow + lane;
#pragma unroll
    for (int j = 0; j < 8; ++j) o8[64 * j] = make_uint2(pk2(v[j].x * r, v[j].y * r), pk2(v[j].z * r, v[j].w * r));
}

__device__ __forceinline__ float ldval(const bf16_t* p) { return bf2f(*p); }
__device__ __forceinline__ float ldval(const float* p) { return *p; }
__device__ __forceinline__ void load8(const bf16_t* p, float (&k)[8]) {
    const uint4 w = *(const uint4*)p;
    k[0] = __uint_as_float(w.x << 16); k[1] = __uint_as_float(w.x & 0xffff0000u);
    k[2] = __uint_as_float(w.y << 16); k[3] = __uint_as_float(w.y & 0xffff0000u);
    k[4] = __uint_as_float(w.z << 16); k[5] = __uint_as_float(w.z & 0xffff0000u);
    k[6] = __uint_as_float(w.w << 16); k[7] = __uint_as_float(w.w & 0xffff0000u);
}
__device__ __forceinline__ void load8(const float* p, float (&k)[8]) {
    const float4 a = ((const float4*)p)[0], b = ((const float4*)p)[1];
    k[0] = a.x; k[1] = a.y; k[2] = a.z; k[3] = a.w; k[4] = b.x; k[5] = b.y; k[6] = b.z; k[7] = b.w;
}

template <int NH, typename KT>
__device__ __forceinline__ void score_chunk(const KT* kmat, size_t rstride, int krow, bool valid, int dist, const float* qs, const float* biasd, float (&s)[NH]) {
    float a[NH];
#pragma unroll
    for (int h = 0; h < NH; ++h) a[h] = 0.f;
    if (valid) {
        const KT* kr = kmat + (size_t)krow * rstride;
#pragma unroll 2
        for (int d8 = 0; d8 < 8; ++d8) {
            float k[8]; load8(kr + 8 * d8, k);
#pragma unroll
            for (int h = 0; h < NH; ++h) {
                const float4 q0 = ((const float4*)(qs + h * 64))[2 * d8], q1 = ((const float4*)(qs + h * 64))[2 * d8 + 1];
                a[h] += q0.x * k[0] + q0.y * k[1] + q0.z * k[2] + q0.w * k[3] + q1.x * k[4] + q1.y * k[5] + q1.z * k[6] + q1.w * k[7];
            }
        }
    }
#pragma unroll
    for (int h = 0; h < NH; ++h) s[h] = valid ? a[h] * 0.125f + biasd[h * 2048 + dist] : -INFINITY;
}
template <int NH, typename VT>
__device__ __forceinline__ void pv_chunk(const VT* vmat, size_t rstride, size_t dstride, int rbase, int rstep, int j0, int j1, const float (&p)[NH], float (&o)[NH], int lane) {
    for (int jj = j0; jj < j1; ++jj) {
        const float vv = ldval(vmat + (size_t)(rbase + jj * rstep) * rstride + (size_t)lane * dstride);
#pragma unroll
        for (int h = 0; h < NH; ++h) o[h] += __uint_as_float(__builtin_amdgcn_readlane(__float_as_uint(p[h]), jj)) * vv;
    }
}
template <int NH, typename KT>
__device__ __forceinline__ void attend_chunk(const KT* kmat, const KT* vmat  , size_t rstride, int rbase, int rstep, int j0, int j1, int dbase, int dstep,
                                             const float* qs, const float* biasd, float (&m)[NH], float (&l)[NH], float (&o)[NH], int lane) {
    if (j1 <= j0) return;
    const bool valid = lane >= j0 && lane < j1;
    float s[NH], p[NH];
    score_chunk<NH, KT>(kmat, rstride, rbase + lane * rstep, valid, dbase + lane * dstep, qs, biasd, s);
#pragma unroll
    for (int h = 0; h < NH; ++h) {
        const float cm = wave_max(s[h]);
        const float mn = fmaxf(m[h], cm);
        const float sc = __expf(m[h] - mn);
        p[h] = valid ? __expf(s[h] - mn) : 0.f;
        l[h] = l[h] * sc + wave_sum(p[h]); o[h] *= sc; m[h] = mn;
    }
    pv_chunk<NH, KT>(vmat, 1, (size_t)M, rbase, rstep, j0, j1, p, o, lane);
}


typedef unsigned u32x4_t_ __attribute__((ext_vector_type(4)));
typedef short abf16x8 __attribute__((ext_vector_type(8)));
typedef float f32x16 __attribute__((ext_vector_type(16)));
constexpr float LOG2E = 1.4426950408889634f, SCL = 0.125f * 1.4426950408889634f;
constexpr int OFF_TA = 0, OFF_TB = 65536, OFF_OSC = 65536 + 8192, OFF_TD = 0;
__device__ __forceinline__ int pi32(int i) { return (i & 19) | ((i & 4) << 1) | ((i & 8) >> 1); }
__device__ __forceinline__ unsigned cvtpk(float lo, float hi) { unsigned r; asm volatile("v_cvt_pk_bf16_f32 %0, %1, %2" : "=v"(r) : "v"(lo), "v"(hi)); return r; }
struct KVF { abf16x8 k[4]; abf16x8 v[4]; };
struct Soft { float m, l; f32x16 o[2]; };
__device__ __forceinline__ void soft_init(Soft& st) {
    st.m = -INFINITY; st.l = 0.f;
#pragma unroll
    for (int r = 0; r < 16; ++r) { st.o[0][r] = 0.f; st.o[1][r] = 0.f; }
}
__device__ __forceinline__ void load_kv(KVF& f, const bf16_t* kp, size_t krs, const bf16_t* vp, size_t vhalf, int key0) {
    const bf16_t* k = kp + (size_t)key0 * krs;
#pragma unroll
    for (int s = 0; s < 4; ++s) f.k[s] = *(const abf16x8*)(k + 16 * s);
    const bf16_t* v = vp + key0;
    f.v[0] = *(const abf16x8*)(v); f.v[1] = *(const abf16x8*)(v + 16); f.v[2] = *(const abf16x8*)(v + vhalf); f.v[3] = *(const abf16x8*)(v + vhalf + 16);
}
template <bool CAUSAL, bool WIN, bool ROWSEL>
__device__ __forceinline__ void tile_step(Soft& st, const KVF& f, const abf16x8 (&qf)[4], const LAS float* tabp, int key0, int D0, int W, bool rowsel) {
    f32x16 acc;
#pragma unroll
    for (int r = 0; r < 16; ++r) acc[r] = 0.f;
#pragma unroll
    for (int s = 0; s < 4; ++s) acc = __builtin_amdgcn_mfma_f32_32x32x16_bf16(f.k[s], qf[s], acc, 0, 0, 0);
    float sv[16]; float tm = -INFINITY;
#pragma unroll
    for (int r = 0; r < 16; ++r) {
        const int ko = (r & 7) + 16 * (r >> 3);
        float x = fmaf(acc[r], SCL, tabp[key0 + ko]);
        bool ok = true;
        if (CAUSAL) ok = ok && (ko <= D0);
        if (WIN) ok = ok && (ko >= D0 - W);
        if (ROWSEL) ok = ok && rowsel;
        if (CAUSAL || WIN || ROWSEL) x = ok ? x : -INFINITY;
        sv[r] = x; tm = fmaxf(tm, x);
    }
    tm = fmaxf(tm, __shfl_xor(tm, 32));
    const float mn = fmaxf(st.m, tm);
    const float alpha = __builtin_amdgcn_exp2f(st.m - mn);
    float rs = 0.f;
#pragma unroll
    for (int r = 0; r < 16; ++r) { sv[r] = __builtin_amdgcn_exp2f(sv[r] - mn); rs += sv[r]; }
    st.l = st.l * alpha + rs; st.m = mn;
    if (__any(alpha != 1.f)) {
#pragma unroll
        for (int r = 0; r < 16; ++r) { st.o[0][r] *= alpha; st.o[1][r] *= alpha; }
    }
    abf16x8 pf[2];
#pragma unroll
    for (int s2 = 0; s2 < 2; ++s2) {
        typedef unsigned u32x4_t __attribute__((ext_vector_type(4)));
        u32x4_t w; w.x = cvtpk(sv[8 * s2 + 0], sv[8 * s2 + 1]); w.y = cvtpk(sv[8 * s2 + 2], sv[8 * s2 + 3]); w.z = cvtpk(sv[8 * s2 + 4], sv[8 * s2 + 5]); w.w = cvtpk(sv[8 * s2 + 6], sv[8 * s2 + 7]);
        pf[s2] = __builtin_bit_cast(abf16x8, w);
    }
#pragma unroll
    for (int dh = 0; dh < 2; ++dh)
#pragma unroll
        for (int s2 = 0; s2 < 2; ++s2) st.o[dh] = __builtin_amdgcn_mfma_f32_32x32x16_bf16(f.v[dh * 2 + s2], pf[s2], st.o[dh], 0, 0, 0);
}
__device__ __forceinline__ void store_rows(const f32x16 (&o)[2], float scale, const bf16_t* gp, bf16_t* op, int h) {
#pragma unroll
    for (int dh = 0; dh < 2; ++dh)
#pragma unroll
        for (int rg = 0; rg < 4; ++rg) {
            const int dim0 = 32 * dh + 8 * rg + 4 * h;
            const uint2 gw = *(const uint2*)(gp + dim0);
            const float g0 = __uint_as_float(gw.x << 16), g1 = __uint_as_float(gw.x & 0xffff0000u), g2 = __uint_as_float(gw.y << 16), g3 = __uint_as_float(gw.y & 0xffff0000u);
            uint2 w; w.x = cvtpk(o[dh][4 * rg + 0] * scale * silu(g0), o[dh][4 * rg + 1] * scale * silu(g1)); w.y = cvtpk(o[dh][4 * rg + 2] * scale * silu(g2), o[dh][4 * rg + 3] * scale * silu(g3));
            *(uint2*)(op + dim0) = w;
        }
}
__device__ __forceinline__ void unit_D(const bf16_t* P, const bf16_t* VT, bf16_t* MIX, const LAS float* tabD, int b, int head, int qt, int lane) {
    asm volatile("" : "+v"(lane));
    const int c = lane & 31, h = lane >> 5, tc = qt * 32 + c;
    const size_t rowq = (size_t)b * S + tc;
    abf16x8 qf[4];
#pragma unroll
    for (int s = 0; s < 4; ++s) qf[s] = *(const abf16x8*)(P + rowq * LDP + C_DQ + head * 64 + 16 * s + 8 * h);
    const bf16_t* kp = P + ((size_t)b * S + pi32(c)) * LDP + C_DK + head * 64 + 8 * h;
    const bf16_t* vp = VT + (size_t)(VR_DV + head * 64 + c) * M + (size_t)b * S + 8 * h;
    const LAS float* tabp = tabD + head * 2048 + (2047 - tc + 8 * h);
    Soft st; soft_init(st);
    KVF cur, nxt;
    load_kv(cur, kp, LDP, vp, (size_t)32 * M, 32 * qt);
    for (int kt = qt; kt >= 0; --kt) {
        if (kt > 0) load_kv(nxt, kp, LDP, vp, (size_t)32 * M, 32 * (kt - 1));
        const int D0 = tc - 32 * kt - 8 * h;
        if (kt == qt) tile_step<true, false, false>(st, cur, qf, tabp, 32 * kt, D0, 0, true);
        else tile_step<false, false, false>(st, cur, qf, tabp, 32 * kt, D0, 0, true);
        if (kt > 0) cur = nxt;
    }
    const float l = st.l + __shfl_xor(st.l, 32);
    store_rows(st.o, 1.f / l, P + rowq * LDP + C_DGATE + head * 64, MIX + rowq * DM + 1536 + head * 64, h);
}

__device__ __forceinline__ void unit_B(const bf16_t* P, const bf16_t* VT, bf16_t* MIX, const LAS float* tabB, const float* sinks, int b, int g, int q8, int lane) {
    asm volatile("" : "+v"(lane));
    const int c = lane & 31, h = lane >> 5, hh = c >> 3, qi = c & 7, t0 = q8 * 8, tc = t0 + qi, head = g * 4 + hh;
    const size_t rowq = (size_t)b * S + tc;
    abf16x8 qf[4];
#pragma unroll
    for (int s = 0; s < 4; ++s) qf[s] = *(const abf16x8*)(P + rowq * LDP + C_BQ + head * 64 + 16 * s + 8 * h);
    const bf16_t* kp = P + ((size_t)b * S + pi32(c)) * LDP + C_BK + g * 64 + 8 * h;
    const bf16_t* vp = VT + (size_t)(VR_BV + g * 64 + c) * M + (size_t)b * S + 8 * h;
    const LAS float* tabp = tabB + head * 256 + (255 - tc + 8 * h);
    Soft st; soft_init(st);
    const int ktd = t0 >> 5, ktlo = (t0 - 127 > 0 ? t0 - 127 : 0) >> 5;
    KVF cur, nxt;
    load_kv(cur, kp, LDP, vp, (size_t)32 * M, 32 * ktd);
    for (int kt = ktd; kt >= ktlo; --kt) {
        if (kt > ktlo) load_kv(nxt, kp, LDP, vp, (size_t)32 * M, 32 * (kt - 1));
        const int D0 = tc - 32 * kt - 8 * h;
        if (kt == ktd) tile_step<true, false, false>(st, cur, qf, tabp, 32 * kt, D0, 0, true);
        else tile_step<false, true, false>(st, cur, qf, tabp, 32 * kt, D0, 127, true);
        if (kt > ktlo) cur = nxt;
    }
    const float l = st.l + __shfl_xor(st.l, 32) + __builtin_amdgcn_exp2f(sinks[head] * LOG2E - st.m);
    store_rows(st.o, 1.f / l, P + rowq * LDP + C_BGATE + head * 64, MIX + rowq * DM + 512 + head * 64, h);
}

__device__ __forceinline__ void unit_A(const bf16_t* P, const bf16_t* VT, const bf16_t* KCMP, const bf16_t* VCMPT, const float* GT, bf16_t* MIX, const LAS float* tabA, LAS float* osc  , int b, int g, int q8, int lane) {
    asm volatile("" : "+v"(lane));
    const int c = lane & 31, h = lane >> 5, hh = c >> 3, qi = c & 7, t0 = q8 * 8, tc = t0 + qi, head = g * 4 + hh;
    const size_t rowq = (size_t)b * S + tc;
    abf16x8 qf[4];
#pragma unroll
    for (int s = 0; s < 4; ++s) qf[s] = *(const abf16x8*)(P + rowq * LDP + C_AQ + head * 64 + 16 * s + 8 * h);
    const LAS float* tabh = tabA + head * 2048;
    unsigned selmask = 0u;
    {
        const int ncv = tc >= 31 ? ((tc - 31) >> 4) + 1 : 0;
        const bf16_t* kp = KCMP + ((size_t)(b * 2 + g) * 128 + pi32(c)) * 64 + 8 * h;
        const bf16_t* vp = VCMPT + ((size_t)(b * 2 + g) * 64 + c) * 128 + 8 * h;
        const LAS float* tabp = tabh + (2047 - tc + 31 + 128 * h);
        float sc[4][16]; float mx = -INFINITY;
#pragma unroll
        for (int kt = 0; kt < 4; ++kt) {
            f32x16 acc;
#pragma unroll
            for (int r = 0; r < 16; ++r) acc[r] = 0.f;
#pragma unroll
            for (int s = 0; s < 4; ++s) acc = __builtin_amdgcn_mfma_f32_32x32x16_bf16(*(const abf16x8*)(kp + (size_t)(32 * kt) * 64 + 16 * s), qf[s], acc, 0, 0, 0);
#pragma unroll
            for (int r = 0; r < 16; ++r) {
                const int ko = (r & 7) + 16 * (r >> 3);
                const bool ok = 32 * kt + 8 * h + ko < ncv;
                const float tb = tabp[512 * kt + 16 * ko];
                const float x = ok ? fmaf(acc[r], SCL, tb) : -INFINITY;
                sc[kt][r] = x; mx = fmaxf(mx, x);
            }
            asm volatile("" ::: "memory");
        }
        mx = fmaxf(mx, __shfl_xor(mx, 32)); mx = fmaxf(mx, -1e30f);
        float sum = 0.f;
#pragma unroll
        for (int kt = 0; kt < 4; ++kt)
#pragma unroll
            for (int r = 0; r < 16; ++r) { sc[kt][r] = __builtin_amdgcn_exp2f(sc[kt][r] - mx); sum += sc[kt][r]; }
        sum += __shfl_xor(sum, 32);
        const float inv = 1.f / fmaxf(sum, 1e-30f);
        f32x16 oc[2];
#pragma unroll
        for (int r = 0; r < 16; ++r) { oc[0][r] = 0.f; oc[1][r] = 0.f; }
#pragma unroll
        for (int kt = 0; kt < 4; ++kt) {
#pragma unroll
            for (int r = 0; r < 16; ++r) sc[kt][r] *= inv;
            abf16x8 pf[2];
#pragma unroll
            for (int s2 = 0; s2 < 2; ++s2) {
                typedef unsigned u32x4_t __attribute__((ext_vector_type(4)));
                u32x4_t w; w.x = cvtpk(sc[kt][8 * s2 + 0], sc[kt][8 * s2 + 1]); w.y = cvtpk(sc[kt][8 * s2 + 2], sc[kt][8 * s2 + 3]); w.z = cvtpk(sc[kt][8 * s2 + 4], sc[kt][8 * s2 + 5]); w.w = cvtpk(sc[kt][8 * s2 + 6], sc[kt][8 * s2 + 7]);
                pf[s2] = __builtin_bit_cast(abf16x8, w);
            }
#pragma unroll
            for (int dh = 0; dh < 2; ++dh)
#pragma unroll
                for (int s2 = 0; s2 < 2; ++s2) oc[dh] = __builtin_amdgcn_mfma_f32_32x32x16_bf16(*(const abf16x8*)(vp + (size_t)dh * 32 * 128 + 32 * kt + 16 * s2), pf[s2], oc[dh], 0, 0, 0);
            asm volatile("" ::: "memory");
        }
        float x7[4], x15[4];
#pragma unroll
        for (int kt = 0; kt < 4; ++kt) { x7[kt] = __shfl_xor(sc[kt][7], 32); x15[kt] = __shfl_xor(sc[kt][15], 32); }
        unsigned key[16];
        const int cur = tc >> 6;
#pragma unroll
        for (int kt = 0; kt < 4; ++kt)
#pragma unroll
            for (int gb = 0; gb < 2; ++gb) {
                const float pl0 = gb == 0 ? (kt > 0 ? x15[kt > 0 ? kt - 1 : 0] : 0.f) : x7[kt];
                const float pl1 = gb == 0 ? x7[kt] : x15[kt];
                const float prevlast = h ? pl1 : pl0;
                float ie = prevlast + sc[kt][8 * gb + 0] + sc[kt][8 * gb + 1] + sc[kt][8 * gb + 2] + sc[kt][8 * gb + 3];
                float io = sc[kt][8 * gb + 3] + sc[kt][8 * gb + 4] + sc[kt][8 * gb + 5] + sc[kt][8 * gb + 6] + sc[kt][8 * gb + 7];
                ie += __shfl_xor(ie, 8); ie += __shfl_xor(ie, 16);
                io += __shfl_xor(io, 8); io += __shfl_xor(io, 16);
#pragma unroll
                for (int eo = 0; eo < 2; ++eo) {
                    const int n = 8 * kt + 2 * h + 4 * gb + eo;
                    const bool forced = n == 0 || n == cur || n == cur - 1;
                    const float v = forced ? 1e4f : (eo ? io : ie);
                    key[(kt * 2 + gb) * 2 + eo] = n > cur ? (unsigned)(31 - n) : ((((__float_as_uint(v) >> 5) + 1u) << 5) | (unsigned)(31 - n));
                }
            }
#pragma unroll 1
        for (int round = 0; round < 8; ++round) {
            unsigned lm = key[0];
#pragma unroll
            for (int i = 1; i < 16; ++i) lm = lm > key[i] ? lm : key[i];
            const unsigned pm = (unsigned)__shfl_xor((int)lm, 32);
            const unsigned best = lm > pm ? lm : pm;
            selmask |= 1u << (31 - (best & 31u));
#pragma unroll
            for (int i = 0; i < 16; ++i) key[i] = key[i] == best ? 0u : key[i];
        }
        const float g0 = sigmoidf(GT[rowq * 24 + 0 * 8 + head]);
#pragma unroll
        for (int r = 0; r < 16; ++r) { osc[r * 64 + lane] = oc[0][r] * g0; osc[(16 + r) * 64 + lane] = oc[1][r] * g0; }
    }
    const int ktd = t0 >> 5;
    const LAS float* tabp = tabh + (2047 - tc + 8 * h);
    {
        unsigned umask = selmask;
#pragma unroll
        for (int o = 1; o < 64; o <<= 1) umask |= (unsigned)__shfl_xor((int)umask, o);
        umask = __builtin_amdgcn_readfirstlane(umask);
        int c2 = lane & 31, h2 = lane >> 5; asm volatile("" : "+v"(c2), "+v"(h2));
        const bf16_t* kp = P + ((size_t)b * S + pi32(c2)) * LDP + C_AKS + g * 64 + 8 * h2;
        const bf16_t* vp = VT + (size_t)(VR_AVS + g * 64 + c2) * M + (size_t)b * S + 8 * h2;
        Soft st; soft_init(st);
        KVF cur, nxt;
        load_kv(cur, kp, LDP, vp, (size_t)32 * M, 32 * ktd);
        int kt = ktd;
        while (kt >= 0) {
            int nk = kt - 1;
            while (nk >= 0 && !((umask >> (nk >> 1)) & 1u)) --nk;
            if (nk >= 0) load_kv(nxt, kp, LDP, vp, (size_t)32 * M, 32 * nk);
            const int D0 = tc - 32 * kt - 8 * h;
            const bool rowsel = (selmask >> (kt >> 1)) & 1u;
            if (kt == ktd) tile_step<true, false, true>(st, cur, qf, tabp, 32 * kt, D0, 0, rowsel);
            else tile_step<false, false, true>(st, cur, qf, tabp, 32 * kt, D0, 0, rowsel);
            if (nk >= 0) cur = nxt;
            kt = nk;
        }
        const float l = st.l + __shfl_xor(st.l, 32);
        const float g1 = sigmoidf(GT[rowq * 24 + 1 * 8 + head]) / l;
#pragma unroll
        for (int r = 0; r < 16; ++r) { osc[r * 64 + lane] += st.o[0][r] * g1; osc[(16 + r) * 64 + lane] += st.o[1][r] * g1; }
    }
    {
        int c2 = lane & 31, h2 = lane >> 5; asm volatile("" : "+v"(c2), "+v"(h2));
        const bf16_t* kp = P + ((size_t)b * S + pi32(c2)) * LDP + C_AKW + g * 64 + 8 * h2;
        const bf16_t* vp = VT + (size_t)(VR_AVW + g * 64 + c2) * M + (size_t)b * S + 8 * h2;
        Soft st; soft_init(st);
        const int ktlo = (t0 - 511 > 0 ? t0 - 511 : 0) >> 5;
        KVF cur, nxt;
        load_kv(cur, kp, LDP, vp, (size_t)32 * M, 32 * ktd);
        for (int kt = ktd; kt >= ktlo; --kt) {
            if (kt > ktlo) load_kv(nxt, kp, LDP, vp, (size_t)32 * M, 32 * (kt - 1));
            const int D0 = tc - 32 * kt - 8 * h;
            if (kt == ktd) tile_step<true, false, false>(st, cur, qf, tabp, 32 * kt, D0, 0, true);
            else if (32 * kt < t0 + 7 - 511) tile_step<false, true, false>(st, cur, qf, tabp, 32 * kt, D0, 511, true);
            else tile_step<false, false, false>(st, cur, qf, tabp, 32 * kt, D0, 0, true);
            if (kt > ktlo) cur = nxt;
        }
        const float l = st.l + __shfl_xor(st.l, 32);
        const float g2 = sigmoidf(GT[rowq * 24 + 2 * 8 + head]) / l;
#pragma unroll
        for (int r = 0; r < 16; ++r) { st.o[0][r] = osc[r * 64 + lane] + st.o[0][r] * g2; st.o[1][r] = osc[(16 + r) * 64 + lane] + st.o[1][r] * g2; }
        int c3 = lane & 31; asm volatile("" : "+v"(c3));
        const size_t rowq3 = (size_t)b * S + t0 + (c3 & 7); const int head3 = g * 4 + (c3 >> 3);
        store_rows(st.o, 1.f, P + rowq3 * LDP + C_AGATE + head3 * 64, MIX + rowq3 * DM + head3 * 64, h2);
    }
}

#define LAUNDER_S(x)
#define PH_COMMON \
    int tid_ = threadIdx.x; asm volatile("" : "+v"(tid_)); const int tid = tid_, lane = tid & 63, wib = __builtin_amdgcn_readfirstlane(tid >> 6); \
    const int G = gridDim.x; const int gthreads = G * NT, gtid = blockIdx.x * NT + tid; const int gwaves = G * NWAVES, gwave = blockIdx.x * NWAVES + wib; \
    unsigned char* ws = prm.ws; asm volatile("" : "+s"(ws)); (void)lane; (void)gthreads; (void)gtid; (void)gwaves; (void)gwave; (void)ws;

__device__ __forceinline__ void phase_prologue(const Params& prm, LAS unsigned char* ldsb) {
    PH_COMMON
    float* biasd = (float*)(ws + WS_BIASD); bf16_t* WG = (bf16_t*)(ws + WS_WG);
    bf16_t* WINT = (bf16_t*)(ws + WS_WIN); bf16_t* WOUTT = (bf16_t*)(ws + WS_WOUT); bf16_t* XB = (bf16_t*)(ws + WS_XB);
    for (int i = gtid; i < 24 * 2048; i += gthreads) { const int h = i >> 11, d = i & 2047; biasd[i] = prm.rel_bias[t5_bucket(d) * 24 + h]; }
    {
        float* img = (float*)(ws + WS_IMG);
        for (int i = gtid; i < 8 * 2048; i += gthreads) { const int h = i >> 11, d = 2047 - (i & 2047);
            img[i] = prm.rel_bias[t5_bucket(d) * 24 + h] * LOG2E;
            const int mult = (d <= 128 ? 1 : 0) + (((d & 3) == 0 && d <= 512) ? 1 : 0) + ((d & 15) == 0 ? 1 : 0);
            img[8 * 2048 + i] = mult == 0 ? -INFINITY : prm.rel_bias[t5_bucket(d) * 24 + 16 + h] * LOG2E + (mult == 1 ? 0.f : (mult == 2 ? 1.f : 1.5849625007211562f)); }
        for (int i = gtid; i < 8 * 256; i += gthreads) { const int h = i >> 8, d = 255 - (i & 255); img[16 * 2048 + i] = prm.rel_bias[t5_bucket(d) * 24 + 8 + h] * LOG2E; }
    }
    for (int i = gtid; i < DEPTH * 32 * 2048; i += gthreads) { const int k = i & 2047, j = (i >> 11) & 31, l = i >> 16;
        WG[i] = j < 24 ? f2bf(prm.w_in[(size_t)l * DM * DIN + (size_t)k * DIN + SRC_GATES + j] * prm.norm_w[l * DM + k]) : (bf16_t)0; }
    {
        bf16_t* W1T = (bf16_t*)(ws + WS_W1T); bf16_t* W2T = (bf16_t*)(ws + WS_W2T); float* PB = (float*)(ws + WS_PB);
        for (int i = gtid; i < 4 * 2048 * 128; i += gthreads) { const int j = i & 127, k = (i >> 7) & 2047, lw = i >> 18;
            const int kk = (lw & 1) ? ((k & 63) * 32 + (k >> 6)) : k;
            W1T[((size_t)lw * 128 + j) * 2048 + kk] = f2bf(prm.cmp_w1[((size_t)lw * 2048 + k) * 128 + j]); }
        for (int i = gtid; i < 4 * 128 * 64; i += gthreads) { const int e = i & 63, j = (i >> 6) & 127, lw = i >> 13; W2T[((size_t)lw * 64 + e) * 128 + j] = f2bf(prm.cmp_w2[((size_t)lw * 128 + j) * 64 + e]); }
        for (int o = gwave; o < 4 * 128; o += gwaves) { const int j = o & 127, lw = o >> 7; float a = 0.f;
            for (int k = lane; k < 2048; k += 64) a += prm.cmp_pos[(size_t)lw * 2048 + k] * prm.cmp_w1[((size_t)lw * 2048 + k) * 128 + j];
            a = wave_sum(a); if (lane == 0) PB[o] = a; }
    }
    {
        LAS float* scr = (LAS float*)(ldsb + wib * 16384);
        constexpr int I_IN = 32 * (NW_IN / 32), I_OUT = 32 * (DM / 32);
        for (int it = gwave; it < DEPTH * (I_IN + I_OUT); it += gwaves) {
            const int l = it / (I_IN + I_OUT); int r = it % (I_IN + I_OUT);
            if (r < I_IN) { const int nb = r % (NW_IN / 32), kb = r / (NW_IN / 32);
                transpose_item(prm.w_in + (size_t)l * DM * DIN, DM, DIN, src_col_of(32 * nb) - 32 * nb, prm.norm_w + l * DM, WINT + (size_t)l * NW_IN * DM, scr, kb, nb, lane); }
            else { r -= I_IN; const int nb = r % (DM / 32), kb = r / (DM / 32);
                transpose_item(prm.w_out + (size_t)l * DM * DM, DM, DM, 0, nullptr, WOUTT + (size_t)l * DM * DM, scr, kb, nb, lane); }
        }
    }
    for (int row = gwave; row < M; row += gwaves) rms_row_to_bf16(prm.x + (size_t)row * DM, XB + (size_t)row * DM, lane);
}

__device__ __forceinline__ void phase_inproj(const Params& prm, int layer, LAS unsigned char* ldsb) {
    LAUNDER_S(layer);
    unsigned char* ws = prm.ws; asm volatile("" : "+s"(ws));
    const bf16_t* W = (const bf16_t*)(ws + WS_WIN) + (size_t)layer * NW_IN * DM;
    {
        pg8::Gemm g{(const bf16_t*)(ws + WS_XB), W, M, LDP, DM}; pg8::StaticOrder So; So.init(M, LDP, (int)gridDim.x, (int)blockIdx.x);
        pg8::EpiBf16 E{(bf16_t*)(ws + WS_P), LDP};
        pg8::gemm_phase<pg8::EpiBf16, pg8::StaticOrder, true, true>(ldsb, g, So, E);
    }
    {
        pg8::Gemm g{W + (size_t)LDP * DM, (const bf16_t*)(ws + WS_XB), NVT, M, DM}; pg8::StaticOrder So; So.init(NVT, M, (int)gridDim.x, (int)blockIdx.x);
        pg8::EpiBf16 E{(bf16_t*)(ws + WS_VT), M};
        pg8::gemm_phase<pg8::EpiBf16, pg8::StaticOrder, true, true>(ldsb, g, So, E);
    }
}
__device__ __forceinline__ void phase_outproj(const Params& prm, int layer, LAS unsigned char* ldsb) {
    LAUNDER_S(layer);
    unsigned char* ws = prm.ws; asm volatile("" : "+s"(ws));
    const float* xin = layer == 0 ? prm.x : prm.out;
    pg8::Gemm g{(const bf16_t*)(ws + WS_MIX), (const bf16_t*)(ws + WS_WOUT) + (size_t)layer * DM * DM, M, DM, DM}; pg8::StaticOrder So; So.init(M, DM, (int)gridDim.x, (int)blockIdx.x);
    pg8::EpiResid E{xin, prm.out, DM};
    pg8::gemm_phase<pg8::EpiResid, pg8::StaticOrder, true, true>(ldsb, g, So, E);
}
__device__ __forceinline__ void phase_gates(const Params& prm, int layer, LAS unsigned char* ldsb) {
    LAUNDER_S(layer);
    PH_COMMON
    const bf16_t* XB = (const bf16_t*)(ws + WS_XB); float* GT = (float*)(ws + WS_G);
    const bf16_t* wg = (const bf16_t*)(ws + WS_WG) + (size_t)layer * 32 * 2048;
    const int c = lane & 31, h = lane >> 5, kq = wib & 3, half = wib >> 2;
    LAS float* red = (LAS float*)ldsb + wib * 1024;
    for (int blk = blockIdx.x; blk < M / 64; blk += G) {
        const int row0 = blk * 64 + half * 32;
        const bf16_t* ap = XB + (size_t)(row0 + c) * DM + kq * 512 + 8 * h;
        const bf16_t* bp = wg + (size_t)c * DM + kq * 512 + 8 * h;
        f32x16 acc;
#pragma unroll
        for (int r = 0; r < 16; ++r) acc[r] = 0.f;
#pragma unroll 8
        for (int s = 0; s < 32; ++s) acc = __builtin_amdgcn_mfma_f32_32x32x16_bf16(*(const abf16x8*)(ap + 16 * s), *(const abf16x8*)(bp + 16 * s), acc, 0, 0, 0);
#pragma unroll
        for (int r = 0; r < 16; ++r) red[r * 64 + lane] = acc[r];
        __syncthreads();
        if (kq == 0 && c < 24) {
#pragma unroll
            for (int r = 0; r < 16; ++r) { const float v = (red[r * 64 + lane] + red[1024 + r * 64 + lane]) + (red[2048 + r * 64 + lane] + red[3072 + r * 64 + lane]);
                GT[(size_t)(row0 + (r & 3) + 8 * (r >> 2) + 4 * h) * 24 + c] = v; }
        }
        __syncthreads();
    }
}
__device__ __forceinline__ void phase_compress(const Params& prm, int layer, LAS unsigned char* ldsb) {
    LAUNDER_S(layer);
    PH_COMMON
    const bf16_t* P = (const bf16_t*)(ws + WS_P); const bf16_t* VT = (const bf16_t*)(ws + WS_VT);
    bf16_t* KCMP = (bf16_t*)(ws + WS_CMP); bf16_t* VCMPT = KCMP + (size_t)NB * 2 * 128 * 64;
    const int c = lane & 31, h = lane >> 5, jt = wib & 3, kh = wib >> 2;
    LAS float* red = (LAS float*)ldsb;
    LAS float* hid = (LAS float*)(ldsb + 32768);
    for (int u = blockIdx.x; u < 2 * NB * 2 * 4; u += G) {
        const int ct = u & 3, g = (u >> 2) & 1, b = (u >> 3) & 7, which = u >> 6;
        const int lw = layer * 2 + which;
        const bf16_t* w1 = (const bf16_t*)(ws + WS_W1T) + ((size_t)lw * 128 + jt * 32 + c) * 2048 + kh * 1024 + 8 * h;
        int cc = ct * 32 + c; if (cc > NCMP - 1) cc = NCMP - 1;
        f32x16 acc;
#pragma unroll
        for (int r = 0; r < 16; ++r) acc[r] = 0.f;
        if (which == 0) {
            const bf16_t* src = P + (size_t)(b * S + 16 * cc) * LDP + C_AKC + g * 64 + 8 * h;
#pragma unroll 8
            for (int s = 0; s < 64; ++s) { const int ks = kh * 64 + s;
                acc = __builtin_amdgcn_mfma_f32_32x32x16_bf16(*(const abf16x8*)(w1 + 16 * s), *(const abf16x8*)(src + (size_t)(ks >> 2) * LDP + (ks & 3) * 16), acc, 0, 0, 0); }
        } else {
            const bf16_t* src = VT + (size_t)(VR_AVC + g * 64) * M + (size_t)(b * S + 16 * cc) + 8 * h;
#pragma unroll 8
            for (int s = 0; s < 64; ++s) { const int ks = kh * 64 + s;
                acc = __builtin_amdgcn_mfma_f32_32x32x16_bf16(*(const abf16x8*)(w1 + 16 * s), *(const abf16x8*)(src + (size_t)(ks >> 1) * M + (ks & 1) * 16), acc, 0, 0, 0); }
        }
#pragma unroll
        for (int r = 0; r < 16; ++r) red[wib * 1024 + r * 64 + lane] = acc[r];
        __syncthreads();
        if (wib < 4) {
            const float* pb = (const float*)(ws + WS_PB) + lw * 128;
#pragma unroll
            for (int r = 0; r < 16; ++r) { const int j = jt * 32 + (r & 3) + 8 * (r >> 2) + 4 * h;
                hid[j * 32 + c] = silu(red[wib * 1024 + r * 64 + lane] + red[(wib + 4) * 1024 + r * 64 + lane] + pb[j]); }
        }
        __syncthreads();
        if (wib < 2) {
            const bf16_t* w2 = (const bf16_t*)(ws + WS_W2T) + ((size_t)lw * 64 + wib * 32 + c) * 128 + 8 * h;
            f32x16 o;
#pragma unroll
            for (int r = 0; r < 16; ++r) o[r] = 0.f;
#pragma unroll
            for (int s = 0; s < 8; ++s) {
                u32x4_t_ w; const LAS float* hp = hid + (16 * s + 8 * h) * 32 + c;
                w.x = cvtpk(hp[0], hp[32]); w.y = cvtpk(hp[64], hp[96]); w.z = cvtpk(hp[128], hp[160]); w.w = cvtpk(hp[192], hp[224]);
                o = __builtin_amdgcn_mfma_f32_32x32x16_bf16(*(const abf16x8*)(w2 + 16 * s), __builtin_bit_cast(abf16x8, w), o, 0, 0, 0);
            }
            const int cw = ct * 32 + c;
            if (which == 0) {
                bf16_t* dst = KCMP + ((size_t)(b * 2 + g) * 128 + cw) * 64 + wib * 32 + 4 * h;
#pragma unroll
                for (int rg = 0; rg < 4; ++rg) { uint2 w; w.x = cvtpk(o[4 * rg], o[4 * rg + 1]); w.y = cvtpk(o[4 * rg + 2], o[4 * rg + 3]); *(uint2*)(dst + 8 * rg) = w; }
            } else {
                bf16_t* dst = VCMPT + ((size_t)(b * 2 + g) * 64 + wib * 32 + 4 * h) * 128 + cw;
#pragma unroll
                for (int r = 0; r < 16; ++r) dst[(size_t)((r & 3) + 8 * (r >> 2)) * 128] = f2bf(o[r]);
            }
        }
        __syncthreads();
    }
}
typedef unsigned u32x4_t __attribute__((ext_vector_type(4)));
__device__ __forceinline__ void phase_mix_ab(const Params& prm, int layer, LAS unsigned char* ldsb) {
    LAUNDER_S(layer);
    PH_COMMON
    {
        const u32x4_t* src = (const u32x4_t*)(ws + WS_IMG); LAS u32x4_t* dst = (LAS u32x4_t*)ldsb;
        for (int i = tid; i < 65536 / 16; i += NT) dst[i] = src[i];
        for (int i = tid; i < 8192 / 16; i += NT) dst[65536 / 16 + i] = src[131072 / 16 + i];
        __syncthreads();
    }
    const float* GT = (const float*)(ws + WS_G); const bf16_t* KCMP = (const bf16_t*)(ws + WS_CMP); const bf16_t* VCMPT = KCMP + (size_t)NB * 2 * 128 * 64;
    const bf16_t* P = (const bf16_t*)(ws + WS_P); bf16_t* MIX = (bf16_t*)(ws + WS_MIX); const bf16_t* VT = (const bf16_t*)(ws + WS_VT);
    const LAS float* tabA = (const LAS float*)(ldsb + OFF_TA);
    LAS float* osc = (LAS float*)(ldsb + OFF_OSC + wib * 8192);
    for (int pr = gwave; pr < NB * 2 * 128; pr += gwaves) {
        const int bg = pr >> 7, qa = pr & 127;
#pragma unroll 1
        for (int k = 0; k < 2; ++k) unit_A(P, VT, KCMP, VCMPT, GT, MIX, tabA, osc, bg >> 1, bg & 1, k ? 255 - qa : qa, lane);
    }
}
__device__ __forceinline__ void phase_mix_b(const Params& prm, int layer, LAS unsigned char* ldsb) {
    LAUNDER_S(layer);
    PH_COMMON
    const bf16_t* P = (const bf16_t*)(ws + WS_P); bf16_t* MIX = (bf16_t*)(ws + WS_MIX); const bf16_t* VT = (const bf16_t*)(ws + WS_VT);
    const float* sinks = prm.sinks + layer * 8;
    const LAS float* tabB = (const LAS float*)(ldsb + OFF_TB);
#pragma unroll 1
    for (int u = gwave; u < NB * 2 * 256; u += gwaves) unit_B(P, VT, MIX, tabB, sinks, u >> 9, (u >> 8) & 1, u & 255, lane);
}
__device__ __forceinline__ void phase_mix_d(const Params& prm, LAS unsigned char* ldsb) {
    PH_COMMON
    {
        const u32x4_t* src = (const u32x4_t*)(ws + WS_IMG + 65536); LAS u32x4_t* dst = (LAS u32x4_t*)(ldsb + OFF_TD);
        for (int i = tid; i < 65536 / 16; i += NT) dst[i] = src[i];
        __syncthreads();
    }
    const bf16_t* P = (const bf16_t*)(ws + WS_P); bf16_t* MIX = (bf16_t*)(ws + WS_MIX); const bf16_t* VT = (const bf16_t*)(ws + WS_VT);
    const LAS float* tabD = (const LAS float*)(ldsb + OFF_TD);
    for (int pr = gwave; pr < NB * 8 * 32; pr += gwaves) {
        const int bh = pr >> 5, qa = pr & 31;
#pragma unroll 1
        for (int k = 0; k < 2; ++k) unit_D(P, VT, MIX, tabD, bh >> 3, bh & 7, k ? 63 - qa : qa, lane);
    }
}
__device__ __forceinline__ void unpack8(const uint4 w, float (&f)[8]) {
    f[0] = __uint_as_float(w.x << 16); f[1] = __uint_as_float(w.x & 0xffff0000u); f[2] = __uint_as_float(w.y << 16); f[3] = __uint_as_float(w.y & 0xffff0000u);
    f[4] = __uint_as_float(w.z << 16); f[5] = __uint_as_float(w.z & 0xffff0000u); f[6] = __uint_as_float(w.w << 16); f[7] = __uint_as_float(w.w & 0xffff0000u);
}
__device__ __forceinline__ void phase_conv(const Params& prm, int layer) {
    LAUNDER_S(layer);
    PH_COMMON
    const bf16_t* P = (const bf16_t*)(ws + WS_P); bf16_t* MIX = (bf16_t*)(ws + WS_MIX);
    const float* convw = prm.conv_w + layer * 3 * 512;
    for (int i = gtid; i < M * 64; i += gthreads) {
        const int c0 = (i & 63) * 8, row = i >> 6, t = row & (S - 1);
        const bf16_t* pr = P + (size_t)row * LDP;
        float cb[8], cg[8], a[8], bb[8], y[8];
        unpack8(*(const uint4*)(pr + C_CB + c0), cb); unpack8(*(const uint4*)(pr + C_CGATE + c0), cg);
        unpack8(*(const uint4*)(pr + C_CC + c0), a); unpack8(*(const uint4*)(pr + C_CH + c0), bb);
#pragma unroll
        for (int j = 0; j < 8; ++j) y[j] = convw[2 * 512 + c0 + j] * a[j] * bb[j];
        if (t >= 1) { unpack8(*(const uint4*)(pr + C_CC + c0 - LDP), a); unpack8(*(const uint4*)(pr + C_CH + c0 - LDP), bb);
#pragma unroll
            for (int j = 0; j < 8; ++j) y[j] += convw[1 * 512 + c0 + j] * a[j] * bb[j]; }
        if (t >= 2) { unpack8(*(const uint4*)(pr + C_CC + c0 - 2 * LDP), a); unpack8(*(const uint4*)(pr + C_CH + c0 - 2 * LDP), bb);
#pragma unroll
            for (int j = 0; j < 8; ++j) y[j] += convw[0 * 512 + c0 + j] * a[j] * bb[j]; }
        uint4 w;
        w.x = cvtpk(cb[0] * y[0] * silu(cg[0]), cb[1] * y[1] * silu(cg[1])); w.y = cvtpk(cb[2] * y[2] * silu(cg[2]), cb[3] * y[3] * silu(cg[3]));
        w.z = cvtpk(cb[4] * y[4] * silu(cg[4]), cb[5] * y[5] * silu(cg[5])); w.w = cvtpk(cb[6] * y[6] * silu(cg[6]), cb[7] * y[7] * silu(cg[7]));
        *(uint4*)(MIX + (size_t)row * DM + 1024 + c0) = w;
    }
}
__device__ __forceinline__ void phase_xb(const Params& prm) {
    PH_COMMON
    bf16_t* XB = (bf16_t*)(ws + WS_XB);
    for (int row = gwave; row < M; row += gwaves) rms_row_to_bf16(prm.out + (size_t)row * DM, XB + (size_t)row * DM, lane);
}
__device__ __forceinline__ void phase_final(const Params& prm) {
    PH_COMMON
    for (int row = gwave; row < M; row += gwaves) {
        float4* xr = (float4*)(prm.out + (size_t)row * DM);
        float4 v[8]; float s = 0.f;
#pragma unroll
        for (int j = 0; j < 8; ++j) { v[j] = xr[lane + 64 * j]; s += v[j].x * v[j].x + v[j].y * v[j].y + v[j].z * v[j].z + v[j].w * v[j].w; }
        s = wave_sum(s);
        const float r = rsqrtf(s * (1.f / DM) + 1e-6f);
#pragma unroll
        for (int j = 0; j < 8; ++j) { const float4 w = ((const float4*)prm.final_norm_w)[lane + 64 * j];
            xr[lane + 64 * j] = make_float4(v[j].x * r * w.x, v[j].y * r * w.y, v[j].z * r * w.z, v[j].w * r * w.w); }
    }
}

#ifndef REP_PRO
#define REP_PRO 1
#endif
#ifndef REP_INP
#define REP_INP 1
#endif
#ifndef REP_GAT
#define REP_GAT 1
#endif
#ifndef REP_CMP
#define REP_CMP 1
#endif
#ifndef REP_MAB
#define REP_MAB 1
#endif
#ifndef REP_MB
#define REP_MB 1
#endif
#ifndef REP_MD
#define REP_MD 1
#endif
#ifndef REP_CNV
#define REP_CNV 1
#endif
#ifndef REP_SYNC
#define REP_SYNC 1
#endif
#define REPEAT(n) _Pragma("unroll 1") for (int rep_ = 0; rep_ < (n); ++rep_)
__global__ void __launch_bounds__(NT, 2) fwd_kernel(Params prm) {
    cg::grid_group grid = cg::this_grid();
    extern __shared__ __attribute__((aligned(16))) unsigned char lds_raw[];
    LAS unsigned char* ldsb = (LAS unsigned char*)lds_raw;
    float* lds = (float*)lds_raw;
    REPEAT(REP_PRO) { phase_prologue(prm, ldsb); __syncthreads(); }
    REPEAT(REP_SYNC) grid.sync();
#pragma unroll
    for (int layer = 0; layer < DEPTH; ++layer) {
        REPEAT(REP_INP) phase_inproj(prm, layer, ldsb);
        REPEAT(REP_GAT) phase_gates(prm, layer, ldsb);
        grid.sync();
        REPEAT(REP_CMP) phase_compress(prm, layer, ldsb);
        grid.sync();
        REPEAT(REP_MAB) { phase_mix_ab(prm, layer, ldsb); __syncthreads(); }
        REPEAT(REP_MB) phase_mix_b(prm, layer, ldsb);
        __syncthreads();
        REPEAT(REP_MD) { phase_mix_d(prm, ldsb); __syncthreads(); }
        REPEAT(REP_CNV) phase_conv(prm, layer);
        grid.sync();
        phase_outproj(prm, layer, ldsb);
        grid.sync();
        if (layer + 1 < DEPTH) { phase_xb(prm); grid.sync(); }
    }
    phase_final(prm);
}

extern "C" void kernel_launch(void* const* d_in, const int* in_sizes, int n_in, void* d_out, int out_size, void* d_ws, size_t ws_size, hipStream_t stream) {
    static int grid_blocks = 0;
    if (!grid_blocks) {
        int dev = 0, cus = 0, per_cu = 0;
        (void)hipGetDevice(&dev);
        (void)hipDeviceGetAttribute(&cus, hipDeviceAttributeMultiprocessorCount, dev);
        if (hipFuncSetAttribute((const void*)fwd_kernel, hipFuncAttributeMaxDynamicSharedMemorySize, LDS_BYTES) != hipSuccess) fprintf(stderr, "kernel_launch: hipFuncSetAttribute failed\n");
        (void)hipOccupancyMaxActiveBlocksPerMultiprocessor(&per_cu, fwd_kernel, NT, LDS_BYTES);
        if (per_cu < 1) fprintf(stderr, "kernel_launch: occupancy query says %d blocks per CU\n", per_cu);
        grid_blocks = cus;
        if (ws_size < WS_END) fprintf(stderr, "kernel_launch: workspace too small: %zu < %zu\n", ws_size, (size_t)WS_END);
    }
    Params p{};
    p.x = (const float*)d_in[0]; p.norm_w = (const float*)d_in[1]; p.w_in = (const float*)d_in[2]; p.w_out = (const float*)d_in[3];
    p.conv_w = (const float*)d_in[4]; p.sinks = (const float*)d_in[5]; p.cmp_pos = (const float*)d_in[6]; p.cmp_w1 = (const float*)d_in[7];
    p.cmp_w2 = (const float*)d_in[8]; p.rel_bias = (const float*)d_in[9]; p.final_norm_w = (const float*)d_in[10];
    p.out = (float*)d_out; p.ws = (unsigned char*)d_ws;
    void* args[] = {&p};
    hipError_t e = hipLaunchCooperativeKernel((void*)fwd_kernel, dim3(grid_blocks), dim3(NT), args, LDS_BYTES, stream);
    if (e != hipSuccess) fprintf(stderr, "cooperative launch failed: %s (grid %d)\n", hipGetErrorString(e), grid_blocks);
}
```

```cpp
#include <hip/hip_runtime.h>
#include <cstdio>
#include <cstdint>

namespace pg8 {
#define PG8_LAS __attribute__((address_space(3)))
typedef unsigned short bf16_t;
typedef short bf16x8 __attribute__((ext_vector_type(8)));
typedef float f32x4 __attribute__((ext_vector_type(4)));
typedef unsigned u32x4 __attribute__((ext_vector_type(4)));
constexpr int BM = 256, BK = 64, HALF = 128, HTB = HALF * BK * 2  , STAGE_BYTES = 8 * HTB, NXCD = 8, WGM = 8;

__host__ __device__ __forceinline__ int lds_byte(int r, int c) { const int st = (r >> 4) * 2 + (c >> 5), rr = r & 15, cc = c & 31, ob = rr * 64 + cc * 2; return st * 1024 + (ob ^ (((ob >> 9) & 1) << 5)); }
__host__ __device__ __forceinline__ void stage_rc(int b, int& R, int& C) { const int st = b / 1024, sb = b % 1024, swz = sb ^ (((sb >> 9) & 1) << 5); R = (st >> 1) * 16 + swz / 64; C = (st & 1) * 32 + (swz % 64) / 2; }
__host__ __device__ __forceinline__ int perm32(int rho) { const int n = rho >> 4, i = rho & 15; return 8 * (i >> 2) + 4 * n + (i & 3); }

struct Unit { int pm, pn; };
struct Gemm { const bf16_t* A; const bf16_t* Bt; int M, N, K; };

struct StaticOrder {
    int nM, nN, nwg, G, c;
    __host__ __device__ void init(int M, int N, int G_, int c_) { nM = M / BM; nN = N / BM; nwg = nM * nN; G = G_; c = c_; }
    __host__ __device__ bool next(int i, Unit& u) const {
        const long L = (long)i * G + c; if (L >= nwg) return false;
        int wgid = (int)L; { const int q = nwg / NXCD, r = nwg % NXCD, xcd = wgid % NXCD, off = wgid / NXCD; wgid = (xcd < r ? xcd * (q + 1) : r * (q + 1) + (xcd - r) * q) + off; }
        const int nig = WGM * nN, gid = wgid / nig, fm = gid * WGM, gsz = (nM - fm) < WGM ? (nM - fm) : WGM;
        u.pm = fm + ((wgid % nig) % gsz); u.pn = (wgid % nig) / gsz; return true;
    }
    __device__ __forceinline__ void a_ready(const Unit&) const {}
    __device__ __forceinline__ void done(const Unit&) const {}
};


__device__ __forceinline__ unsigned cvt_pk_bf16(float lo, float hi) { unsigned r; asm volatile("v_cvt_pk_bf16_f32 %0, %1, %2" : "=v"(r) : "v"(lo), "v"(hi)); return r; }
struct EpiBf16 {
    static constexpr bool PERM = true, AFTER_DRAIN = false;
    bf16_t* O; int ldc;
    __device__ __forceinline__ void operator()(const f32x4 (&acc)[2][2][4][2], const Unit& u, int wr, int wc, int fr, int fq) const {
        const int row0 = u.pm * BM + wr * 64 + fr; const int col0 = u.pn * BM + wc * 32 + 8 * fq;
#pragma unroll
        for (int ai = 0; ai < 2; ++ai)
#pragma unroll
            for (int m = 0; m < 4; ++m) { bf16_t* rowp = O + (size_t)(row0 + ai * HALF + m * 16) * ldc + col0;
#pragma unroll
                for (int bj = 0; bj < 2; ++bj) { const f32x4 v0 = acc[ai][bj][m][0], v1 = acc[ai][bj][m][1];
                    u32x4 w; w.x = cvt_pk_bf16(v0[0], v0[1]); w.y = cvt_pk_bf16(v0[2], v0[3]); w.z = cvt_pk_bf16(v1[0], v1[1]); w.w = cvt_pk_bf16(v1[2], v1[3]);
                    *(u32x4*)(rowp + bj * HALF) = w; } }
    }
};
struct EpiResid {
    static constexpr bool PERM = false, AFTER_DRAIN = false;
    const float* base; float* out; int ldc;
    __device__ __forceinline__ void operator()(const f32x4 (&acc)[2][2][4][2], const Unit& u, int wr, int wc, int fr, int fq) const {
        const int col0 = u.pn * BM + wc * 32 + 4 * fq;
#pragma unroll
        for (int ai = 0; ai < 2; ++ai)
#pragma unroll
            for (int m = 0; m < 4; ++m) { const size_t off = (size_t)(u.pm * BM + ai * HALF + wr * 64 + m * 16 + fr) * ldc + col0;
#pragma unroll
                for (int bj = 0; bj < 2; ++bj)
#pragma unroll
                    for (int n = 0; n < 2; ++n) { const f32x4 bs = *(const f32x4*)(base + off + bj * HALF + n * 16); *(f32x4*)(out + off + bj * HALF + n * 16) = bs + acc[ai][bj][m][n]; } }
    }
};

template <class Epi, class Sched, bool ALIGN_EPI = false, bool SP2 = false>
__device__ __forceinline__ void gemm_phase(PG8_LAS unsigned char* lds, const Gemm g, const Sched& S, const Epi& E) {
    int tid_ = threadIdx.x; asm volatile("" : "+v"(tid_));
    const int tid = tid_, wid = __builtin_amdgcn_readfirstlane(tid >> 6), lane = tid & 63, wr = wid >> 2, wc = wid & 3, fr = lane & 15, fq = lane >> 4;
    const int K = g.K, nt = K / BK;
    unsigned voffA[2], voffB[2];
#pragma unroll
    for (int i = 0; i < 2; ++i) { int R, C; stage_rc(tid * 16 + i * 8192, R, C); const int Rb = Epi::PERM ? ((R & ~31) + perm32(R & 31)) : R;
        voffA[i] = (unsigned)(R * K + C) * 2u; voffB[i] = (unsigned)(Rb * K + C) * 2u; }
    const size_t kstep = (size_t)(BK * 2);
    const size_t hstep = (size_t)HALF * K * 2;
    const size_t tstep = 2 * hstep;
    const unsigned ldsw = (unsigned)wid * 1024u;
    const unsigned ldsm0 = __builtin_amdgcn_readfirstlane((unsigned)(unsigned long long)lds + ldsw);
    const int aoff = lds_byte(wr * 64 + fr, fq * 8), boff = lds_byte(wc * 32 + fr, fq * 8);
#define PG8_SA(b, h) (((b) * 2 + (h)) * HTB)
#define PG8_SB(b, h) ((4 + (b) * 2 + (h)) * HTB)
#define PG8_STAGE(bufoff, gbase, voff) do { _Pragma("unroll") for (int _i = 0; _i < 2; ++_i) \
        asm volatile("s_mov_b32 m0, %0\n\ts_nop 0\n\tglobal_load_lds_dwordx4 %1, %2" :: "s"(ldsm0 + (unsigned)((bufoff) + _i * 8192)), "v"((voff)[_i]), "s"((const char*)(gbase)) : "m0", "memory"); } while (0)
#define PG8_LDA(dst, b, h) do { _Pragma("unroll") for (int m = 0; m < 4; ++m) _Pragma("unroll") for (int k = 0; k < 2; ++k) dst[m][k] = *(const PG8_LAS bf16x8*)(lds + PG8_SA(b, h) + aoff + m * 2048 + k * 1024); } while (0)
#define PG8_LDB(dst, b, h) do { _Pragma("unroll") for (int n = 0; n < 2; ++n) _Pragma("unroll") for (int k = 0; k < 2; ++k) dst[n][k] = *(const PG8_LAS bf16x8*)(lds + PG8_SB(b, h) + boff + n * 2048 + k * 1024); } while (0)
#define PG8_MMA(ai, bj, At, Bt) do { __builtin_amdgcn_s_setprio(1); _Pragma("unroll") for (int m = 0; m < 4; ++m) _Pragma("unroll") for (int n = 0; n < 2; ++n) _Pragma("unroll") for (int k = 0; k < 2; ++k) \
        acc[ai][bj][m][n] = __builtin_amdgcn_mfma_f32_16x16x32_bf16(Bt[n][k], At[m][k], acc[ai][bj][m][n], 0, 0, 0); __builtin_amdgcn_s_setprio(0); } while (0)
#define PG8_WAIT_V(n) asm volatile("s_waitcnt vmcnt(" #n ")" ::: "memory")
#define PG8_WAIT_L(n) asm volatile("s_waitcnt lgkmcnt(" #n ")" ::: "memory")
#define PG8_BAR __builtin_amdgcn_s_barrier()
#define PG8_SCHED __builtin_amdgcn_sched_barrier(0)
    Unit cur, nxt; int ui = 0;
    if (!S.next(0, cur)) return;
    f32x4 acc[2][2][4][2];
#pragma unroll
    for (int a = 0; a < 2; ++a)
#pragma unroll
        for (int b = 0; b < 2; ++b)
#pragma unroll
            for (int m = 0; m < 4; ++m)
#pragma unroll
                for (int n = 0; n < 2; ++n) acc[a][b][m][n] = (f32x4){0.f, 0.f, 0.f, 0.f};
    bf16x8 At[4][2], B0[2][2], B1[2][2];
    const char* cA = (const char*)g.A + (size_t)cur.pm * tstep; const char* cB = (const char*)g.Bt + (size_t)cur.pn * tstep;
    S.a_ready(cur);
    if constexpr (SP2) {
        PG8_STAGE(PG8_SB(0, 0), cB, voffB); PG8_STAGE(PG8_SB(0, 1), cB + hstep, voffB); PG8_STAGE(PG8_SA(0, 0), cA, voffA); PG8_STAGE(PG8_SA(0, 1), cA + hstep, voffA);
        if (wr == 1) PG8_BAR;
        PG8_WAIT_V(2); PG8_BAR;
        PG8_STAGE(PG8_SB(1, 0), cB + kstep, voffB); PG8_STAGE(PG8_SA(1, 0), cA + kstep, voffA); PG8_STAGE(PG8_SB(1, 1), cB + hstep + kstep, voffB);
        PG8_WAIT_V(6); PG8_BAR;
    } else {
        PG8_STAGE(PG8_SB(0, 0), cB, voffB); PG8_STAGE(PG8_SA(0, 0), cA, voffA); PG8_STAGE(PG8_SB(0, 1), cB + hstep, voffB); PG8_STAGE(PG8_SA(0, 1), cA + hstep, voffA);
        if (wr == 1) PG8_BAR;
        PG8_WAIT_V(4); PG8_BAR;
        PG8_STAGE(PG8_SB(1, 0), cB + kstep, voffB); PG8_STAGE(PG8_SA(1, 0), cA + kstep, voffA); PG8_STAGE(PG8_SB(1, 1), cB + hstep + kstep, voffB);
        PG8_WAIT_V(6); PG8_BAR;
    }
    for (;;) {
        const bool has_next = S.next(ui + 1, nxt);
        const char* nA = has_next ? (const char*)g.A + (size_t)nxt.pm * tstep : cA; const char* nB = has_next ? (const char*)g.Bt + (size_t)nxt.pn * tstep : cB;
        for (int t = 0; t < nt; t += 2) {
            const bool last = (t == nt - 2);
            const char* a1 = cA + (size_t)(t + 1) * kstep;
            const char* a2 = last ? nA : cA + (size_t)(t + 2) * kstep; const char* b2 = last ? nB : cB + (size_t)(t + 2) * kstep;
            const char* a3 = a2 + kstep; const char* b3 = b2 + kstep;
            if (last && has_next) S.a_ready(nxt);
            if constexpr (SP2) {
            PG8_LDB(B0, 0, 0); PG8_LDB(B1, 0, 1); PG8_SCHED; PG8_LDA(At, 0, 0); PG8_STAGE(PG8_SA(1, 1), a1 + hstep, voffA);
            PG8_WAIT_V(8); PG8_WAIT_L(0); PG8_BAR; PG8_MMA(0, 0, At, B0); PG8_MMA(0, 1, At, B1); PG8_BAR; PG8_SCHED;
            PG8_LDA(At, 0, 1); PG8_STAGE(PG8_SB(0, 0), b2, voffB); PG8_STAGE(PG8_SB(0, 1), b2 + hstep, voffB); PG8_STAGE(PG8_SA(0, 0), a2, voffA);
            PG8_WAIT_V(8); PG8_WAIT_L(0); PG8_BAR; PG8_MMA(1, 0, At, B0); PG8_MMA(1, 1, At, B1); PG8_BAR; PG8_SCHED;
            PG8_LDB(B0, 1, 0); PG8_LDB(B1, 1, 1); PG8_SCHED; PG8_LDA(At, 1, 0); PG8_STAGE(PG8_SA(0, 1), a2 + hstep, voffA);
            PG8_WAIT_V(8); PG8_WAIT_L(0); PG8_BAR; PG8_MMA(0, 0, At, B0); PG8_MMA(0, 1, At, B1); PG8_BAR; PG8_SCHED;
            PG8_LDA(At, 1, 1); PG8_STAGE(PG8_SB(1, 0), b3, voffB); PG8_STAGE(PG8_SB(1, 1), b3 + hstep, voffB); PG8_STAGE(PG8_SA(1, 0), a3, voffA);
            PG8_WAIT_V(8); PG8_WAIT_L(0); PG8_BAR; PG8_MMA(1, 0, At, B0); PG8_MMA(1, 1, At, B1); PG8_BAR; PG8_SCHED;
            } else {
            PG8_LDB(B0, 0, 0); PG8_SCHED; PG8_LDA(At, 0, 0); PG8_STAGE(PG8_SA(1, 1), a1 + hstep, voffA);
            PG8_WAIT_L(8); PG8_BAR; PG8_WAIT_L(0); PG8_MMA(0, 0, At, B0); PG8_BAR; PG8_SCHED;
            PG8_LDB(B1, 0, 1); PG8_STAGE(PG8_SB(0, 0), b2, voffB);
            PG8_BAR; PG8_WAIT_L(0); PG8_MMA(0, 1, At, B1); PG8_BAR;
            PG8_LDA(At, 0, 1); PG8_STAGE(PG8_SA(0, 0), a2, voffA);
            PG8_BAR; PG8_WAIT_L(0); PG8_MMA(1, 0, At, B0); PG8_BAR; PG8_SCHED;
            PG8_STAGE(PG8_SB(0, 1), b2 + hstep, voffB);
            PG8_WAIT_V(6); PG8_BAR; PG8_MMA(1, 1, At, B1); PG8_BAR;
            PG8_LDB(B0, 1, 0); PG8_SCHED; PG8_LDA(At, 1, 0); PG8_STAGE(PG8_SA(0, 1), a2 + hstep, voffA);
            PG8_WAIT_L(8); PG8_BAR; PG8_WAIT_L(0); PG8_MMA(0, 0, At, B0); PG8_BAR; PG8_SCHED;
            PG8_LDB(B1, 1, 1); PG8_STAGE(PG8_SB(1, 0), b3, voffB);
            PG8_BAR; PG8_WAIT_L(0); PG8_MMA(0, 1, At, B1); PG8_BAR;
            PG8_LDA(At, 1, 1); PG8_STAGE(PG8_SA(1, 0), a3, voffA);
            PG8_BAR; PG8_WAIT_L(0); PG8_MMA(1, 0, At, B0); PG8_BAR; PG8_SCHED;
            PG8_STAGE(PG8_SB(1, 1), b3 + hstep, voffB);
            PG8_WAIT_V(6); PG8_BAR; PG8_MMA(1, 1, At, B1); PG8_BAR;
            }
        }
        if constexpr (ALIGN_EPI) { if (wr == 0) PG8_BAR; }
        if constexpr (!Epi::AFTER_DRAIN) { E(acc, cur, wr, wc, fr, fq); S.done(cur); }
        if (!has_next) break;
#pragma unroll
        for (int a = 0; a < 2; ++a)
#pragma unroll
            for (int b = 0; b < 2; ++b)
#pragma unroll
                for (int m = 0; m < 4; ++m)
#pragma unroll
                    for (int n = 0; n < 2; ++n) acc[a][b][m][n] = (f32x4){0.f, 0.f, 0.f, 0.f};
        cur = nxt; cA = nA; cB = nB; ++ui;
        if constexpr (ALIGN_EPI) { if (wr == 1) PG8_BAR; }
    }
    PG8_WAIT_V(0);
    if constexpr (!ALIGN_EPI) { if (wr == 0) PG8_BAR; }
    PG8_BAR;
    if constexpr (Epi::AFTER_DRAIN) { E.fused(acc, cur, wr, wc, fr, fq, lds, wid, lane); S.done(cur); }
#undef PG8_SA
#undef PG8_SB
#undef PG8_STAGE
#undef PG8_LDA
#undef PG8_LDB
#undef PG8_MMA
#undef PG8_WAIT_V
#undef PG8_WAIT_L
#undef PG8_BAR
#undef PG8_SCHED
}
}

typedef unsigned short bf16_t;
#define LAS __attribute__((address_space(3)))
constexpr int DM = 2048, NB = 8, S = 2048, M = NB * S, DIN = 7192, DEPTH = 2, LDP = 6144, NVT = 1024, NW_IN = LDP + NVT;
constexpr int NWAVES = 8, NT = NWAVES * 64;
constexpr int C_AQ = 0, C_AKC = 512, C_AKS = 640, C_AKW = 768, C_AGATE = 896;
constexpr int C_BQ = 1408, C_BK = 1920, C_BGATE = 2048;
constexpr int C_CB = 2560, C_CC = 3072, C_CH = 3584, C_CGATE = 4096;
constexpr int C_DQ = 4608, C_DK = 5120, C_DGATE = 5632;
constexpr int VR_AVC = 0, VR_AVS = 128, VR_AVW = 256, VR_BV = 384, VR_DV = 512;
__host__ __device__ __forceinline__ int src_col_of(int n) {
    if (n < 640) return n;
    if (n < 768) return n - 640 + 768;
    if (n < 896) return n - 768 + 1024;
    if (n < 1408) return n - 896 + 1304;
    if (n < 1920) return n - 1408 + 1816;
    if (n < 2048) return n - 1920 + 2328;
    if (n < 2560) return n - 2048 + 2584;
    if (n < 4608) return n - 2560 + 3096;
    if (n < 5120) return n - 4608 + 5144;
    if (n < 5632) return n - 5120 + 5656;
    if (n < 6144) return n - 5632 + 6680;
    if (n < 6272) return n - 6144 + 640;
    if (n < 6400) return n - 6272 + 896;
    if (n < 6528) return n - 6400 + 1152;
    if (n < 6656) return n - 6528 + 2456;
    return n - 6656 + 6168;
}
constexpr int SRC_GATES = 1280;
constexpr int NCMP = 127;

constexpr size_t MiB = 1u << 20;
constexpr size_t WS_BIASD = 1 * MiB;
constexpr size_t WS_IMG = 1 * MiB + 512 * 1024;
constexpr size_t WS_G = 2 * MiB;
constexpr size_t WS_WG = 4 * MiB;
constexpr size_t WS_PB = 4 * MiB + 512 * 1024;
constexpr size_t WS_W2T = 4 * MiB + 768 * 1024;
constexpr size_t WS_W1T = 6 * MiB;
constexpr size_t WS_CMP = 5 * MiB;
constexpr size_t WS_WIN = 8 * MiB;
constexpr size_t WS_WOUT = 64 * MiB;
constexpr size_t WS_XB = 80 * MiB;
constexpr size_t WS_MIX = 144 * MiB;
constexpr size_t WS_P = 208 * MiB;
constexpr size_t WS_VT = 400 * MiB;
constexpr size_t WS_END = 432 * MiB;
constexpr int LDS_BYTES = 147456;

struct Params {
    const float* x; const float* norm_w; const float* w_in; const float* w_out; const float* conv_w; const float* sinks;
    const float* cmp_pos; const float* cmp_w1; const float* cmp_w2; const float* rel_bias; const float* final_norm_w;
    float* out; unsigned char* ws;
};

__device__ __forceinline__ float bf2f(bf16_t v) { return __uint_as_float(((unsigned)v) << 16); }
__device__ __forceinline__ unsigned f2bfu(float f) { unsigned u = __float_as_uint(f); return (u + 0x7fffu + ((u >> 16) & 1u)) >> 16; }
__device__ __forceinline__ bf16_t f2bf(float f) { return (bf16_t)f2bfu(f); }
__device__ __forceinline__ unsigned pk2(float lo, float hi) { return f2bfu(lo) | (f2bfu(hi) << 16); }
__device__ __forceinline__ float wave_sum(float v) {
#pragma unroll
    for (int o = 32; o > 0; o >>= 1) v += __shfl_xor(v, o);
    return v;
}
__device__ __forceinline__ float wave_max(float v) {
#pragma unroll
    for (int o = 32; o > 0; o >>= 1) v = fmaxf(v, __shfl_xor(v, o));
    return v;
}
__device__ __forceinline__ float silu(float v) { return v / (1.f + __expf(-v)); }
__device__ __forceinline__ float sigmoidf(float v) { return 1.f / (1.f + __expf(-v)); }
#define LDS_FENCE() asm volatile("s_waitcnt lgkmcnt(0)" ::: "memory")

__device__ __forceinline__ int t5_bucket(int d) {
    if (d < 16) return d < 0 ? 0 : d;
    int b = 16;
    b += (d >= 22); b += (d >= 30); b += (d >= 40); b += (d >= 54); b += (d >= 73); b += (d >= 99); b += (d >= 134); b += (d >= 182);
    b += (d >= 246); b += (d >= 332); b += (d >= 450); b += (d >= 609); b += (d >= 825); b += (d >= 1117); b += (d >= 1513);
    return b;
}

__device__ __forceinline__ void transpose_item(const float* W, int K, int srcld, int src_n0, const float* ksc, bf16_t* WT, LAS float* scr, int kb, int nb, int lane) {
    const int k0 = 64 * kb, n0 = 32 * nb;
#pragma unroll 8
    for (int i = 0; i < 32; ++i) { const int kk = 2 * i + (lane >> 5); const float sc = ksc ? ksc[k0 + kk] : 1.f; scr[kk * 33 + (lane & 31)] = W[(size_t)(k0 + kk) * srcld + src_n0 + n0 + (lane & 31)] * sc; }
    LDS_FENCE();
    const int c = lane & 7;
#pragma unroll
    for (int j = 0; j < 4; ++j) { const int n = (lane >> 3) + 8 * j; const LAS float* s = scr + (8 * c) * 33 + n;
        uint4 o; o.x = pk2(s[0 * 33], s[1 * 33]); o.y = pk2(s[2 * 33], s[3 * 33]); o.z = pk2(s[4 * 33], s[5 * 33]); o.w = pk2(s[6 * 33], s[7 * 33]);
        *(uint4*)(WT + (size_t)(n0 + n) * K + k0 + 8 * c) = o; }
    LDS_FENCE();
}
__device__ __forceinline__ void rms_row_to_bf16(const float* xrow, bf16_t* orow, int lane) {
    const float4* xr = (const float4*)xrow + lane;
    float4 v[8]; float s = 0.f;
#pragma unroll
    for (int j = 0; j < 8; ++j) { v[j] = xr[64 * j]; s += (v[j].x * v[j].x + v[j].y * v[j].y) + (v[j].z * v[j].z + v[j].w * v[j].w); }
    const float r = rsqrtf(wave_sum(s) * (1.f / DM) + 1e-6f);
    uint2* o8 = (uint2*)orow + lane;
#pragma unroll
    for (int j = 0; j < 8; ++j) o8[64 * j] = make_uint2(pk2(v[j].x * r, v[j].y * r), pk2(v[j].z * r, v[j].w * r));
}

__device__ __forceinline__ float ldval(const bf16_t* p) { return bf2f(*p); }
__device__ __forceinline__ float ldval(const float* p) { return *p; }
__device__ __forceinline__ void load8(const bf16_t* p, float (&k)[8]) {
    const uint4 w = *(const uint4*)p;
    k[0] = __uint_as_float(w.x << 16); k[1] = __uint_as_float(w.x & 0xffff0000u);
    k[2] = __uint_as_float(w.y << 16); k[3] = __uint_as_float(w.y & 0xffff0000u);
    k[4] = __uint_as_float(w.z << 16); k[5] = __uint_as_float(w.z & 0xffff0000u);
    k[6] = __uint_as_float(w.w << 16); k[7] = __uint_as_float(w.w & 0xffff0000u);
}
__device__ __forceinline__ void load8(const float* p, float (&k)[8]) {
    const float4 a = ((const float4*)p)[0], b = ((const float4*)p)[1];
    k[0] = a.x; k[1] = a.y; k[2] = a.z; k[3] = a.w; k[4] = b.x; k[5] = b.y; k[6] = b.z; k[7] = b.w;
}

template <int NH, typename KT>
__device__ __forceinline__ void score_chunk(const KT* kmat, size_t rstride, int krow, bool valid, int dist, const float* qs, const float* biasd, float (&s)[NH]) {
    float a[NH];
#pragma unroll
    for (int h = 0; h < NH; ++h) a[h] = 0.f;
    if (valid) {
        const KT* kr = kmat + (size_t)krow * rstride;
#pragma unroll 2
        for (int d8 = 0; d8 < 8; ++d8) {
            float k[8]; load8(kr + 8 * d8, k);
#pragma unroll
            for (int h = 0; h < NH; ++h) {
                const float4 q0 = ((const float4*)(qs + h * 64))[2 * d8], q1 = ((const float4*)(qs + h * 64))[2 * d8 + 1];
                a[h] += q0.x * k[0] + q0.y * k[1] + q0.z * k[2] + q0.w * k[3] + q1.x * k[4] + q1.y * k[5] + q1.z * k[6] + q1.w * k[7];
            }
        }
    }
#pragma unroll
    for (int h = 0; h < NH; ++h) s[h] = valid ? a[h] * 0.125f + biasd[h * 2048 + dist] : -INFINITY;
}
template <int NH, typename VT>
__device__ __forceinline__ void pv_chunk(const VT* vmat, size_t rstride, size_t dstride, int rbase, int rstep, int j0, int j1, const float (&p)[NH], float (&o)[NH], int lane) {
    for (int jj = j0; jj < j1; ++jj) {
        const float vv = ldval(vmat + (size_t)(rbase + jj * rstep) * rstride + (size_t)lane * dstride);
#pragma unroll
        for (int h = 0; h < NH; ++h) o[h] += __uint_as_float(__builtin_amdgcn_readlane(__float_as_uint(p[h]), jj)) * vv;
    }
}
template <int NH, typename KT>
__device__ __forceinline__ void attend_chunk(const KT* kmat, const KT* vmat  , size_t rstride, int rbase, int rstep, int j0, int j1, int dbase, int dstep,
                                             const float* qs, const float* biasd, float (&m)[NH], float (&l)[NH], float (&o)[NH], int lane) {
    if (j1 <= j0) return;
    const bool valid = lane >= j0 && lane < j1;
    float s[NH], p[NH];
    score_chunk<NH, KT>(kmat, rstride, rbase + lane * rstep, valid, dbase + lane * dstep, qs, biasd, s);
#pragma unroll
    for (int h = 0; h < NH; ++h) {
        const float cm = wave_max(s[h]);
        const float mn = fmaxf(m[h], cm);
        const float sc = __expf(m[h] - mn);
        p[h] = valid ? __expf(s[h] - mn) : 0.f;
        l[h] = l[h] * sc + wave_sum(p[h]); o[h] *= sc; m[h] = mn;
    }
    pv_chunk<NH, KT>(vmat, 1, (size_t)M, rbase, rstep, j0, j1, p, o, lane);
}


typedef unsigned u32x4_t_ __attribute__((ext_vector_type(4)));
typedef short abf16x8 __attribute__((ext_vector_type(8)));
typedef float f32x16 __attribute__((ext_vector_type(16)));
constexpr float LOG2E = 1.4426950408889634f, SCL = 0.125f * 1.4426950408889634f;
constexpr int OFF_TA = 0, OFF_TB = 65536, OFF_OSC = 65536 + 8192, OFF_TD = 0;
__device__ __forceinline__ int pi32(int i) { return (i & 19) | ((i & 4) << 1) | ((i & 8) >> 1); }
__device__ __forceinline__ unsigned cvtpk(float lo, float hi) { unsigned r; asm volatile("v_cvt_pk_bf16_f32 %0, %1, %2" : "=v"(r) : "v"(lo), "v"(hi)); return r; }
struct KVF { abf16x8 k[4]; abf16x8 v[4]; };
struct Soft { float m, l; f32x16 o[2]; };
__device__ __forceinline__ void soft_init(Soft& st) {
    st.m = -INFINITY; st.l = 0.f;
#pragma unroll
    for (int r = 0; r < 16; ++r) { st.o[0][r] = 0.f; st.o[1][r] = 0.f; }
}
__device__ __forceinline__ void load_kv(KVF& f, const bf16_t* kp, size_t krs, const bf16_t* vp, size_t vhalf, int key0) {
    const bf16_t* k = kp + (size_t)key0 * krs;
#pragma unroll
    for (int s = 0; s < 4; ++s) f.k[s] = *(const abf16x8*)(k + 16 * s);
    const bf16_t* v = vp + key0;
    f.v[0] = *(const abf16x8*)(v); f.v[1] = *(const abf16x8*)(v + 16); f.v[2] = *(const abf16x8*)(v + vhalf); f.v[3] = *(const abf16x8*)(v + vhalf + 16);
}
template <bool CAUSAL, bool WIN, bool ROWSEL>
__device__ __forceinline__ void tile_step(Soft& st, const KVF& f, const abf16x8 (&qf)[4], const LAS float* tabp, int key0, int D0, int W, bool rowsel) {
    f32x16 acc;
#pragma unroll
    for (int r = 0; r < 16; ++r) acc[r] = 0.f;
#pragma unroll
    for (int s = 0; s < 4; ++s) acc = __builtin_amdgcn_mfma_f32_32x32x16_bf16(f.k[s], qf[s], acc, 0, 0, 0);
    float sv[16]; float tm = -INFINITY;
#pragma unroll
    for (int r = 0; r < 16; ++r) {
        const int ko = (r & 7) + 16 * (r >> 3);
        float x = fmaf(acc[r], SCL, tabp[key0 + ko]);
        bool ok = true;
        if (CAUSAL) ok = ok && (ko <= D0);
        if (WIN) ok = ok && (ko >= D0 - W);
        if (ROWSEL) ok = ok && rowsel;
        if (CAUSAL || WIN || ROWSEL) x = ok ? x : -INFINITY;
        sv[r] = x; tm = fmaxf(tm, x);
    }
    tm = fmaxf(tm, __shfl_xor(tm, 32));
    const float mn = fmaxf(st.m, tm);
    const float alpha = __builtin_amdgcn_exp2f(st.m - mn);
    float rs = 0.f;
#pragma unroll
    for (int r = 0; r < 16; ++r) { sv[r] = __builtin_amdgcn_exp2f(sv[r] - mn); rs += sv[r]; }
    st.l = st.l * alpha + rs; st.m = mn;
    if (__any(alpha != 1.f)) {
#pragma unroll
        for (int r = 0; r < 16; ++r) { st.o[0][r] *= alpha; st.o[1][r] *= alpha; }
    }
    abf16x8 pf[2];
#pragma unroll
    for (int s2 = 0; s2 < 2; ++s2) {
        typedef unsigned u32x4_t __attribute__((ext_vector_type(4)));
        u32x4_t w; w.x = cvtpk(sv[8 * s2 + 0], sv[8 * s2 + 1]); w.y = cvtpk(sv[8 * s2 + 2], sv[8 * s2 + 3]); w.z = cvtpk(sv[8 * s2 + 4], sv[8 * s2 + 5]); w.w = cvtpk(sv[8 * s2 + 6], sv[8 * s2 + 7]);
        pf[s2] = __builtin_bit_cast(abf16x8, w);
    }
#pragma unroll
    for (int dh = 0; dh < 2; ++dh)
#pragma unroll
        for (int s2 = 0; s2 < 2; ++s2) st.o[dh] = __builtin_amdgcn_mfma_f32_32x32x16_bf16(f.v[dh * 2 + s2], pf[s2], st.o[dh], 0, 0, 0);
}
__device__ __forceinline__ void store_rows(const f32x16 (&o)[2], float scale, const bf16_t* gp, bf16_t* op, int h) {
#pragma unroll
    for (int dh = 0; dh < 2; ++dh)
#pragma unroll
        for (int rg = 0; rg < 4; ++rg) {
            const int dim0 = 32 * dh + 8 * rg + 4 * h;
            const uint2 gw = *(const uint2*)(gp + dim0);
            const float g0 = __uint_as_float(gw.x << 16), g1 = __uint_as_float(gw.x & 0xffff0000u), g2 = __uint_as_float(gw.y << 16), g3 = __uint_as_float(gw.y & 0xffff0000u);
            uint2 w; w.x = cvtpk(o[dh][4 * rg + 0] * scale * silu(g0), o[dh][4 * rg + 1] * scale * silu(g1)); w.y = cvtpk(o[dh][4 * rg + 2] * scale * silu(g2), o[dh][4 * rg + 3] * scale * silu(g3));
            *(uint2*)(op + dim0) = w;
        }
}
__device__ __forceinline__ void unit_D(const bf16_t* P, const bf16_t* VT, bf16_t* MIX, const LAS float* tabD, int b, int head, int qt, int lane) {
    asm volatile("" : "+v"(lane));
    const int c = lane & 31, h = lane >> 5, tc = qt * 32 + c;
    const size_t rowq = (size_t)b * S + tc;
    abf16x8 qf[4];
#pragma unroll
    for (int s = 0; s < 4; ++s) qf[s] = *(const abf16x8*)(P + rowq * LDP + C_DQ + head * 64 + 16 * s + 8 * h);
    const bf16_t* kp = P + ((size_t)b * S + pi32(c)) * LDP + C_DK + head * 64 + 8 * h;
    const bf16_t* vp = VT + (size_t)(VR_DV + head * 64 + c) * M + (size_t)b * S + 8 * h;
    const LAS float* tabp = tabD + head * 2048 + (2047 - tc + 8 * h);
    Soft st; soft_init(st);
    KVF cur, nxt;
    load_kv(cur, kp, LDP, vp, (size_t)32 * M, 32 * qt);
    for (int kt = qt; kt >= 0; --kt) {
        if (kt > 0) load_kv(nxt, kp, LDP, vp, (size_t)32 * M, 32 * (kt - 1));
        const int D0 = tc - 32 * kt - 8 * h;
        if (kt == qt) tile_step<true, false, false>(st, cur, qf, tabp, 32 * kt, D0, 0, true);
        else tile_step<false, false, false>(st, cur, qf, tabp, 32 * kt, D0, 0, true);
        if (kt > 0) cur = nxt;
    }
    const float l = st.l + __shfl_xor(st.l, 32);
    store_rows(st.o, 1.f / l, P + rowq * LDP + C_DGATE + head * 64, MIX + rowq * DM + 1536 + head * 64, h);
}

__device__ __forceinline__ void unit_B(const bf16_t* P, const bf16_t* VT, bf16_t* MIX, const LAS float* tabB, const float* sinks, int b, int g, int q8, int lane) {
    asm volatile("" : "+v"(lane));
    const int c = lane & 31, h = lane >> 5, hh = c >> 3, qi = c & 7, t0 = q8 * 8, tc = t0 + qi, head = g * 4 + hh;
    const size_t rowq = (size_t)b * S + tc;
    abf16x8 qf[4];
#pragma unroll
    for (int s = 0; s < 4; ++s) qf[s] = *(const abf16x8*)(P + rowq * LDP + C_BQ + head * 64 + 16 * s + 8 * h);
    const bf16_t* kp = P + ((size_t)b * S + pi32(c)) * LDP + C_BK + g * 64 + 8 * h;
    const bf16_t* vp = VT + (size_t)(VR_BV + g * 64 + c) * M + (size_t)b * S + 8 * h;
    const LAS float* tabp = tabB + head * 256 + (255 - tc + 8 * h);
    Soft st; soft_init(st);
    const int ktd = t0 >> 5, ktlo = (t0 - 127 > 0 ? t0 - 127 : 0) >> 5;
    KVF cur, nxt;
    load_kv(cur, kp, LDP, vp, (size_t)32 * M, 32 * ktd);
    for (int kt = ktd; kt >= ktlo; --kt) {
        if (kt > ktlo) load_kv(nxt, kp, LDP, vp, (size_t)32 * M, 32 * (kt - 1));
        const int D0 = tc - 32 * kt - 8 * h;
        if (kt == ktd) tile_step<true, false, false>(st, cur, qf, tabp, 32 * kt, D0, 0, true);
        else tile_step<false, true, false>(st, cur, qf, tabp, 32 * kt, D0, 127, true);
        if (kt > ktlo) cur = nxt;
    }
    const float l = st.l + __shfl_xor(st.l, 32) + __builtin_amdgcn_exp2f(sinks[head] * LOG2E - st.m);
    store_rows(st.o, 1.f / l, P + rowq * LDP + C_BGATE + head * 64, MIX + rowq * DM + 512 + head * 64, h);
}

__device__ __forceinline__ void unit_A(const bf16_t* P, const bf16_t* VT, const bf16_t* KCMP, const bf16_t* VCMPT, const float* GT, bf16_t* MIX, const LAS float* tabA, LAS float* osc  , int b, int g, int q8, int lane) {
    asm volatile("" : "+v"(lane));
    const int c = lane & 31, h = lane >> 5, hh = c >> 3, qi = c & 7, t0 = q8 * 8, tc = t0 + qi, head = g * 4 + hh;
    const size_t rowq = (size_t)b * S + tc;
    abf16x8 qf[4];
#pragma unroll
    for (int s = 0; s < 4; ++s) qf[s] = *(const abf16x8*)(P + rowq * LDP + C_AQ + head * 64 + 16 * s + 8 * h);
    const LAS float* tabh = tabA + head * 2048;
    unsigned selmask = 0u;
    {
        const int ncv = tc >= 31 ? ((tc - 31) >> 4) + 1 : 0;
        const bf16_t* kp = KCMP + ((size_t)(b * 2 + g) * 128 + pi32(c)) * 64 + 8 * h;
        const bf16_t* vp = VCMPT + ((size_t)(b * 2 + g) * 64 + c) * 128 + 8 * h;
        const LAS float* tabp = tabh + (2047 - tc + 31 + 128 * h);
        float sc[4][16]; float mx = -INFINITY;
#pragma unroll
        for (int kt = 0; kt < 4; ++kt) {
            f32x16 acc;
#pragma unroll
            for (int r = 0; r < 16; ++r) acc[r] = 0.f;
#pragma unroll
            for (int s = 0; s < 4; ++s) acc = __builtin_amdgcn_mfma_f32_32x32x16_bf16(*(const abf16x8*)(kp + (size_t)(32 * kt) * 64 + 16 * s), qf[s], acc, 0, 0, 0);
#pragma unroll
            for (int r = 0; r < 16; ++r) {
                const int ko = (r & 7) + 16 * (r >> 3);
                const bool ok = 32 * kt + 8 * h + ko < ncv;
                const float tb = tabp[512 * kt + 16 * ko];
                const float x = ok ? fmaf(acc[r], SCL, tb) : -INFINITY;
                sc[kt][r] = x; mx = fmaxf(mx, x);
            }
            asm volatile("" ::: "memory");
        }
        mx = fmaxf(mx, __shfl_xor(mx, 32)); mx = fmaxf(mx, -1e30f);
        float sum = 0.f;
#pragma unroll
        for (int kt = 0; kt < 4; ++kt)
#pragma unroll
            for (int r = 0; r < 16; ++r) { sc[kt][r] = __builtin_amdgcn_exp2f(sc[kt][r] - mx); sum += sc[kt][r]; }
        sum += __shfl_xor(sum, 32);
        const float inv = 1.f / fmaxf(sum, 1e-30f);
        f32x16 oc[2];
#pragma unroll
        for (int r = 0; r < 16; ++r) { oc[0][r] = 0.f; oc[1][r] = 0.f; }
#pragma unroll
        for (int kt = 0; kt < 4; ++kt) {
#pragma unroll
            for (int r = 0; r < 16; ++r) sc[kt][r] *= inv;
            abf16x8 pf[2];
#pragma unroll
            for (int s2 = 0; s2 < 2; ++s2) {
                typedef unsigned u32x4_t __attribute__((ext_vector_type(4)));
                u32x4_t w; w.x = cvtpk(sc[kt][8 * s2 + 0], sc[kt][8 * s2 + 1]); w.y = cvtpk(sc[kt][8 * s2 + 2], sc[kt][8 * s2 + 3]); w.z = cvtpk(sc[kt][8 * s2 + 4], sc[kt][8 * s2 + 5]); w.w = cvtpk(sc[kt][8 * s2 + 6], sc[kt][8 * s2 + 7]);
                pf[s2] = __builtin_bit_cast(abf16x8, w);
            }
#pragma unroll
            for (int dh = 0; dh < 2; ++dh)
#pragma unroll
                for (int s2 = 0; s2 < 2; ++s2) oc[dh] = __builtin_amdgcn_mfma_f32_32x32x16_bf16(*(const abf16x8*)(vp + (size_t)dh * 32 * 128 + 32 * kt + 16 * s2), pf[s2], oc[dh], 0, 0, 0);
            asm volatile("" ::: "memory");
        }
        float x7[4], x15[4];
#pragma unroll
        for (int kt = 0; kt < 4; ++kt) { x7[kt] = __shfl_xor(sc[kt][7], 32); x15[kt] = __shfl_xor(sc[kt][15], 32); }
        unsigned key[16];
        const int cur = tc >> 6;
#pragma unroll
        for (int kt = 0; kt < 4; ++kt)
#pragma unroll
            for (int gb = 0; gb < 2; ++gb) {
                const float pl0 = gb == 0 ? (kt > 0 ? x15[kt > 0 ? kt - 1 : 0] : 0.f) : x7[kt];
                const float pl1 = gb == 0 ? x7[kt] : x15[kt];
                const float prevlast = h ? pl1 : pl0;
                float ie = prevlast + sc[kt][8 * gb + 0] + sc[kt][8 * gb + 1] + sc[kt][8 * gb + 2] + sc[kt][8 * gb + 3];
                float io = sc[kt][8 * gb + 3] + sc[kt][8 * gb + 4] + sc[kt][8 * gb + 5] + sc[kt][8 * gb + 6] + sc[kt][8 * gb + 7];
                ie += __shfl_xor(ie, 8); ie += __shfl_xor(ie, 16);
                io += __shfl_xor(io, 8); io += __shfl_xor(io, 16);
#pragma unroll
                for (int eo = 0; eo < 2; ++eo) {
                    const int n = 8 * kt + 2 * h + 4 * gb + eo;
                    const bool forced = n == 0 || n == cur || n == cur - 1;
                    const float v = forced ? 1e4f : (eo ? io : ie);
                    key[(kt * 2 + gb) * 2 + eo] = n > cur ? (unsigned)(31 - n) : ((((__float_as_uint(v) >> 5) + 1u) << 5) | (unsigned)(31 - n));
                }
            }
#pragma unroll 1
        for (int round = 0; round < 8; ++round) {
            unsigned lm = key[0];
#pragma unroll
            for (int i = 1; i < 16; ++i) lm = lm > key[i] ? lm : key[i];
            const unsigned pm = (unsigned)__shfl_xor((int)lm, 32);
            const unsigned best = lm > pm ? lm : pm;
            selmask |= 1u << (31 - (best & 31u));
#pragma unroll
            for (int i = 0; i < 16; ++i) key[i] = key[i] == best ? 0u : key[i];
        }
        const float g0 = sigmoidf(GT[rowq * 24 + 0 * 8 + head]);
#pragma unroll
        for (int r = 0; r < 16; ++r) { osc[r * 64 + lane] = oc[0][r] * g0; osc[(16 + r) * 64 + lane] = oc[1][r] * g0; }
    }
    const int ktd = t0 >> 5;
    const LAS float* tabp = tabh + (2047 - tc + 8 * h);
    {
        unsigned umask = selmask;
#pragma unroll
        for (int o = 1; o < 64; o <<= 1) umask |= (unsigned)__shfl_xor((int)umask, o);
        umask = __builtin_amdgcn_readfirstlane(umask);
        int c2 = lane & 31, h2 = lane >> 5; asm volatile("" : "+v"(c2), "+v"(h2));
        const bf16_t* kp = P + ((size_t)b * S + pi32(c2)) * LDP + C_AKS + g * 64 + 8 * h2;
        const bf16_t* vp = VT + (size_t)(VR_AVS + g * 64 + c2) * M + (size_t)b * S + 8 * h2;
        Soft st; soft_init(st);
        KVF cur, nxt;
        load_kv(cur, kp, LDP, vp, (size_t)32 * M, 32 * ktd);
        int kt = ktd;
        while (kt >= 0) {
            int nk = kt - 1;
            while (nk >= 0 && !((umask >> (nk >> 1)) & 1u)) --nk;
            if (nk >= 0) load_kv(nxt, kp, LDP, vp, (size_t)32 * M, 32 * nk);
            const int D0 = tc - 32 * kt - 8 * h;
            const bool rowsel = (selmask >> (kt >> 1)) & 1u;
            if (kt == ktd) tile_step<true, false, true>(st, cur, qf, tabp, 32 * kt, D0, 0, rowsel);
            else tile_step<false, false, true>(st, cur, qf, tabp, 32 * kt, D0, 0, rowsel);
            if (nk >= 0) cur = nxt;
            kt = nk;
        }
        const float l = st.l + __shfl_xor(st.l, 32);
        const float g1 = sigmoidf(GT[rowq * 24 + 1 * 8 + head]) / l;
#pragma unroll
        for (int r = 0; r < 16; ++r) { osc[r * 64 + lane] += st.o[0][r] * g1; osc[(16 + r) * 64 + lane] += st.o[1][r] * g1; }
    }
    {
        int c2 = lane & 31, h2 = lane >> 5; asm volatile("" : "+v"(c2), "+v"(h2));
        const bf16_t* kp = P + ((size_t)b * S + pi32(c2)) * LDP + C_AKW + g * 64 + 8 * h2;
        const bf16_t* vp = VT + (size_t)(VR_AVW + g * 64 + c2) * M + (size_t)b * S + 8 * h2;
        Soft st; soft_init(st);
        const int ktlo = (t0 - 511 > 0 ? t0 - 511 : 0) >> 5;
        KVF cur, nxt;
        load_kv(cur, kp, LDP, vp, (size_t)32 * M, 32 * ktd);
        for (int kt = ktd; kt >= ktlo; --kt) {
            if (kt > ktlo) load_kv(nxt, kp, LDP, vp, (size_t)32 * M, 32 * (kt - 1));
            const int D0 = tc - 32 * kt - 8 * h;
            if (kt == ktd) tile_step<true, false, false>(st, cur, qf, tabp, 32 * kt, D0, 0, true);
            else if (32 * kt < t0 + 7 - 511) tile_step<false, true, false>(st, cur, qf, tabp, 32 * kt, D0, 511, true);
            else tile_step<false, false, false>(st, cur, qf, tabp, 32 * kt, D0, 0, true);
            if (kt > ktlo) cur = nxt;
        }
        const float l = st.l + __shfl_xor(st.l, 32);
        const float g2 = sigmoidf(GT[rowq * 24 + 2 * 8 + head]) / l;
#pragma unroll
        for (int r = 0; r < 16; ++r) { st.o[0][r] = osc[r * 64 + lane] + st.o[0][r] * g2; st.o[1][r] = osc[(16 + r) * 64 + lane] + st.o[1][r] * g2; }
        int c3 = lane & 31; asm volatile("" : "+v"(c3));
        const size_t rowq3 = (size_t)b * S + t0 + (c3 & 7); const int head3 = g * 4 + (c3 >> 3);
        store_rows(st.o, 1.f, P + rowq3 * LDP + C_AGATE + head3 * 64, MIX + rowq3 * DM + head3 * 64, h2);
    }
}


typedef __attribute__((address_space(1))) unsigned gu32;
constexpr size_t WS_CTL = 0; constexpr size_t CTL_ZERO_BYTES = 64 * 1024; constexpr int CW_BAR = 1024;
constexpr int MISC_OFF = LDS_BYTES - 128;
#define XB_TMO      128
#define XB_XCNT(j)  (256  + 64 * (j))
#define XB_XSUB(j)  (1280 + 64 * (j))
#define XB_XGEN(j)  (2304 + 64 * (j))
#define XB_TOP      3328
#define XB_TOPGEN   3392
#define XCD_BAR_WORDS 3456
#define XB_SPIN_CAP (1u << 18)

__device__ __forceinline__ unsigned xb_ld(unsigned* p)              { return __hip_atomic_load(p, __ATOMIC_RELAXED, __HIP_MEMORY_SCOPE_AGENT); }
__device__ __forceinline__ unsigned xb_add(unsigned* p, unsigned v) { return __hip_atomic_fetch_add(p, v, __ATOMIC_RELAXED, __HIP_MEMORY_SCOPE_AGENT); }
__device__ __forceinline__ unsigned xb_xcc_id() { return (unsigned)__builtin_amdgcn_s_getreg((3 << 11) | 20) & 0xFu; }
#define XB_SPIN(cond, bar) do { unsigned _sp = 0; while (cond) { __builtin_amdgcn_s_sleep(1); \
    if ((++_sp & 255u) == 0u) { if (xb_ld(&(bar)[XB_TMO])) break; if (_sp > XB_SPIN_CAP) { atomicAdd(&(bar)[XB_TMO], 1u); break; } } } } while (0)

struct XcdBarrier {
    unsigned* bar; unsigned x;
    volatile LAS unsigned* st;
};

__device__ __forceinline__ XcdBarrier xcd_barrier_post(unsigned* bar, volatile LAS unsigned* st) {
    XcdBarrier b; b.bar = bar; b.x = xb_xcc_id(); b.st = st;
    if (threadIdx.x == 0) (void)xb_add(&bar[XB_XCNT(b.x)], 1u);
    return b;
}
__device__ __forceinline__ void xcd_barrier_complete(unsigned* bar, unsigned x, unsigned& nloc, unsigned& nx) {
    const unsigned G = gridDim.x * gridDim.y * gridDim.z;
    unsigned sum, cnt, mine, sp = 0u;
    for (;;) {
        sum = 0u; cnt = 0u; mine = 0u;
#pragma unroll
        for (unsigned j = 0; j < 16; ++j) { const unsigned c = xb_ld(&bar[XB_XCNT(j)]); sum += c; cnt += (c > 0u) ? 1u : 0u; mine = (j == x) ? c : mine; }
        if (sum == G) break;
        __builtin_amdgcn_s_sleep(1);
        if ((++sp & 255u) == 0u) { if (xb_ld(&bar[XB_TMO])) break; if (sp > XB_SPIN_CAP) { atomicAdd(&bar[XB_TMO], 1u); break; } }
    }
    nloc = mine > 0u ? mine : 1u; nx = cnt > 0u ? cnt : 1u;
}

__device__ __forceinline__ void xcd_barrier(const XcdBarrier& b) {
    asm volatile("s_waitcnt vmcnt(0)" ::: "memory");
    __syncthreads();
    if (threadIdx.x == 0) {
        unsigned* bar = b.bar;
        __builtin_amdgcn_s_waitcnt(0);
        unsigned nloc = b.st[0], nx = b.st[1];
        if (nloc == 0u) { xcd_barrier_complete(bar, b.x, nloc, nx); b.st[0] = nloc; b.st[1] = nx; }
        const unsigned old = xb_add(&bar[XB_XSUB(b.x)], 1u);
        const unsigned gen = old / nloc;
        if (old + 1u == (gen + 1u) * nloc) {
            __builtin_amdgcn_fence(__ATOMIC_RELEASE, "agent");
            asm volatile("s_waitcnt vmcnt(0)" ::: "memory");
            const unsigned og = xb_add(&bar[XB_TOP], 1u);
            const unsigned tg = og / nx;
            if (og + 1u == (tg + 1u) * nx) xb_add(&bar[XB_TOPGEN], 1u);
            else XB_SPIN(xb_ld(&bar[XB_TOPGEN]) == tg, bar);
            __builtin_amdgcn_fence(__ATOMIC_ACQUIRE, "agent");
            xb_add(&bar[XB_XGEN(b.x)], 1u);
            asm volatile("s_waitcnt vmcnt(0)" ::: "memory");
        } else {
            XB_SPIN(xb_ld(&bar[XB_XGEN(b.x)]) == gen, bar);
            __builtin_amdgcn_fence(__ATOMIC_ACQUIRE, "agent");
            asm volatile("s_waitcnt vmcnt(0)" ::: "memory");
        }
    }
    __syncthreads();
}


#define LAUNDER_S(x)
#define PH_COMMON \
    int tid_ = threadIdx.x; asm volatile("" : "+v"(tid_)); const int tid = tid_, lane = tid & 63, wib = __builtin_amdgcn_readfirstlane(tid >> 6); \
    const int G = gridDim.x; const int gthreads = G * NT, gtid = blockIdx.x * NT + tid; const int gwaves = G * NWAVES, gwave = blockIdx.x * NWAVES + wib; \
    unsigned char* ws = prm.ws; asm volatile("" : "+s"(ws)); (void)lane; (void)gthreads; (void)gtid; (void)gwaves; (void)gwave; (void)ws;

__device__ __forceinline__ void phase_prologue(const Params& prm, LAS unsigned char* ldsb) {
    PH_COMMON
    float* biasd = (float*)(ws + WS_BIASD); bf16_t* WG = (bf16_t*)(ws + WS_WG);
    bf16_t* WINT = (bf16_t*)(ws + WS_WIN); bf16_t* WOUTT = (bf16_t*)(ws + WS_WOUT); bf16_t* XB = (bf16_t*)(ws + WS_XB);
    for (int i = gtid; i < 24 * 2048; i += gthreads) { const int h = i >> 11, d = i & 2047; biasd[i] = prm.rel_bias[t5_bucket(d) * 24 + h]; }
    {
        float* img = (float*)(ws + WS_IMG);
        for (int i = gtid; i < 8 * 2048; i += gthreads) { const int h = i >> 11, d = 2047 - (i & 2047);
            img[i] = prm.rel_bias[t5_bucket(d) * 24 + h] * LOG2E;
            const int mult = (d <= 128 ? 1 : 0) + (((d & 3) == 0 && d <= 512) ? 1 : 0) + ((d & 15) == 0 ? 1 : 0);
            img[8 * 2048 + i] = mult == 0 ? -INFINITY : prm.rel_bias[t5_bucket(d) * 24 + 16 + h] * LOG2E + (mult == 1 ? 0.f : (mult == 2 ? 1.f : 1.5849625007211562f)); }
        for (int i = gtid; i < 8 * 256; i += gthreads) { const int h = i >> 8, d = 255 - (i & 255); img[16 * 2048 + i] = prm.rel_bias[t5_bucket(d) * 24 + 8 + h] * LOG2E; }
    }
    for (int i = gtid; i < DEPTH * 32 * 2048; i += gthreads) { const int k = i & 2047, j = (i >> 11) & 31, l = i >> 16;
        WG[i] = j < 24 ? f2bf(prm.w_in[(size_t)l * DM * DIN + (size_t)k * DIN + SRC_GATES + j] * prm.norm_w[l * DM + k]) : (bf16_t)0; }
    {
        bf16_t* W1T = (bf16_t*)(ws + WS_W1T); bf16_t* W2T = (bf16_t*)(ws + WS_W2T); float* PB = (float*)(ws + WS_PB);
        for (int i = gtid; i < 4 * 2048 * 128; i += gthreads) { const int j = i & 127, k = (i >> 7) & 2047, lw = i >> 18;
            const int kk = (lw & 1) ? ((k & 63) * 32 + (k >> 6)) : k;
            W1T[((size_t)lw * 128 + j) * 2048 + kk] = f2bf(prm.cmp_w1[((size_t)lw * 2048 + k) * 128 + j]); }
        for (int i = gtid; i < 4 * 128 * 64; i += gthreads) { const int e = i & 63, j = (i >> 6) & 127, lw = i >> 13; W2T[((size_t)lw * 64 + e) * 128 + j] = f2bf(prm.cmp_w2[((size_t)lw * 128 + j) * 64 + e]); }
        for (int o = gwave; o < 4 * 128; o += gwaves) { const int j = o & 127, lw = o >> 7; float a = 0.f;
            for (int k = lane; k < 2048; k += 64) a += prm.cmp_pos[(size_t)lw * 2048 + k] * prm.cmp_w1[((size_t)lw * 2048 + k) * 128 + j];
            a = wave_sum(a); if (lane == 0) PB[o] = a; }
    }
    {
        LAS float* scr = (LAS float*)(ldsb + wib * 16384);
        constexpr int I_IN = 32 * (NW_IN / 32), I_OUT = 32 * (DM / 32);
        for (int it = gwave; it < DEPTH * (I_IN + I_OUT); it += gwaves) {
            const int l = it / (I_IN + I_OUT); int r = it % (I_IN + I_OUT);
            if (r < I_IN) { const int nb = r % (NW_IN / 32), kb = r / (NW_IN / 32);
                transpose_item(prm.w_in + (size_t)l * DM * DIN, DM, DIN, src_col_of(32 * nb) - 32 * nb, prm.norm_w + l * DM, WINT + (size_t)l * NW_IN * DM, scr, kb, nb, lane); }
            else { r -= I_IN; const int nb = r % (DM / 32), kb = r / (DM / 32);
                transpose_item(prm.w_out + (size_t)l * DM * DM, DM, DM, 0, nullptr, WOUTT + (size_t)l * DM * DM, scr, kb, nb, lane); }
        }
    }
    for (int row = gwave; row < M; row += gwaves) rms_row_to_bf16(prm.x + (size_t)row * DM, XB + (size_t)row * DM, lane);
}

__device__ __forceinline__ void phase_inproj(const Params& prm, int layer, LAS unsigned char* ldsb) {
    LAUNDER_S(layer);
    unsigned char* ws = prm.ws; asm volatile("" : "+s"(ws));
    const bf16_t* W = (const bf16_t*)(ws + WS_WIN) + (size_t)layer * NW_IN * DM;
    {
        pg8::Gemm g{(const bf16_t*)(ws + WS_XB), W, M, LDP, DM}; pg8::StaticOrder So; So.init(M, LDP, (int)gridDim.x, (int)blockIdx.x);
        pg8::EpiBf16 E{(bf16_t*)(ws + WS_P), LDP};
        pg8::gemm_phase<pg8::EpiBf16, pg8::StaticOrder, true, true>(ldsb, g, So, E);
    }
    {
        pg8::Gemm g{W + (size_t)LDP * DM, (const bf16_t*)(ws + WS_XB), NVT, M, DM}; pg8::StaticOrder So; So.init(NVT, M, (int)gridDim.x, (int)blockIdx.x);
        pg8::EpiBf16 E{(bf16_t*)(ws + WS_VT), M};
        pg8::gemm_phase<pg8::EpiBf16, pg8::StaticOrder, true, true>(ldsb, g, So, E);
    }
}
__device__ __forceinline__ void phase_outproj(const Params& prm, int layer, LAS unsigned char* ldsb) {
    LAUNDER_S(layer);
    unsigned char* ws = prm.ws; asm volatile("" : "+s"(ws));
    const float* xin = layer == 0 ? prm.x : prm.out;
    pg8::Gemm g{(const bf16_t*)(ws + WS_MIX), (const bf16_t*)(ws + WS_WOUT) + (size_t)layer * DM * DM, M, DM, DM}; pg8::StaticOrder So; So.init(M, DM, (int)gridDim.x, (int)blockIdx.x);
    pg8::EpiResid E{xin, prm.out, DM};
    pg8::gemm_phase<pg8::EpiResid, pg8::StaticOrder, true, true>(ldsb, g, So, E);
}
__device__ __forceinline__ void phase_gates(const Params& prm, int layer, LAS unsigned char* ldsb) {
    LAUNDER_S(layer);
    PH_COMMON
    const bf16_t* XB = (const bf16_t*)(ws + WS_XB); float* GT = (float*)(ws + WS_G);
    const bf16_t* wg = (const bf16_t*)(ws + WS_WG) + (size_t)layer * 32 * 2048;
    const int c = lane & 31, h = lane >> 5, kq = wib & 3, half = wib >> 2;
    LAS float* red = (LAS float*)ldsb + wib * 1024;
    for (int blk = blockIdx.x; blk < M / 64; blk += G) {
        const int row0 = blk * 64 + half * 32;
        const bf16_t* ap = XB + (size_t)(row0 + c) * DM + kq * 512 + 8 * h;
        const bf16_t* bp = wg + (size_t)c * DM + kq * 512 + 8 * h;
        f32x16 acc;
#pragma unroll
        for (int r = 0; r < 16; ++r) acc[r] = 0.f;
#pragma unroll 8
        for (int s = 0; s < 32; ++s) acc = __builtin_amdgcn_mfma_f32_32x32x16_bf16(*(const abf16x8*)(ap + 16 * s), *(const abf16x8*)(bp + 16 * s), acc, 0, 0, 0);
#pragma unroll
        for (int r = 0; r < 16; ++r) red[r * 64 + lane] = acc[r];
        __syncthreads();
        if (kq == 0 && c < 24) {
#pragma unroll
            for (int r = 0; r < 16; ++r) { const float v = (red[r * 64 + lane] + red[1024 + r * 64 + lane]) + (red[2048 + r * 64 + lane] + red[3072 + r * 64 + lane]);
                GT[(size_t)(row0 + (r & 3) + 8 * (r >> 2) + 4 * h) * 24 + c] = v; }
        }
        __syncthreads();
    }
}
__device__ __forceinline__ void phase_compress(const Params& prm, int layer, LAS unsigned char* ldsb) {
    LAUNDER_S(layer);
    PH_COMMON
    const bf16_t* P = (const bf16_t*)(ws + WS_P); const bf16_t* VT = (const bf16_t*)(ws + WS_VT);
    bf16_t* KCMP = (bf16_t*)(ws + WS_CMP); bf16_t* VCMPT = KCMP + (size_t)NB * 2 * 128 * 64;
    const int c = lane & 31, h = lane >> 5, jt = wib & 3, kh = wib >> 2;
    LAS float* red = (LAS float*)ldsb;
    LAS float* hid = (LAS float*)(ldsb + 32768);
    for (int u = blockIdx.x; u < 2 * NB * 2 * 4; u += G) {
        const int ct = u & 3, g = (u >> 2) & 1, b = (u >> 3) & 7, which = u >> 6;
        const int lw = layer * 2 + which;
        const bf16_t* w1 = (const bf16_t*)(ws + WS_W1T) + ((size_t)lw * 128 + jt * 32 + c) * 2048 + kh * 1024 + 8 * h;
        int cc = ct * 32 + c; if (cc > NCMP - 1) cc = NCMP - 1;
        f32x16 acc;
#pragma unroll
        for (int r = 0; r < 16; ++r) acc[r] = 0.f;
        if (which == 0) {
            const bf16_t* src = P + (size_t)(b * S + 16 * cc) * LDP + C_AKC + g * 64 + 8 * h;
#pragma unroll 8
            for (int s = 0; s < 64; ++s) { const int ks = kh * 64 + s;
                acc = __builtin_amdgcn_mfma_f32_32x32x16_bf16(*(const abf16x8*)(w1 + 16 * s), *(const abf16x8*)(src + (size_t)(ks >> 2) * LDP + (ks & 3) * 16), acc, 0, 0, 0); }
        } else {
            const bf16_t* src = VT + (size_t)(VR_AVC + g * 64) * M + (size_t)(b * S + 16 * cc) + 8 * h;
#pragma unroll 8
            for (int s = 0; s < 64; ++s) { const int ks = kh * 64 + s;
                acc = __builtin_amdgcn_mfma_f32_32x32x16_bf16(*(const abf16x8*)(w1 + 16 * s), *(const abf16x8*)(src + (size_t)(ks >> 1) * M + (ks & 1) * 16), acc, 0, 0, 0); }
        }
#pragma unroll
        for (int r = 0; r < 16; ++r) red[wib * 1024 + r * 64 + lane] = acc[r];
        __syncthreads();
        if (wib < 4) {
            const float* pb = (const float*)(ws + WS_PB) + lw * 128;
#pragma unroll
            for (int r = 0; r < 16; ++r) { const int j = jt * 32 + (r & 3) + 8 * (r >> 2) + 4 * h;
                hid[j * 32 + c] = silu(red[wib * 1024 + r * 64 + lane] + red[(wib + 4) * 1024 + r * 64 + lane] + pb[j]); }
        }
        __syncthreads();
        if (wib < 2) {
            const bf16_t* w2 = (const bf16_t*)(ws + WS_W2T) + ((size_t)lw * 64 + wib * 32 + c) * 128 + 8 * h;
            f32x16 o;
#pragma unroll
            for (int r = 0; r < 16; ++r) o[r] = 0.f;
#pragma unroll
            for (int s = 0; s < 8; ++s) {
                u32x4_t_ w; const LAS float* hp = hid + (16 * s + 8 * h) * 32 + c;
                w.x = cvtpk(hp[0], hp[32]); w.y = cvtpk(hp[64], hp[96]); w.z = cvtpk(hp[128], hp[160]); w.w = cvtpk(hp[192], hp[224]);
                o = __builtin_amdgcn_mfma_f32_32x32x16_bf16(*(const abf16x8*)(w2 + 16 * s), __builtin_bit_cast(abf16x8, w), o, 0, 0, 0);
            }
            const int cw = ct * 32 + c;
            if (which == 0) {
                bf16_t* dst = KCMP + ((size_t)(b * 2 + g) * 128 + cw) * 64 + wib * 32 + 4 * h;
#pragma unroll
                for (int rg = 0; rg < 4; ++rg) { uint2 w; w.x = cvtpk(o[4 * rg], o[4 * rg + 1]); w.y = cvtpk(o[4 * rg + 2], o[4 * rg + 3]); *(uint2*)(dst + 8 * rg) = w; }
            } else {
                bf16_t* dst = VCMPT + ((size_t)(b * 2 + g) * 64 + wib * 32 + 4 * h) * 128 + cw;
#pragma unroll
                for (int r = 0; r < 16; ++r) dst[(size_t)((r & 3) + 8 * (r >> 2)) * 128] = f2bf(o[r]);
            }
        }
        __syncthreads();
    }
}
typedef unsigned u32x4_t __attribute__((ext_vector_type(4)));
__device__ __forceinline__ void phase_mix_ab(const Params& prm, int layer, LAS unsigned char* ldsb) {
    LAUNDER_S(layer);
    PH_COMMON
    {
        const u32x4_t* src = (const u32x4_t*)(ws + WS_IMG); LAS u32x4_t* dst = (LAS u32x4_t*)ldsb;
        for (int i = tid; i < 65536 / 16; i += NT) dst[i] = src[i];
        for (int i = tid; i < 8192 / 16; i += NT) dst[65536 / 16 + i] = src[131072 / 16 + i];
        __syncthreads();
    }
    const float* GT = (const float*)(ws + WS_G); const bf16_t* KCMP = (const bf16_t*)(ws + WS_CMP); const bf16_t* VCMPT = KCMP + (size_t)NB * 2 * 128 * 64;
    const bf16_t* P = (const bf16_t*)(ws + WS_P); bf16_t* MIX = (bf16_t*)(ws + WS_MIX); const bf16_t* VT = (const bf16_t*)(ws + WS_VT);
    const LAS float* tabA = (const LAS float*)(ldsb + OFF_TA);
    LAS float* osc = (LAS float*)(ldsb + OFF_OSC + wib * 8192);
    for (int pr = gwave; pr < NB * 2 * 128; pr += gwaves) {
        const int bg = pr >> 7, qa = pr & 127;
#pragma unroll 1
        for (int k = 0; k < 2; ++k) unit_A(P, VT, KCMP, VCMPT, GT, MIX, tabA, osc, bg >> 1, bg & 1, k ? 255 - qa : qa, lane);
    }
}
__device__ __forceinline__ void phase_mix_b(const Params& prm, int layer, LAS unsigned char* ldsb) {
    LAUNDER_S(layer);
    PH_COMMON
    const bf16_t* P = (const bf16_t*)(ws + WS_P); bf16_t* MIX = (bf16_t*)(ws + WS_MIX); const bf16_t* VT = (const bf16_t*)(ws + WS_VT);
    const float* sinks = prm.sinks + layer * 8;
    const LAS float* tabB = (const LAS float*)(ldsb + OFF_TB);
#pragma unroll 1
    for (int u = gwave; u < NB * 2 * 256; u += gwaves) unit_B(P, VT, MIX, tabB, sinks, u >> 9, (u >> 8) & 1, u & 255, lane);
}
__device__ __forceinline__ void phase_mix_d(const Params& prm, LAS unsigned char* ldsb) {
    PH_COMMON
    {
        const u32x4_t* src = (const u32x4_t*)(ws + WS_IMG + 65536); LAS u32x4_t* dst = (LAS u32x4_t*)(ldsb + OFF_TD);
        for (int i = tid; i < 65536 / 16; i += NT) dst[i] = src[i];
        __syncthreads();
    }
    const bf16_t* P = (const bf16_t*)(ws + WS_P); bf16_t* MIX = (bf16_t*)(ws + WS_MIX); const bf16_t* VT = (const bf16_t*)(ws + WS_VT);
    const LAS float* tabD = (const LAS float*)(ldsb + OFF_TD);
    for (int pr = gwave; pr < NB * 8 * 32; pr += gwaves) {
        const int bh = pr >> 5, qa = pr & 31;
#pragma unroll 1
        for (int k = 0; k < 2; ++k) unit_D(P, VT, MIX, tabD, bh >> 3, bh & 7, k ? 63 - qa : qa, lane);
    }
}
__device__ __forceinline__ void unpack8(const uint4 w, float (&f)[8]) {
    f[0] = __uint_as_float(w.x << 16); f[1] = __uint_as_float(w.x & 0xffff0000u); f[2] = __uint_as_float(w.y << 16); f[3] = __uint_as_float(w.y & 0xffff0000u);
    f[4] = __uint_as_float(w.z << 16); f[5] = __uint_as_float(w.z & 0xffff0000u); f[6] = __uint_as_float(w.w << 16); f[7] = __uint_as_float(w.w & 0xffff0000u);
}
__device__ __forceinline__ void phase_conv(const Params& prm, int layer) {
    LAUNDER_S(layer);
    PH_COMMON
    const bf16_t* P = (const bf16_t*)(ws + WS_P); bf16_t* MIX = (bf16_t*)(ws + WS_MIX);
    const float* convw = prm.conv_w + layer * 3 * 512;
    for (int i = gtid; i < M * 64; i += gthreads) {
        const int c0 = (i & 63) * 8, row = i >> 6, t = row & (S - 1);
        const bf16_t* pr = P + (size_t)row * LDP;
        float cb[8], cg[8], a[8], bb[8], y[8];
        unpack8(*(const uint4*)(pr + C_CB + c0), cb); unpack8(*(const uint4*)(pr + C_CGATE + c0), cg);
        unpack8(*(const uint4*)(pr + C_CC + c0), a); unpack8(*(const uint4*)(pr + C_CH + c0), bb);
#pragma unroll
        for (int j = 0; j < 8; ++j) y[j] = convw[2 * 512 + c0 + j] * a[j] * bb[j];
        if (t >= 1) { unpack8(*(const uint4*)(pr + C_CC + c0 - LDP), a); unpack8(*(const uint4*)(pr + C_CH + c0 - LDP), bb);
#pragma unroll
            for (int j = 0; j < 8; ++j) y[j] += convw[1 * 512 + c0 + j] * a[j] * bb[j]; }
        if (t >= 2) { unpack8(*(const uint4*)(pr + C_CC + c0 - 2 * LDP), a); unpack8(*(const uint4*)(pr + C_CH + c0 - 2 * LDP), bb);
#pragma unroll
            for (int j = 0; j < 8; ++j) y[j] += convw[0 * 512 + c0 + j] * a[j] * bb[j]; }
        uint4 w;
        w.x = cvtpk(cb[0] * y[0] * silu(cg[0]), cb[1] * y[1] * silu(cg[1])); w.y = cvtpk(cb[2] * y[2] * silu(cg[2]), cb[3] * y[3] * silu(cg[3]));
        w.z = cvtpk(cb[4] * y[4] * silu(cg[4]), cb[5] * y[5] * silu(cg[5])); w.w = cvtpk(cb[6] * y[6] * silu(cg[6]), cb[7] * y[7] * silu(cg[7]));
        *(uint4*)(MIX + (size_t)row * DM + 1024 + c0) = w;
    }
}
__device__ __forceinline__ void phase_xb(const Params& prm) {
    PH_COMMON
    bf16_t* XB = (bf16_t*)(ws + WS_XB);
    for (int row = gwave; row < M; row += gwaves) rms_row_to_bf16(prm.out + (size_t)row * DM, XB + (size_t)row * DM, lane);
}
__device__ __forceinline__ void phase_final(const Params& prm) {
    PH_COMMON
    for (int row = gwave; row < M; row += gwaves) {
        float4* xr = (float4*)(prm.out + (size_t)row * DM);
        float4 v[8]; float s = 0.f;
#pragma unroll
        for (int j = 0; j < 8; ++j) { v[j] = xr[lane + 64 * j]; s += v[j].x * v[j].x + v[j].y * v[j].y + v[j].z * v[j].z + v[j].w * v[j].w; }
        s = wave_sum(s);
        const float r = rsqrtf(s * (1.f / DM) + 1e-6f);
#pragma unroll
        for (int j = 0; j < 8; ++j) { const float4 w = ((const float4*)prm.final_norm_w)[lane + 64 * j];
            xr[lane + 64 * j] = make_float4(v[j].x * r * w.x, v[j].y * r * w.y, v[j].z * r * w.z, v[j].w * r * w.w); }
    }
}

#ifndef REP_PRO
#define REP_PRO 1
#endif
#ifndef REP_INP
#define REP_INP 1
#endif
#ifndef REP_GAT
#define REP_GAT 1
#endif
#ifndef REP_CMP
#define REP_CMP 1
#endif
#ifndef REP_MAB
#define REP_MAB 1
#endif
#ifndef REP_MB
#define REP_MB 1
#endif
#ifndef REP_MD
#define REP_MD 1
#endif
#ifndef REP_CNV
#define REP_CNV 1
#endif
#ifndef REP_SYNC
#define REP_SYNC 1
#endif
#define REPEAT(n) _Pragma("unroll 1") for (int rep_ = 0; rep_ < (n); ++rep_)
__global__ void __launch_bounds__(NT, 2) fwd_kernel(Params prm) {
    extern __shared__ __attribute__((aligned(16))) unsigned char lds_raw[];
    LAS unsigned char* ldsb = (LAS unsigned char*)lds_raw;
    volatile LAS unsigned* MISC = (volatile LAS unsigned*)(ldsb + MISC_OFF);
    if (threadIdx.x < 32) MISC[threadIdx.x] = 0u;
    __syncthreads();
    const XcdBarrier bar = xcd_barrier_post((unsigned*)(prm.ws + WS_CTL) + CW_BAR, MISC + 8);
#define GRID_SYNC() xcd_barrier(bar)
    REPEAT(REP_PRO) { phase_prologue(prm, ldsb); __syncthreads(); }
    REPEAT(REP_SYNC) GRID_SYNC();
#pragma unroll
    for (int layer = 0; layer < DEPTH; ++layer) {
        REPEAT(REP_INP) phase_inproj(prm, layer, ldsb);
        REPEAT(REP_GAT) phase_gates(prm, layer, ldsb);
        GRID_SYNC();
        REPEAT(REP_CMP) phase_compress(prm, layer, ldsb);
        GRID_SYNC();
        REPEAT(REP_MAB) { phase_mix_ab(prm, layer, ldsb); __syncthreads(); }
        REPEAT(REP_MB) phase_mix_b(prm, layer, ldsb);
        __syncthreads();
        REPEAT(REP_MD) { phase_mix_d(prm, ldsb); __syncthreads(); }
        REPEAT(REP_CNV) phase_conv(prm, layer);
        GRID_SYNC();
        phase_outproj(prm, layer, ldsb);
        GRID_SYNC();
        if (layer + 1 < DEPTH) { phase_xb(prm); GRID_SYNC(); }
    }
    phase_final(prm);
}

extern "C" void kernel_launch(void* const* d_in, const int* in_sizes, int n_in, void* d_out, int out_size, void* d_ws, size_t ws_size, hipStream_t stream) {
    static int grid_blocks = 0;
    if (!grid_blocks) {
        int dev = 0, cus = 0, per_cu = 0;
        (void)hipGetDevice(&dev);
        (void)hipDeviceGetAttribute(&cus, hipDeviceAttributeMultiprocessorCount, dev);
        if (hipFuncSetAttribute((const void*)fwd_kernel, hipFuncAttributeMaxDynamicSharedMemorySize, LDS_BYTES) != hipSuccess) fprintf(stderr, "kernel_launch: hipFuncSetAttribute failed\n");
        (void)hipOccupancyMaxActiveBlocksPerMultiprocessor(&per_cu, fwd_kernel, NT, LDS_BYTES);
        if (per_cu < 1) fprintf(stderr, "kernel_launch: occupancy query says %d blocks per CU\n", per_cu);
        grid_blocks = cus;
        if (ws_size < WS_END) fprintf(stderr, "kernel_launch: workspace too small: %zu < %zu\n", ws_size, (size_t)WS_END);
    }
    Params p{};
    p.x = (const float*)d_in[0]; p.norm_w = (const float*)d_in[1]; p.w_in = (const float*)d_in[2]; p.w_out = (const float*)d_in[3];
    p.conv_w = (const float*)d_in[4]; p.sinks = (const float*)d_in[5]; p.cmp_pos = (const float*)d_in[6]; p.cmp_w1 = (const float*)d_in[7];
    p.cmp_w2 = (const float*)d_in[8]; p.rel_bias = (const float*)d_in[9]; p.final_norm_w = (const float*)d_in[10];
    p.out = (float*)d_out; p.ws = (unsigned char*)d_ws;
    if (hipMemsetAsync((char*)d_ws + WS_CTL, 0, CTL_ZERO_BYTES, stream) != hipSuccess) { fprintf(stderr, "kernel_launch: memset of the control words failed\n"); return; }
    hipLaunchKernelGGL(fwd_kernel, dim3(grid_blocks), dim3(NT), LDS_BYTES, stream, p);
    hipError_t e = hipPeekAtLastError();
    if (e != hipSuccess) fprintf(stderr, "launch failed: %s (grid %d)\n", hipGetErrorString(e), grid_blocks);
}
```

```cpp
#include <hip/hip_runtime.h>
#include <cstdio>
#include <cstdint>

namespace pg8 {
#define PG8_LAS __attribute__((address_space(3)))
typedef unsigned short bf16_t;
typedef short bf16x8 __attribute__((ext_vector_type(8)));
typedef float f32x4 __attribute__((ext_vector_type(4)));
typedef unsigned u32x4 __attribute__((ext_vector_type(4)));
constexpr int BM = 256, BK = 64, HALF = 128, HTB = HALF * BK * 2  , STAGE_BYTES = 8 * HTB, NXCD = 8, WGM = 8;

__host__ __device__ __forceinline__ int lds_byte(int r, int c) { const int st = (r >> 4) * 2 + (c >> 5), rr = r & 15, cc = c & 31, ob = rr * 64 + cc * 2; return st * 1024 + (ob ^ (((ob >> 9) & 1) << 5)); }
__host__ __device__ __forceinline__ void stage_rc(int b, int& R, int& C) { const int st = b / 1024, sb = b % 1024, swz = sb ^ (((sb >> 9) & 1) << 5); R = (st >> 1) * 16 + swz / 64; C = (st & 1) * 32 + (swz % 64) / 2; }
__host__ __device__ __forceinline__ int perm32(int rho) { const int n = rho >> 4, i = rho & 15; return 8 * (i >> 2) + 4 * n + (i & 3); }

struct Unit { int pm, pn; };
struct Gemm { const bf16_t* A; const bf16_t* Bt; int M, N, K; };

struct StaticOrder {
    int nM, nN, nwg, G, c;
    __host__ __device__ void init(int M, int N, int G_, int c_) { nM = M / BM; nN = N / BM; nwg = nM * nN; G = G_; c = c_; }
    __host__ __device__ bool next(int i, Unit& u) const {
        const long L = (long)i * G + c; if (L >= nwg) return false;
        int wgid = (int)L; { const int q = nwg / NXCD, r = nwg % NXCD, xcd = wgid % NXCD, off = wgid / NXCD; wgid = (xcd < r ? xcd * (q + 1) : r * (q + 1) + (xcd - r) * q) + off; }
        const int nig = WGM * nN, gid = wgid / nig, fm = gid * WGM, gsz = (nM - fm) < WGM ? (nM - fm) : WGM;
        u.pm = fm + ((wgid % nig) % gsz); u.pn = (wgid % nig) / gsz; return true;
    }
    __device__ __forceinline__ void a_ready(const Unit&) const {}
    __device__ __forceinline__ void done(const Unit&) const {}
};


__device__ __forceinline__ unsigned cvt_pk_bf16(float lo, float hi) { unsigned r; asm volatile("v_cvt_pk_bf16_f32 %0, %1, %2" : "=v"(r) : "v"(lo), "v"(hi)); return r; }
struct EpiBf16 {
    static constexpr bool PERM = true, AFTER_DRAIN = false;
    bf16_t* O; int ldc;
    __device__ __forceinline__ void operator()(const f32x4 (&acc)[2][2][4][2], const Unit& u, int wr, int wc, int fr, int fq) const {
        const int row0 = u.pm * BM + wr * 64 + fr; const int col0 = u.pn * BM + wc * 32 + 8 * fq;
#pragma unroll
        for (int ai = 0; ai < 2; ++ai)
#pragma unroll
            for (int m = 0; m < 4; ++m) { bf16_t* rowp = O + (size_t)(row0 + ai * HALF + m * 16) * ldc + col0;
#pragma unroll
                for (int bj = 0; bj < 2; ++bj) { const f32x4 v0 = acc[ai][bj][m][0], v1 = acc[ai][bj][m][1];
                    u32x4 w; w.x = cvt_pk_bf16(v0[0], v0[1]); w.y = cvt_pk_bf16(v0[2], v0[3]); w.z = cvt_pk_bf16(v1[0], v1[1]); w.w = cvt_pk_bf16(v1[2], v1[3]);
                    *(u32x4*)(rowp + bj * HALF) = w; } }
    }
};
struct EpiResid {
    static constexpr bool PERM = false, AFTER_DRAIN = false;
    const float* base; float* out; int ldc;
    __device__ __forceinline__ void operator()(const f32x4 (&acc)[2][2][4][2], const Unit& u, int wr, int wc, int fr, int fq) const {
        const int col0 = u.pn * BM + wc * 32 + 4 * fq;
#pragma unroll
        for (int ai = 0; ai < 2; ++ai)
#pragma unroll
            for (int m = 0; m < 4; ++m) { const size_t off = (size_t)(u.pm * BM + ai * HALF + wr * 64 + m * 16 + fr) * ldc + col0;
#pragma unroll
                for (int bj = 0; bj < 2; ++bj)
#pragma unroll
                    for (int n = 0; n < 2; ++n) { const f32x4 bs = *(const f32x4*)(base + off + bj * HALF + n * 16); *(f32x4*)(out + off + bj * HALF + n * 16) = bs + acc[ai][bj][m][n]; } }
    }
};

template <class Epi, class Sched, bool ALIGN_EPI = false, bool SP2 = false>
__device__ __forceinline__ void gemm_phase(PG8_LAS unsigned char* lds, const Gemm g, const Sched& S, const Epi& E) {
    int tid_ = threadIdx.x; asm volatile("" : "+v"(tid_));
    const int tid = tid_, wid = __builtin_amdgcn_readfirstlane(tid >> 6), lane = tid & 63, wr = wid >> 2, wc = wid & 3, fr = lane & 15, fq = lane >> 4;
    const int K = g.K, nt = K / BK;
    unsigned voffA[2], voffB[2];
#pragma unroll
    for (int i = 0; i < 2; ++i) { int R, C; stage_rc(tid * 16 + i * 8192, R, C); const int Rb = Epi::PERM ? ((R & ~31) + perm32(R & 31)) : R;
        voffA[i] = (unsigned)(R * K + C) * 2u; voffB[i] = (unsigned)(Rb * K + C) * 2u; }
    const size_t kstep = (size_t)(BK * 2);
    const size_t hstep = (size_t)HALF * K * 2;
    const size_t tstep = 2 * hstep;
    const unsigned ldsw = (unsigned)wid * 1024u;
    const unsigned ldsm0 = __builtin_amdgcn_readfirstlane((unsigned)(unsigned long long)lds + ldsw);
    const int aoff = lds_byte(wr * 64 + fr, fq * 8), boff = lds_byte(wc * 32 + fr, fq * 8);
#define PG8_SA(b, h) (((b) * 2 + (h)) * HTB)
#define PG8_SB(b, h) ((4 + (b) * 2 + (h)) * HTB)
#define PG8_STAGE(bufoff, gbase, voff) do { _Pragma("unroll") for (int _i = 0; _i < 2; ++_i) \
        asm volatile("s_mov_b32 m0, %0\n\ts_nop 0\n\tglobal_load_lds_dwordx4 %1, %2" :: "s"(ldsm0 + (unsigned)((bufoff) + _i * 8192)), "v"((voff)[_i]), "s"((const char*)(gbase)) : "m0", "memory"); } while (0)
#define PG8_LDA(dst, b, h) do { _Pragma("unroll") for (int m = 0; m < 4; ++m) _Pragma("unroll") for (int k = 0; k < 2; ++k) dst[m][k] = *(const PG8_LAS bf16x8*)(lds + PG8_SA(b, h) + aoff + m * 2048 + k * 1024); } while (0)
#define PG8_LDB(dst, b, h) do { _Pragma("unroll") for (int n = 0; n < 2; ++n) _Pragma("unroll") for (int k = 0; k < 2; ++k) dst[n][k] = *(const PG8_LAS bf16x8*)(lds + PG8_SB(b, h) + boff + n * 2048 + k * 1024); } while (0)
#define PG8_MMA(ai, bj, At, Bt) do { __builtin_amdgcn_s_setprio(1); _Pragma("unroll") for (int m = 0; m < 4; ++m) _Pragma("unroll") for (int n = 0; n < 2; ++n) _Pragma("unroll") for (int k = 0; k < 2; ++k) \
        acc[ai][bj][m][n] = __builtin_amdgcn_mfma_f32_16x16x32_bf16(Bt[n][k], At[m][k], acc[ai][bj][m][n], 0, 0, 0); __builtin_amdgcn_s_setprio(0); } while (0)
#define PG8_WAIT_V(n) asm volatile("s_waitcnt vmcnt(" #n ")" ::: "memory")
#define PG8_WAIT_L(n) asm volatile("s_waitcnt lgkmcnt(" #n ")" ::: "memory")
#define PG8_BAR __builtin_amdgcn_s_barrier()
#define PG8_SCHED __builtin_amdgcn_sched_barrier(0)
    Unit cur, nxt; int ui = 0;
    if (!S.next(0, cur)) return;
    f32x4 acc[2][2][4][2];
#pragma unroll
    for (int a = 0; a < 2; ++a)
#pragma unroll
        for (int b = 0; b < 2; ++b)
#pragma unroll
            for (int m = 0; m < 4; ++m)
#pragma unroll
                for (int n = 0; n < 2; ++n) acc[a][b][m][n] = (f32x4){0.f, 0.f, 0.f, 0.f};
    bf16x8 At[4][2], B0[2][2], B1[2][2];
    const char* cA = (const char*)g.A + (size_t)cur.pm * tstep; const char* cB = (const char*)g.Bt + (size_t)cur.pn * tstep;
    S.a_ready(cur);
    if constexpr (SP2) {
        PG8_STAGE(PG8_SB(0, 0), cB, voffB); PG8_STAGE(PG8_SB(0, 1), cB + hstep, voffB); PG8_STAGE(PG8_SA(0, 0), cA, voffA); PG8_STAGE(PG8_SA(0, 1), cA + hstep, voffA);
        if (wr == 1) PG8_BAR;
        PG8_WAIT_V(2); PG8_BAR;
        PG8_STAGE(PG8_SB(1, 0), cB + kstep, voffB); PG8_STAGE(PG8_SA(1, 0), cA + kstep, voffA); PG8_STAGE(PG8_SB(1, 1), cB + hstep + kstep, voffB);
        PG8_WAIT_V(6); PG8_BAR;
    } else {
        PG8_STAGE(PG8_SB(0, 0), cB, voffB); PG8_STAGE(PG8_SA(0, 0), cA, voffA); PG8_STAGE(PG8_SB(0, 1), cB + hstep, voffB); PG8_STAGE(PG8_SA(0, 1), cA + hstep, voffA);
        if (wr == 1) PG8_BAR;
        PG8_WAIT_V(4); PG8_BAR;
        PG8_STAGE(PG8_SB(1, 0), cB + kstep, voffB); PG8_STAGE(PG8_SA(1, 0), cA + kstep, voffA); PG8_STAGE(PG8_SB(1, 1), cB + hstep + kstep, voffB);
        PG8_WAIT_V(6); PG8_BAR;
    }
    for (;;) {
        const bool has_next = S.next(ui + 1, nxt);
        const char* nA = has_next ? (const char*)g.A + (size_t)nxt.pm * tstep : cA; const char* nB = has_next ? (const char*)g.Bt + (size_t)nxt.pn * tstep : cB;
        for (int t = 0; t < nt; t += 2) {
            const bool last = (t == nt - 2);
            const char* a1 = cA + (size_t)(t + 1) * kstep;
            const char* a2 = last ? nA : cA + (size_t)(t + 2) * kstep; const char* b2 = last ? nB : cB + (size_t)(t + 2) * kstep;
            const char* a3 = a2 + kstep; const char* b3 = b2 + kstep;
            if (last && has_next) S.a_ready(nxt);
            if constexpr (SP2) {
            PG8_LDB(B0, 0, 0); PG8_LDB(B1, 0, 1); PG8_SCHED; PG8_LDA(At, 0, 0); PG8_STAGE(PG8_SA(1, 1), a1 + hstep, voffA);
            PG8_WAIT_V(8); PG8_WAIT_L(0); PG8_BAR; PG8_MMA(0, 0, At, B0); PG8_MMA(0, 1, At, B1); PG8_BAR; PG8_SCHED;
            PG8_LDA(At, 0, 1); PG8_STAGE(PG8_SB(0, 0), b2, voffB); PG8_STAGE(PG8_SB(0, 1), b2 + hstep, voffB); PG8_STAGE(PG8_SA(0, 0), a2, voffA);
            PG8_WAIT_V(8); PG8_WAIT_L(0); PG8_BAR; PG8_MMA(1, 0, At, B0); PG8_MMA(1, 1, At, B1); PG8_BAR; PG8_SCHED;
            PG8_LDB(B0, 1, 0); PG8_LDB(B1, 1, 1); PG8_SCHED; PG8_LDA(At, 1, 0); PG8_STAGE(PG8_SA(0, 1), a2 + hstep, voffA);
            PG8_WAIT_V(8); PG8_WAIT_L(0); PG8_BAR; PG8_MMA(0, 0, At, B0); PG8_MMA(0, 1, At, B1); PG8_BAR; PG8_SCHED;
            PG8_LDA(At, 1, 1); PG8_STAGE(PG8_SB(1, 0), b3, voffB); PG8_STAGE(PG8_SB(1, 1), b3 + hstep, voffB); PG8_STAGE(PG8_SA(1, 0), a3, voffA);
            PG8_WAIT_V(8); PG8_WAIT_L(0); PG8_BAR; PG8_MMA(1, 0, At, B0); PG8_MMA(1, 1, At, B1); PG8_BAR; PG8_SCHED;
            } else {
            PG8_LDB(B0, 0, 0); PG8_SCHED; PG8_LDA(At, 0, 0); PG8_STAGE(PG8_SA(1, 1), a1 + hstep, voffA);
            PG8_WAIT_L(8); PG8_BAR; PG8_WAIT_L(0); PG8_MMA(0, 0, At, B0); PG8_BAR; PG8_SCHED;
            PG8_LDB(B1, 0, 1); PG8_STAGE(PG8_SB(0, 0), b2, voffB);
            PG8_BAR; PG8_WAIT_L(0); PG8_MMA(0, 1, At, B1); PG8_BAR;
            PG8_LDA(At, 0, 1); PG8_STAGE(PG8_SA(0, 0), a2, voffA);
            PG8_BAR; PG8_WAIT_L(0); PG8_MMA(1, 0, At, B0); PG8_BAR; PG8_SCHED;
            PG8_STAGE(PG8_SB(0, 1), b2 + hstep, voffB);
            PG8_WAIT_V(6); PG8_BAR; PG8_MMA(1, 1, At, B1); PG8_BAR;
            PG8_LDB(B0, 1, 0); PG8_SCHED; PG8_LDA(At, 1, 0); PG8_STAGE(PG8_SA(0, 1), a2 + hstep, voffA);
            PG8_WAIT_L(8); PG8_BAR; PG8_WAIT_L(0); PG8_MMA(0, 0, At, B0); PG8_BAR; PG8_SCHED;
            PG8_LDB(B1, 1, 1); PG8_STAGE(PG8_SB(1, 0), b3, voffB);
            PG8_BAR; PG8_WAIT_L(0); PG8_MMA(0, 1, At, B1); PG8_BAR;
            PG8_LDA(At, 1, 1); PG8_STAGE(PG8_SA(1, 0), a3, voffA);
            PG8_BAR; PG8_WAIT_L(0); PG8_MMA(1, 0, At, B0); PG8_BAR; PG8_SCHED;
            PG8_STAGE(PG8_SB(1, 1), b3 + hstep, voffB);
            PG8_WAIT_V(6); PG8_BAR; PG8_MMA(1, 1, At, B1); PG8_BAR;
            }
        }
        if constexpr (ALIGN_EPI) { if (wr == 0) PG8_BAR; }
        if constexpr (!Epi::AFTER_DRAIN) { E(acc, cur, wr, wc, fr, fq); S.done(cur); }
        if (!has_next) break;
#pragma unroll
        for (int a = 0; a < 2; ++a)
#pragma unroll
            for (int b = 0; b < 2; ++b)
#pragma unroll
                for (int m = 0; m < 4; ++m)
#pragma unroll
                    for (int n = 0; n < 2; ++n) acc[a][b][m][n] = (f32x4){0.f, 0.f, 0.f, 0.f};
        cur = nxt; cA = nA; cB = nB; ++ui;
        if constexpr (ALIGN_EPI) { if (wr == 1) PG8_BAR; }
    }
    PG8_WAIT_V(0);
    if constexpr (!ALIGN_EPI) { if (wr == 0) PG8_BAR; }
    PG8_BAR;
    if constexpr (Epi::AFTER_DRAIN) { E.fused(acc, cur, wr, wc, fr, fq, lds, wid, lane); S.done(cur); }
#undef PG8_SA
#undef PG8_SB
#undef PG8_STAGE
#undef PG8_LDA
#undef PG8_LDB
#undef PG8_MMA
#undef PG8_WAIT_V
#undef PG8_WAIT_L
#undef PG8_BAR
#undef PG8_SCHED
}
}

typedef unsigned short bf16_t;
#define LAS __attribute__((address_space(3)))
constexpr int DM = 2048, NB = 8, S = 2048, M = NB * S, DIN = 7192, DEPTH = 2, LDP = 6144, NVT = 1024, NW_IN = LDP + NVT;
constexpr int NWAVES = 8, NT = NWAVES * 64;
constexpr int C_AQ = 0, C_AKC = 512, C_AKS = 640, C_AKW = 768, C_AGATE = 896;
constexpr int C_BQ = 1408, C_BK = 1920, C_BGATE = 2048;
constexpr int C_CB = 2560, C_CC = 3072, C_CH = 3584, C_CGATE = 4096;
constexpr int C_DQ = 4608, C_DK = 5120, C_DGATE = 5632;
constexpr int VR_AVC = 0, VR_AVS = 128, VR_AVW = 256, VR_BV = 384, VR_DV = 512;
__host__ __device__ __forceinline__ int src_col_of(int n) {
    if (n < 640) return n;
    if (n < 768) return n - 640 + 768;
    if (n < 896) return n - 768 + 1024;
    if (n < 1408) return n - 896 + 1304;
    if (n < 1920) return n - 1408 + 1816;
    if (n < 2048) return n - 1920 + 2328;
    if (n < 2560) return n - 2048 + 2584;
    if (n < 4608) return n - 2560 + 3096;
    if (n < 5120) return n - 4608 + 5144;
    if (n < 5632) return n - 5120 + 5656;
    if (n < 6144) return n - 5632 + 6680;
    if (n < 6272) return n - 6144 + 640;
    if (n < 6400) return n - 6272 + 896;
    if (n < 6528) return n - 6400 + 1152;
    if (n < 6656) return n - 6528 + 2456;
    return n - 6656 + 6168;
}
constexpr int SRC_GATES = 1280;
constexpr int NCMP = 127;

constexpr size_t MiB = 1u << 20;
constexpr size_t WS_BIASD = 1 * MiB;
constexpr size_t WS_IMG = 1 * MiB + 512 * 1024;
constexpr size_t WS_G = 2 * MiB;
constexpr size_t WS_WG = 4 * MiB;
constexpr size_t WS_PB = 4 * MiB + 512 * 1024;
constexpr size_t WS_W2T = 4 * MiB + 768 * 1024;
constexpr size_t WS_W1T = 6 * MiB;
constexpr size_t WS_CMP = 5 * MiB;
constexpr size_t WS_WIN = 8 * MiB;
constexpr size_t WS_WOUT = 64 * MiB;
constexpr size_t WS_XB = 80 * MiB;
constexpr size_t WS_MIX = 144 * MiB;
constexpr size_t WS_P = 208 * MiB;
constexpr size_t WS_VT = 400 * MiB;
constexpr size_t WS_END = 432 * MiB;
constexpr int LDS_BYTES = 147456;

struct Params {
    const float* x; const float* norm_w; const float* w_in; const float* w_out; const float* conv_w; const float* sinks;
    const float* cmp_pos; const float* cmp_w1; const float* cmp_w2; const float* rel_bias; const float* final_norm_w;
    float* out; unsigned char* ws;
};

__device__ __forceinline__ float bf2f(bf16_t v) { return __uint_as_float(((unsigned)v) << 16); }
__device__ __forceinline__ unsigned f2bfu(float f) { unsigned u = __float_as_uint(f); return (u + 0x7fffu + ((u >> 16) & 1u)) >> 16; }
__device__ __forceinline__ bf16_t f2bf(float f) { return (bf16_t)f2bfu(f); }
__device__ __forceinline__ unsigned pk2(float lo, float hi) { return f2bfu(lo) | (f2bfu(hi) << 16); }
__device__ __forceinline__ float wave_sum(float v) {
#pragma unroll
    for (int o = 32; o > 0; o >>= 1) v += __shfl_xor(v, o);
    return v;
}
__device__ __forceinline__ float wave_max(float v) {
#pragma unroll
    for (int o = 32; o > 0; o >>= 1) v = fmaxf(v, __shfl_xor(v, o));
    return v;
}
__device__ __forceinline__ float silu(float v) { return v / (1.f + __expf(-v)); }
__device__ __forceinline__ float sigmoidf(float v) { return 1.f / (1.f + __expf(-v)); }
#define LDS_FENCE() asm volatile("s_waitcnt lgkmcnt(0)" ::: "memory")

__device__ __forceinline__ int t5_bucket(int d) {
    if (d < 16) return d < 0 ? 0 : d;
    int b = 16;
    b += (d >= 22); b += (d >= 30); b += (d >= 40); b += (d >= 54); b += (d >= 73); b += (d >= 99); b += (d >= 134); b += (d >= 182);
    b += (d >= 246); b += (d >= 332); b += (d >= 450); b += (d >= 609); b += (d >= 825); b += (d >= 1117); b += (d >= 1513);
    return b;
}

__device__ __forceinline__ void transpose_item(const float* W, int K, int srcld, int src_n0, const float* ksc, bf16_t* WT, LAS float* scr, int kb, int nb, int lane) {
    const int k0 = 64 * kb, n0 = 32 * nb;
#pragma unroll 8
    for (int i = 0; i < 32; ++i) { const int kk = 2 * i + (lane >> 5); const float sc = ksc ? ksc[k0 + kk] : 1.f; scr[kk * 33 + (lane & 31)] = W[(size_t)(k0 + kk) * srcld + src_n0 + n0 + (lane & 31)] * sc; }
    LDS_FENCE();
    const int c = lane & 7;
#pragma unroll
    for (int j = 0; j < 4; ++j) { const int n = (lane >> 3) + 8 * j; const LAS float* s = scr + (8 * c) * 33 + n;
        uint4 o; o.x = pk2(s[0 * 33], s[1 * 33]); o.y = pk2(s[2 * 33], s[3 * 33]); o.z = pk2(s[4 * 33], s[5 * 33]); o.w = pk2(s[6 * 33], s[7 * 33]);
        *(uint4*)(WT + (size_t)(n0 + n) * K + k0 + 8 * c) = o; }
    LDS_FENCE();
}
__device__ __forceinline__ void rms_row_to_bf16(const float* xrow, bf16_t* orow, int lane) {
    const float4* xr = (const float4*)xrow + lane;
    float4 v[8]; float s = 0.f;
#pragma unroll
    for (int j = 0; j < 8; ++j) { v[j] = xr[64 * j]; s += (v[j].x * v[j].x + v[j].y * v[j].y) + (v[j].z * v[j].z + v[j].w * v[j].w); }
    const float r = rsqrtf(wave_sum(s) * (1.f / DM) + 1e-6f);
    uint2* o8 = (uint2*)orow + lane;
#pragma unroll
    for (int j = 0; j < 8; ++j) o8[64 * j] = make_uint2(pk2(v[j].x * r, v[j].y * r), pk2(v[j].z * r, v[j].w * r));
}

__device__ __forceinline__ float ldval(const bf16_t* p) { return bf2f(*p); }
__device__ __forceinline__ float ldval(const float* p) { return *p; }
__device__ __forceinline__ void load8(const bf16_t* p, float (&k)[8]) {
    const uint4 w = *(const uint4*)p;
    k[0] = __uint_as_float(w.x << 16); k[1] = __uint_as_float(w.x & 0xffff0000u);
    k[2] = __uint_as_float(w.y << 16); k[3] = __uint_as_float(w.y & 0xffff0000u);
    k[4] = __uint_as_float(w.z << 16); k[5] = __uint_as_float(w.z & 0xffff0000u);
    k[6] = __uint_as_float(w.w << 16); k[7] = __uint_as_float(w.w & 0xffff0000u);
}
__device__ __forceinline__ void load8(const float* p, float (&k)[8]) {
    const float4 a = ((const float4*)p)[0], b = ((const float4*)p)[1];
    k[0] = a.x; k[1] = a.y; k[2] = a.z; k[3] = a.w; k[4] = b.x; k[5] = b.y; k[6] = b.z; k[7] = b.w;
}

template <int NH, typename KT>
__device__ __forceinline__ void score_chunk(const KT* kmat, size_t rstride, int krow, bool valid, int dist, const float* qs, const float* biasd, float (&s)[NH]) {
    float a[NH];
#pragma unroll
    for (int h = 0; h < NH; ++h) a[h] = 0.f;
    if (valid) {
        const KT* kr = kmat + (size_t)krow * rstride;
#pragma unroll 2
        for (int d8 = 0; d8 < 8; ++d8) {
            float k[8]; load8(kr + 8 * d8, k);
#pragma unroll
            for (int h = 0; h < NH; ++h) {
                const float4 q0 = ((const float4*)(qs + h * 64))[2 * d8], q1 = ((const float4*)(qs + h * 64))[2 * d8 + 1];
                a[h] += q0.x * k[0] + q0.y * k[1] + q0.z * k[2] + q0.w * k[3] + q1.x * k[4] + q1.y * k[5] + q1.z * k[6] + q1.w * k[7];
            }
        }
    }
#pragma unroll
    for (int h = 0; h < NH; ++h) s[h] = valid ? a[h] * 0.125f + biasd[h * 2048 + dist] : -INFINITY;
}
template <int NH, typename VT>
__device__ __forceinline__ void pv_chunk(const VT* vmat, size_t rstride, size_t dstride, int rbase, int rstep, int j0, int j1, const float (&p)[NH], float (&o)[NH], int lane) {
    for (int jj = j0; jj < j1; ++jj) {
        const float vv = ldval(vmat + (size_t)(rbase + jj * rstep) * rstride + (size_t)lane * dstride);
#pragma unroll
        for (int h = 0; h < NH; ++h) o[h] += __uint_as_float(__builtin_amdgcn_readlane(__float_as_uint(p[h]), jj)) * vv;
    }
}
template <int NH, typename KT>
__device__ __forceinline__ void attend_chunk(const KT* kmat, const KT* vmat  , size_t rstride, int rbase, int rstep, int j0, int j1, int dbase, int dstep,
                                             const float* qs, const float* biasd, float (&m)[NH], float (&l)[NH], float (&o)[NH], int lane) {
    if (j1 <= j0) return;
    const bool valid = lane >= j0 && lane < j1;
    float s[NH], p[NH];
    score_chunk<NH, KT>(kmat, rstride, rbase + lane * rstep, valid, dbase + lane * dstep, qs, biasd, s);
#pragma unroll
    for (int h = 0; h < NH; ++h) {
        const float cm = wave_max(s[h]);
        const float mn = fmaxf(m[h], cm);
        const float sc = __expf(m[h] - mn);
        p[h] = valid ? __expf(s[h] - mn) : 0.f;
        l[h] = l[h] * sc + wave_sum(p[h]); o[h] *= sc; m[h] = mn;
    }
    pv_chunk<NH, KT>(vmat, 1, (size_t)M, rbase, rstep, j0, j1, p, o, lane);
}


typedef unsigned u32x4_t_ __attribute__((ext_vector_type(4)));
typedef short abf16x8 __attribute__((ext_vector_type(8)));
typedef float f32x16 __attribute__((ext_vector_type(16)));
constexpr float LOG2E = 1.4426950408889634f, SCL = 0.125f * 1.4426950408889634f;
constexpr int OFF_TA = 0, OFF_TB = 65536, OFF_OSC = 65536 + 8192, OFF_TD = 0;
__device__ __forceinline__ int pi32(int i) { return (i & 19) | ((i & 4) << 1) | ((i & 8) >> 1); }
__device__ __forceinline__ unsigned cvtpk(float lo, float hi) { unsigned r; asm volatile("v_cvt_pk_bf16_f32 %0, %1, %2" : "=v"(r) : "v"(lo), "v"(hi)); return r; }
struct KVF { abf16x8 k[4]; abf16x8 v[4]; };
struct Soft { float m, l; f32x16 o[2]; };
__device__ __forceinline__ void soft_init(Soft& st) {
    st.m = -INFINITY; st.l = 0.f;
#pragma unroll
    for (int r = 0; r < 16; ++r) { st.o[0][r] = 0.f; st.o[1][r] = 0.f; }
}
__device__ __forceinline__ void load_kv(KVF& f, const bf16_t* kp, size_t krs, const bf16_t* vp, size_t vhalf, int key0) {
    const bf16_t* k = kp + (size_t)key0 * krs;
#pragma unroll
    for (int s = 0; s < 4; ++s) f.k[s] = *(const abf16x8*)(k + 16 * s);
    const bf16_t* v = vp + key0;
    f.v[0] = *(const abf16x8*)(v); f.v[1] = *(const abf16x8*)(v + 16); f.v[2] = *(const abf16x8*)(v + vhalf); f.v[3] = *(const abf16x8*)(v + vhalf + 16);
}
template <bool CAUSAL, bool WIN, bool ROWSEL>
__device__ __forceinline__ void tile_step(Soft& st, const KVF& f, const abf16x8 (&qf)[4], const LAS float* tabp, int key0, int D0, int W, bool rowsel) {
    f32x16 acc;
#pragma unroll
    for (int r = 0; r < 16; ++r) acc[r] = 0.f;
#pragma unroll
    for (int s = 0; s < 4; ++s) acc = __builtin_amdgcn_mfma_f32_32x32x16_bf16(f.k[s], qf[s], acc, 0, 0, 0);
    float sv[16]; float tm = -INFINITY;
#pragma unroll
    for (int r = 0; r < 16; ++r) {
        const int ko = (r & 7) + 16 * (r >> 3);
        float x = fmaf(acc[r], SCL, tabp[key0 + ko]);
        bool ok = true;
        if (CAUSAL) ok = ok && (ko <= D0);
        if (WIN) ok = ok && (ko >= D0 - W);
        if (ROWSEL) ok = ok && rowsel;
        if (CAUSAL || WIN || ROWSEL) x = ok ? x : -INFINITY;
        sv[r] = x; tm = fmaxf(tm, x);
    }
    tm = fmaxf(tm, __shfl_xor(tm, 32));
    const float mn = fmaxf(st.m, tm);
    const float alpha = __builtin_amdgcn_exp2f(st.m - mn);
    float rs = 0.f;
#pragma unroll
    for (int r = 0; r < 16; ++r) { sv[r] = __builtin_amdgcn_exp2f(sv[r] - mn); rs += sv[r]; }
    st.l = st.l * alpha + rs; st.m = mn;
    if (__any(alpha != 1.f)) {
#pragma unroll
        for (int r = 0; r < 16; ++r) { st.o[0][r] *= alpha; st.o[1][r] *= alpha; }
    }
    abf16x8 pf[2];
#pragma unroll
    for (int s2 = 0; s2 < 2; ++s2) {
        typedef unsigned u32x4_t __attribute__((ext_vector_type(4)));
        u32x4_t w; w.x = cvtpk(sv[8 * s2 + 0], sv[8 * s2 + 1]); w.y = cvtpk(sv[8 * s2 + 2], sv[8 * s2 + 3]); w.z = cvtpk(sv[8 * s2 + 4], sv[8 * s2 + 5]); w.w = cvtpk(sv[8 * s2 + 6], sv[8 * s2 + 7]);
        pf[s2] = __builtin_bit_cast(abf16x8, w);
    }
#pragma unroll
    for (int dh = 0; dh < 2; ++dh)
#pragma unroll
        for (int s2 = 0; s2 < 2; ++s2) st.o[dh] = __builtin_amdgcn_mfma_f32_32x32x16_bf16(f.v[dh * 2 + s2], pf[s2], st.o[dh], 0, 0, 0);
}
__device__ __forceinline__ void store_rows(const f32x16 (&o)[2], float scale, const bf16_t* gp, bf16_t* op, int h) {
#pragma unroll
    for (int dh = 0; dh < 2; ++dh)
#pragma unroll
        for (int rg = 0; rg < 4; ++rg) {
            const int dim0 = 32 * dh + 8 * rg + 4 * h;
            const uint2 gw = *(const uint2*)(gp + dim0);
            const float g0 = __uint_as_float(gw.x << 16), g1 = __uint_as_float(gw.x & 0xffff0000u), g2 = __uint_as_float(gw.y << 16), g3 = __uint_as_float(gw.y & 0xffff0000u);
            uint2 w; w.x = cvtpk(o[dh][4 * rg + 0] * scale * silu(g0), o[dh][4 * rg + 1] * scale * silu(g1)); w.y = cvtpk(o[dh][4 * rg + 2] * scale * silu(g2), o[dh][4 * rg + 3] * scale * silu(g3));
            *(uint2*)(op + dim0) = w;
        }
}
__device__ __forceinline__ void unit_D(const bf16_t* P, const bf16_t* VT, bf16_t* MIX, const LAS float* tabD, int b, int head, int qt, int lane) {
    asm volatile("" : "+v"(lane));
    const int c = lane & 31, h = lane >> 5, tc = qt * 32 + c;
    const size_t rowq = (size_t)b * S + tc;
    abf16x8 qf[4];
#pragma unroll
    for (int s = 0; s < 4; ++s) qf[s] = *(const abf16x8*)(P + rowq * LDP + C_DQ + head * 64 + 16 * s + 8 * h);
    const bf16_t* kp = P + ((size_t)b * S + pi32(c)) * LDP + C_DK + head * 64 + 8 * h;
    const bf16_t* vp = VT + (size_t)(VR_DV + head * 64 + c) * M + (size_t)b * S + 8 * h;
    const LAS float* tabp = tabD + head * 2048 + (2047 - tc + 8 * h);
    Soft st; soft_init(st);
    KVF cur, nxt;
    load_kv(cur, kp, LDP, vp, (size_t)32 * M, 32 * qt);
    for (int kt = qt; kt >= 0; --kt) {
        if (kt > 0) load_kv(nxt, kp, LDP, vp, (size_t)32 * M, 32 * (kt - 1));
        const int D0 = tc - 32 * kt - 8 * h;
        if (kt == qt) tile_step<true, false, false>(st, cur, qf, tabp, 32 * kt, D0, 0, true);
        else tile_step<false, false, false>(st, cur, qf, tabp, 32 * kt, D0, 0, true);
        if (kt > 0) cur = nxt;
    }
    const float l = st.l + __shfl_xor(st.l, 32);
    store_rows(st.o, 1.f / l, P + rowq * LDP + C_DGATE + head * 64, MIX + rowq * DM + 1536 + head * 64, h);
}

__device__ __forceinline__ void unit_B(const bf16_t* P, const bf16_t* VT, bf16_t* MIX, const LAS float* tabB, const float* sinks, int b, int g, int q8, int lane) {
    asm volatile("" : "+v"(lane));
    const int c = lane & 31, h = lane >> 5, hh = c >> 3, qi = c & 7, t0 = q8 * 8, tc = t0 + qi, head = g * 4 + hh;
    const size_t rowq = (size_t)b * S + tc;
    abf16x8 qf[4];
#pragma unroll
    for (int s = 0; s < 4; ++s) qf[s] = *(const abf16x8*)(P + rowq * LDP + C_BQ + head * 64 + 16 * s + 8 * h);
    const bf16_t* kp = P + ((size_t)b * S + pi32(c)) * LDP + C_BK + g * 64 + 8 * h;
    const bf16_t* vp = VT + (size_t)(VR_BV + g * 64 + c) * M + (size_t)b * S + 8 * h;
    const LAS float* tabp = tabB + head * 256 + (255 - tc + 8 * h);
    Soft st; soft_init(st);
    const int ktd = t0 >> 5, ktlo = (t0 - 127 > 0 ? t0 - 127 : 0) >> 5;
    KVF cur, nxt;
    load_kv(cur, kp, LDP, vp, (size_t)32 * M, 32 * ktd);
    for (int kt = ktd; kt >= ktlo; --kt) {
        if (kt > ktlo) load_kv(nxt, kp, LDP, vp, (size_t)32 * M, 32 * (kt - 1));
        const int D0 = tc - 32 * kt - 8 * h;
        if (kt == ktd) tile_step<true, false, false>(st, cur, qf, tabp, 32 * kt, D0, 0, true);
        else tile_step<false, true, false>(st, cur, qf, tabp, 32 * kt, D0, 127, true);
        if (kt > ktlo) cur = nxt;
    }
    const float l = st.l + __shfl_xor(st.l, 32) + __builtin_amdgcn_exp2f(sinks[head] * LOG2E - st.m);
    store_rows(st.o, 1.f / l, P + rowq * LDP + C_BGATE + head * 64, MIX + rowq * DM + 512 + head * 64, h);
}

__device__ __forceinline__ void unit_A(const bf16_t* P, const bf16_t* VT, const bf16_t* KCMP, const bf16_t* VCMPT, const float* GT, bf16_t* MIX, const LAS float* tabA, LAS float* osc  , int b, int g, int q8, int lane) {
    asm volatile("" : "+v"(lane));
    const int c = lane & 31, h = lane >> 5, hh = c >> 3, qi = c & 7, t0 = q8 * 8, tc = t0 + qi, head = g * 4 + hh;
    const size_t rowq = (size_t)b * S + tc;
    abf16x8 qf[4];
#pragma unroll
    for (int s = 0; s < 4; ++s) qf[s] = *(const abf16x8*)(P + rowq * LDP + C_AQ + head * 64 + 16 * s + 8 * h);
    const LAS float* tabh = tabA + head * 2048;
    unsigned selmask = 0u;
    {
        const int ncv = tc >= 31 ? ((tc - 31) >> 4) + 1 : 0;
        const bf16_t* kp = KCMP + ((size_t)(b * 2 + g) * 128 + pi32(c)) * 64 + 8 * h;
        const bf16_t* vp = VCMPT + ((size_t)(b * 2 + g) * 64 + c) * 128 + 8 * h;
        const LAS float* tabp = tabh + (2047 - tc + 31 + 128 * h);
        float sc[4][16]; float mx = -INFINITY;
#pragma unroll
        for (int kt = 0; kt < 4; ++kt) {
            f32x16 acc;
#pragma unroll
            for (int r = 0; r < 16; ++r) acc[r] = 0.f;
#pragma unroll
            for (int s = 0; s < 4; ++s) acc = __builtin_amdgcn_mfma_f32_32x32x16_bf16(*(const abf16x8*)(kp + (size_t)(32 * kt) * 64 + 16 * s), qf[s], acc, 0, 0, 0);
#pragma unroll
            for (int r = 0; r < 16; ++r) {
                const int ko = (r & 7) + 16 * (r >> 3);
                const bool ok = 32 * kt + 8 * h + ko < ncv;
                const float tb = tabp[512 * kt + 16 * ko];
                const float x = ok ? fmaf(acc[r], SCL, tb) : -INFINITY;
                sc[kt][r] = x; mx = fmaxf(mx, x);
            }
            asm volatile("" ::: "memory");
        }
        mx = fmaxf(mx, __shfl_xor(mx, 32)); mx = fmaxf(mx, -1e30f);
        float sum = 0.f;
#pragma unroll
        for (int kt = 0; kt < 4; ++kt)
#pragma unroll
            for (int r = 0; r < 16; ++r) { sc[kt][r] = __builtin_amdgcn_exp2f(sc[kt][r] - mx); sum += sc[kt][r]; }
        sum += __shfl_xor(sum, 32);
        const float inv = 1.f / fmaxf(sum, 1e-30f);
        f32x16 oc[2];
#pragma unroll
        for (int r = 0; r < 16; ++r) { oc[0][r] = 0.f; oc[1][r] = 0.f; }
#pragma unroll
        for (int kt = 0; kt < 4; ++kt) {
#pragma unroll
            for (int r = 0; r < 16; ++r) sc[kt][r] *= inv;
            abf16x8 pf[2];
#pragma unroll
            for (int s2 = 0; s2 < 2; ++s2) {
                typedef unsigned u32x4_t __attribute__((ext_vector_type(4)));
                u32x4_t w; w.x = cvtpk(sc[kt][8 * s2 + 0], sc[kt][8 * s2 + 1]); w.y = cvtpk(sc[kt][8 * s2 + 2], sc[kt][8 * s2 + 3]); w.z = cvtpk(sc[kt][8 * s2 + 4], sc[kt][8 * s2 + 5]); w.w = cvtpk(sc[kt][8 * s2 + 6], sc[kt][8 * s2 + 7]);
                pf[s2] = __builtin_bit_cast(abf16x8, w);
            }
#pragma unroll
            for (int dh = 0; dh < 2; ++dh)
#pragma unroll
                for (int s2 = 0; s2 < 2; ++s2) oc[dh] = __builtin_amdgcn_mfma_f32_32x32x16_bf16(*(const abf16x8*)(vp + (size_t)dh * 32 * 128 + 32 * kt + 16 * s2), pf[s2], oc[dh], 0, 0, 0);
            asm volatile("" ::: "memory");
        }
        float x7[4], x15[4];
#pragma unroll
        for (int kt = 0; kt < 4; ++kt) { x7[kt] = __shfl_xor(sc[kt][7], 32); x15[kt] = __shfl_xor(sc[kt][15], 32); }
        unsigned key[16];
        const int cur = tc >> 6;
#pragma unroll
        for (int kt = 0; kt < 4; ++kt)
#pragma unroll
            for (int gb = 0; gb < 2; ++gb) {
                const float pl0 = gb == 0 ? (kt > 0 ? x15[kt > 0 ? kt - 1 : 0] : 0.f) : x7[kt];
                const float pl1 = gb == 0 ? x7[kt] : x15[kt];
                const float prevlast = h ? pl1 : pl0;
                float ie = prevlast + sc[kt][8 * gb + 0] + sc[kt][8 * gb + 1] + sc[kt][8 * gb + 2] + sc[kt][8 * gb + 3];
                float io = sc[kt][8 * gb + 3] + sc[kt][8 * gb + 4] + sc[kt][8 * gb + 5] + sc[kt][8 * gb + 6] + sc[kt][8 * gb + 7];
                ie += __shfl_xor(ie, 8); ie += __shfl_xor(ie, 16);
                io += __shfl_xor(io, 8); io += __shfl_xor(io, 16);
#pragma unroll
                for (int eo = 0; eo < 2; ++eo) {
                    const int n = 8 * kt + 2 * h + 4 * gb + eo;
                    const bool forced = n == 0 || n == cur || n == cur - 1;
                    const float v = forced ? 1e4f : (eo ? io : ie);
                    key[(kt * 2 + gb) * 2 + eo] = n > cur ? (unsigned)(31 - n) : ((((__float_as_uint(v) >> 5) + 1u) << 5) | (unsigned)(31 - n));
                }
            }
#pragma unroll 1
        for (int round = 0; round < 8; ++round) {
            unsigned lm = key[0];
#pragma unroll
            for (int i = 1; i < 16; ++i) lm = lm > key[i] ? lm : key[i];
            const unsigned pm = (unsigned)__shfl_xor((int)lm, 32);
            const unsigned best = lm > pm ? lm : pm;
            selmask |= 1u << (31 - (best & 31u));
#pragma unroll
            for (int i = 0; i < 16; ++i) key[i] = key[i] == best ? 0u : key[i];
        }
        const float g0 = sigmoidf(GT[rowq * 24 + 0 * 8 + head]);
#pragma unroll
        for (int r = 0; r < 16; ++r) { osc[r * 64 + lane] = oc[0][r] * g0; osc[(16 + r) * 64 + lane] = oc[1][r] * g0; }
    }
    const int ktd = t0 >> 5;
    const LAS float* tabp = tabh + (2047 - tc + 8 * h);
    {
        unsigned umask = selmask;
#pragma unroll
        for (int o = 1; o < 64; o <<= 1) umask |= (unsigned)__shfl_xor((int)umask, o);
        umask = __builtin_amdgcn_readfirstlane(umask);
        int c2 = lane & 31, h2 = lane >> 5; asm volatile("" : "+v"(c2), "+v"(h2));
        const bf16_t* kp = P + ((size_t)b * S + pi32(c2)) * LDP + C_AKS + g * 64 + 8 * h2;
        const bf16_t* vp = VT + (size_t)(VR_AVS + g * 64 + c2) * M + (size_t)b * S + 8 * h2;
        Soft st; soft_init(st);
        KVF cur, nxt;
        load_kv(cur, kp, LDP, vp, (size_t)32 * M, 32 * ktd);
        int kt = ktd;
        while (kt >= 0) {
            int nk = kt - 1;
            while (nk >= 0 && !((umask >> (nk >> 1)) & 1u)) --nk;
            if (nk >= 0) load_kv(nxt, kp, LDP, vp, (size_t)32 * M, 32 * nk);
            const int D0 = tc - 32 * kt - 8 * h;
            const bool rowsel = (selmask >> (kt >> 1)) & 1u;
            if (kt == ktd) tile_step<true, false, true>(st, cur, qf, tabp, 32 * kt, D0, 0, rowsel);
            else tile_step<false, false, true>(st, cur, qf, tabp, 32 * kt, D0, 0, rowsel);
            if (nk >= 0) cur = nxt;
            kt = nk;
        }
        const float l = st.l + __shfl_xor(st.l, 32);
        const float g1 = sigmoidf(GT[rowq * 24 + 1 * 8 + head]) / l;
#pragma unroll
        for (int r = 0; r < 16; ++r) { osc[r * 64 + lane] += st.o[0][r] * g1; osc[(16 + r) * 64 + lane] += st.o[1][r] * g1; }
    }
    {
        int c2 = lane & 31, h2 = lane >> 5; asm volatile("" : "+v"(c2), "+v"(h2));
        const bf16_t* kp = P + ((size_t)b * S + pi32(c2)) * LDP + C_AKW + g * 64 + 8 * h2;
        const bf16_t* vp = VT + (size_t)(VR_AVW + g * 64 + c2) * M + (size_t)b * S + 8 * h2;
        Soft st; soft_init(st);
        const int ktlo = (t0 - 511 > 0 ? t0 - 511 : 0) >> 5;
        KVF cur, nxt;
        load_kv(cur, kp, LDP, vp, (size_t)32 * M, 32 * ktd);
        for (int kt = ktd; kt >= ktlo; --kt) {
            if (kt > ktlo) load_kv(nxt, kp, LDP, vp, (size_t)32 * M, 32 * (kt - 1));
            const int D0 = tc - 32 * kt - 8 * h;
            if (kt == ktd) tile_step<true, false, false>(st, cur, qf, tabp, 32 * kt, D0, 0, true);
            else if (32 * kt < t0 + 7 - 511) tile_step<false, true, false>(st, cur, qf, tabp, 32 * kt, D0, 511, true);
            else tile_step<false, false, false>(st, cur, qf, tabp, 32 * kt, D0, 0, true);
            if (kt > ktlo) cur = nxt;
        }
        const float l = st.l + __shfl_xor(st.l, 32);
        const float g2 = sigmoidf(GT[rowq * 24 + 2 * 8 + head]) / l;
#pragma unroll
        for (int r = 0; r < 16; ++r) { st.o[0][r] = osc[r * 64 + lane] + st.o[0][r] * g2; st.o[1][r] = osc[(16 + r) * 64 + lane] + st.o[1][r] * g2; }
        int c3 = lane & 31; asm volatile("" : "+v"(c3));
        const size_t rowq3 = (size_t)b * S + t0 + (c3 & 7); const int head3 = g * 4 + (c3 >> 3);
        store_rows(st.o, 1.f, P + rowq3 * LDP + C_AGATE + head3 * 64, MIX + rowq3 * DM + head3 * 64, h2);
    }
}


constexpr int KVB = 8192, KVROUND = 2 * KVB;
struct StageRegs { u32x4_t_ k, v; };
__device__ __forceinline__ void stage_load(StageRegs& sr, const bf16_t* kg, size_t krs, const bf16_t* vg, int R, int tid) {
    const int row = tid >> 3, ch = tid & 7;
    sr.k = *(const u32x4_t_*)(kg + (size_t)(64 * R + row) * krs + ch * 8);
    sr.v = *(const u32x4_t_*)(vg + (size_t)row * M + 64 * R + ch * 8);
}
__device__ __forceinline__ void stage_write(const StageRegs& sr, LAS unsigned char* kvb, int tid) {
    const int row = tid >> 3, ch = tid & 7;
    const int off = row * 128 + ((ch ^ ((row >> 1) & 7)) << 4);
    *(LAS u32x4_t_*)(kvb + off) = sr.k; *(LAS u32x4_t_*)(kvb + KVB + off) = sr.v;
}
__device__ __forceinline__ void frag_read(KVF& f, const LAS unsigned char* kvb, int j, int lane) {
    const int i = lane & 31, h = lane >> 5;
    const int rr = 32 * j + pi32(i), sw = (rr >> 1) & 7;
#pragma unroll
    for (int s = 0; s < 4; ++s) f.k[s] = *(const LAS abf16x8*)(kvb + rr * 128 + (((2 * s + h) ^ sw) << 4));
#pragma unroll
    for (int dh = 0; dh < 2; ++dh) { const int dim = i + 32 * dh, swv = (dim >> 1) & 7;
#pragma unroll
        for (int s2 = 0; s2 < 2; ++s2) f.v[dh * 2 + s2] = *(const LAS abf16x8*)(kvb + KVB + dim * 128 + (((4 * j + 2 * s2 + h) ^ swv) << 4)); }
}
#define ROUND_LOOP(rm_, kg_, krs_, vg_, kvbase_, tid_, lane_, ...) do { \
    unsigned rm__ = (rm_); int R__ = 31 - __builtin_clz(rm__); int bs__ = 0; StageRegs sr__; \
    stage_load(sr__, kg_, krs_, vg_, R__, tid_); stage_write(sr__, (kvbase_), tid_); __syncthreads(); \
    for (;;) { rm__ &= ~(1u << R__); const int Rn__ = rm__ ? 31 - __builtin_clz(rm__) : -1; \
        if (Rn__ >= 0) stage_load(sr__, kg_, krs_, vg_, Rn__, tid_); \
        { const LAS unsigned char* kvb__ = (kvbase_) + bs__ * KVROUND; const int R = R__; \
          _Pragma("unroll 1") for (int j = 1; j >= 0; --j) { const int kt = 2 * R + j; __VA_ARGS__ } } \
        if (Rn__ < 0) break; \
        stage_write(sr__, (kvbase_) + (bs__ ^ 1) * KVROUND, tid_); __syncthreads(); bs__ ^= 1; R__ = Rn__; } \
    __syncthreads(); } while (0)

__device__ __forceinline__ void bunit_D(const bf16_t* P, const bf16_t* VT, bf16_t* MIX, const LAS float* tabD1  , LAS unsigned char* kvbase, int b, int head, int qb, int tid, int wib) {
    int lane = tid & 63; asm volatile("" : "+v"(lane));
    const int c = lane & 31, h = lane >> 5, qt = 8 * qb + wib, tc = qt * 32 + c;
    const size_t rowq = (size_t)b * S + tc;
    abf16x8 qf[4];
#pragma unroll
    for (int s = 0; s < 4; ++s) qf[s] = *(const abf16x8*)(P + rowq * LDP + C_DQ + head * 64 + 16 * s + 8 * h);
    const bf16_t* kg = P + (size_t)b * S * LDP + C_DK + head * 64;
    const bf16_t* vg = VT + (size_t)(VR_DV + head * 64) * M + (size_t)b * S;
    const LAS float* tabp = tabD1 + (2047 - tc + 8 * h);
    Soft st; soft_init(st);
    const unsigned rm = 0xffffffffu >> (31 - (4 * qb + 3));
    ROUND_LOOP(rm, kg, (size_t)LDP, vg, kvbase, tid, lane,
        if (kt <= qt) { KVF f; frag_read(f, kvb__, j, lane); const int D0 = tc - 32 * kt - 8 * h;
            if (kt == qt) tile_step<true, false, false>(st, f, qf, tabp, 32 * kt, D0, 0, true);
            else tile_step<false, false, false>(st, f, qf, tabp, 32 * kt, D0, 0, true); }
    );
    const float l = st.l + __shfl_xor(st.l, 32);
    store_rows(st.o, 1.f / l, P + rowq * LDP + C_DGATE + head * 64, MIX + rowq * DM + 1536 + head * 64, h);
}

__device__ __forceinline__ void bunit_B(const bf16_t* P, const bf16_t* VT, bf16_t* MIX, const LAS float* tabB, const float* sinks, LAS unsigned char* kvbase, int b, int g, int q64, int tid, int wib) {
    int lane = tid & 63; asm volatile("" : "+v"(lane));
    const int c = lane & 31, h = lane >> 5, hh = c >> 3, qi = c & 7, t0 = 64 * q64 + 8 * wib, tc = t0 + qi, head = g * 4 + hh;
    const size_t rowq = (size_t)b * S + tc;
    abf16x8 qf[4];
#pragma unroll
    for (int s = 0; s < 4; ++s) qf[s] = *(const abf16x8*)(P + rowq * LDP + C_BQ + head * 64 + 16 * s + 8 * h);
    const bf16_t* kg = P + (size_t)b * S * LDP + C_BK + g * 64;
    const bf16_t* vg = VT + (size_t)(VR_BV + g * 64) * M + (size_t)b * S;
    const LAS float* tabp = tabB + head * 256 + (255 - tc + 8 * h);
    Soft st; soft_init(st);
    const int ktd = t0 >> 5, ktlo = (t0 - 127 > 0 ? t0 - 127 : 0) >> 5;
    const int Rlo = (64 * q64 - 127 > 0 ? 64 * q64 - 127 : 0) >> 6;
    const unsigned rm = (0xffffffffu >> (31 - q64)) & (0xffffffffu << Rlo);
    ROUND_LOOP(rm, kg, (size_t)LDP, vg, kvbase, tid, lane,
        if (kt <= ktd && kt >= ktlo) { KVF f; frag_read(f, kvb__, j, lane); const int D0 = tc - 32 * kt - 8 * h;
            if (kt == ktd) tile_step<true, false, false>(st, f, qf, tabp, 32 * kt, D0, 0, true);
            else tile_step<false, true, false>(st, f, qf, tabp, 32 * kt, D0, 127, true); }
    );
    const float l = st.l + __shfl_xor(st.l, 32) + __builtin_amdgcn_exp2f(sinks[head] * LOG2E - st.m);
    store_rows(st.o, 1.f / l, P + rowq * LDP + C_BGATE + head * 64, MIX + rowq * DM + 512 + head * 64, h);
}

__device__ __forceinline__ void bunit_A(const bf16_t* P, const bf16_t* VT, const bf16_t* KCMP, const bf16_t* VCMPT, const float* GT, bf16_t* MIX, const LAS float* tabA4, LAS float* osc  ,
                                        volatile LAS unsigned* um  , LAS unsigned char* kvbase, int b, int g, int q64, int tid, int wib) {
    int lane = tid & 63; asm volatile("" : "+v"(lane));
    const int c = lane & 31, h = lane >> 5, hh = c >> 3, qi = c & 7, t0 = 64 * q64 + 8 * wib, tc = t0 + qi, head = g * 4 + hh;
    const size_t rowq = (size_t)b * S + tc;
    abf16x8 qf[4];
#pragma unroll
    for (int s = 0; s < 4; ++s) qf[s] = *(const abf16x8*)(P + rowq * LDP + C_AQ + head * 64 + 16 * s + 8 * h);
    const LAS float* tabh = tabA4 + hh * 2048;
    unsigned selmask = 0u;
    {
        const int ncv = tc >= 31 ? ((tc - 31) >> 4) + 1 : 0;
        const bf16_t* kp = KCMP + ((size_t)(b * 2 + g) * 128 + pi32(c)) * 64 + 8 * h;
        const bf16_t* vp = VCMPT + ((size_t)(b * 2 + g) * 64 + c) * 128 + 8 * h;
        const LAS float* tabp = tabh + (2047 - tc + 31 + 128 * h);
        float sc[4][16]; float mx = -INFINITY;
#pragma unroll
        for (int kt = 0; kt < 4; ++kt) {
            f32x16 acc;
#pragma unroll
            for (int r = 0; r < 16; ++r) acc[r] = 0.f;
#pragma unroll
            for (int s = 0; s < 4; ++s) acc = __builtin_amdgcn_mfma_f32_32x32x16_bf16(*(const abf16x8*)(kp + (size_t)(32 * kt) * 64 + 16 * s), qf[s], acc, 0, 0, 0);
#pragma unroll
            for (int r = 0; r < 16; ++r) {
                const int ko = (r & 7) + 16 * (r >> 3);
                const bool ok = 32 * kt + 8 * h + ko < ncv;
                const float tb = tabp[512 * kt + 16 * ko];
                const float x = ok ? fmaf(acc[r], SCL, tb) : -INFINITY;
                sc[kt][r] = x; mx = fmaxf(mx, x);
            }
            asm volatile("" ::: "memory");
        }
        mx = fmaxf(mx, __shfl_xor(mx, 32)); mx = fmaxf(mx, -1e30f);
        float sum = 0.f;
#pragma unroll
        for (int kt = 0; kt < 4; ++kt)
#pragma unroll
            for (int r = 0; r < 16; ++r) { sc[kt][r] = __builtin_amdgcn_exp2f(sc[kt][r] - mx); sum += sc[kt][r]; }
        sum += __shfl_xor(sum, 32);
        const float inv = 1.f / fmaxf(sum, 1e-30f);
        f32x16 oc[2];
#pragma unroll
        for (int r = 0; r < 16; ++r) { oc[0][r] = 0.f; oc[1][r] = 0.f; }
#pragma unroll
        for (int kt = 0; kt < 4; ++kt) {
#pragma unroll
            for (int r = 0; r < 16; ++r) sc[kt][r] *= inv;
            abf16x8 pf[2];
#pragma unroll
            for (int s2 = 0; s2 < 2; ++s2) {
                u32x4_t_ w; w.x = cvtpk(sc[kt][8 * s2 + 0], sc[kt][8 * s2 + 1]); w.y = cvtpk(sc[kt][8 * s2 + 2], sc[kt][8 * s2 + 3]); w.z = cvtpk(sc[kt][8 * s2 + 4], sc[kt][8 * s2 + 5]); w.w = cvtpk(sc[kt][8 * s2 + 6], sc[kt][8 * s2 + 7]);
                pf[s2] = __builtin_bit_cast(abf16x8, w);
            }
#pragma unroll
            for (int dh = 0; dh < 2; ++dh)
#pragma unroll
                for (int s2 = 0; s2 < 2; ++s2) oc[dh] = __builtin_amdgcn_mfma_f32_32x32x16_bf16(*(const abf16x8*)(vp + (size_t)dh * 32 * 128 + 32 * kt + 16 * s2), pf[s2], oc[dh], 0, 0, 0);
            asm volatile("" ::: "memory");
        }
        float x7[4], x15[4];
#pragma unroll
        for (int kt = 0; kt < 4; ++kt) { x7[kt] = __shfl_xor(sc[kt][7], 32); x15[kt] = __shfl_xor(sc[kt][15], 32); }
        unsigned key[16];
        const int cur = q64;
#pragma unroll
        for (int kt = 0; kt < 4; ++kt)
#pragma unroll
            for (int gb = 0; gb < 2; ++gb) {
                const float pl0 = gb == 0 ? (kt > 0 ? x15[kt > 0 ? kt - 1 : 0] : 0.f) : x7[kt];
                const float pl1 = gb == 0 ? x7[kt] : x15[kt];
                const float prevlast = h ? pl1 : pl0;
                float ie = prevlast + sc[kt][8 * gb + 0] + sc[kt][8 * gb + 1] + sc[kt][8 * gb + 2] + sc[kt][8 * gb + 3];
                float io = sc[kt][8 * gb + 3] + sc[kt][8 * gb + 4] + sc[kt][8 * gb + 5] + sc[kt][8 * gb + 6] + sc[kt][8 * gb + 7];
                ie += __shfl_xor(ie, 8); ie += __shfl_xor(ie, 16);
                io += __shfl_xor(io, 8); io += __shfl_xor(io, 16);
#pragma unroll
                for (int eo = 0; eo < 2; ++eo) {
                    const int n = 8 * kt + 2 * h + 4 * gb + eo;
                    const bool forced = n == 0 || n == cur || n == cur - 1;
                    const float v = forced ? 1e4f : (eo ? io : ie);
                    key[(kt * 2 + gb) * 2 + eo] = n > cur ? (unsigned)(31 - n) : ((((__float_as_uint(v) >> 5) + 1u) << 5) | (unsigned)(31 - n));
                }
            }
#pragma unroll 1
        for (int round = 0; round < 8; ++round) {
            unsigned lm = key[0];
#pragma unroll
            for (int i = 1; i < 16; ++i) lm = lm > key[i] ? lm : key[i];
            const unsigned pm = (unsigned)__shfl_xor((int)lm, 32);
            const unsigned best = lm > pm ? lm : pm;
            selmask |= 1u << (31 - (best & 31u));
#pragma unroll
            for (int i = 0; i < 16; ++i) key[i] = key[i] == best ? 0u : key[i];
        }
        const float g0 = sigmoidf(GT[rowq * 24 + 0 * 8 + head]);
#pragma unroll
        for (int r = 0; r < 16; ++r) { osc[r * 64 + lane] = oc[0][r] * g0; osc[(16 + r) * 64 + lane] = oc[1][r] * g0; }
    }
    const int ktd = t0 >> 5;
    unsigned umask = selmask;
#pragma unroll
    for (int o = 1; o < 64; o <<= 1) umask |= (unsigned)__shfl_xor((int)umask, o);
    umask = __builtin_amdgcn_readfirstlane(umask) & (0xffffffffu >> (31 - q64));
    if (lane == 0) um[wib] = umask;
    __syncthreads();
    unsigned bmask = 0u;
#pragma unroll
    for (int w = 0; w < 8; ++w) bmask |= um[w];
    bmask = __builtin_amdgcn_readfirstlane(bmask);
    {
        int h2 = lane >> 5; asm volatile("" : "+v"(h2));
        const LAS float* tabp = tabh + (2047 - tc + 8 * h2);
        const bf16_t* kg = P + (size_t)b * S * LDP + C_AKS + g * 64;
        const bf16_t* vg = VT + (size_t)(VR_AVS + g * 64) * M + (size_t)b * S;
        Soft st; soft_init(st);
        ROUND_LOOP(bmask, kg, (size_t)LDP, vg, kvbase, tid, lane,
            if (((umask >> R) & 1u) && kt <= ktd) { KVF f; frag_read(f, kvb__, j, lane); const int D0 = tc - 32 * kt - 8 * h2;
                const bool rowsel = (selmask >> R) & 1u;
                if (kt == ktd) tile_step<true, false, true>(st, f, qf, tabp, 32 * kt, D0, 0, rowsel);
                else tile_step<false, false, true>(st, f, qf, tabp, 32 * kt, D0, 0, rowsel); }
        );
        const float l = st.l + __shfl_xor(st.l, 32);
        const float g1 = sigmoidf(GT[rowq * 24 + 1 * 8 + head]) / l;
#pragma unroll
        for (int r = 0; r < 16; ++r) { osc[r * 64 + lane] += st.o[0][r] * g1; osc[(16 + r) * 64 + lane] += st.o[1][r] * g1; }
    }
    {
        int h2 = lane >> 5; asm volatile("" : "+v"(h2));
        const LAS float* tabp = tabh + (2047 - tc + 8 * h2);
        const bf16_t* kg = P + (size_t)b * S * LDP + C_AKW + g * 64;
        const bf16_t* vg = VT + (size_t)(VR_AVW + g * 64) * M + (size_t)b * S;
        Soft st; soft_init(st);
        const int ktlo = (t0 - 511 > 0 ? t0 - 511 : 0) >> 5;
        const int Rlo = (64 * q64 - 511 > 0 ? 64 * q64 - 511 : 0) >> 6;
        const unsigned rm = (0xffffffffu >> (31 - q64)) & (0xffffffffu << Rlo);
        ROUND_LOOP(rm, kg, (size_t)LDP, vg, kvbase, tid, lane,
            if (kt <= ktd && kt >= ktlo) { KVF f; frag_read(f, kvb__, j, lane); const int D0 = tc - 32 * kt - 8 * h2;
                if (kt == ktd) tile_step<true, false, false>(st, f, qf, tabp, 32 * kt, D0, 0, true);
                else if (32 * kt < t0 + 7 - 511) tile_step<false, true, false>(st, f, qf, tabp, 32 * kt, D0, 511, true);
                else tile_step<false, false, false>(st, f, qf, tabp, 32 * kt, D0, 0, true); }
        );
        const float l = st.l + __shfl_xor(st.l, 32);
        const float g2 = sigmoidf(GT[rowq * 24 + 2 * 8 + head]) / l;
#pragma unroll
        for (int r = 0; r < 16; ++r) { st.o[0][r] = osc[r * 64 + lane] + st.o[0][r] * g2; st.o[1][r] = osc[(16 + r) * 64 + lane] + st.o[1][r] * g2; }
        int c3 = lane & 31; asm volatile("" : "+v"(c3));
        const size_t rowq3 = (size_t)b * S + t0 + (c3 & 7); const int head3 = g * 4 + (c3 >> 3);
        store_rows(st.o, 1.f, P + rowq3 * LDP + C_AGATE + head3 * 64, MIX + rowq3 * DM + head3 * 64, h2);
    }
}

typedef __attribute__((address_space(1))) unsigned gu32;
constexpr size_t WS_CTL = 0; constexpr size_t CTL_ZERO_BYTES = 64 * 1024; constexpr int CW_BAR = 1024;
constexpr int MISC_OFF = LDS_BYTES - 128;
#define XB_TMO      128
#define XB_XCNT(j)  (256  + 64 * (j))
#define XB_XSUB(j)  (1280 + 64 * (j))
#define XB_XGEN(j)  (2304 + 64 * (j))
#define XB_TOP      3328
#define XB_TOPGEN   3392
#define XCD_BAR_WORDS 3456
#define XB_SPIN_CAP (1u << 18)

__device__ __forceinline__ unsigned xb_ld(unsigned* p)              { return __hip_atomic_load(p, __ATOMIC_RELAXED, __HIP_MEMORY_SCOPE_AGENT); }
__device__ __forceinline__ unsigned xb_add(unsigned* p, unsigned v) { return __hip_atomic_fetch_add(p, v, __ATOMIC_RELAXED, __HIP_MEMORY_SCOPE_AGENT); }
__device__ __forceinline__ unsigned xb_xcc_id() { return (unsigned)__builtin_amdgcn_s_getreg((3 << 11) | 20) & 0xFu; }
#define XB_SPIN(cond, bar) do { unsigned _sp = 0; while (cond) { __builtin_amdgcn_s_sleep(1); \
    if ((++_sp & 255u) == 0u) { if (xb_ld(&(bar)[XB_TMO])) break; if (_sp > XB_SPIN_CAP) { atomicAdd(&(bar)[XB_TMO], 1u); break; } } } } while (0)

struct XcdBarrier {
    unsigned* bar; unsigned x;
    volatile LAS unsigned* st;
};

__device__ __forceinline__ XcdBarrier xcd_barrier_post(unsigned* bar, volatile LAS unsigned* st) {
    XcdBarrier b; b.bar = bar; b.x = xb_xcc_id(); b.st = st;
    if (threadIdx.x == 0) (void)xb_add(&bar[XB_XCNT(b.x)], 1u);
    return b;
}
__device__ __forceinline__ void xcd_barrier_complete(unsigned* bar, unsigned x, unsigned& nloc, unsigned& nx) {
    const unsigned G = gridDim.x * gridDim.y * gridDim.z;
    unsigned sum, cnt, mine, sp = 0u;
    for (;;) {
        sum = 0u; cnt = 0u; mine = 0u;
#pragma unroll
        for (unsigned j = 0; j < 16; ++j) { const unsigned c = xb_ld(&bar[XB_XCNT(j)]); sum += c; cnt += (c > 0u) ? 1u : 0u; mine = (j == x) ? c : mine; }
        if (sum == G) break;
        __builtin_amdgcn_s_sleep(1);
        if ((++sp & 255u) == 0u) { if (xb_ld(&bar[XB_TMO])) break; if (sp > XB_SPIN_CAP) { atomicAdd(&bar[XB_TMO], 1u); break; } }
    }
    nloc = mine > 0u ? mine : 1u; nx = cnt > 0u ? cnt : 1u;
}

__device__ __forceinline__ void xcd_barrier(const XcdBarrier& b) {
    asm volatile("s_waitcnt vmcnt(0)" ::: "memory");
    __syncthreads();
    if (threadIdx.x == 0) {
        unsigned* bar = b.bar;
        __builtin_amdgcn_s_waitcnt(0);
        unsigned nloc = b.st[0], nx = b.st[1];
        if (nloc == 0u) { xcd_barrier_complete(bar, b.x, nloc, nx); b.st[0] = nloc; b.st[1] = nx; }
        const unsigned old = xb_add(&bar[XB_XSUB(b.x)], 1u);
        const unsigned gen = old / nloc;
        if (old + 1u == (gen + 1u) * nloc) {
            __builtin_amdgcn_fence(__ATOMIC_RELEASE, "agent");
            asm volatile("s_waitcnt vmcnt(0)" ::: "memory");
            const unsigned og = xb_add(&bar[XB_TOP], 1u);
            const unsigned tg = og / nx;
            if (og + 1u == (tg + 1u) * nx) xb_add(&bar[XB_TOPGEN], 1u);
            else XB_SPIN(xb_ld(&bar[XB_TOPGEN]) == tg, bar);
            __builtin_amdgcn_fence(__ATOMIC_ACQUIRE, "agent");
            xb_add(&bar[XB_XGEN(b.x)], 1u);
            asm volatile("s_waitcnt vmcnt(0)" ::: "memory");
        } else {
            XB_SPIN(xb_ld(&bar[XB_XGEN(b.x)]) == gen, bar);
            __builtin_amdgcn_fence(__ATOMIC_ACQUIRE, "agent");
            asm volatile("s_waitcnt vmcnt(0)" ::: "memory");
        }
    }
    __syncthreads();
}


#define LAUNDER_S(x)
#define PH_COMMON \
    int tid_ = threadIdx.x; asm volatile("" : "+v"(tid_)); const int tid = tid_, lane = tid & 63, wib = __builtin_amdgcn_readfirstlane(tid >> 6); \
    const int G = gridDim.x; const int vblk = (G & 7) == 0 ? (int)(blockIdx.x & 7) * (G >> 3) + (int)(blockIdx.x >> 3) : (int)blockIdx.x;     \
    const int gthreads = G * NT, gtid = vblk * NT + tid; const int gwaves = G * NWAVES, gwave = vblk * NWAVES + wib; \
    unsigned char* ws = prm.ws; asm volatile("" : "+s"(ws)); (void)lane; (void)gthreads; (void)gtid; (void)gwaves; (void)gwave; (void)ws;

__device__ __forceinline__ void phase_prologue(const Params& prm, LAS unsigned char* ldsb) {
    PH_COMMON
    float* biasd = (float*)(ws + WS_BIASD); bf16_t* WG = (bf16_t*)(ws + WS_WG);
    bf16_t* WINT = (bf16_t*)(ws + WS_WIN); bf16_t* WOUTT = (bf16_t*)(ws + WS_WOUT); bf16_t* XB = (bf16_t*)(ws + WS_XB);
    for (int i = gtid; i < 24 * 2048; i += gthreads) { const int h = i >> 11, d = i & 2047; biasd[i] = prm.rel_bias[t5_bucket(d) * 24 + h]; }
    {
        float* img = (float*)(ws + WS_IMG);
        for (int i = gtid; i < 8 * 2048; i += gthreads) { const int h = i >> 11, d = 2047 - (i & 2047);
            img[i] = prm.rel_bias[t5_bucket(d) * 24 + h] * LOG2E;
            const int mult = (d <= 128 ? 1 : 0) + (((d & 3) == 0 && d <= 512) ? 1 : 0) + ((d & 15) == 0 ? 1 : 0);
            img[8 * 2048 + i] = mult == 0 ? -INFINITY : prm.rel_bias[t5_bucket(d) * 24 + 16 + h] * LOG2E + (mult == 1 ? 0.f : (mult == 2 ? 1.f : 1.5849625007211562f)); }
        for (int i = gtid; i < 8 * 256; i += gthreads) { const int h = i >> 8, d = 255 - (i & 255); img[16 * 2048 + i] = prm.rel_bias[t5_bucket(d) * 24 + 8 + h] * LOG2E; }
    }
    for (int i = gtid; i < DEPTH * 32 * 2048; i += gthreads) { const int k = i & 2047, j = (i >> 11) & 31, l = i >> 16;
        WG[i] = j < 24 ? f2bf(prm.w_in[(size_t)l * DM * DIN + (size_t)k * DIN + SRC_GATES + j] * prm.norm_w[l * DM + k]) : (bf16_t)0; }
    {
        bf16_t* W1T = (bf16_t*)(ws + WS_W1T); bf16_t* W2T = (bf16_t*)(ws + WS_W2T); float* PB = (float*)(ws + WS_PB);
        for (int i = gtid; i < 4 * 2048 * 128; i += gthreads) { const int j = i & 127, k = (i >> 7) & 2047, lw = i >> 18;
            const int kk = (lw & 1) ? ((k & 63) * 32 + (k >> 6)) : k;
            W1T[((size_t)lw * 128 + j) * 2048 + kk] = f2bf(prm.cmp_w1[((size_t)lw * 2048 + k) * 128 + j]); }
        for (int i = gtid; i < 4 * 128 * 64; i += gthreads) { const int e = i & 63, j = (i >> 6) & 127, lw = i >> 13; W2T[((size_t)lw * 64 + e) * 128 + j] = f2bf(prm.cmp_w2[((size_t)lw * 128 + j) * 64 + e]); }
        for (int o = gwave; o < 4 * 128; o += gwaves) { const int j = o & 127, lw = o >> 7; float a = 0.f;
            for (int k = lane; k < 2048; k += 64) a += prm.cmp_pos[(size_t)lw * 2048 + k] * prm.cmp_w1[((size_t)lw * 2048 + k) * 128 + j];
            a = wave_sum(a); if (lane == 0) PB[o] = a; }
    }
    {
        LAS float* scr = (LAS float*)(ldsb + wib * 16384);
        constexpr int I_IN = 32 * (NW_IN / 32), I_OUT = 32 * (DM / 32);
        for (int it = gwave; it < DEPTH * (I_IN + I_OUT); it += gwaves) {
            const int l = it / (I_IN + I_OUT); int r = it % (I_IN + I_OUT);
            if (r < I_IN) { const int nb = r % (NW_IN / 32), kb = r / (NW_IN / 32);
                transpose_item(prm.w_in + (size_t)l * DM * DIN, DM, DIN, src_col_of(32 * nb) - 32 * nb, prm.norm_w + l * DM, WINT + (size_t)l * NW_IN * DM, scr, kb, nb, lane); }
            else { r -= I_IN; const int nb = r % (DM / 32), kb = r / (DM / 32);
                transpose_item(prm.w_out + (size_t)l * DM * DM, DM, DM, 0, nullptr, WOUTT + (size_t)l * DM * DM, scr, kb, nb, lane); }
        }
    }
    for (int row = gwave; row < M; row += gwaves) rms_row_to_bf16(prm.x + (size_t)row * DM, XB + (size_t)row * DM, lane);
}

__device__ __forceinline__ void phase_inproj(const Params& prm, int layer, LAS unsigned char* ldsb) {
    LAUNDER_S(layer);
    unsigned char* ws = prm.ws; asm volatile("" : "+s"(ws));
    const bf16_t* W = (const bf16_t*)(ws + WS_WIN) + (size_t)layer * NW_IN * DM;
    {
        pg8::Gemm g{(const bf16_t*)(ws + WS_XB), W, M, LDP, DM}; pg8::StaticOrder So; So.init(M, LDP, (int)gridDim.x, (int)blockIdx.x);
        pg8::EpiBf16 E{(bf16_t*)(ws + WS_P), LDP};
        pg8::gemm_phase<pg8::EpiBf16, pg8::StaticOrder, true, true>(ldsb, g, So, E);
    }
    {
        pg8::Gemm g{W + (size_t)LDP * DM, (const bf16_t*)(ws + WS_XB), NVT, M, DM}; pg8::StaticOrder So; So.init(NVT, M, (int)gridDim.x, (int)blockIdx.x);
        pg8::EpiBf16 E{(bf16_t*)(ws + WS_VT), M};
        pg8::gemm_phase<pg8::EpiBf16, pg8::StaticOrder, true, true>(ldsb, g, So, E);
    }
}
__device__ __forceinline__ void phase_outproj(const Params& prm, int layer, LAS unsigned char* ldsb) {
    LAUNDER_S(layer);
    unsigned char* ws = prm.ws; asm volatile("" : "+s"(ws));
    const float* xin = layer == 0 ? prm.x : prm.out;
    pg8::Gemm g{(const bf16_t*)(ws + WS_MIX), (const bf16_t*)(ws + WS_WOUT) + (size_t)layer * DM * DM, M, DM, DM}; pg8::StaticOrder So; So.init(M, DM, (int)gridDim.x, (int)blockIdx.x);
    pg8::EpiResid E{xin, prm.out, DM};
    pg8::gemm_phase<pg8::EpiResid, pg8::StaticOrder, true, true>(ldsb, g, So, E);
}
__device__ __forceinline__ void phase_gates(const Params& prm, int layer, LAS unsigned char* ldsb) {
    LAUNDER_S(layer);
    PH_COMMON
    const bf16_t* XB = (const bf16_t*)(ws + WS_XB); float* GT = (float*)(ws + WS_G);
    const bf16_t* wg = (const bf16_t*)(ws + WS_WG) + (size_t)layer * 32 * 2048;
    const int c = lane & 31, h = lane >> 5, kq = wib & 3, half = wib >> 2;
    LAS float* red = (LAS float*)ldsb + wib * 1024;
    for (int blk = blockIdx.x; blk < M / 64; blk += G) {
        const int row0 = blk * 64 + half * 32;
        const bf16_t* ap = XB + (size_t)(row0 + c) * DM + kq * 512 + 8 * h;
        const bf16_t* bp = wg + (size_t)c * DM + kq * 512 + 8 * h;
        f32x16 acc;
#pragma unroll
        for (int r = 0; r < 16; ++r) acc[r] = 0.f;
#pragma unroll 8
        for (int s = 0; s < 32; ++s) acc = __builtin_amdgcn_mfma_f32_32x32x16_bf16(*(const abf16x8*)(ap + 16 * s), *(const abf16x8*)(bp + 16 * s), acc, 0, 0, 0);
#pragma unroll
        for (int r = 0; r < 16; ++r) red[r * 64 + lane] = acc[r];
        __syncthreads();
        if (kq == 0 && c < 24) {
#pragma unroll
            for (int r = 0; r < 16; ++r) { const float v = (red[r * 64 + lane] + red[1024 + r * 64 + lane]) + (red[2048 + r * 64 + lane] + red[3072 + r * 64 + lane]);
                GT[(size_t)(row0 + (r & 3) + 8 * (r >> 2) + 4 * h) * 24 + c] = v; }
        }
        __syncthreads();
    }
}
__device__ __forceinline__ void phase_compress(const Params& prm, int layer, LAS unsigned char* ldsb) {
    LAUNDER_S(layer);
    PH_COMMON
    const bf16_t* P = (const bf16_t*)(ws + WS_P); const bf16_t* VT = (const bf16_t*)(ws + WS_VT);
    bf16_t* KCMP = (bf16_t*)(ws + WS_CMP); bf16_t* VCMPT = KCMP + (size_t)NB * 2 * 128 * 64;
    const int c = lane & 31, h = lane >> 5, jt = wib & 3, kh = wib >> 2;
    LAS float* red = (LAS float*)ldsb;
    LAS float* hid = (LAS float*)(ldsb + 32768);
    for (int u = blockIdx.x; u < 2 * NB * 2 * 4; u += G) {
        const int ct = u & 3, g = (u >> 2) & 1, b = (u >> 3) & 7, which = u >> 6;
        const int lw = layer * 2 + which;
        const bf16_t* w1 = (const bf16_t*)(ws + WS_W1T) + ((size_t)lw * 128 + jt * 32 + c) * 2048 + kh * 1024 + 8 * h;
        int cc = ct * 32 + c; if (cc > NCMP - 1) cc = NCMP - 1;
        f32x16 acc;
#pragma unroll
        for (int r = 0; r < 16; ++r) acc[r] = 0.f;
        if (which == 0) {
            const bf16_t* src = P + (size_t)(b * S + 16 * cc) * LDP + C_AKC + g * 64 + 8 * h;
#pragma unroll 8
            for (int s = 0; s < 64; ++s) { const int ks = kh * 64 + s;
                acc = __builtin_amdgcn_mfma_f32_32x32x16_bf16(*(const abf16x8*)(w1 + 16 * s), *(const abf16x8*)(src + (size_t)(ks >> 2) * LDP + (ks & 3) * 16), acc, 0, 0, 0); }
        } else {
            const bf16_t* src = VT + (size_t)(VR_AVC + g * 64) * M + (size_t)(b * S + 16 * cc) + 8 * h;
#pragma unroll 8
            for (int s = 0; s < 64; ++s) { const int ks = kh * 64 + s;
                acc = __builtin_amdgcn_mfma_f32_32x32x16_bf16(*(const abf16x8*)(w1 + 16 * s), *(const abf16x8*)(src + (size_t)(ks >> 1) * M + (ks & 1) * 16), acc, 0, 0, 0); }
        }
#pragma unroll
        for (int r = 0; r < 16; ++r) red[wib * 1024 + r * 64 + lane] = acc[r];
        __syncthreads();
        if (wib < 4) {
            const float* pb = (const float*)(ws + WS_PB) + lw * 128;
#pragma unroll
            for (int r = 0; r < 16; ++r) { const int j = jt * 32 + (r & 3) + 8 * (r >> 2) + 4 * h;
                hid[j * 32 + c] = silu(red[wib * 1024 + r * 64 + lane] + red[(wib + 4) * 1024 + r * 64 + lane] + pb[j]); }
        }
        __syncthreads();
        if (wib < 2) {
            const bf16_t* w2 = (const bf16_t*)(ws + WS_W2T) + ((size_t)lw * 64 + wib * 32 + c) * 128 + 8 * h;
            f32x16 o;
#pragma unroll
            for (int r = 0; r < 16; ++r) o[r] = 0.f;
#pragma unroll
            for (int s = 0; s < 8; ++s) {
                u32x4_t_ w; const LAS float* hp = hid + (16 * s + 8 * h) * 32 + c;
                w.x = cvtpk(hp[0], hp[32]); w.y = cvtpk(hp[64], hp[96]); w.z = cvtpk(hp[128], hp[160]); w.w = cvtpk(hp[192], hp[224]);
                o = __builtin_amdgcn_mfma_f32_32x32x16_bf16(*(const abf16x8*)(w2 + 16 * s), __builtin_bit_cast(abf16x8, w), o, 0, 0, 0);
            }
            const int cw = ct * 32 + c;
            if (which == 0) {
                bf16_t* dst = KCMP + ((size_t)(b * 2 + g) * 128 + cw) * 64 + wib * 32 + 4 * h;
#pragma unroll
                for (int rg = 0; rg < 4; ++rg) { uint2 w; w.x = cvtpk(o[4 * rg], o[4 * rg + 1]); w.y = cvtpk(o[4 * rg + 2], o[4 * rg + 3]); *(uint2*)(dst + 8 * rg) = w; }
            } else {
                bf16_t* dst = VCMPT + ((size_t)(b * 2 + g) * 64 + wib * 32 + 4 * h) * 128 + cw;
#pragma unroll
                for (int r = 0; r < 16; ++r) dst[(size_t)((r & 3) + 8 * (r >> 2)) * 128] = f2bf(o[r]);
            }
        }
        __syncthreads();
    }
}
typedef unsigned u32x4_t __attribute__((ext_vector_type(4)));
__device__ __forceinline__ void phase_mix_ab(const Params& prm, int layer, LAS unsigned char* ldsb) {
    LAUNDER_S(layer);
    PH_COMMON
    {
        const u32x4_t* src = (const u32x4_t*)(ws + WS_IMG); LAS u32x4_t* dst = (LAS u32x4_t*)ldsb;
        for (int i = tid; i < 65536 / 16; i += NT) dst[i] = src[i];
        for (int i = tid; i < 8192 / 16; i += NT) dst[65536 / 16 + i] = src[131072 / 16 + i];
        __syncthreads();
    }
    const float* GT = (const float*)(ws + WS_G); const bf16_t* KCMP = (const bf16_t*)(ws + WS_CMP); const bf16_t* VCMPT = KCMP + (size_t)NB * 2 * 128 * 64;
    const bf16_t* P = (const bf16_t*)(ws + WS_P); bf16_t* MIX = (bf16_t*)(ws + WS_MIX); const bf16_t* VT = (const bf16_t*)(ws + WS_VT);
    const LAS float* tabA = (const LAS float*)(ldsb + OFF_TA);
    LAS float* osc = (LAS float*)(ldsb + OFF_OSC + wib * 8192);
    for (int pr = gwave; pr < NB * 2 * 128; pr += gwaves) {
        const int bg = pr >> 7, qa = pr & 127;
#pragma unroll 1
        for (int k = 0; k < 2; ++k) unit_A(P, VT, KCMP, VCMPT, GT, MIX, tabA, osc, bg >> 1, bg & 1, k ? 255 - qa : qa, lane);
    }
}
__device__ __forceinline__ void phase_mix_b(const Params& prm, int layer, LAS unsigned char* ldsb) {
    LAUNDER_S(layer);
    PH_COMMON
    const bf16_t* P = (const bf16_t*)(ws + WS_P); bf16_t* MIX = (bf16_t*)(ws + WS_MIX); const bf16_t* VT = (const bf16_t*)(ws + WS_VT);
    const float* sinks = prm.sinks + layer * 8;
    const LAS float* tabB = (const LAS float*)(ldsb + OFF_TB);
#pragma unroll 1
    for (int u = gwave; u < NB * 2 * 256; u += gwaves) unit_B(P, VT, MIX, tabB, sinks, u >> 9, (u >> 8) & 1, u & 255, lane);
}
__device__ __forceinline__ void phase_mix_d(const Params& prm, LAS unsigned char* ldsb) {
    PH_COMMON
    {
        const u32x4_t* src = (const u32x4_t*)(ws + WS_IMG + 65536); LAS u32x4_t* dst = (LAS u32x4_t*)(ldsb + OFF_TD);
        for (int i = tid; i < 65536 / 16; i += NT) dst[i] = src[i];
        __syncthreads();
    }
    const bf16_t* P = (const bf16_t*)(ws + WS_P); bf16_t* MIX = (bf16_t*)(ws + WS_MIX); const bf16_t* VT = (const bf16_t*)(ws + WS_VT);
    const LAS float* tabD = (const LAS float*)(ldsb + OFF_TD);
    for (int pr = gwave; pr < NB * 8 * 32; pr += gwaves) {
        const int bh = pr >> 5, qa = pr & 31;
#pragma unroll 1
        for (int k = 0; k < 2; ++k) unit_D(P, VT, MIX, tabD, bh >> 3, bh & 7, k ? 63 - qa : qa, lane);
    }
}

constexpr int L1_TA = 0, L1_TB = 32768, L1_OSC = 40960, L1_UM = 106496, L1_KV = 106752;
__device__ __forceinline__ void phase_mix_ab2(const Params& prm, int layer, LAS unsigned char* ldsb) {
    LAUNDER_S(layer);
    PH_COMMON
    const float* GT = (const float*)(ws + WS_G); const bf16_t* KCMP = (const bf16_t*)(ws + WS_CMP); const bf16_t* VCMPT = KCMP + (size_t)NB * 2 * 128 * 64;
    const bf16_t* P = (const bf16_t*)(ws + WS_P); bf16_t* MIX = (bf16_t*)(ws + WS_MIX); const bf16_t* VT = (const bf16_t*)(ws + WS_VT);
    const float* sinks = prm.sinks + layer * 8;
    {
        const u32x4_t* src = (const u32x4_t*)(ws + WS_IMG + 131072); LAS u32x4_t* dst = (LAS u32x4_t*)(ldsb + L1_TB);
        for (int i = tid; i < 8192 / 16; i += NT) dst[i] = src[i];
    }
    for (int pair = vblk; pair < 256; pair += G) {
        const int bg = pair >> 4, qa = pair & 15;
        __syncthreads();
        {
            const u32x4_t* src = (const u32x4_t*)(ws + WS_IMG + (size_t)(bg & 1) * 32768); LAS u32x4_t* dst = (LAS u32x4_t*)(ldsb + L1_TA);
            for (int i = tid; i < 32768 / 16; i += NT) dst[i] = src[i];
        }
        __syncthreads();
#pragma unroll 1
        for (int k = 0; k < 2; ++k)
            bunit_A(P, VT, KCMP, VCMPT, GT, MIX, (const LAS float*)(ldsb + L1_TA), (LAS float*)(ldsb + L1_OSC + wib * 8192), (volatile LAS unsigned*)(ldsb + L1_UM), ldsb + L1_KV, bg >> 1, bg & 1, k ? 31 - qa : qa, tid, wib);
    }
#pragma unroll 1
    for (int u = vblk; u < 512; u += G) bunit_B(P, VT, MIX, (const LAS float*)(ldsb + L1_TB), sinks, ldsb + L1_KV, u >> 6, (u >> 5) & 1, u & 31, tid, wib);
}
__device__ __forceinline__ void phase_mix_d2(const Params& prm, LAS unsigned char* ldsb) {
    PH_COMMON
    const bf16_t* P = (const bf16_t*)(ws + WS_P); bf16_t* MIX = (bf16_t*)(ws + WS_MIX); const bf16_t* VT = (const bf16_t*)(ws + WS_VT);
    for (int pair = vblk; pair < 256; pair += G) {
        const int bh = pair >> 2, qa = pair & 3;
        __syncthreads();
        {
            const u32x4_t* src = (const u32x4_t*)(ws + WS_IMG + 65536 + (size_t)(bh & 7) * 8192); LAS u32x4_t* dst = (LAS u32x4_t*)ldsb;
            for (int i = tid; i < 8192 / 16; i += NT) dst[i] = src[i];
        }
        __syncthreads();
#pragma unroll 1
        for (int k = 0; k < 2; ++k) bunit_D(P, VT, MIX, (const LAS float*)ldsb, ldsb + 8192, bh >> 3, bh & 7, k ? 7 - qa : qa, tid, wib);
    }
}
__device__ __forceinline__ void unpack8(const uint4 w, float (&f)[8]) {
    f[0] = __uint_as_float(w.x << 16); f[1] = __uint_as_float(w.x & 0xffff0000u); f[2] = __uint_as_float(w.y << 16); f[3] = __uint_as_float(w.y & 0xffff0000u);
    f[4] = __uint_as_float(w.z << 16); f[5] = __uint_as_float(w.z & 0xffff0000u); f[6] = __uint_as_float(w.w << 16); f[7] = __uint_as_float(w.w & 0xffff0000u);
}
__device__ __forceinline__ void phase_conv(const Params& prm, int layer) {
    LAUNDER_S(layer);
    PH_COMMON
    const bf16_t* P = (const bf16_t*)(ws + WS_P); bf16_t* MIX = (bf16_t*)(ws + WS_MIX);
    const float* convw = prm.conv_w + layer * 3 * 512;
    for (int i = gtid; i < M * 64; i += gthreads) {
        const int c0 = (i & 63) * 8, row = i >> 6, t = row & (S - 1);
        const bf16_t* pr = P + (size_t)row * LDP;
        float cb[8], cg[8], a[8], bb[8], y[8];
        unpack8(*(const uint4*)(pr + C_CB + c0), cb); unpack8(*(const uint4*)(pr + C_CGATE + c0), cg);
        unpack8(*(const uint4*)(pr + C_CC + c0), a); unpack8(*(const uint4*)(pr + C_CH + c0), bb);
#pragma unroll
        for (int j = 0; j < 8; ++j) y[j] = convw[2 * 512 + c0 + j] * a[j] * bb[j];
        if (t >= 1) { unpack8(*(const uint4*)(pr + C_CC + c0 - LDP), a); unpack8(*(const uint4*)(pr + C_CH + c0 - LDP), bb);
#pragma unroll
            for (int j = 0; j < 8; ++j) y[j] += convw[1 * 512 + c0 + j] * a[j] * bb[j]; }
        if (t >= 2) { unpack8(*(const uint4*)(pr + C_CC + c0 - 2 * LDP), a); unpack8(*(const uint4*)(pr + C_CH + c0 - 2 * LDP), bb);
#pragma unroll
            for (int j = 0; j < 8; ++j) y[j] += convw[0 * 512 + c0 + j] * a[j] * bb[j]; }
        uint4 w;
        w.x = cvtpk(cb[0] * y[0] * silu(cg[0]), cb[1] * y[1] * silu(cg[1])); w.y = cvtpk(cb[2] * y[2] * silu(cg[2]), cb[3] * y[3] * silu(cg[3]));
        w.z = cvtpk(cb[4] * y[4] * silu(cg[4]), cb[5] * y[5] * silu(cg[5])); w.w = cvtpk(cb[6] * y[6] * silu(cg[6]), cb[7] * y[7] * silu(cg[7]));
        *(uint4*)(MIX + (size_t)row * DM + 1024 + c0) = w;
    }
}
__device__ __forceinline__ void phase_xb(const Params& prm) {
    PH_COMMON
    bf16_t* XB = (bf16_t*)(ws + WS_XB);
    for (int row = gwave; row < M; row += gwaves) rms_row_to_bf16(prm.out + (size_t)row * DM, XB + (size_t)row * DM, lane);
}
__device__ __forceinline__ void phase_final(const Params& prm) {
    PH_COMMON
    for (int row = gwave; row < M; row += gwaves) {
        float4* xr = (float4*)(prm.out + (size_t)row * DM);
        float4 v[8]; float s = 0.f;
#pragma unroll
        for (int j = 0; j < 8; ++j) { v[j] = xr[lane + 64 * j]; s += v[j].x * v[j].x + v[j].y * v[j].y + v[j].z * v[j].z + v[j].w * v[j].w; }
        s = wave_sum(s);
        const float r = rsqrtf(s * (1.f / DM) + 1e-6f);
#pragma unroll
        for (int j = 0; j < 8; ++j) { const float4 w = ((const float4*)prm.final_norm_w)[lane + 64 * j];
            xr[lane + 64 * j] = make_float4(v[j].x * r * w.x, v[j].y * r * w.y, v[j].z * r * w.z, v[j].w * r * w.w); }
    }
}

#ifndef REP_PRO
#define REP_PRO 1
#endif
#ifndef REP_INP
#define REP_INP 1
#endif
#ifndef REP_GAT
#define REP_GAT 1
#endif
#ifndef REP_CMP
#define REP_CMP 1
#endif
#ifndef REP_MAB
#define REP_MAB 1
#endif
#ifndef REP_MB
#define REP_MB 1
#endif
#ifndef REP_MD
#define REP_MD 1
#endif
#ifndef REP_CNV
#define REP_CNV 1
#endif
#ifndef REP_SYNC
#define REP_SYNC 1
#endif
#define REPEAT(n) _Pragma("unroll 1") for (int rep_ = 0; rep_ < (n); ++rep_)
__global__ void __launch_bounds__(NT, 2) fwd_kernel(Params prm) {
    extern __shared__ __attribute__((aligned(16))) unsigned char lds_raw[];
    LAS unsigned char* ldsb = (LAS unsigned char*)lds_raw;
    volatile LAS unsigned* MISC = (volatile LAS unsigned*)(ldsb + MISC_OFF);
    if (threadIdx.x < 32) MISC[threadIdx.x] = 0u;
    __syncthreads();
    const XcdBarrier bar = xcd_barrier_post((unsigned*)(prm.ws + WS_CTL) + CW_BAR, MISC + 8);
#define GRID_SYNC() xcd_barrier(bar)
    REPEAT(REP_PRO) { phase_prologue(prm, ldsb); __syncthreads(); }
    REPEAT(REP_SYNC) GRID_SYNC();
#pragma unroll
    for (int layer = 0; layer < DEPTH; ++layer) {
        REPEAT(REP_INP) phase_inproj(prm, layer, ldsb);
        REPEAT(REP_GAT) phase_gates(prm, layer, ldsb);
        GRID_SYNC();
        REPEAT(REP_CMP) phase_compress(prm, layer, ldsb);
        GRID_SYNC();
        REPEAT(REP_MAB) { phase_mix_ab2(prm, layer, ldsb); __syncthreads(); }
        REPEAT(REP_MD) { phase_mix_d2(prm, ldsb); __syncthreads(); }
        REPEAT(REP_CNV) phase_conv(prm, layer);
        GRID_SYNC();
        phase_outproj(prm, layer, ldsb);
        GRID_SYNC();
        if (layer + 1 < DEPTH) { phase_xb(prm); GRID_SYNC(); }
    }
    phase_final(prm);
}

extern "C" void kernel_launch(void* const* d_in, const int* in_sizes, int n_in, void* d_out, int out_size, void* d_ws, size_t ws_size, hipStream_t stream) {
    static int grid_blocks = 0;
    if (!grid_blocks) {
        int dev = 0, cus = 0, per_cu = 0;
        (void)hipGetDevice(&dev);
        (void)hipDeviceGetAttribute(&cus, hipDeviceAttributeMultiprocessorCount, dev);
        if (hipFuncSetAttribute((const void*)fwd_kernel, hipFuncAttributeMaxDynamicSharedMemorySize, LDS_BYTES) != hipSuccess) fprintf(stderr, "kernel_launch: hipFuncSetAttribute failed\n");
        (void)hipOccupancyMaxActiveBlocksPerMultiprocessor(&per_cu, fwd_kernel, NT, LDS_BYTES);
        if (per_cu < 1) fprintf(stderr, "kernel_launch: occupancy query says %d blocks per CU\n", per_cu);
        grid_blocks = cus;
        if (ws_size < WS_END) fprintf(stderr, "kernel_launch: workspace too small: %zu < %zu\n", ws_size, (size_t)WS_END);
    }
    Params p{};
    p.x = (const float*)d_in[0]; p.norm_w = (const float*)d_in[1]; p.w_in = (const float*)d_in[2]; p.w_out = (const float*)d_in[3];
    p.conv_w = (const float*)d_in[4]; p.sinks = (const float*)d_in[5]; p.cmp_pos = (const float*)d_in[6]; p.cmp_w1 = (const float*)d_in[7];
    p.cmp_w2 = (const float*)d_in[8]; p.rel_bias = (const float*)d_in[9]; p.final_norm_w = (const float*)d_in[10];
    p.out = (float*)d_out; p.ws = (unsigned char*)d_ws;
    if (hipMemsetAsync((char*)d_ws + WS_CTL, 0, CTL_ZERO_BYTES, stream) != hipSuccess) { fprintf(stderr, "kernel_launch: memset of the control words failed\n"); return; }
    hipLaunchKernelGGL(fwd_kernel, dim3(grid_blocks), dim3(NT), LDS_BYTES, stream, p);
    hipError_t e = hipPeekAtLastError();
    if (e != hipSuccess) fprintf(stderr, "launch failed: %s (grid %d)\n", hipGetErrorString(e), grid_blocks);
}
```

```cpp
#define F_TB 1
#define F_RSEL 1
#define F_LAZY 1
#include <hip/hip_runtime.h>
#include <cstdio>
#include <cstdint>

namespace pg8 {
#define PG8_LAS __attribute__((address_space(3)))
typedef unsigned short bf16_t;
typedef short bf16x8 __attribute__((ext_vector_type(8)));
typedef float f32x4 __attribute__((ext_vector_type(4)));
typedef unsigned u32x4 __attribute__((ext_vector_type(4)));
constexpr int BM = 256, BK = 64, HALF = 128, HTB = HALF * BK * 2  , STAGE_BYTES = 8 * HTB, NXCD = 8, WGM = 2;

__host__ __device__ __forceinline__ int lds_byte(int r, int c) { const int st = (r >> 4) * 2 + (c >> 5), rr = r & 15, cc = c & 31, ob = rr * 64 + cc * 2; return st * 1024 + (ob ^ (((ob >> 9) & 1) << 5)); }
__host__ __device__ __forceinline__ void stage_rc(int b, int& R, int& C) { const int st = b / 1024, sb = b % 1024, swz = sb ^ (((sb >> 9) & 1) << 5); R = (st >> 1) * 16 + swz / 64; C = (st & 1) * 32 + (swz % 64) / 2; }
__host__ __device__ __forceinline__ int perm32(int rho) { const int n = rho >> 4, i = rho & 15; return 8 * (i >> 2) + 4 * n + (i & 3); }

struct Unit { int pm, pn; };
struct Gemm { const bf16_t* A; const bf16_t* Bt; int M, N, K; };

struct StaticOrder {
    int nM, nN, nwg, G, c;
    __host__ __device__ void init(int M, int N, int G_, int c_) { nM = M / BM; nN = N / BM; nwg = nM * nN; G = G_; c = c_; }
    __host__ __device__ bool next(int i, Unit& u) const {
        const long L = (long)i * G + c; if (L >= nwg) return false;
        int wgid = (int)L; { const int q = nwg / NXCD, r = nwg % NXCD, xcd = wgid % NXCD, off = wgid / NXCD; wgid = (xcd < r ? xcd * (q + 1) : r * (q + 1) + (xcd - r) * q) + off; }
        const int nig = WGM * nN, gid = wgid / nig, fm = gid * WGM, gsz = (nM - fm) < WGM ? (nM - fm) : WGM;
        u.pm = fm + ((wgid % nig) % gsz); u.pn = (wgid % nig) / gsz; return true;
    }
    __device__ __forceinline__ void a_ready(const Unit&) const {}
    __device__ __forceinline__ void done(const Unit&) const {}
};


__device__ __forceinline__ unsigned cvt_pk_bf16(float lo, float hi) { unsigned r; asm volatile("v_cvt_pk_bf16_f32 %0, %1, %2" : "=v"(r) : "v"(lo), "v"(hi)); return r; }
struct EpiBf16 {
    static constexpr bool PERM = true, AFTER_DRAIN = false;
    bf16_t* O; int ldc;
    __device__ __forceinline__ void operator()(const f32x4 (&acc)[2][2][4][2], const Unit& u, int wr, int wc, int fr, int fq) const {
        const int row0 = u.pm * BM + wr * 64 + fr; const int col0 = u.pn * BM + wc * 32 + 8 * fq;
#pragma unroll
        for (int ai = 0; ai < 2; ++ai)
#pragma unroll
            for (int m = 0; m < 4; ++m) { bf16_t* rowp = O + (size_t)(row0 + ai * HALF + m * 16) * ldc + col0;
#pragma unroll
                for (int bj = 0; bj < 2; ++bj) { const f32x4 v0 = acc[ai][bj][m][0], v1 = acc[ai][bj][m][1];
                    u32x4 w; w.x = cvt_pk_bf16(v0[0], v0[1]); w.y = cvt_pk_bf16(v0[2], v0[3]); w.z = cvt_pk_bf16(v1[0], v1[1]); w.w = cvt_pk_bf16(v1[2], v1[3]);
                    *(u32x4*)(rowp + bj * HALF) = w; } }
    }
};
struct EpiBf16RowScale {
    static constexpr bool PERM = true, AFTER_DRAIN = false;
    bf16_t* O; int ldc; const float* rss;
    __device__ __forceinline__ void operator()(const f32x4 (&acc)[2][2][4][2], const Unit& u, int wr, int wc, int fr, int fq) const {
        const int row0 = u.pm * BM + wr * 64 + fr; const int col0 = u.pn * BM + wc * 32 + 8 * fq;
#pragma unroll
        for (int ai = 0; ai < 2; ++ai)
#pragma unroll
            for (int m = 0; m < 4; ++m) { const int row = row0 + ai * HALF + m * 16; bf16_t* rowp = O + (size_t)row * ldc + col0;
                const float sc = rsqrtf(rss[row] * (1.f / 2048.f) + 1e-6f);
#pragma unroll
                for (int bj = 0; bj < 2; ++bj) { const f32x4 v0 = acc[ai][bj][m][0] * sc, v1 = acc[ai][bj][m][1] * sc;
                    u32x4 w; w.x = cvt_pk_bf16(v0[0], v0[1]); w.y = cvt_pk_bf16(v0[2], v0[3]); w.z = cvt_pk_bf16(v1[0], v1[1]); w.w = cvt_pk_bf16(v1[2], v1[3]);
                    *(u32x4*)(rowp + bj * HALF) = w; } }
    }
};
struct EpiBf16ColScale {
    static constexpr bool PERM = true, AFTER_DRAIN = false;
    bf16_t* O; int ldc; const float* rss;
    __device__ __forceinline__ void operator()(const f32x4 (&acc)[2][2][4][2], const Unit& u, int wr, int wc, int fr, int fq) const {
        const int row0 = u.pm * BM + wr * 64 + fr; const int col0 = u.pn * BM + wc * 32 + 8 * fq;
#pragma unroll
        for (int bj = 0; bj < 2; ++bj) {
            f32x4 c0 = *(const f32x4*)(rss + col0 + bj * HALF), c1 = *(const f32x4*)(rss + col0 + bj * HALF + 4);
#pragma unroll
            for (int i = 0; i < 4; ++i) { c0[i] = rsqrtf(c0[i] * (1.f / 2048.f) + 1e-6f); c1[i] = rsqrtf(c1[i] * (1.f / 2048.f) + 1e-6f); }
#pragma unroll
            for (int ai = 0; ai < 2; ++ai)
#pragma unroll
                for (int m = 0; m < 4; ++m) { const f32x4 v0 = acc[ai][bj][m][0] * c0, v1 = acc[ai][bj][m][1] * c1;
                    u32x4 w; w.x = cvt_pk_bf16(v0[0], v0[1]); w.y = cvt_pk_bf16(v0[2], v0[3]); w.z = cvt_pk_bf16(v1[0], v1[1]); w.w = cvt_pk_bf16(v1[2], v1[3]);
                    *(u32x4*)(O + (size_t)(row0 + ai * HALF + m * 16) * ldc + col0 + bj * HALF) = w; }
        }
    }
};
template <bool BASE_F32> struct EpiResidBf16 {
    static constexpr bool PERM = true, AFTER_DRAIN = false;
    const float* basef; bf16_t* O; int ldc; float* rss;
    __device__ __forceinline__ void operator()(const f32x4 (&acc)[2][2][4][2], const Unit& u, int wr, int wc, int fr, int fq) const {
        const int row0 = u.pm * BM + wr * 64 + fr; const int col0 = u.pn * BM + wc * 32 + 8 * fq;
#pragma unroll
        for (int ai = 0; ai < 2; ++ai)
#pragma unroll
            for (int m = 0; m < 4; ++m) { const size_t off = (size_t)(row0 + ai * HALF + m * 16) * ldc + col0; float sq = 0.f;
#pragma unroll
                for (int bj = 0; bj < 2; ++bj) { f32x4 b0, b1;
                    if (BASE_F32) { b0 = *(const f32x4*)(basef + off + bj * HALF); b1 = *(const f32x4*)(basef + off + bj * HALF + 4); }
                    else { const u32x4 w = *(const u32x4*)(O + off + bj * HALF);
                        b0 = (f32x4){__builtin_bit_cast(float, w.x << 16), __builtin_bit_cast(float, w.x & 0xffff0000u), __builtin_bit_cast(float, w.y << 16), __builtin_bit_cast(float, w.y & 0xffff0000u)};
                        b1 = (f32x4){__builtin_bit_cast(float, w.z << 16), __builtin_bit_cast(float, w.z & 0xffff0000u), __builtin_bit_cast(float, w.w << 16), __builtin_bit_cast(float, w.w & 0xffff0000u)}; }
                    const f32x4 v0 = b0 + acc[ai][bj][m][0], v1 = b1 + acc[ai][bj][m][1];
                    u32x4 o; o.x = cvt_pk_bf16(v0[0], v0[1]); o.y = cvt_pk_bf16(v0[2], v0[3]); o.z = cvt_pk_bf16(v1[0], v1[1]); o.w = cvt_pk_bf16(v1[2], v1[3]);
                    *(u32x4*)(O + off + bj * HALF) = o;
                    sq += (v0[0] * v0[0] + v0[1] * v0[1]) + (v0[2] * v0[2] + v0[3] * v0[3]) + (v1[0] * v1[0] + v1[1] * v1[1]) + (v1[2] * v1[2] + v1[3] * v1[3]); }
                if (rss) { sq += __shfl_xor(sq, 16); sq += __shfl_xor(sq, 32); if (fq == 0) atomicAdd(rss + row0 + ai * HALF + m * 16, sq); } }
    }
};
struct EpiResid {
    static constexpr bool PERM = false, AFTER_DRAIN = false;
    const float* base; float* out; int ldc;
    __device__ __forceinline__ void operator()(const f32x4 (&acc)[2][2][4][2], const Unit& u, int wr, int wc, int fr, int fq) const {
        const int col0 = u.pn * BM + wc * 32 + 4 * fq;
#pragma unroll
        for (int ai = 0; ai < 2; ++ai)
#pragma unroll
            for (int m = 0; m < 4; ++m) { const size_t off = (size_t)(u.pm * BM + ai * HALF + wr * 64 + m * 16 + fr) * ldc + col0;
#pragma unroll
                for (int bj = 0; bj < 2; ++bj)
#pragma unroll
                    for (int n = 0; n < 2; ++n) { const f32x4 bs = *(const f32x4*)(base + off + bj * HALF + n * 16); *(f32x4*)(out + off + bj * HALF + n * 16) = bs + acc[ai][bj][m][n]; } }
    }
};

template <class Epi, class Sched, bool ALIGN_EPI = false, bool SP2 = false>
__device__ __forceinline__ void gemm_phase(PG8_LAS unsigned char* lds, const Gemm g, const Sched& S, const Epi& E) {
    int tid_ = threadIdx.x; asm volatile("" : "+v"(tid_));
    const int tid = tid_, wid = __builtin_amdgcn_readfirstlane(tid >> 6), lane = tid & 63, wr = wid >> 2, wc = wid & 3, fr = lane & 15, fq = lane >> 4;
    const int K = g.K, nt = K / BK;
    unsigned voffA[2], voffB[2];
#pragma unroll
    for (int i = 0; i < 2; ++i) { int R, C; stage_rc(tid * 16 + i * 8192, R, C); const int Rb = Epi::PERM ? ((R & ~31) + perm32(R & 31)) : R;
        voffA[i] = (unsigned)(R * K + C) * 2u; voffB[i] = (unsigned)(Rb * K + C) * 2u; }
    const size_t kstep = (size_t)(BK * 2);
    const size_t hstep = (size_t)HALF * K * 2;
    const size_t tstep = 2 * hstep;
    const unsigned ldsw = (unsigned)wid * 1024u;
    const unsigned ldsm0 = __builtin_amdgcn_readfirstlane((unsigned)(unsigned long long)lds + ldsw);
    const int aoff = lds_byte(wr * 64 + fr, fq * 8), boff = lds_byte(wc * 32 + fr, fq * 8);
#define PG8_SA(b, h) (((b) * 2 + (h)) * HTB)
#define PG8_SB(b, h) ((4 + (b) * 2 + (h)) * HTB)
#define PG8_STAGE(bufoff, gbase, voff) do { _Pragma("unroll") for (int _i = 0; _i < 2; ++_i) \
        asm volatile("s_mov_b32 m0, %0\n\ts_nop 0\n\tglobal_load_lds_dwordx4 %1, %2" :: "s"(ldsm0 + (unsigned)((bufoff) + _i * 8192)), "v"((voff)[_i]), "s"((const char*)(gbase)) : "m0", "memory"); } while (0)
#define PG8_LDA(dst, b, h) do { _Pragma("unroll") for (int m = 0; m < 4; ++m) _Pragma("unroll") for (int k = 0; k < 2; ++k) dst[m][k] = *(const PG8_LAS bf16x8*)(lds + PG8_SA(b, h) + aoff + m * 2048 + k * 1024); } while (0)
#define PG8_LDB(dst, b, h) do { _Pragma("unroll") for (int n = 0; n < 2; ++n) _Pragma("unroll") for (int k = 0; k < 2; ++k) dst[n][k] = *(const PG8_LAS bf16x8*)(lds + PG8_SB(b, h) + boff + n * 2048 + k * 1024); } while (0)
#define PG8_MMA(ai, bj, At, Bt) do { __builtin_amdgcn_s_setprio(1); _Pragma("unroll") for (int m = 0; m < 4; ++m) _Pragma("unroll") for (int n = 0; n < 2; ++n) _Pragma("unroll") for (int k = 0; k < 2; ++k) \
        acc[ai][bj][m][n] = __builtin_amdgcn_mfma_f32_16x16x32_bf16(Bt[n][k], At[m][k], acc[ai][bj][m][n], 0, 0, 0); __builtin_amdgcn_s_setprio(0); } while (0)
#define PG8_WAIT_V(n) asm volatile("s_waitcnt vmcnt(" #n ")" ::: "memory")
#define PG8_WAIT_L(n) asm volatile("s_waitcnt lgkmcnt(" #n ")" ::: "memory")
#define PG8_BAR __builtin_amdgcn_s_barrier()
#define PG8_SCHED __builtin_amdgcn_sched_barrier(0)
    Unit cur, nxt; int ui = 0;
    if (!S.next(0, cur)) return;
    f32x4 acc[2][2][4][2];
#pragma unroll
    for (int a = 0; a < 2; ++a)
#pragma unroll
        for (int b = 0; b < 2; ++b)
#pragma unroll
            for (int m = 0; m < 4; ++m)
#pragma unroll
                for (int n = 0; n < 2; ++n) acc[a][b][m][n] = (f32x4){0.f, 0.f, 0.f, 0.f};
    bf16x8 At[4][2], B0[2][2], B1[2][2];
    const char* cA = (const char*)g.A + (size_t)cur.pm * tstep; const char* cB = (const char*)g.Bt + (size_t)cur.pn * tstep;
    S.a_ready(cur);
    if constexpr (SP2) {
        PG8_STAGE(PG8_SB(0, 0), cB, voffB); PG8_STAGE(PG8_SB(0, 1), cB + hstep, voffB); PG8_STAGE(PG8_SA(0, 0), cA, voffA); PG8_STAGE(PG8_SA(0, 1), cA + hstep, voffA);
        if (wr == 1) PG8_BAR;
        PG8_WAIT_V(2); PG8_BAR;
        PG8_STAGE(PG8_SB(1, 0), cB + kstep, voffB); PG8_STAGE(PG8_SA(1, 0), cA + kstep, voffA); PG8_STAGE(PG8_SB(1, 1), cB + hstep + kstep, voffB);
        PG8_WAIT_V(6); PG8_BAR;
    } else {
        PG8_STAGE(PG8_SB(0, 0), cB, voffB); PG8_STAGE(PG8_SA(0, 0), cA, voffA); PG8_STAGE(PG8_SB(0, 1), cB + hstep, voffB); PG8_STAGE(PG8_SA(0, 1), cA + hstep, voffA);
        if (wr == 1) PG8_BAR;
        PG8_WAIT_V(4); PG8_BAR;
        PG8_STAGE(PG8_SB(1, 0), cB + kstep, voffB); PG8_STAGE(PG8_SA(1, 0), cA + kstep, voffA); PG8_STAGE(PG8_SB(1, 1), cB + hstep + kstep, voffB);
        PG8_WAIT_V(6); PG8_BAR;
    }
    for (;;) {
        const bool has_next = S.next(ui + 1, nxt);
        const char* nA = has_next ? (const char*)g.A + (size_t)nxt.pm * tstep : cA; const char* nB = has_next ? (const char*)g.Bt + (size_t)nxt.pn * tstep : cB;
        for (int t = 0; t < nt; t += 2) {
            const bool last = (t == nt - 2);
            const char* a1 = cA + (size_t)(t + 1) * kstep;
            const char* a2 = last ? nA : cA + (size_t)(t + 2) * kstep; const char* b2 = last ? nB : cB + (size_t)(t + 2) * kstep;
            const char* a3 = a2 + kstep; const char* b3 = b2 + kstep;
            if (last && has_next) S.a_ready(nxt);
            if constexpr (SP2) {
            PG8_LDB(B0, 0, 0); PG8_LDB(B1, 0, 1); PG8_SCHED; PG8_LDA(At, 0, 0); PG8_STAGE(PG8_SA(1, 1), a1 + hstep, voffA);
            PG8_WAIT_V(8); PG8_WAIT_L(0); PG8_BAR; PG8_MMA(0, 0, At, B0); PG8_MMA(0, 1, At, B1); PG8_BAR; PG8_SCHED;
            PG8_LDA(At, 0, 1); PG8_STAGE(PG8_SB(0, 0), b2, voffB); PG8_STAGE(PG8_SB(0, 1), b2 + hstep, voffB); PG8_STAGE(PG8_SA(0, 0), a2, voffA);
            PG8_WAIT_V(8); PG8_WAIT_L(0); PG8_BAR; PG8_MMA(1, 0, At, B0); PG8_MMA(1, 1, At, B1); PG8_BAR; PG8_SCHED;
            PG8_LDB(B0, 1, 0); PG8_LDB(B1, 1, 1); PG8_SCHED; PG8_LDA(At, 1, 0); PG8_STAGE(PG8_SA(0, 1), a2 + hstep, voffA);
            PG8_WAIT_V(8); PG8_WAIT_L(0); PG8_BAR; PG8_MMA(0, 0, At, B0); PG8_MMA(0, 1, At, B1); PG8_BAR; PG8_SCHED;
            PG8_LDA(At, 1, 1); PG8_STAGE(PG8_SB(1, 0), b3, voffB); PG8_STAGE(PG8_SB(1, 1), b3 + hstep, voffB); PG8_STAGE(PG8_SA(1, 0), a3, voffA);
            PG8_WAIT_V(8); PG8_WAIT_L(0); PG8_BAR; PG8_MMA(1, 0, At, B0); PG8_MMA(1, 1, At, B1); PG8_BAR; PG8_SCHED;
            } else {
            PG8_LDB(B0, 0, 0); PG8_SCHED; PG8_LDA(At, 0, 0); PG8_STAGE(PG8_SA(1, 1), a1 + hstep, voffA);
            PG8_WAIT_L(8); PG8_BAR; PG8_WAIT_L(0); PG8_MMA(0, 0, At, B0); PG8_BAR; PG8_SCHED;
            PG8_LDB(B1, 0, 1); PG8_STAGE(PG8_SB(0, 0), b2, voffB);
            PG8_BAR; PG8_WAIT_L(0); PG8_MMA(0, 1, At, B1); PG8_BAR;
            PG8_LDA(At, 0, 1); PG8_STAGE(PG8_SA(0, 0), a2, voffA);
            PG8_BAR; PG8_WAIT_L(0); PG8_MMA(1, 0, At, B0); PG8_BAR; PG8_SCHED;
            PG8_STAGE(PG8_SB(0, 1), b2 + hstep, voffB);
            PG8_WAIT_V(6); PG8_BAR; PG8_MMA(1, 1, At, B1); PG8_BAR;
            PG8_LDB(B0, 1, 0); PG8_SCHED; PG8_LDA(At, 1, 0); PG8_STAGE(PG8_SA(0, 1), a2 + hstep, voffA);
            PG8_WAIT_L(8); PG8_BAR; PG8_WAIT_L(0); PG8_MMA(0, 0, At, B0); PG8_BAR; PG8_SCHED;
            PG8_LDB(B1, 1, 1); PG8_STAGE(PG8_SB(1, 0), b3, voffB);
            PG8_BAR; PG8_WAIT_L(0); PG8_MMA(0, 1, At, B1); PG8_BAR;
            PG8_LDA(At, 1, 1); PG8_STAGE(PG8_SA(1, 0), a3, voffA);
            PG8_BAR; PG8_WAIT_L(0); PG8_MMA(1, 0, At, B0); PG8_BAR; PG8_SCHED;
            PG8_STAGE(PG8_SB(1, 1), b3 + hstep, voffB);
            PG8_WAIT_V(6); PG8_BAR; PG8_MMA(1, 1, At, B1); PG8_BAR;
            }
        }
        if constexpr (ALIGN_EPI) { if (wr == 0) PG8_BAR; }
        if constexpr (!Epi::AFTER_DRAIN) { E(acc, cur, wr, wc, fr, fq); S.done(cur); }
        if (!has_next) break;
#pragma unroll
        for (int a = 0; a < 2; ++a)
#pragma unroll
            for (int b = 0; b < 2; ++b)
#pragma unroll
                for (int m = 0; m < 4; ++m)
#pragma unroll
                    for (int n = 0; n < 2; ++n) acc[a][b][m][n] = (f32x4){0.f, 0.f, 0.f, 0.f};
        cur = nxt; cA = nA; cB = nB; ++ui;
        if constexpr (ALIGN_EPI) { if (wr == 1) PG8_BAR; }
    }
    PG8_WAIT_V(0);
    if constexpr (!ALIGN_EPI) { if (wr == 0) PG8_BAR; }
    PG8_BAR;
    if constexpr (Epi::AFTER_DRAIN) { E.fused(acc, cur, wr, wc, fr, fq, lds, wid, lane); S.done(cur); }
#undef PG8_SA
#undef PG8_SB
#undef PG8_STAGE
#undef PG8_LDA
#undef PG8_LDB
#undef PG8_MMA
#undef PG8_WAIT_V
#undef PG8_WAIT_L
#undef PG8_BAR
#undef PG8_SCHED
}
}

typedef unsigned short bf16_t;
#define LAS __attribute__((address_space(3)))
#ifndef TSEL
#define TSEL 0
#endif
#ifndef TMUL
#define TMUL 10
#endif
#define TS_ACC_PTR ((volatile LAS unsigned long long*)(147456 - 64))
#define TS_BEGIN(id) unsigned long long ts_##id = 0; if (TSEL == (id)) ts_##id = __builtin_amdgcn_s_memrealtime();
#ifndef TSBLK
#define TSBLK 0
#endif
#define TS_END(id) if (TSEL == (id) && blockIdx.x == TSBLK && threadIdx.x == 0) { *TS_ACC_PTR += __builtin_amdgcn_s_memrealtime() - ts_##id; }
constexpr int DM = 2048, NB = 8, S = 2048, M = NB * S, DIN = 7192, DEPTH = 2, LDP = 6144, NVT = 1024, NW_IN = LDP + NVT;
constexpr int NWAVES = 8, NT = NWAVES * 64;
constexpr int C_AQ = 0, C_AKC = 512, C_AKS = 640, C_AKW = 768, C_AGATE = 896;
constexpr int C_BQ = 1408, C_BK = 1920, C_BGATE = 2048;
constexpr int C_CB = 2560, C_CC = 3072, C_CH = 3584, C_CGATE = 4096;
constexpr int C_DQ = 4608, C_DK = 5120, C_DGATE = 5632;
constexpr int VR_AVC = 0, VR_AVS = 128, VR_AVW = 256, VR_BV = 384, VR_DV = 512;
__host__ __device__ __forceinline__ int src_col_of(int n) {
    if (n < 640) return n;
    if (n < 768) return n - 640 + 768;
    if (n < 896) return n - 768 + 1024;
    if (n < 1408) return n - 896 + 1304;
    if (n < 1920) return n - 1408 + 1816;
    if (n < 2048) return n - 1920 + 2328;
    if (n < 2560) return n - 2048 + 2584;
    if (n < 4608) return n - 2560 + 3096;
    if (n < 5120) return n - 4608 + 5144;
    if (n < 5632) return n - 5120 + 5656;
    if (n < 6144) return n - 5632 + 6680;
    if (n < 6272) return n - 6144 + 640;
    if (n < 6400) return n - 6272 + 896;
    if (n < 6528) return n - 6400 + 1152;
    if (n < 6656) return n - 6528 + 2456;
    return n - 6656 + 6168;
}
constexpr int SRC_GATES = 1280;
constexpr int NCMP = 127;

constexpr size_t MiB = 1u << 20;
constexpr size_t WS_BIASD = 1 * MiB;
constexpr size_t WS_IMG = 1 * MiB + 512 * 1024;
constexpr size_t WS_G = 2 * MiB;
constexpr size_t WS_RSS = 3 * MiB + 768 * 1024;
constexpr size_t WS_WG = 4 * MiB;
constexpr size_t WS_PB = 4 * MiB + 512 * 1024;
constexpr size_t WS_W2T = 4 * MiB + 768 * 1024;
constexpr size_t WS_W1T = 6 * MiB;
constexpr size_t WS_CMP = 5 * MiB;
constexpr size_t WS_WIN = 8 * MiB;
constexpr size_t WS_WOUT = 64 * MiB;
constexpr size_t WS_XB = 80 * MiB;
constexpr size_t WS_MIX = 144 * MiB;
constexpr size_t WS_P = 208 * MiB;
constexpr size_t WS_VT = 400 * MiB;
constexpr size_t WS_END = 432 * MiB;
constexpr int LDS_BYTES = 163840;

struct Params {
    const float* x; const float* norm_w; const float* w_in; const float* w_out; const float* conv_w; const float* sinks;
    const float* cmp_pos; const float* cmp_w1; const float* cmp_w2; const float* rel_bias; const float* final_norm_w;
    float* out; unsigned char* ws;
};

__device__ __forceinline__ float bf2f(bf16_t v) { return __uint_as_float(((unsigned)v) << 16); }
__device__ __forceinline__ unsigned f2bfu(float f) { unsigned u = __float_as_uint(f); return (u + 0x7fffu + ((u >> 16) & 1u)) >> 16; }
__device__ __forceinline__ bf16_t f2bf(float f) { return (bf16_t)f2bfu(f); }
__device__ __forceinline__ unsigned pk2(float lo, float hi) { return f2bfu(lo) | (f2bfu(hi) << 16); }
__device__ __forceinline__ float wave_sum(float v) {
#pragma unroll
    for (int o = 32; o > 0; o >>= 1) v += __shfl_xor(v, o);
    return v;
}
__device__ __forceinline__ float wave_max(float v) {
#pragma unroll
    for (int o = 32; o > 0; o >>= 1) v = fmaxf(v, __shfl_xor(v, o));
    return v;
}
__device__ __forceinline__ float silu(float v) { return v / (1.f + __expf(-v)); }
__device__ __forceinline__ float sigmoidf(float v) { return 1.f / (1.f + __expf(-v)); }
__device__ __forceinline__ void unpack8(const uint4 w, float (&f)[8]) {
    f[0] = __uint_as_float(w.x << 16); f[1] = __uint_as_float(w.x & 0xffff0000u); f[2] = __uint_as_float(w.y << 16); f[3] = __uint_as_float(w.y & 0xffff0000u);
    f[4] = __uint_as_float(w.z << 16); f[5] = __uint_as_float(w.z & 0xffff0000u); f[6] = __uint_as_float(w.w << 16); f[7] = __uint_as_float(w.w & 0xffff0000u);
}
#define LDS_FENCE() asm volatile("s_waitcnt lgkmcnt(0)" ::: "memory")

__device__ __forceinline__ int t5_bucket(int d) {
    if (d < 16) return d < 0 ? 0 : d;
    int b = 16;
    b += (d >= 22); b += (d >= 30); b += (d >= 40); b += (d >= 54); b += (d >= 73); b += (d >= 99); b += (d >= 134); b += (d >= 182);
    b += (d >= 246); b += (d >= 332); b += (d >= 450); b += (d >= 609); b += (d >= 825); b += (d >= 1117); b += (d >= 1513);
    return b;
}

struct TrItem { const float* W; const LAS float* ksc; bf16_t* WT; int K, srcld, src_n0, kb, nb; };
__device__ __forceinline__ void tr_load(const TrItem& t, float (&wv)[32], int lane) {
    const int k0 = 64 * t.kb, n0 = 32 * t.nb;
#pragma unroll
    for (int i = 0; i < 32; ++i) wv[i] = __builtin_nontemporal_load(&t.W[(size_t)(k0 + 2 * i + (lane >> 5)) * t.srcld + t.src_n0 + n0 + (lane & 31)]);
}
__device__ __forceinline__ void tr_store(const TrItem& t, const float (&wv)[32], LAS float* scr, int lane) {
    const int k0 = 64 * t.kb, n0 = 32 * t.nb;
#pragma unroll
    for (int i = 0; i < 32; ++i) { const int kk = 2 * i + (lane >> 5); const float sc = t.ksc ? t.ksc[k0 + kk] : 1.f; scr[kk * 33 + (lane & 31)] = wv[i] * sc; }
    LDS_FENCE();
    const int c = lane & 7;
#pragma unroll
    for (int j = 0; j < 4; ++j) { const int n = (lane >> 3) + 8 * j; const LAS float* s = scr + (8 * c) * 33 + n;
        uint4 o; o.x = pk2(s[0 * 33], s[1 * 33]); o.y = pk2(s[2 * 33], s[3 * 33]); o.z = pk2(s[4 * 33], s[5 * 33]); o.w = pk2(s[6 * 33], s[7 * 33]);
        *(uint4*)(t.WT + (size_t)(n0 + n) * t.K + k0 + 8 * c) = o; }
    LDS_FENCE();
}
__device__ __forceinline__ void rms_row_to_bf16(const float* xrow, bf16_t* orow, int lane) {
    const float4* xr = (const float4*)xrow + lane;
    float4 v[8]; float s = 0.f;
#pragma unroll
    for (int j = 0; j < 8; ++j) { v[j] = xr[64 * j]; s += (v[j].x * v[j].x + v[j].y * v[j].y) + (v[j].z * v[j].z + v[j].w * v[j].w); }
    const float r = rsqrtf(wave_sum(s) * (1.f / DM) + 1e-6f);
    uint2* o8 = (uint2*)orow + lane;
#pragma unroll
    for (int j = 0; j < 8; ++j) o8[64 * j] = make_uint2(pk2(v[j].x * r, v[j].y * r), pk2(v[j].z * r, v[j].w * r));
}

typedef unsigned u32x4_t_ __attribute__((ext_vector_type(4)));
typedef short abf16x8 __attribute__((ext_vector_type(8)));
typedef float f32x16 __attribute__((ext_vector_type(16)));
constexpr float LOG2E = 1.4426950408889634f, SCL = 0.125f * 1.4426950408889634f;
constexpr int OFF_TA = 0, OFF_TB = 65536, OFF_OSC = 65536 + 8192, OFF_TD = 0;
__device__ __forceinline__ int pi32(int i) { return (i & 19) | ((i & 4) << 1) | ((i & 8) >> 1); }
typedef float f32x2_t_ __attribute__((ext_vector_type(2))); typedef __bf16 bf16x2_t_ __attribute__((ext_vector_type(2)));
__device__ __forceinline__ unsigned cvtpk(float lo, float hi) { f32x2_t_ v = {lo, hi}; bf16x2_t_ b = __builtin_convertvector(v, bf16x2_t_); return __builtin_bit_cast(unsigned, b); }
struct KVF { abf16x8 k[4]; abf16x8 v[4]; };
struct Soft { float m, l; f32x16 o[2]; int reb; };
#ifndef F_TB
#define F_TB 1
#endif
#ifndef F_RSEL
#define F_RSEL 1
#endif
#ifndef F_LAZY
#define F_LAZY 1
#endif
__device__ __forceinline__ void soft_init(Soft& st) {
    st.m = F_LAZY ? 0.f : -INFINITY; st.l = 0.f; st.reb = 0;
#pragma unroll
    for (int r = 0; r < 16; ++r) { st.o[0][r] = 0.f; st.o[1][r] = 0.f; }
}
__device__ __forceinline__ void store_rows(const f32x16 (&o)[2], float scale, const bf16_t* gp, bf16_t* op, int h) {
    uint2 gw[8];
#pragma unroll
    for (int q = 0; q < 8; ++q) gw[q] = *(const uint2*)(gp + 32 * (q >> 2) + 8 * (q & 3) + 4 * h);
#pragma unroll
    for (int dh = 0; dh < 2; ++dh)
#pragma unroll
        for (int rg = 0; rg < 4; ++rg) {
            const int dim0 = 32 * dh + 8 * rg + 4 * h;
            const uint2 g = gw[dh * 4 + rg];
            const float g0 = __uint_as_float(g.x << 16), g1 = __uint_as_float(g.x & 0xffff0000u), g2 = __uint_as_float(g.y << 16), g3 = __uint_as_float(g.y & 0xffff0000u);
            uint2 w; w.x = cvtpk(o[dh][4 * rg + 0] * scale * silu(g0), o[dh][4 * rg + 1] * scale * silu(g1)); w.y = cvtpk(o[dh][4 * rg + 2] * scale * silu(g2), o[dh][4 * rg + 3] * scale * silu(g3));
            *(uint2*)(op + dim0) = w;
        }
}
constexpr int KVB = 8192, KVROUND = 2 * KVB;
struct StageRegs { u32x4_t_ k, v; };
__device__ __forceinline__ void stage_load(StageRegs& sr, const bf16_t* kg, size_t krs, const bf16_t* vg, int R, int tid) {
    const int row = tid >> 3, ch = tid & 7;
    sr.k = *(const u32x4_t_*)(kg + (size_t)(64 * R + row) * krs + ch * 8);
    sr.v = *(const u32x4_t_*)(vg + (size_t)row * M + 64 * R + ch * 8);
}
__device__ __forceinline__ void stage_write(const StageRegs& sr, LAS unsigned char* kvb, int tid) {
    const int row = tid >> 3, ch = tid & 7;
    const int off = row * 128 + ((ch ^ ((row >> 1) & 7)) << 4);
    *(LAS u32x4_t_*)(kvb + off) = sr.k; *(LAS u32x4_t_*)(kvb + KVB + off) = sr.v;
}
__device__ __forceinline__ void kfrag_read64(abf16x8 (&k0)[4], abf16x8 (&k1)[4], const LAS unsigned char* kvb, int lane) {
    const int i = lane & 31, h = lane >> 5, rr = pi32(i), sw = (rr >> 1) & 7;
#pragma unroll
    for (int s = 0; s < 4; ++s) { const int off = rr * 128 + (((2 * s + h) ^ sw) << 4); k0[s] = *(const LAS abf16x8*)(kvb + off); k1[s] = *(const LAS abf16x8*)(kvb + 4096 + off); }
}
__device__ __forceinline__ void vfrag_read64(abf16x8 (&v)[8], const LAS unsigned char* kvb, int lane) {
    const int i = lane & 31, h = lane >> 5, swv = (i >> 1) & 7;
#pragma unroll
    for (int j = 0; j < 2; ++j)
#pragma unroll
        for (int s2 = 0; s2 < 2; ++s2) { const int off = KVB + i * 128 + (((4 * j + 2 * s2 + h) ^ swv) << 4); v[j * 4 + s2] = *(const LAS abf16x8*)(kvb + off); v[j * 4 + 2 + s2] = *(const LAS abf16x8*)(kvb + 4096 + off); }
}
__device__ __forceinline__ float xhalf_max(float m) {
    auto rr = __builtin_amdgcn_permlane32_swap(__float_as_uint(m), __float_as_uint(m), false, false);
    return fmaxf(__uint_as_float(rr[0]), __uint_as_float(rr[1]));
}
__device__ __forceinline__ abf16x8 pack8(const float* p) {
    u32x4_t_ w; w.x = cvtpk(p[0], p[1]); w.y = cvtpk(p[2], p[3]); w.z = cvtpk(p[4], p[5]); w.w = cvtpk(p[6], p[7]);
    return __builtin_bit_cast(abf16x8, w);
}
__device__ __forceinline__ float max3f(float a, float b, float c) { return fmaxf(fmaxf(a, b), c); }
constexpr float THR_HI = 64.f;
template <bool CAUSAL, bool WIN, bool ROWSEL>
__device__ __forceinline__ void tile64_step(Soft& st, const LAS unsigned char* kvb, const abf16x8 (&qf)[4], const LAS float* tabp, int key0, int D0, int W, bool rowsel, int lane) {
    f32x16 a0, a1;
#pragma unroll
    for (int r = 0; r < 16; ++r) { a0[r] = 0.f; a1[r] = 0.f; }
    const LAS float* tb = tabp + key0;
#if F_TB
    asm volatile("" : "+v"(tb));
#endif
    float tv[32];
    {
        abf16x8 k0[4], k1[4]; kfrag_read64(k0, k1, kvb, lane);
#pragma unroll
        for (int r = 0; r < 16; ++r) { const int ko = (r & 7) + 16 * (r >> 3); tv[r] = tb[ko]; tv[16 + r] = tb[32 + ko]; }
        asm volatile("" : "+v"(k0[0]), "+v"(k0[1]), "+v"(k0[2]), "+v"(k0[3]), "+v"(k1[0]), "+v"(k1[1]), "+v"(k1[2]), "+v"(k1[3]) :: "memory");
#pragma unroll
        for (int s = 0; s < 4; ++s) { a0 = __builtin_amdgcn_mfma_f32_32x32x16_bf16(k0[s], qf[s], a0, 0, 0, 0); a1 = __builtin_amdgcn_mfma_f32_32x32x16_bf16(k1[s], qf[s], a1, 0, 0, 0); }
    }
    constexpr bool MASKX = CAUSAL || WIN || (ROWSEL && !F_RSEL);
    float sv[32]; float tm = -INFINITY;
#pragma unroll
    for (int r = 0; r < 16; ++r) {
        const int ko = (r & 7) + 16 * (r >> 3);
        float x0 = fmaf(a0[r], SCL, tv[r]), x1 = fmaf(a1[r], SCL, tv[16 + r]);
        if (MASKX) {
            bool ok0 = true, ok1 = true;
            if (CAUSAL) { ok0 = ok0 && (ko <= D0); ok1 = ok1 && (ko + 32 <= D0); }
            if (WIN) { ok0 = ok0 && (ko >= D0 - W); ok1 = ok1 && (ko + 32 >= D0 - W); }
            if (ROWSEL && !F_RSEL) { ok0 = ok0 && rowsel; ok1 = ok1 && rowsel; }
            x0 = ok0 ? x0 : -INFINITY; x1 = ok1 ? x1 : -INFINITY;
        }
        sv[r] = x0; sv[16 + r] = x1;
#if F_TB
        tm = max3f(tm, x0, x1);
#else
        tm = fmaxf(tm, fmaxf(x0, x1));
#endif
    }
    asm volatile("" ::: "memory");
    if (ROWSEL && F_RSEL) tm = rowsel ? tm : -INFINITY;
#if F_LAZY
    bool slow = st.reb != 0;
    if (CAUSAL) { const float tmx = xhalf_max(tm); slow = slow || __any(!(fabsf(tmx) <= THR_HI)); }
    else slow = slow || __any(tm > THR_HI);
    if (slow) {
        const float tmx = xhalf_max(tm);
        const float mn = CAUSAL ? tmx : fmaxf(st.m, tmx);
        const float alpha = CAUSAL ? 1.f : __builtin_amdgcn_exp2f(st.m - mn);
#pragma unroll
        for (int r = 0; r < 16; ++r) { st.o[0][r] *= alpha; st.o[1][r] *= alpha; }
        st.l *= alpha; st.m = mn; st.reb = 1;
#pragma unroll
        for (int r = 0; r < 32; ++r) sv[r] -= mn;
    }
#else
    {
        tm = xhalf_max(tm);
        const float mn = fmaxf(st.m, tm);
        const float alpha = __builtin_amdgcn_exp2f(st.m - mn);
        if (__any(alpha != 1.f)) {
#pragma unroll
            for (int r = 0; r < 16; ++r) { st.o[0][r] *= alpha; st.o[1][r] *= alpha; }
        }
        st.l *= alpha; st.m = mn;
#pragma unroll
        for (int r = 0; r < 32; ++r) sv[r] -= mn;
    }
#endif
    float rs = 0.f;
    const int i = lane & 31, h = lane >> 5, swv = (i >> 1) & 7;
#pragma unroll
    for (int j = 0; j < 2; ++j) {
        abf16x8 vf[4];
#pragma unroll
        for (int s2 = 0; s2 < 2; ++s2) { const int off = KVB + i * 128 + (((4 * j + 2 * s2 + h) ^ swv) << 4); vf[s2] = *(const LAS abf16x8*)(kvb + off); vf[2 + s2] = *(const LAS abf16x8*)(kvb + 4096 + off); }
#pragma unroll
        for (int r = 0; r < 16; ++r) { sv[16 * j + r] = __builtin_amdgcn_exp2f(sv[16 * j + r]); rs += sv[16 * j + r]; }
#pragma unroll
        for (int s2 = 0; s2 < 2; ++s2) {
            u32x4_t_ w; const float* p = sv + 16 * j + 8 * s2;
            w.x = cvtpk(p[0], p[1]); w.y = cvtpk(p[2], p[3]); w.z = cvtpk(p[4], p[5]); w.w = cvtpk(p[6], p[7]);
            if (ROWSEL && F_RSEL) { w.x = rowsel ? w.x : 0u; w.y = rowsel ? w.y : 0u; w.z = rowsel ? w.z : 0u; w.w = rowsel ? w.w : 0u; }
            const abf16x8 pf = __builtin_bit_cast(abf16x8, w);
            st.o[0] = __builtin_amdgcn_mfma_f32_32x32x16_bf16(vf[s2], pf, st.o[0], 0, 0, 0);
            st.o[1] = __builtin_amdgcn_mfma_f32_32x32x16_bf16(vf[2 + s2], pf, st.o[1], 0, 0, 0); }
    }
    if (ROWSEL && F_RSEL) rs = rowsel ? rs : 0.f;
    st.l += rs;
}
#define ROUND_LOOP64(rm_, kg_, krs_, vg_, kvbase_, tid_, ...) do { \
    unsigned rm__ = (rm_); int R__ = 31 - __builtin_clz(rm__); int bs__ = 0; StageRegs sr__; \
    stage_load(sr__, kg_, krs_, vg_, R__, tid_); stage_write(sr__, (kvbase_), tid_); \
    asm volatile("" :: "v"(qf[0]), "v"(qf[1]), "v"(qf[2]), "v"(qf[3]));     \
    __syncthreads(); \
    for (;;) { rm__ &= ~(1u << R__); const int Rn__ = rm__ ? 31 - __builtin_clz(rm__) : -1; \
        if (Rn__ >= 0) stage_load(sr__, kg_, krs_, vg_, Rn__, tid_); \
        { const LAS unsigned char* kvb__ = (kvbase_) + bs__ * KVROUND; const int R = R__; __VA_ARGS__ } \
        if (Rn__ < 0) break; \
        { TS_BEGIN(5) stage_write(sr__, (kvbase_) + (bs__ ^ 1) * KVROUND, tid_); __syncthreads(); TS_END(5) } bs__ ^= 1; R__ = Rn__; } \
    __syncthreads(); } while (0)
__device__ __forceinline__ void bunit_D(const bf16_t* P, const bf16_t* VT, bf16_t* MIX, const LAS float* tabD1  , LAS unsigned char* kvbase, int b, int head, int qb, int tid, int wib) {
    asm volatile("" : "+v"(tid));
    int lane = tid & 63; asm volatile("" : "+v"(lane));
    const int c = lane & 31, h = lane >> 5, qt = 8 * qb + wib, tc = qt * 32 + c;
    const size_t rowq = (size_t)b * S + tc;
    abf16x8 qf[4];
#pragma unroll
    for (int s = 0; s < 4; ++s) qf[s] = *(const abf16x8*)(P + rowq * LDP + C_DQ + head * 64 + 16 * s + 8 * h);
    const bf16_t* kg = P + (size_t)b * S * LDP + C_DK + head * 64;
    const bf16_t* vg = VT + (size_t)(VR_DV + head * 64) * M + (size_t)b * S;
    const LAS float* tabp = tabD1 + (2047 - tc + 8 * h);
    Soft st; soft_init(st);
    const unsigned rm = 0xffffffffu >> (31 - (4 * qb + 3));
    const int Rw = qt >> 1;
    ROUND_LOOP64(rm, kg, (size_t)LDP, vg, kvbase, tid,
        if (R <= Rw) { const int D0 = tc - 64 * R - 8 * h;
            if (R == Rw) tile64_step<true, false, false>(st, kvb__, qf, tabp, 64 * R, D0, 0, true, lane);
            else tile64_step<false, false, false>(st, kvb__, qf, tabp, 64 * R, D0, 0, true, lane); }
    );
    const float l = st.l + __shfl_xor(st.l, 32);
    store_rows(st.o, 1.f / l, P + rowq * LDP + C_DGATE + head * 64, MIX + rowq * DM + 1536 + head * 64, h);
}

__device__ __forceinline__ void bunit_B(const bf16_t* P, const bf16_t* VT, bf16_t* MIX, const LAS float* tabB, const float* sinks, LAS unsigned char* kvbase, int b, int g, int q64, int tid, int wib) {
    asm volatile("" : "+v"(tid));
    int lane = tid & 63; asm volatile("" : "+v"(lane));
    const int c = lane & 31, h = lane >> 5, hh = c >> 3, qi = c & 7, t0 = 64 * q64 + 8 * wib, tc = t0 + qi, head = g * 4 + hh;
    const size_t rowq = (size_t)b * S + tc;
    abf16x8 qf[4];
#pragma unroll
    for (int s = 0; s < 4; ++s) qf[s] = *(const abf16x8*)(P + rowq * LDP + C_BQ + head * 64 + 16 * s + 8 * h);
    const bf16_t* kg = P + (size_t)b * S * LDP + C_BK + g * 64;
    const bf16_t* vg = VT + (size_t)(VR_BV + g * 64) * M + (size_t)b * S;
    const LAS float* tabp = tabB + head * 264 + (255 - tc + 8 * h);
    Soft st; soft_init(st);
    const int ktd = t0 >> 5, ktlo = (t0 - 127 > 0 ? t0 - 127 : 0) >> 5;
    const int Rlo = (64 * q64 - 127 > 0 ? 64 * q64 - 127 : 0) >> 6;
    const unsigned rm = (0xffffffffu >> (31 - q64)) & (0xffffffffu << Rlo);
    (void)ktd;
    ROUND_LOOP64(rm, kg, (size_t)LDP, vg, kvbase, tid,
        if (2 * R + 1 >= ktlo) { const int D0 = tc - 64 * R - 8 * h;
            if (R == q64) tile64_step<true, false, false>(st, kvb__, qf, tabp, 64 * R, D0, 0, true, lane);
            else tile64_step<false, true, false>(st, kvb__, qf, tabp, 64 * R, D0, 127, true, lane); }
    );
    const float l = st.l + __shfl_xor(st.l, 32) + __builtin_amdgcn_exp2f(sinks[head] * LOG2E - st.m);
    store_rows(st.o, 1.f / l, P + rowq * LDP + C_BGATE + head * 64, MIX + rowq * DM + 512 + head * 64, h);
}

constexpr int D6_SLOT = 8192, D6_K = 0, D6_V = 3 * D6_SLOT, D6_WS = 6 * D6_SLOT, D6_OST = D6_WS + 8 * 256, D6_TD = D6_OST + 8 * 4096, D6_TDN = 2304, D6_END = D6_TD + D6_TDN * 4;
constexpr float D6_THR = 8.f;
#define D6_SBAR() __builtin_amdgcn_sched_barrier(0)
#define D6_PIN(x) asm volatile("" : "+v"(x))
#define D6_MFMA(a, b, c) __builtin_amdgcn_mfma_f32_32x32x16_bf16(a, b, c, 0, 0, 0)
#define D6_WAIT_BAR(N) asm volatile("s_waitcnt vmcnt(" #N ") lgkmcnt(0)\n\ts_barrier" ::: "memory")
__device__ __forceinline__ int d6_crow(int r, int hi) { return (r & 3) + 8 * (r >> 2) + 4 * hi; }
__device__ __forceinline__ void d6_glds16(const void* g, unsigned lds_base) {
    unsigned sv; asm volatile("s_mov_b32 %0, m0\n\ts_mov_b32 m0, %2\n\ts_nop 0\n\tglobal_load_lds_dwordx4 %1, off\n\ts_mov_b32 m0, %0" : "=&s"(sv) : "v"(g), "s"(lds_base) : "memory"); }
typedef const LAS unsigned char* d6_lptr;
__device__ __forceinline__ void d6_kload2(abf16x8* kf, d6_lptr kp, int d0) { kf[2 * d0] = *(const LAS abf16x8*)(kp + d0 * 2048); kf[2 * d0 + 1] = *(const LAS abf16x8*)(kp + d0 * 2048 + 512); }
#define D6_MX3(a, b, c) __builtin_fmaxf(__builtin_fmaxf((a), (b)), (c))
__device__ __forceinline__ float d6_rowmax(const f32x16& p0, const f32x16& p1) {
    float a = D6_MX3(p0[0], p0[1], p1[0]), b = D6_MX3(p0[2], p0[3], p1[1]); a = D6_MX3(a, p1[2], p1[3]);
#pragma unroll
    for (int r = 4; r < 16; r += 4) { a = D6_MX3(a, p0[r], p0[r + 1]); b = D6_MX3(b, p0[r + 2], p0[r + 3]); a = D6_MX3(a, p1[r], p1[r + 1]); b = D6_MX3(b, p1[r + 2], p1[r + 3]); }
    float m = __builtin_fmaxf(a, b); auto rr = __builtin_amdgcn_permlane32_swap(__float_as_uint(m), __float_as_uint(m), false, false);
    return __builtin_fmaxf(__uint_as_float(rr[0]), __uint_as_float(rr[1])); }
#define D6_TLOAD(X0, X1, tq, tt, r0, r1) do { _Pragma("unroll") for (int r_ = (r0); r_ < (r1); ++r_) { const int ko_ = (r_ & 7) + 16 * (r_ >> 3); X0[r_] = (tq)[64 * (tt) + ko_]; X1[r_] = (tq)[64 * (tt) + 32 + ko_]; } } while (0)
__device__ __forceinline__ void dunit64(const bf16_t* P, const bf16_t* VT, bf16_t* MIX, LAS unsigned char* lds, int b, int head, int qb, int tid_in) {
    int tid = tid_in; asm volatile("" : "+v"(tid));
    const int lane = tid & 63, r32 = lane & 31, hi = lane >> 5; const int wid = __builtin_amdgcn_readfirstlane(tid >> 6);
    const size_t rowbase = (size_t)b * S; const int q0 = qb * 256, NT_ = (q0 + 256) / 64;
    const bf16_t* Qw = P + (rowbase + q0 + wid * 32) * LDP + C_DQ + head * 64;
    const unsigned lds0 = (unsigned)(uintptr_t)lds; LAS float* wsf = (LAS float*)(lds + D6_WS) + wid * 64;
    const bf16_t* ksrc = P + rowbase * LDP + C_DK + head * 64 + (size_t)lane * LDP + wid * 8;
    const bf16_t* vsrc = VT + (size_t)(VR_DV + head * 64 + lane) * M + rowbase + wid * 8;
    const unsigned kdst = lds0 + D6_K + wid * 1024, vdst = lds0 + D6_V + wid * 1024;
#define D6_DMA_K(t, slot) d6_glds16(ksrc + (size_t)(t) * 64 * LDP, (unsigned)__builtin_amdgcn_readfirstlane(kdst + (slot)))
#define D6_DMA_V(t, slot) d6_glds16(vsrc + (size_t)(t) * 64, (unsigned)__builtin_amdgcn_readfirstlane(vdst + (slot)))
    const d6_lptr vp0 = (d6_lptr)lds + D6_V + hi * 1024 + r32 * 16;
    const d6_lptr kp0 = (d6_lptr)lds + D6_K + hi * 1024 + pi32(r32) * 16;
    D6_DMA_K(0, 0); D6_DMA_V(0, 0); D6_DMA_K(1, D6_SLOT);
    abf16x8 qr[4];
#pragma unroll
    for (int d0 = 0; d0 < 4; ++d0) qr[d0] = *(const abf16x8*)(Qw + (size_t)r32 * LDP + d0 * 16 + hi * 8);
    float mhat = 0.f, l_reg = 0.f; f32x16 o[2];
#pragma unroll
    for (int r = 0; r < 16; ++r) { o[0][r] = 0.f; o[1][r] = 0.f; }
    const int tc = q0 + wid * 32 + r32; bool resc = false;
    const LAS float* tq = (const LAS float*)(lds + D6_TD) + (2047 - tc + 8 * hi);
    f32x16 pA0, pA1, pB0, pB1; abf16x8 kf[8]; abf16x8 vf[8]; u32x4_t_ pw0, pw1, pw2, pw3;
    int sl_prev = 0, sl_cur = 0, sl_next = D6_SLOT;
#define D6_ROT() do { sl_prev = sl_cur; sl_cur = sl_next; sl_next = (sl_next == 2 * D6_SLOT) ? 0 : sl_next + D6_SLOT; } while (0)
#define D6_EX(v) __builtin_amdgcn_exp2f(__builtin_fmaf((v), SCL, nmh))
#define D6_RESC() do { if (resc) { _Pragma("unroll") for (int d_ = 0; d_ < 2; ++d_) _Pragma("unroll") for (int r = 0; r < 16; ++r) o[d_][r] *= wsf[d6_crow(r, hi)]; } } while (0)
    D6_DMA_K(2, 2 * D6_SLOT);
    D6_TLOAD(pA0, pA1, tq, 0, 0, 16);
    D6_WAIT_BAR(3);
    _Pragma("unroll") for (int d0 = 0; d0 < 4; ++d0) d6_kload2(kf, kp0, d0);
    pA0 = D6_MFMA(kf[0], qr[0], pA0); pA1 = D6_MFMA(kf[1], qr[0], pA1); pA0 = D6_MFMA(kf[2], qr[1], pA0); pA1 = D6_MFMA(kf[3], qr[1], pA1);
    pA0 = D6_MFMA(kf[4], qr[2], pA0); pA1 = D6_MFMA(kf[5], qr[2], pA1); pA0 = D6_MFMA(kf[6], qr[3], pA0); pA1 = D6_MFMA(kf[7], qr[3], pA1);
    D6_TLOAD(pB0, pB1, tq, 1, 0, 16);
    { const float rm = d6_rowmax(pA0, pA1) * SCL;
      if (__any(rm > D6_THR)) mhat = __builtin_fmaxf(rm, 0.f);
      const float nmh = -mhat;
#pragma unroll
      for (int r = 0; r < 16; ++r) { pA0[r] = D6_EX(pA0[r]); pA1[r] = D6_EX(pA1[r]); } }
    D6_WAIT_BAR(0);
    D6_DMA_K(3, 0); D6_DMA_V(1, D6_SLOT); D6_ROT();
    _Pragma("unroll") for (int d0 = 0; d0 < 4; ++d0) d6_kload2(kf, kp0 + sl_cur, d0);
    D6_WAIT_BAR(2);
#define D6_PKW(P_, i) cvtpk(P_[i], P_[i + 1])
#define D6_PAF(k) __builtin_bit_cast(abf16x8, pw##k)
#define D6_VRD(i) do { vf[i] = *(const LAS abf16x8*)(vp_ + (((i) & 3) * 2048 + ((i) >> 2) * 512)); } while (0)
#define D6_KRD(G_, d0) do { if (G_) { d6_kload2(kf, kp0 + sl_next, d0); D6_SBAR(); } } while (0)
#define D6_TRD(G_, X0, X1, tt, r0, r1) do { if (G_) { D6_TLOAD(X0, X1, tq, tt, r0, r1); D6_SBAR(); } } while (0)
#define D6_GAPA(MF, a0, a1, a2, a3, W0, W1, PW) do { MF; sacc += a0; sacc += a1; sacc += a2; sacc += a3; W0; W1; D6_PIN(PW); D6_PIN(sacc); D6_SBAR(); } while (0)
#define D6_GAPB(MF, X, i) do { MF; X[i] = D6_EX(X[i]); X[i + 1] = D6_EX(X[i + 1]); X[i + 2] = D6_EX(X[i + 2]); X[i + 3] = D6_EX(X[i + 3]); D6_PIN(X); D6_SBAR(); } while (0)
#define D6_STEP(C0, C1, P0, P1, t, GK, GV, GL) do { D6_SBAR(); \
    const d6_lptr vp_ = vp0 + sl_prev; \
    D6_VRD(0); D6_SBAR(); float sacc = P0[0] + P0[1]; \
                       D6_GAPA(C0 = D6_MFMA(kf[0], qr[0], C0), P0[2], P0[3], P0[4], P0[5],     pw0[0] = D6_PKW(P0, 0),  pw0[1] = D6_PKW(P0, 2),  pw0); \
    D6_VRD(4); D6_SBAR(); D6_GAPA(C1 = D6_MFMA(kf[1], qr[0], C1), P0[6], P0[7], P0[8], P0[9],     pw0[2] = D6_PKW(P0, 4),  pw0[3] = D6_PKW(P0, 6),  pw0); \
    D6_VRD(1); D6_SBAR(); D6_GAPA(C0 = D6_MFMA(kf[2], qr[1], C0),    P0[10], P0[11], P0[12], P0[13], pw1[0] = D6_PKW(P0, 8),  pw1[1] = D6_PKW(P0, 10), pw1); \
    D6_VRD(5); D6_SBAR(); D6_GAPA(C1 = D6_MFMA(kf[3], qr[1], C1),    P0[14], P0[15], P1[0], P1[1],   pw1[2] = D6_PKW(P0, 12), pw1[3] = D6_PKW(P0, 14), pw1); \
    D6_VRD(2); D6_SBAR(); D6_GAPA(C0 = D6_MFMA(kf[4], qr[2], C0),    P1[2], P1[3], P1[4], P1[5],     pw2[0] = D6_PKW(P1, 0),  pw2[1] = D6_PKW(P1, 2),  pw2); \
    D6_VRD(6); D6_SBAR(); D6_GAPA(C1 = D6_MFMA(kf[5], qr[2], C1),    P1[6], P1[7], P1[8], P1[9],     pw2[2] = D6_PKW(P1, 4),  pw2[3] = D6_PKW(P1, 6),  pw2); \
    D6_VRD(3); D6_SBAR(); D6_GAPA(C0 = D6_MFMA(kf[6], qr[3], C0),    P1[10], P1[11], P1[12], P1[13], pw3[0] = D6_PKW(P1, 8),  pw3[1] = D6_PKW(P1, 10), pw3); \
    D6_VRD(7); D6_SBAR(); D6_GAPA(C1 = D6_MFMA(kf[7], qr[3], C1),    P1[14], P1[15], 0.f, 0.f,       pw3[2] = D6_PKW(P1, 12), pw3[3] = D6_PKW(P1, 14), pw3); \
    l_reg += sacc; \
    if (GK) D6_DMA_K((t) + 3, sl_cur); if (GV) D6_DMA_V((t) + 1, sl_next); \
    { const float rm = __builtin_fmaf(d6_rowmax(C0, C1), SCL, -mhat); resc = false; \
      if (__builtin_expect(__any(rm > D6_THR), 0)) { const float dl = __builtin_fmaxf(rm, 0.f); mhat += dl; \
          const float f = __builtin_amdgcn_exp2f(-dl); l_reg *= f; if (hi == 0) wsf[r32] = f; resc = true; } } \
    const float nmh = -mhat; D6_SBAR(); \
    D6_TRD(GL, P0, P1, (t) + 1, 0, 4);  D6_GAPB(o[0] = D6_MFMA(D6_PAF(0), vf[0], o[0]), C0, 0);  D6_TRD(GL, P0, P1, (t) + 1, 4, 8);  D6_GAPB(o[1] = D6_MFMA(D6_PAF(0), vf[4], o[1]), C0, 4); \
    D6_KRD(GL, 0); D6_GAPB(o[0] = D6_MFMA(D6_PAF(1), vf[1], o[0]), C0, 8);  D6_KRD(GL, 1); D6_GAPB(o[1] = D6_MFMA(D6_PAF(1), vf[5], o[1]), C0, 12); \
    D6_KRD(GL, 2); D6_GAPB(o[0] = D6_MFMA(D6_PAF(2), vf[2], o[0]), C1, 0);  D6_KRD(GL, 3); D6_GAPB(o[1] = D6_MFMA(D6_PAF(2), vf[6], o[1]), C1, 4); \
    D6_TRD(GL, P0, P1, (t) + 1, 8, 12); D6_GAPB(o[0] = D6_MFMA(D6_PAF(3), vf[3], o[0]), C1, 8);  D6_TRD(GL, P0, P1, (t) + 1, 12, 16); D6_GAPB(o[1] = D6_MFMA(D6_PAF(3), vf[7], o[1]), C1, 12); \
    } while (0)
    int t = 1;
    for (; t + 5 < NT_; t += 2) {
        D6_STEP(pB0, pB1, pA0, pA1, t, true, true, true);     D6_WAIT_BAR(2); D6_RESC(); D6_ROT();
        D6_STEP(pA0, pA1, pB0, pB1, t + 1, true, true, true); D6_WAIT_BAR(2); D6_RESC(); D6_ROT();
    }
#define D6_ENDW(tt) do { if ((tt) + 3 < NT_) { D6_WAIT_BAR(2); } else if ((tt) + 2 < NT_) { D6_WAIT_BAR(1); } else { D6_WAIT_BAR(0); } } while (0)
    for (; t + 1 < NT_; t += 2) {
        D6_STEP(pB0, pB1, pA0, pA1, t, (t + 3 < NT_), (t + 1 < NT_), (t + 1 < NT_));         D6_ENDW(t);     D6_RESC(); D6_ROT();
        D6_STEP(pA0, pA1, pB0, pB1, t + 1, (t + 4 < NT_), (t + 2 < NT_), (t + 2 < NT_));     D6_ENDW(t + 1); D6_RESC(); D6_ROT();
    }
    D6_STEP(pB0, pB1, pA0, pA1, NT_ - 1, false, false, false); D6_RESC();
    { float sacc = pB0[0] + pB0[1];
#pragma unroll
      for (int r = 2; r < 16; ++r) sacc += pB0[r];
#pragma unroll
      for (int r = 0; r < 16; ++r) sacc += pB1[r];
      l_reg += sacc;
      pw0 = (u32x4_t_){D6_PKW(pB0, 0), D6_PKW(pB0, 2), D6_PKW(pB0, 4), D6_PKW(pB0, 6)}; pw1 = (u32x4_t_){D6_PKW(pB0, 8), D6_PKW(pB0, 10), D6_PKW(pB0, 12), D6_PKW(pB0, 14)};
      pw2 = (u32x4_t_){D6_PKW(pB1, 0), D6_PKW(pB1, 2), D6_PKW(pB1, 4), D6_PKW(pB1, 6)}; pw3 = (u32x4_t_){D6_PKW(pB1, 8), D6_PKW(pB1, 10), D6_PKW(pB1, 12), D6_PKW(pB1, 14)};
      const d6_lptr vp_ = vp0 + sl_cur; _Pragma("unroll") for (int i = 0; i < 8; ++i) D6_VRD(i);
      o[0] = D6_MFMA(D6_PAF(0), vf[0], o[0]); o[1] = D6_MFMA(D6_PAF(0), vf[4], o[1]); o[0] = D6_MFMA(D6_PAF(1), vf[1], o[0]); o[1] = D6_MFMA(D6_PAF(1), vf[5], o[1]);
      o[0] = D6_MFMA(D6_PAF(2), vf[2], o[0]); o[1] = D6_MFMA(D6_PAF(2), vf[6], o[1]); o[0] = D6_MFMA(D6_PAF(3), vf[3], o[0]); o[1] = D6_MFMA(D6_PAF(3), vf[7], o[1]); }
    { auto rr = __builtin_amdgcn_permlane32_swap(__float_as_uint(l_reg), __float_as_uint(l_reg), false, false); l_reg = __uint_as_float(rr[0]) + __uint_as_float(rr[1]); }
    if (hi == 0) wsf[32 + r32] = l_reg; asm volatile("s_waitcnt lgkmcnt(0)" ::: "memory");
    float rli[16];
#pragma unroll
    for (int r = 0; r < 16; ++r) rli[r] = __builtin_amdgcn_rcpf(wsf[32 + d6_crow(r, hi)]);
    LAS bf16_t* stg = (LAS bf16_t*)(lds + D6_OST) + wid * 2048;
#pragma unroll
    for (int r = 0; r < 16; ++r) { const int orow = d6_crow(r, hi);
#pragma unroll
        for (int d0 = 0; d0 < 2; ++d0) stg[orow * 64 + d0 * 32 + r32] = (bf16_t)(cvtpk(o[d0][r] * rli[r], 0.f) & 0xffffu); }
    asm volatile("s_waitcnt lgkmcnt(0)" ::: "memory");
    {
        const size_t row0 = rowbase + q0 + wid * 32;
        uint4 gv[4];
#pragma unroll
        for (int i = 0; i < 4; ++i) { const int row = i * 8 + (lane >> 3), ch = lane & 7; gv[i] = *(const uint4*)(P + (row0 + row) * LDP + C_DGATE + head * 64 + ch * 8); }
#pragma unroll
        for (int i = 0; i < 4; ++i) { const int row = i * 8 + (lane >> 3), ch = lane & 7;
            const u32x4_t_ ovv = *(const LAS u32x4_t_*)(stg + row * 64 + ch * 8); const uint4 ov = make_uint4(ovv.x, ovv.y, ovv.z, ovv.w);
            float fo[8], fg[8]; unpack8(ov, fo); unpack8(gv[i], fg);
            uint4 w; w.x = cvtpk(fo[0] * silu(fg[0]), fo[1] * silu(fg[1])); w.y = cvtpk(fo[2] * silu(fg[2]), fo[3] * silu(fg[3]));
            w.z = cvtpk(fo[4] * silu(fg[4]), fo[5] * silu(fg[5])); w.w = cvtpk(fo[6] * silu(fg[6]), fo[7] * silu(fg[7]));
            *(uint4*)(MIX + (row0 + row) * DM + 1536 + head * 64 + ch * 8) = w; }
    }
    asm volatile("s_waitcnt vmcnt(0) lgkmcnt(0)\n\ts_barrier" ::: "memory");
}
#define A6_POP(seq, R_, real_) do { real_ = seq##_m != 0u; if (real_) { seq##_last = __builtin_ctz(seq##_m); seq##_m &= seq##_m - 1u; } R_ = seq##_last; } while (0)
#define A6_TLOAD(X0, X1, tp_, r0, r1) do { _Pragma("unroll") for (int r_ = (r0); r_ < (r1); ++r_) { const int ko_ = (r_ & 7) + 16 * (r_ >> 3); X0[r_] = (tp_)[ko_]; X1[r_] = (tp_)[32 + ko_]; } } while (0)
template <bool SEL>
__device__ __forceinline__ void a_sweep64(const bf16_t* kbase  , const bf16_t* vbase  ,
                                          LAS unsigned char* lds  , LAS float* wsf, unsigned tmask, unsigned selmask, const LAS float* tabq, const LAS float* ninfp,
                                          const abf16x8 (&qr)[4], f32x16 (&o)[2], float& l_out, int tid_in) {
    int tid = tid_in; asm volatile("" : "+v"(tid));
    const int lane = tid & 63, r32 = lane & 31, hi = lane >> 5; const int wid = __builtin_amdgcn_readfirstlane(tid >> 6);
    const int nreal = __builtin_popcount(tmask); const int NT_ = nreal < 4 ? 4 : ((nreal + 1) & ~1);
    const unsigned lds0 = (unsigned)(uintptr_t)lds;
    const bf16_t* ksrc = kbase + (size_t)lane * LDP + wid * 8;
    const bf16_t* vsrc = vbase + (size_t)lane * M + wid * 8;
    const unsigned kdst = lds0 + wid * 1024, vdst = lds0 + 3 * D6_SLOT + wid * 1024;
#define A6_DMA_K(R_, slot) d6_glds16(ksrc + (size_t)(R_) * 64 * LDP, (unsigned)__builtin_amdgcn_readfirstlane(kdst + (slot)))
#define A6_DMA_V(R_, slot) d6_glds16(vsrc + (size_t)(R_) * 64, (unsigned)__builtin_amdgcn_readfirstlane(vdst + (slot)))
#define A6_TPTR(R_, real_) (((real_) && (!SEL || ((selmask >> (R_)) & 1u))) ? tabq + 64 * (R_) : ninfp)
    const d6_lptr vp0 = (d6_lptr)lds + 3 * D6_SLOT + hi * 1024 + r32 * 16;
    const d6_lptr kp0 = (d6_lptr)lds + hi * 1024 + pi32(r32) * 16;
    unsigned sK_m = tmask, sV_m = tmask, sT_m = tmask; int sK_last = __builtin_ctz(tmask), sV_last = sK_last, sT_last = sK_last;
    int Rk, Rv, Rt; bool rk, rv, rt; (void)rk; (void)rv;
    asm volatile("s_waitcnt vmcnt(0)" ::: "memory");
    A6_POP(sK, Rk, rk); A6_DMA_K(Rk, 0); A6_POP(sV, Rv, rv); A6_DMA_V(Rv, 0); A6_POP(sK, Rk, rk); A6_DMA_K(Rk, D6_SLOT); A6_POP(sK, Rk, rk); A6_DMA_K(Rk, 2 * D6_SLOT);
    float mhat = 0.f, l_reg = 0.f;
#pragma unroll
    for (int r = 0; r < 16; ++r) { o[0][r] = 0.f; o[1][r] = 0.f; }
    bool resc = false;
    f32x16 pA0, pA1, pB0, pB1; abf16x8 kf[8]; abf16x8 vf[8]; u32x4_t_ pw0, pw1, pw2, pw3;
    int sl_prev = 0, sl_cur = 0, sl_next = D6_SLOT;
    { A6_POP(sT, Rt, rt); const LAS float* tp = A6_TPTR(Rt, rt); A6_TLOAD(pA0, pA1, tp, 0, 16); }
    D6_WAIT_BAR(3);
    _Pragma("unroll") for (int d0 = 0; d0 < 4; ++d0) d6_kload2(kf, kp0, d0);
    pA0 = D6_MFMA(kf[0], qr[0], pA0); pA1 = D6_MFMA(kf[1], qr[0], pA1); pA0 = D6_MFMA(kf[2], qr[1], pA0); pA1 = D6_MFMA(kf[3], qr[1], pA1);
    pA0 = D6_MFMA(kf[4], qr[2], pA0); pA1 = D6_MFMA(kf[5], qr[2], pA1); pA0 = D6_MFMA(kf[6], qr[3], pA0); pA1 = D6_MFMA(kf[7], qr[3], pA1);
    { A6_POP(sT, Rt, rt); const LAS float* tp = A6_TPTR(Rt, rt); A6_TLOAD(pB0, pB1, tp, 0, 16); }
    { const float rm = d6_rowmax(pA0, pA1) * SCL;
      if (__any(rm > D6_THR)) mhat = __builtin_fmaxf(rm, 0.f);
      const float nmh = -mhat;
#pragma unroll
      for (int r = 0; r < 16; ++r) { pA0[r] = D6_EX(pA0[r]); pA1[r] = D6_EX(pA1[r]); } }
    D6_WAIT_BAR(0);
    A6_POP(sK, Rk, rk); A6_DMA_K(Rk, 0); A6_POP(sV, Rv, rv); A6_DMA_V(Rv, D6_SLOT); D6_ROT();
    _Pragma("unroll") for (int d0 = 0; d0 < 4; ++d0) d6_kload2(kf, kp0 + sl_cur, d0);
    D6_WAIT_BAR(2);
#define A6_TRD(G_, X0, X1, r0, r1) do { if (G_) { A6_TLOAD(X0, X1, tpn, r0, r1); D6_SBAR(); } } while (0)
#define A6_STEP(C0, C1, P0, P1, GK, GV, GL) do { D6_SBAR(); \
    const d6_lptr vp_ = vp0 + sl_prev; \
    D6_VRD(0); D6_SBAR(); float sacc = P0[0] + P0[1]; \
                       D6_GAPA(C0 = D6_MFMA(kf[0], qr[0], C0), P0[2], P0[3], P0[4], P0[5],     pw0[0] = D6_PKW(P0, 0),  pw0[1] = D6_PKW(P0, 2),  pw0); \
    D6_VRD(4); D6_SBAR(); D6_GAPA(C1 = D6_MFMA(kf[1], qr[0], C1), P0[6], P0[7], P0[8], P0[9],     pw0[2] = D6_PKW(P0, 4),  pw0[3] = D6_PKW(P0, 6),  pw0); \
    D6_VRD(1); D6_SBAR(); D6_GAPA(C0 = D6_MFMA(kf[2], qr[1], C0),    P0[10], P0[11], P0[12], P0[13], pw1[0] = D6_PKW(P0, 8),  pw1[1] = D6_PKW(P0, 10), pw1); \
    D6_VRD(5); D6_SBAR(); D6_GAPA(C1 = D6_MFMA(kf[3], qr[1], C1),    P0[14], P0[15], P1[0], P1[1],   pw1[2] = D6_PKW(P0, 12), pw1[3] = D6_PKW(P0, 14), pw1); \
    D6_VRD(2); D6_SBAR(); D6_GAPA(C0 = D6_MFMA(kf[4], qr[2], C0),    P1[2], P1[3], P1[4], P1[5],     pw2[0] = D6_PKW(P1, 0),  pw2[1] = D6_PKW(P1, 2),  pw2); \
    D6_VRD(6); D6_SBAR(); D6_GAPA(C1 = D6_MFMA(kf[5], qr[2], C1),    P1[6], P1[7], P1[8], P1[9],     pw2[2] = D6_PKW(P1, 4),  pw2[3] = D6_PKW(P1, 6),  pw2); \
    D6_VRD(3); D6_SBAR(); D6_GAPA(C0 = D6_MFMA(kf[6], qr[3], C0),    P1[10], P1[11], P1[12], P1[13], pw3[0] = D6_PKW(P1, 8),  pw3[1] = D6_PKW(P1, 10), pw3); \
    D6_VRD(7); D6_SBAR(); D6_GAPA(C1 = D6_MFMA(kf[7], qr[3], C1),    P1[14], P1[15], 0.f, 0.f,       pw3[2] = D6_PKW(P1, 12), pw3[3] = D6_PKW(P1, 14), pw3); \
    l_reg += sacc; \
    if (GK) { A6_POP(sK, Rk, rk); A6_DMA_K(Rk, sl_cur); } if (GV) { A6_POP(sV, Rv, rv); A6_DMA_V(Rv, sl_next); } \
    const LAS float* tpn = ninfp; if (GL) { A6_POP(sT, Rt, rt); tpn = A6_TPTR(Rt, rt); } \
    { const float rm = __builtin_fmaf(d6_rowmax(C0, C1), SCL, -mhat); resc = false; \
      if (__builtin_expect(__any(rm > D6_THR), 0)) { const float dl = __builtin_fmaxf(rm, 0.f); mhat += dl; \
          const float f = __builtin_amdgcn_exp2f(-dl); l_reg *= f; if (hi == 0) wsf[r32] = f; resc = true; } } \
    const float nmh = -mhat; D6_SBAR(); \
    A6_TRD(GL, P0, P1, 0, 4);  D6_GAPB(o[0] = D6_MFMA(D6_PAF(0), vf[0], o[0]), C0, 0);  A6_TRD(GL, P0, P1, 4, 8);  D6_GAPB(o[1] = D6_MFMA(D6_PAF(0), vf[4], o[1]), C0, 4); \
    D6_KRD(GL, 0); D6_GAPB(o[0] = D6_MFMA(D6_PAF(1), vf[1], o[0]), C0, 8);  D6_KRD(GL, 1); D6_GAPB(o[1] = D6_MFMA(D6_PAF(1), vf[5], o[1]), C0, 12); \
    D6_KRD(GL, 2); D6_GAPB(o[0] = D6_MFMA(D6_PAF(2), vf[2], o[0]), C1, 0);  D6_KRD(GL, 3); D6_GAPB(o[1] = D6_MFMA(D6_PAF(2), vf[6], o[1]), C1, 4); \
    A6_TRD(GL, P0, P1, 8, 12); D6_GAPB(o[0] = D6_MFMA(D6_PAF(3), vf[3], o[0]), C1, 8);  A6_TRD(GL, P0, P1, 12, 16); D6_GAPB(o[1] = D6_MFMA(D6_PAF(3), vf[7], o[1]), C1, 12); \
    } while (0)
    int t = 1;
    for (; t + 5 < NT_; t += 2) {
        A6_STEP(pB0, pB1, pA0, pA1, true, true, true); D6_WAIT_BAR(2); D6_RESC(); D6_ROT();
        A6_STEP(pA0, pA1, pB0, pB1, true, true, true); D6_WAIT_BAR(2); D6_RESC(); D6_ROT();
    }
    for (; t + 1 < NT_; t += 2) {
        A6_STEP(pB0, pB1, pA0, pA1, (t + 3 < NT_), (t + 1 < NT_), (t + 1 < NT_));         D6_ENDW(t);     D6_RESC(); D6_ROT();
        A6_STEP(pA0, pA1, pB0, pB1, (t + 4 < NT_), (t + 2 < NT_), (t + 2 < NT_));         D6_ENDW(t + 1); D6_RESC(); D6_ROT();
    }
    A6_STEP(pB0, pB1, pA0, pA1, false, false, false); D6_RESC();
    { float sacc = pB0[0] + pB0[1];
#pragma unroll
      for (int r = 2; r < 16; ++r) sacc += pB0[r];
#pragma unroll
      for (int r = 0; r < 16; ++r) sacc += pB1[r];
      l_reg += sacc;
      pw0 = (u32x4_t_){D6_PKW(pB0, 0), D6_PKW(pB0, 2), D6_PKW(pB0, 4), D6_PKW(pB0, 6)}; pw1 = (u32x4_t_){D6_PKW(pB0, 8), D6_PKW(pB0, 10), D6_PKW(pB0, 12), D6_PKW(pB0, 14)};
      pw2 = (u32x4_t_){D6_PKW(pB1, 0), D6_PKW(pB1, 2), D6_PKW(pB1, 4), D6_PKW(pB1, 6)}; pw3 = (u32x4_t_){D6_PKW(pB1, 8), D6_PKW(pB1, 10), D6_PKW(pB1, 12), D6_PKW(pB1, 14)};
      const d6_lptr vp_ = vp0 + sl_cur; _Pragma("unroll") for (int i = 0; i < 8; ++i) D6_VRD(i);
      o[0] = D6_MFMA(D6_PAF(0), vf[0], o[0]); o[1] = D6_MFMA(D6_PAF(0), vf[4], o[1]); o[0] = D6_MFMA(D6_PAF(1), vf[1], o[0]); o[1] = D6_MFMA(D6_PAF(1), vf[5], o[1]);
      o[0] = D6_MFMA(D6_PAF(2), vf[2], o[0]); o[1] = D6_MFMA(D6_PAF(2), vf[6], o[1]); o[0] = D6_MFMA(D6_PAF(3), vf[3], o[0]); o[1] = D6_MFMA(D6_PAF(3), vf[7], o[1]); }
    l_out = l_reg;
    asm volatile("s_waitcnt vmcnt(0) lgkmcnt(0)\n\ts_barrier" ::: "memory");
}
typedef float f32x4_t_ __attribute__((ext_vector_type(4)));
constexpr int TA_HS = 2048 + 128 + 8;
constexpr int TW_N = 648, TW_HS = 680;
__device__ __forceinline__ void bunit_A(const bf16_t* P, const bf16_t* VT, const bf16_t* KCMP, const bf16_t* VCMPT, const float* GT, bf16_t* MIX, const LAS float* tabA4, const LAS float* tabW4, LAS float* osc  ,
                                        LAS float* wsf  , volatile LAS unsigned* um  , LAS unsigned char* ring, int b, int g, int q64, int tid, int wib) {
    asm volatile("" : "+v"(tid));
    int lane = tid & 63; asm volatile("" : "+v"(lane));
    const int c = lane & 31, h = lane >> 5, hh = c >> 3, qi = c & 7, t0 = 64 * q64 + 8 * wib, tc = t0 + qi, head = g * 4 + hh;
    const size_t rowq = (size_t)b * S + tc;
    abf16x8 qf[4];
#pragma unroll
    for (int s = 0; s < 4; ++s) qf[s] = *(const abf16x8*)(P + rowq * LDP + C_AQ + head * 64 + 16 * s + 8 * h);
    const LAS float* tabh = tabA4 + hh * TA_HS;
    unsigned selmask = 0u;
    TS_BEGIN(1)
    {
        const int ncv = tc >= 31 ? ((tc - 31) >> 4) + 1 : 0;
        const bf16_t* kp = KCMP + ((size_t)(b * 2 + g) * 128 + pi32(c)) * 64 + 8 * h;
        const bf16_t* vp = VCMPT + ((size_t)(b * 2 + g) * 64 + c) * 128 + 8 * h;
        const LAS float* tabp = tabh + (2047 - tc + 31 + 128 * h);
        float sc[4][16]; float mx = -INFINITY;
        abf16x8 kcf[4][4];
#pragma unroll
        for (int kt = 0; kt < 4; ++kt)
#pragma unroll
            for (int s = 0; s < 4; ++s) kcf[kt][s] = *(const abf16x8*)(kp + (size_t)(32 * kt) * 64 + 16 * s);
#pragma unroll
        for (int kt = 0; kt < 4; ++kt) {
            f32x16 acc;
#pragma unroll
            for (int r = 0; r < 16; ++r) acc[r] = tabp[512 * kt + 16 * ((r & 7) + 16 * (r >> 3))];
#pragma unroll
            for (int s = 0; s < 4; ++s) acc = __builtin_amdgcn_mfma_f32_32x32x16_bf16(kcf[kt][s], qf[s], acc, 0, 0, 0);
#pragma unroll
            for (int r = 0; r < 16; ++r) {
                const int ko = (r & 7) + 16 * (r >> 3);
                const bool ok = 32 * kt + 8 * h + ko < ncv;
                const float x = ok ? acc[r] * SCL : -INFINITY;
                sc[kt][r] = x; mx = fmaxf(mx, x);
            }
        }
        abf16x8 vcf[4][4];
#pragma unroll
        for (int kt = 0; kt < 4; ++kt)
#pragma unroll
            for (int dh = 0; dh < 2; ++dh)
#pragma unroll
                for (int s2 = 0; s2 < 2; ++s2) vcf[kt][dh * 2 + s2] = *(const abf16x8*)(vp + (size_t)dh * 32 * 128 + 32 * kt + 16 * s2);
        mx = fmaxf(mx, __shfl_xor(mx, 32)); mx = fmaxf(mx, -1e30f);
        float sum = 0.f;
#pragma unroll
        for (int kt = 0; kt < 4; ++kt)
#pragma unroll
            for (int r = 0; r < 16; ++r) { sc[kt][r] = __builtin_amdgcn_exp2f(sc[kt][r] - mx); sum += sc[kt][r]; }
        sum += __shfl_xor(sum, 32);
        const float inv = 1.f / fmaxf(sum, 1e-30f);
        f32x16 oc[2];
#pragma unroll
        for (int r = 0; r < 16; ++r) { oc[0][r] = 0.f; oc[1][r] = 0.f; }
#pragma unroll
        for (int kt = 0; kt < 4; ++kt) {
#pragma unroll
            for (int r = 0; r < 16; ++r) sc[kt][r] *= inv;
            abf16x8 pf[2];
#pragma unroll
            for (int s2 = 0; s2 < 2; ++s2) {
                u32x4_t_ w; w.x = cvtpk(sc[kt][8 * s2 + 0], sc[kt][8 * s2 + 1]); w.y = cvtpk(sc[kt][8 * s2 + 2], sc[kt][8 * s2 + 3]); w.z = cvtpk(sc[kt][8 * s2 + 4], sc[kt][8 * s2 + 5]); w.w = cvtpk(sc[kt][8 * s2 + 6], sc[kt][8 * s2 + 7]);
                pf[s2] = __builtin_bit_cast(abf16x8, w);
            }
#pragma unroll
            for (int dh = 0; dh < 2; ++dh)
#pragma unroll
                for (int s2 = 0; s2 < 2; ++s2) oc[dh] = __builtin_amdgcn_mfma_f32_32x32x16_bf16(pf[s2], vcf[kt][dh * 2 + s2], oc[dh], 0, 0, 0);
        }
        float x7[4], x15[4];
#pragma unroll
        for (int kt = 0; kt < 4; ++kt) { x7[kt] = __shfl_xor(sc[kt][7], 32); x15[kt] = __shfl_xor(sc[kt][15], 32); }
        unsigned key[16];
        const int cur = q64;
#pragma unroll
        for (int kt = 0; kt < 4; ++kt)
#pragma unroll
            for (int gb = 0; gb < 2; ++gb) {
                const float pl0 = gb == 0 ? (kt > 0 ? x15[kt > 0 ? kt - 1 : 0] : 0.f) : x7[kt];
                const float pl1 = gb == 0 ? x7[kt] : x15[kt];
                const float prevlast = h ? pl1 : pl0;
                float ie = prevlast + sc[kt][8 * gb + 0] + sc[kt][8 * gb + 1] + sc[kt][8 * gb + 2] + sc[kt][8 * gb + 3];
                float io = sc[kt][8 * gb + 3] + sc[kt][8 * gb + 4] + sc[kt][8 * gb + 5] + sc[kt][8 * gb + 6] + sc[kt][8 * gb + 7];
                ie += __shfl_xor(ie, 8); ie += __shfl_xor(ie, 16);
                io += __shfl_xor(io, 8); io += __shfl_xor(io, 16);
#pragma unroll
                for (int eo = 0; eo < 2; ++eo) {
                    const int n = 8 * kt + 2 * h + 4 * gb + eo;
                    const bool forced = n == 0 || n == cur || n == cur - 1;
                    const float v = forced ? 1e4f : (eo ? io : ie);
                    key[(kt * 2 + gb) * 2 + eo] = n > cur ? (unsigned)(31 - n) : ((((__float_as_uint(v) >> 5) + 1u) << 5) | (unsigned)(31 - n));
                }
            }
#pragma unroll 1
        for (int round = 0; round < 8; ++round) {
            unsigned lm = key[0];
#pragma unroll
            for (int i = 1; i < 16; ++i) lm = lm > key[i] ? lm : key[i];
            const unsigned pm = (unsigned)__shfl_xor((int)lm, 32);
            const unsigned best = lm > pm ? lm : pm;
            selmask |= 1u << (31 - (best & 31u));
#pragma unroll
            for (int i = 0; i < 16; ++i) key[i] = key[i] == best ? 0u : key[i];
        }
        if (h == 0) wsf[32 + c] = sigmoidf(GT[rowq * 24 + 0 * 8 + head]);
        asm volatile("s_waitcnt lgkmcnt(0)" ::: "memory");
#pragma unroll
        for (int r = 0; r < 16; ++r) { const int row = d6_crow(r, h); const float g0 = wsf[32 + row]; osc[row * 64 + c] = oc[0][r] * g0; osc[row * 64 + 32 + c] = oc[1][r] * g0; }
    }
    TS_END(1)
    unsigned umask = selmask;
#pragma unroll
    for (int o = 1; o < 64; o <<= 1) umask |= (unsigned)__shfl_xor((int)umask, o);
    umask = __builtin_amdgcn_readfirstlane(umask) & (0xffffffffu >> (31 - q64));
    if (lane == 0) um[wib] = umask;
    __syncthreads();
    unsigned bmask = 0u;
#pragma unroll
    for (int w = 0; w < 8; ++w) bmask |= um[w];
    bmask = __builtin_amdgcn_readfirstlane(bmask);
    {
        int h2 = lane >> 5; asm volatile("" : "+v"(h2));
        int c2 = lane & 31; asm volatile("" : "+v"(c2));
        f32x16 o[2]; float l;
        TS_BEGIN(2)
        a_sweep64<true>(P + (size_t)b * S * LDP + C_AKS + g * 64, VT + (size_t)(VR_AVS + g * 64) * M + (size_t)b * S, ring, wsf, bmask, selmask, tabh + (2047 - tc + 8 * h2), tabh + 2112, qf, o, l, tid);
        TS_END(2)
        { auto rr = __builtin_amdgcn_permlane32_swap(__float_as_uint(l), __float_as_uint(l), false, false); l = __uint_as_float(rr[0]) + __uint_as_float(rr[1]); }
        if (h2 == 0) wsf[32 + c2] = sigmoidf(GT[rowq * 24 + 1 * 8 + head]) / l;
        asm volatile("s_waitcnt lgkmcnt(0)" ::: "memory");
#pragma unroll
        for (int r = 0; r < 16; ++r) { const int row = d6_crow(r, h2); const float g1 = wsf[32 + row]; osc[row * 64 + c2] += o[0][r] * g1; osc[row * 64 + 32 + c2] += o[1][r] * g1; }
    }
    {
        int h2 = lane >> 5; asm volatile("" : "+v"(h2));
        int c2 = lane & 31; asm volatile("" : "+v"(c2));
        const LAS float* tabw = tabW4 + (c2 >> 3) * TW_HS;
        const int Rlo = (64 * q64 - 511 > 0 ? 64 * q64 - 511 : 0) >> 6;
        const unsigned rm = (0xffffffffu >> (31 - q64)) & (0xffffffffu << Rlo);
        f32x16 o[2]; float l;
        TS_BEGIN(3)
        a_sweep64<false>(P + (size_t)b * S * LDP + C_AKW + g * 64, VT + (size_t)(VR_AVW + g * 64) * M + (size_t)b * S, ring, wsf, rm, 0u, tabw + (575 - tc + 8 * h2), tabw + 576, qf, o, l, tid);
        TS_END(3)
        { auto rr = __builtin_amdgcn_permlane32_swap(__float_as_uint(l), __float_as_uint(l), false, false); l = __uint_as_float(rr[0]) + __uint_as_float(rr[1]); }
        if (h2 == 0) wsf[32 + c2] = sigmoidf(GT[rowq * 24 + 2 * 8 + head]) / l;
        asm volatile("s_waitcnt lgkmcnt(0)" ::: "memory");
#pragma unroll
        for (int r = 0; r < 16; ++r) { const int row = d6_crow(r, h2); const float g2 = wsf[32 + row]; osc[row * 64 + c2] += o[0][r] * g2; osc[row * 64 + 32 + c2] += o[1][r] * g2; }
        asm volatile("s_waitcnt lgkmcnt(0)" ::: "memory");
        int ln = lane; asm volatile("" : "+v"(ln));
        uint4 gv[4];
#pragma unroll
        for (int i = 0; i < 4; ++i) { const int row = i * 8 + (ln >> 3), ch = ln & 7; gv[i] = *(const uint4*)(P + ((size_t)b * S + t0 + (row & 7)) * LDP + C_AGATE + (g * 4 + (row >> 3)) * 64 + ch * 8); }
#pragma unroll
        for (int i = 0; i < 4; ++i) { const int row = i * 8 + (ln >> 3), ch = ln & 7;
            const f32x4_t_ oa = *(const LAS f32x4_t_*)(osc + row * 64 + ch * 8), ob = *(const LAS f32x4_t_*)(osc + row * 64 + ch * 8 + 4);
            float fg[8]; unpack8(gv[i], fg);
            uint4 w; w.x = cvtpk(oa.x * silu(fg[0]), oa.y * silu(fg[1])); w.y = cvtpk(oa.z * silu(fg[2]), oa.w * silu(fg[3]));
            w.z = cvtpk(ob.x * silu(fg[4]), ob.y * silu(fg[5])); w.w = cvtpk(ob.z * silu(fg[6]), ob.w * silu(fg[7]));
            *(uint4*)(MIX + ((size_t)b * S + t0 + (row & 7)) * DM + (g * 4 + (row >> 3)) * 64 + ch * 8) = w; }
    }
}

typedef __attribute__((address_space(1))) unsigned gu32;
constexpr size_t WS_CTL = 0; constexpr size_t CTL_ZERO_BYTES = 64 * 1024; constexpr int CW_BAR = 1024;
constexpr int MISC_OFF = LDS_BYTES - 128;
#define XB_TMO      128
#define XB_XCNT(j)  (256  + 64 * (j))
#define XB_XSUB(j)  (1280 + 64 * (j))
#define XB_XGEN(j)  (2304 + 64 * (j))
#define XB_TOP      3328
#define XB_TOPGEN   3392
#define XCD_BAR_WORDS 3456
#define XB_SPIN_CAP (1u << 18)

__device__ __forceinline__ unsigned xb_ld(unsigned* p)              { return __hip_atomic_load(p, __ATOMIC_RELAXED, __HIP_MEMORY_SCOPE_AGENT); }
__device__ __forceinline__ unsigned xb_add(unsigned* p, unsigned v) { return __hip_atomic_fetch_add(p, v, __ATOMIC_RELAXED, __HIP_MEMORY_SCOPE_AGENT); }
__device__ __forceinline__ unsigned xb_xcc_id() { return (unsigned)__builtin_amdgcn_s_getreg((3 << 11) | 20) & 0xFu; }
#define XB_SPIN(cond, bar) do { unsigned _sp = 0; while (cond) { __builtin_amdgcn_s_sleep(1); \
    if ((++_sp & 255u) == 0u) { if (xb_ld(&(bar)[XB_TMO])) break; if (_sp > XB_SPIN_CAP) { atomicAdd(&(bar)[XB_TMO], 1u); break; } } } } while (0)

struct XcdBarrier {
    unsigned* bar; unsigned x;
    volatile LAS unsigned* st;
};

__device__ __forceinline__ XcdBarrier xcd_barrier_post(unsigned* bar, volatile LAS unsigned* st) {
    XcdBarrier b; b.bar = bar; b.x = xb_xcc_id(); b.st = st;
    if (threadIdx.x == 0) (void)xb_add(&bar[XB_XCNT(b.x)], 1u);
    return b;
}
__device__ __forceinline__ void xcd_barrier_complete(unsigned* bar, unsigned x, unsigned& nloc, unsigned& nx) {
    const unsigned G = gridDim.x * gridDim.y * gridDim.z;
    unsigned sum, cnt, mine, sp = 0u;
    for (;;) {
        sum = 0u; cnt = 0u; mine = 0u;
#pragma unroll
        for (unsigned j = 0; j < 16; ++j) { const unsigned c = xb_ld(&bar[XB_XCNT(j)]); sum += c; cnt += (c > 0u) ? 1u : 0u; mine = (j == x) ? c : mine; }
        if (sum == G) break;
        __builtin_amdgcn_s_sleep(1);
        if ((++sp & 255u) == 0u) { if (xb_ld(&bar[XB_TMO])) break; if (sp > XB_SPIN_CAP) { atomicAdd(&bar[XB_TMO], 1u); break; } }
    }
    nloc = mine > 0u ? mine : 1u; nx = cnt > 0u ? cnt : 1u;
}

__device__ __forceinline__ void xcd_barrier(const XcdBarrier& b) {
    asm volatile("s_waitcnt vmcnt(0)" ::: "memory");
    __syncthreads();
    if (threadIdx.x == 0) {
        unsigned* bar = b.bar;
        __builtin_amdgcn_s_waitcnt(0);
        unsigned nloc = b.st[0], nx = b.st[1];
        if (nloc == 0u) { xcd_barrier_complete(bar, b.x, nloc, nx); b.st[0] = nloc; b.st[1] = nx; }
        const unsigned old = xb_add(&bar[XB_XSUB(b.x)], 1u);
        const unsigned gen = old / nloc;
        if (old + 1u == (gen + 1u) * nloc) {
            __builtin_amdgcn_fence(__ATOMIC_RELEASE, "agent");
            asm volatile("s_waitcnt vmcnt(0)" ::: "memory");
            const unsigned og = xb_add(&bar[XB_TOP], 1u);
            const unsigned tg = og / nx;
            if (og + 1u == (tg + 1u) * nx) xb_add(&bar[XB_TOPGEN], 1u);
            else XB_SPIN(xb_ld(&bar[XB_TOPGEN]) == tg, bar);
            __builtin_amdgcn_fence(__ATOMIC_ACQUIRE, "agent");
            xb_add(&bar[XB_XGEN(b.x)], 1u);
            asm volatile("s_waitcnt vmcnt(0)" ::: "memory");
        } else {
            XB_SPIN(xb_ld(&bar[XB_XGEN(b.x)]) == gen, bar);
            __builtin_amdgcn_fence(__ATOMIC_ACQUIRE, "agent");
            asm volatile("s_waitcnt vmcnt(0)" ::: "memory");
        }
    }
    __syncthreads();
}


typedef unsigned u4v_nt __attribute__((ext_vector_type(4)));
__device__ __forceinline__ uint4 ld_nt16(const void* p) { const u4v_nt t = __builtin_nontemporal_load((const u4v_nt*)p); return make_uint4(t.x, t.y, t.z, t.w); }
constexpr int CW_SPLIT = 8192;
__device__ __forceinline__ void split_arrive(unsigned* cnt) {
    asm volatile("s_waitcnt vmcnt(0)" ::: "memory");
    __syncthreads();
    if (threadIdx.x == 0) {
        __builtin_amdgcn_fence(__ATOMIC_RELEASE, "agent");
        asm volatile("s_waitcnt vmcnt(0)" ::: "memory");
        (void)__hip_atomic_fetch_add(cnt, 1u, __ATOMIC_RELAXED, __HIP_MEMORY_SCOPE_AGENT);
    }
}
__device__ __forceinline__ void split_wait(unsigned* cnt, unsigned* tmo) {
    if (threadIdx.x == 0) {
        const unsigned G = gridDim.x; unsigned sp = 0u;
        while (__hip_atomic_load(cnt, __ATOMIC_RELAXED, __HIP_MEMORY_SCOPE_AGENT) < G) {
            __builtin_amdgcn_s_sleep(1);
            if ((++sp & 255u) == 0u) { if (__hip_atomic_load(tmo, __ATOMIC_RELAXED, __HIP_MEMORY_SCOPE_AGENT)) break; if (sp > XB_SPIN_CAP) { atomicAdd(tmo, 1u); break; } }
        }
        __builtin_amdgcn_fence(__ATOMIC_ACQUIRE, "agent");
        asm volatile("s_waitcnt vmcnt(0)" ::: "memory");
    }
    __syncthreads();
}

#define LAUNDER_S(x)
#define PH_COMMON \
    int tid_ = threadIdx.x; asm volatile("" : "+v"(tid_)); const int tid = tid_, lane = tid & 63, wib = __builtin_amdgcn_readfirstlane(tid >> 6); \
    const int G = gridDim.x; const int vblk = (G & 7) == 0 ? (int)(blockIdx.x & 7) * (G >> 3) + (int)(blockIdx.x >> 3) : (int)blockIdx.x;     \
    const int gthreads = G * NT, gtid = vblk * NT + tid; const int gwaves = G * NWAVES, gwave = vblk * NWAVES + wib; \
    unsigned char* ws = prm.ws; asm volatile("" : "+s"(ws)); (void)lane; (void)gthreads; (void)gtid; (void)gwaves; (void)gwave; (void)ws;

__device__ __forceinline__ void phase_prologue(const Params& prm, LAS unsigned char* ldsb, int part) {
    PH_COMMON
    float* biasd = (float*)(ws + WS_BIASD); bf16_t* WG = (bf16_t*)(ws + WS_WG);
    bf16_t* WINT = (bf16_t*)(ws + WS_WIN); bf16_t* WOUTT = (bf16_t*)(ws + WS_WOUT); bf16_t* XB = (bf16_t*)(ws + WS_XB);
    if (part == 1) for (int i = gtid; i < 24 * 2048; i += gthreads) { const int h = i >> 11, d = i & 2047; biasd[i] = prm.rel_bias[t5_bucket(d) * 24 + h]; }
    if (part == 1) {
        float* img = (float*)(ws + WS_IMG);
        for (int i = gtid; i < 8 * 2048; i += gthreads) { const int h = i >> 11, d = 2047 - (i & 2047);
            img[i] = prm.rel_bias[t5_bucket(d) * 24 + h] * LOG2E;
            const int mult = (d <= 128 ? 1 : 0) + (((d & 3) == 0 && d <= 512) ? 1 : 0) + ((d & 15) == 0 ? 1 : 0);
            img[8 * 2048 + i] = mult == 0 ? -INFINITY : prm.rel_bias[t5_bucket(d) * 24 + 16 + h] * LOG2E + (mult == 1 ? 0.f : (mult == 2 ? 1.f : 1.5849625007211562f)); }
        for (int i = gtid; i < 8 * 256; i += gthreads) { const int h = i >> 8, d = 255 - (i & 255); img[16 * 2048 + i] = prm.rel_bias[t5_bucket(d) * 24 + 8 + h] * LOG2E; }
    }
    if (part == 0) for (int i = gtid; i < DEPTH * 256 * 32; i += gthreads) { const int j = i & 31, k8 = (i >> 5) & 255, l = i >> 13;
        uint4 o = make_uint4(0u, 0u, 0u, 0u);
        if (j < 24) { float v[8];
#pragma unroll
            for (int e = 0; e < 8; ++e) { const int k = 8 * k8 + e; v[e] = prm.w_in[(size_t)l * DM * DIN + (size_t)k * DIN + SRC_GATES + j] * prm.norm_w[l * DM + k]; }
            o = make_uint4(pk2(v[0], v[1]), pk2(v[2], v[3]), pk2(v[4], v[5]), pk2(v[6], v[7])); }
        *(uint4*)(WG + (size_t)i * 8) = o; }
    if (part == 1) {
        bf16_t* W1T = (bf16_t*)(ws + WS_W1T); bf16_t* W2T = (bf16_t*)(ws + WS_W2T); bf16_t* POSB = (bf16_t*)(ws + WS_PB);
        for (int i = gtid; i < 4 * 256 * 128; i += gthreads) { const int j = i & 127, g8 = (i >> 7) & 255, lw = i >> 15;
            float v[8];
#pragma unroll
            for (int e = 0; e < 8; ++e) { const int kk = 8 * g8 + e; const int k = (lw & 1) ? ((kk & 31) * 64 + (kk >> 5)) : kk;
                v[e] = prm.cmp_w1[((size_t)lw * 2048 + k) * 128 + j]; }
            *(uint4*)(W1T + ((size_t)lw * 128 + j) * 2048 + 8 * g8) = make_uint4(pk2(v[0], v[1]), pk2(v[2], v[3]), pk2(v[4], v[5]), pk2(v[6], v[7])); }
        for (int i = gtid; i < 4 * 2048; i += gthreads) { const int kk = i & 2047, lw = i >> 11; const int k = (lw & 1) ? ((kk & 31) * 64 + (kk >> 5)) : kk;
            POSB[i] = f2bf(prm.cmp_pos[(size_t)lw * 2048 + k]); }
        for (int i = gtid; i < 4 * 128 * 64; i += gthreads) { const int e = i & 63, j = (i >> 6) & 127, lw = i >> 13; W2T[((size_t)lw * 64 + e) * 128 + j] = f2bf(prm.cmp_w2[((size_t)lw * 128 + j) * 64 + e]); }
    }
    {
        LAS float* scr = (LAS float*)(ldsb + wib * 8448);
        LAS float* nwl = (LAS float*)(ldsb + 8 * 8448);
        for (int i = tid; i < DEPTH * DM; i += NT) nwl[i] = prm.norm_w[i];
        __syncthreads();
        constexpr int I_IN = 32 * (NW_IN / 32), I_OUT = 32 * (DM / 32), NIT = DEPTH * (I_IN + I_OUT);
        auto decode = [&](int it) -> TrItem {
            const int l = it / (I_IN + I_OUT); int r = it % (I_IN + I_OUT); TrItem t;
            if (r < I_IN) { t.nb = r % (NW_IN / 32); t.kb = r / (NW_IN / 32); t.W = prm.w_in + (size_t)l * DM * DIN; t.K = DM; t.srcld = DIN; t.src_n0 = src_col_of(32 * t.nb) - 32 * t.nb; t.ksc = nwl + l * DM; t.WT = WINT + (size_t)l * NW_IN * DM; }
            else { r -= I_IN; t.nb = r % (DM / 32); t.kb = r / (DM / 32); t.W = prm.w_out + (size_t)l * DM * DM; t.K = DM; t.srcld = DM; t.src_n0 = 0; t.ksc = nullptr; t.WT = WOUTT + (size_t)l * DM * DM; }
            return t; };
        float wa[32], wb[32]; TrItem ta, tb;
        const int itend = part == 0 ? I_IN : NIT;
        int it = (part == 0 ? 0 : I_IN) + gwave;
        if (it < itend) { ta = decode(it); tr_load(ta, wa, lane); }
        while (it < itend) {
            const int it2 = it + gwaves;
            if (it2 < itend) { tb = decode(it2); tr_load(tb, wb, lane); }
            tr_store(ta, wa, scr, lane);
            const int it3 = it2 + gwaves;
            if (it3 < itend) { ta = decode(it3); tr_load(ta, wa, lane); }
            if (it2 < itend) tr_store(tb, wb, scr, lane);
            it = it3;
        }
    }
    if (part == 0) {
        float* rss = (float*)(ws + WS_RSS);
        for (int i = gtid; i < M; i += gthreads) rss[M + i] = 0.f;
        auto rload = [&](int row, float4 (&v)[8]) { const float4* xr = (const float4*)(prm.x + (size_t)row * DM) + lane;
#pragma unroll
            for (int j = 0; j < 8; ++j) { typedef float f4v __attribute__((ext_vector_type(4))); const f4v t4 = __builtin_nontemporal_load((const f4v*)&xr[64 * j]); v[j] = make_float4(t4.x, t4.y, t4.z, t4.w); } };
        auto rstore = [&](int row, const float4 (&v)[8]) { uint2* o8 = (uint2*)(XB + (size_t)row * DM) + lane; float sq = 0.f;
#pragma unroll
            for (int j = 0; j < 8; ++j) { sq += (v[j].x * v[j].x + v[j].y * v[j].y) + (v[j].z * v[j].z + v[j].w * v[j].w); o8[64 * j] = make_uint2(pk2(v[j].x, v[j].y), pk2(v[j].z, v[j].w)); }
            sq = wave_sum(sq);
            if (lane == 0) rss[row] = sq; };
        float4 va[8], vb[8];
        int row = gwave;
        if (row < M) rload(row, va);
        while (row < M) {
            const int r2 = row + gwaves;
            if (r2 < M) rload(r2, vb);
            rstore(row, va);
            const int r3 = r2 + gwaves;
            if (r3 < M) rload(r3, va);
            if (r2 < M) rstore(r2, vb);
            row = r3;
        }
    }
}

__device__ __forceinline__ void phase_inproj(const Params& prm, int layer, LAS unsigned char* ldsb) {
    LAUNDER_S(layer);
    unsigned char* ws = prm.ws; asm volatile("" : "+s"(ws));
    const bf16_t* W = (const bf16_t*)(ws + WS_WIN) + (size_t)layer * NW_IN * DM;
    {
        pg8::Gemm g{(const bf16_t*)(ws + WS_XB), W, M, LDP, DM}; pg8::StaticOrder So; So.init(M, LDP, (int)gridDim.x, (int)blockIdx.x);
        pg8::EpiBf16RowScale E{(bf16_t*)(ws + WS_P), LDP, (const float*)(ws + WS_RSS) + (size_t)layer * M};
        pg8::gemm_phase<pg8::EpiBf16RowScale, pg8::StaticOrder, true, true>(ldsb, g, So, E);
    }
    {
        pg8::Gemm g{W + (size_t)LDP * DM, (const bf16_t*)(ws + WS_XB), NVT, M, DM}; pg8::StaticOrder So; So.init(NVT, M, (int)gridDim.x, (int)blockIdx.x);
        pg8::EpiBf16ColScale E{(bf16_t*)(ws + WS_VT), M, (const float*)(ws + WS_RSS) + (size_t)layer * M};
        pg8::gemm_phase<pg8::EpiBf16ColScale, pg8::StaticOrder, true, true>(ldsb, g, So, E);
    }
}
__device__ __forceinline__ void phase_outproj(const Params& prm, int layer, LAS unsigned char* ldsb) {
    LAUNDER_S(layer);
    unsigned char* ws = prm.ws; asm volatile("" : "+s"(ws));
    pg8::Gemm g{(const bf16_t*)(ws + WS_MIX), (const bf16_t*)(ws + WS_WOUT) + (size_t)layer * DM * DM, M, DM, DM}; pg8::StaticOrder So; So.init(M, DM, (int)gridDim.x, (int)blockIdx.x);
    pg8::EpiResidBf16<false> E{nullptr, (bf16_t*)(ws + WS_XB), DM, layer == 0 ? (float*)(ws + WS_RSS) + M : nullptr};
    pg8::gemm_phase<pg8::EpiResidBf16<false>, pg8::StaticOrder, true, true>(ldsb, g, So, E);
}
__device__ __forceinline__ void phase_gates(const Params& prm, int layer, LAS unsigned char* ldsb) {
    LAUNDER_S(layer);
    PH_COMMON
    const bf16_t* XB = (const bf16_t*)(ws + WS_XB); float* GT = (float*)(ws + WS_G);
    const bf16_t* wg = (const bf16_t*)(ws + WS_WG) + (size_t)layer * 32 * 2048;
    const float* rss = (const float*)(ws + WS_RSS) + (size_t)layer * M;
    const int c = lane & 31, h = lane >> 5, kq = wib & 3, half = wib >> 2;
    LAS float* red = (LAS float*)ldsb + wib * 1024;
    const bool split = false;
    const int blk0 = split ? 2 * ((int)blockIdx.x - 128) : (int)blockIdx.x, blk1 = split ? ((int)blockIdx.x >= 128 ? blk0 + 2 : blk0) : M / 64, bstep = split ? 1 : G;
    for (int blk = blk0; blk < blk1; blk += bstep) {
        const int row0 = blk * 64 + half * 32;
        const bf16_t* ap = XB + (size_t)(row0 + c) * DM + kq * 512 + 8 * h;
        const bf16_t* bp = wg + ((size_t)(kq * 64 + h) * 32 + c) * 8;
        f32x16 acc;
#pragma unroll
        for (int r = 0; r < 16; ++r) acc[r] = 0.f;
#pragma unroll 8
        for (int s = 0; s < 32; ++s) acc = __builtin_amdgcn_mfma_f32_32x32x16_bf16(*(const abf16x8*)(ap + 16 * s), *(const abf16x8*)(bp + (size_t)s * 512), acc, 0, 0, 0);
#pragma unroll
        for (int r = 0; r < 16; ++r) red[r * 64 + lane] = acc[r];
        __syncthreads();
        if (kq == 0 && c < 24) {
#pragma unroll
            for (int r = 0; r < 16; ++r) { const float v = (red[r * 64 + lane] + red[1024 + r * 64 + lane]) + (red[2048 + r * 64 + lane] + red[3072 + r * 64 + lane]);
                const int row = row0 + (r & 3) + 8 * (r >> 2) + 4 * h;
                GT[(size_t)row * 24 + c] = v * rsqrtf(rss[row] * (1.f / 2048.f) + 1e-6f); }
        }
        __syncthreads();
    }
}
__device__ __forceinline__ void phase_compress(const Params& prm, int layer, LAS unsigned char* ldsb) {
    LAUNDER_S(layer);
    PH_COMMON
    const bf16_t* P = (const bf16_t*)(ws + WS_P); const bf16_t* VT = (const bf16_t*)(ws + WS_VT);
    bf16_t* KCMP = (bf16_t*)(ws + WS_CMP); bf16_t* VCMPT = KCMP + (size_t)NB * 2 * 128 * 64;
    const int c = lane & 31, h = lane >> 5, jt = wib & 3, kh = wib >> 2;
    LAS float* red = (LAS float*)ldsb;
    LAS float* hid = (LAS float*)(ldsb + 32768);
    for (int u = blockIdx.x; u < 2 * NB * 2 * 4; u += G) {
        const int ct = u & 3, g = (u >> 2) & 1, b = (u >> 3) & 7, which = u >> 6;
        const int lw = layer * 2 + which;
        const bf16_t* w1 = (const bf16_t*)(ws + WS_W1T) + ((size_t)lw * 128 + jt * 32 + c) * 2048 + kh * 1024 + 8 * h;
        const bf16_t* posb = (const bf16_t*)(ws + WS_PB) + (size_t)lw * 2048 + kh * 1024 + 8 * h;
        int cc = ct * 32 + c; if (cc > NCMP - 1) cc = NCMP - 1;
        f32x16 acc;
#pragma unroll
        for (int r = 0; r < 16; ++r) acc[r] = 0.f;
        if (which == 0) {
            const bf16_t* src = P + (size_t)(b * S + 16 * cc) * LDP + C_AKC + g * 64 + 8 * h;
#pragma unroll 8
            for (int s = 0; s < 64; ++s) { const int ks = kh * 64 + s;
                const abf16x8 wf = *(const abf16x8*)(w1 + 16 * s);
                acc = __builtin_amdgcn_mfma_f32_32x32x16_bf16(wf, *(const abf16x8*)(src + (size_t)(ks >> 2) * LDP + (ks & 3) * 16), acc, 0, 0, 0);
                acc = __builtin_amdgcn_mfma_f32_32x32x16_bf16(wf, *(const abf16x8*)(posb + 16 * s), acc, 0, 0, 0); }
        } else {
            const bf16_t* src = VT + (size_t)(VR_AVC + g * 64) * M + (size_t)(b * S + 16 * cc) + 8 * h;
#pragma unroll 8
            for (int s = 0; s < 64; ++s) { const int ks = kh * 64 + s;
                const abf16x8 wf = *(const abf16x8*)(w1 + 16 * s);
                acc = __builtin_amdgcn_mfma_f32_32x32x16_bf16(wf, *(const abf16x8*)(src + (size_t)(ks >> 1) * M + (ks & 1) * 16), acc, 0, 0, 0);
                acc = __builtin_amdgcn_mfma_f32_32x32x16_bf16(wf, *(const abf16x8*)(posb + 16 * s), acc, 0, 0, 0); }
        }
#pragma unroll
        for (int r = 0; r < 16; ++r) red[wib * 1024 + r * 64 + lane] = acc[r];
        __syncthreads();
        if (wib < 4) {
#pragma unroll
            for (int r = 0; r < 16; ++r) { const int j = jt * 32 + (r & 3) + 8 * (r >> 2) + 4 * h;
                hid[j * 32 + c] = silu(red[wib * 1024 + r * 64 + lane] + red[(wib + 4) * 1024 + r * 64 + lane]); }
        }
        __syncthreads();
        if (wib < 2) {
            const bf16_t* w2 = (const bf16_t*)(ws + WS_W2T) + ((size_t)lw * 64 + wib * 32 + c) * 128 + 8 * h;
            f32x16 o;
#pragma unroll
            for (int r = 0; r < 16; ++r) o[r] = 0.f;
#pragma unroll
            for (int s = 0; s < 8; ++s) {
                u32x4_t_ w; const LAS float* hp = hid + (16 * s + 8 * h) * 32 + c;
                w.x = cvtpk(hp[0], hp[32]); w.y = cvtpk(hp[64], hp[96]); w.z = cvtpk(hp[128], hp[160]); w.w = cvtpk(hp[192], hp[224]);
                o = __builtin_amdgcn_mfma_f32_32x32x16_bf16(*(const abf16x8*)(w2 + 16 * s), __builtin_bit_cast(abf16x8, w), o, 0, 0, 0);
            }
            const int cw = ct * 32 + c;
            if (which == 0) {
                bf16_t* dst = KCMP + ((size_t)(b * 2 + g) * 128 + cw) * 64 + wib * 32 + 4 * h;
#pragma unroll
                for (int rg = 0; rg < 4; ++rg) { uint2 w; w.x = cvtpk(o[4 * rg], o[4 * rg + 1]); w.y = cvtpk(o[4 * rg + 2], o[4 * rg + 3]); *(uint2*)(dst + 8 * rg) = w; }
            } else {
                bf16_t* dst = VCMPT + ((size_t)(b * 2 + g) * 64 + wib * 32 + 4 * h) * 128 + cw;
#pragma unroll
                for (int r = 0; r < 16; ++r) dst[(size_t)((r & 3) + 8 * (r >> 2)) * 128] = f2bf(o[r]);
            }
        }
        __syncthreads();
    }
}
typedef unsigned u32x4_t __attribute__((ext_vector_type(4)));
constexpr int LY_TA = 0, LY_OSC = 4 * TA_HS * 4, LY_UM = LY_OSC + 65536, LY_RING = LY_UM + 256, LY_TW = LY_RING + 6 * D6_SLOT, LY_WSF = LY_TW + 4 * TW_HS * 4, LY_END = LY_WSF + 2048;
static_assert(LY_END <= LDS_BYTES - 128, "phase Y LDS map");
__device__ __forceinline__ void phase_mix_a(const Params& prm, int layer, LAS unsigned char* ldsb) {
    LAUNDER_S(layer);
    PH_COMMON
    const float* GT = (const float*)(ws + WS_G); const bf16_t* KCMP = (const bf16_t*)(ws + WS_CMP); const bf16_t* VCMPT = KCMP + (size_t)NB * 2 * 128 * 64;
    const bf16_t* P = (const bf16_t*)(ws + WS_P); bf16_t* MIX = (bf16_t*)(ws + WS_MIX); const bf16_t* VT = (const bf16_t*)(ws + WS_VT);
    for (int pair = vblk; pair < 256; pair += G) {
        const int bg = pair >> 4, qa = pair & 15;
        __syncthreads();
        {
            const float* src = (const float*)(ws + WS_IMG + (size_t)(bg & 1) * 32768);
            for (int i = tid; i < 4 * 2176; i += NT) { const int hh = i / 2176, e = i - hh * 2176; ((LAS float*)(ldsb + LY_TA))[hh * TA_HS + e] = e < 2048 ? src[hh * 2048 + e] * (1.f / SCL) : -INFINITY; }
            for (int i = tid; i < 4 * TW_N; i += NT) { const int hh = i / TW_N, e = i - hh * TW_N, d = 575 - e; ((LAS float*)(ldsb + LY_TW))[hh * TW_HS + e] = (d < 0 || d > 511) ? -INFINITY : src[hh * 2048 + 2047 - d] * (1.f / SCL); }
        }
        __syncthreads();
#pragma unroll 1
        for (int k = 0; k < 2; ++k)
            bunit_A(P, VT, KCMP, VCMPT, GT, MIX, (const LAS float*)(ldsb + LY_TA), (const LAS float*)(ldsb + LY_TW), (LAS float*)(ldsb + LY_OSC + wib * 8192), (LAS float*)(ldsb + LY_WSF) + wib * 64,
                    (volatile LAS unsigned*)(ldsb + LY_UM), ldsb + LY_RING, bg >> 1, bg & 1, k ? 31 - qa : qa, tid, wib);
    }
}
constexpr int LX_KV = 0, LX_TB = D6_END;
__device__ __forceinline__ void phase_mix_db(const Params& prm, int layer, LAS unsigned char* ldsb) {
    LAUNDER_S(layer);
    PH_COMMON
    const bf16_t* P = (const bf16_t*)(ws + WS_P); bf16_t* MIX = (bf16_t*)(ws + WS_MIX); const bf16_t* VT = (const bf16_t*)(ws + WS_VT);
    const float* sinks = prm.sinks + layer * 8;
    __syncthreads();
    {
        const u32x4_t* src = (const u32x4_t*)(ws + WS_IMG + 131072);
        for (int i = tid; i < 8192 / 16; i += NT) *(LAS u32x4_t*)(ldsb + LX_TB + (i >> 6) * (264 * 4) + (i & 63) * 16) = src[i];
    }
    for (int pair = vblk; pair < 256; pair += G) {
        const int bh = pair >> 2, qa = pair & 3;
        __syncthreads();
        {
            const float* src = (const float*)(ws + WS_IMG + 65536 + (size_t)(bh & 7) * 8192); LAS float* dst = (LAS float*)(ldsb + D6_TD);
            for (int i = tid; i < D6_TDN; i += NT) dst[i] = i < 2048 ? src[i] * (1.f / SCL) : -INFINITY;
        }
        __syncthreads();
#pragma unroll 1
        for (int k = 0; k < 2; ++k) dunit64(P, VT, MIX, ldsb, bh >> 3, bh & 7, k ? 7 - qa : qa, tid);
    }
#pragma unroll 1
    for (int u = vblk; u < 512; u += G) bunit_B(P, VT, MIX, (const LAS float*)(ldsb + LX_TB), sinks, ldsb + LX_KV, u >> 6, (u >> 5) & 1, u & 31, tid, wib);
}
constexpr int CW_CONV = 8192 + 64 * 8;
__device__ __forceinline__ void phase_conv(const Params& prm, int layer, volatile LAS unsigned* slot  ) {
    LAUNDER_S(layer);
    PH_COMMON
    const bf16_t* P = (const bf16_t*)(ws + WS_P); bf16_t* MIX = (bf16_t*)(ws + WS_MIX);
    const float* convw = prm.conv_w + layer * 3 * 512;
    unsigned* ctr = (unsigned*)(ws + WS_CTL) + CW_CONV + 64 * layer;
    constexpr unsigned NCH = M / 16;
    unsigned nxt = 0u;
    if (tid == 0) nxt = __hip_atomic_fetch_add(ctr, 1u, __ATOMIC_RELAXED, __HIP_MEMORY_SCOPE_AGENT);
    for (;;) {
        __syncthreads();
        if (tid == 0) *slot = nxt;
        __syncthreads();
        const unsigned ch = *slot;
        if (ch >= NCH) break;
        if (tid == 0) nxt = __hip_atomic_fetch_add(ctr, 1u, __ATOMIC_RELAXED, __HIP_MEMORY_SCOPE_AGENT);
#pragma unroll
    for (int q = 0; q < 2; ++q) { const int i = (int)ch * 1024 + q * NT + tid; {
        const int c0 = (i & 63) * 8, row = i >> 6, t = row & (S - 1);
        const bf16_t* pr = P + (size_t)row * LDP;
        float cb[8], cg[8], a[8], bb[8], y[8];
        unpack8(ld_nt16(pr + C_CB + c0), cb); unpack8(ld_nt16(pr + C_CGATE + c0), cg);
        unpack8(*(const uint4*)(pr + C_CC + c0), a); unpack8(*(const uint4*)(pr + C_CH + c0), bb);
#pragma unroll
        for (int j = 0; j < 8; ++j) y[j] = convw[2 * 512 + c0 + j] * a[j] * bb[j];
        if (t >= 1) { unpack8(*(const uint4*)(pr + C_CC + c0 - LDP), a); unpack8(*(const uint4*)(pr + C_CH + c0 - LDP), bb);
#pragma unroll
            for (int j = 0; j < 8; ++j) y[j] += convw[1 * 512 + c0 + j] * a[j] * bb[j]; }
        if (t >= 2) { unpack8(*(const uint4*)(pr + C_CC + c0 - 2 * LDP), a); unpack8(*(const uint4*)(pr + C_CH + c0 - 2 * LDP), bb);
#pragma unroll
            for (int j = 0; j < 8; ++j) y[j] += convw[0 * 512 + c0 + j] * a[j] * bb[j]; }
        uint4 w;
        w.x = cvtpk(cb[0] * y[0] * silu(cg[0]), cb[1] * y[1] * silu(cg[1])); w.y = cvtpk(cb[2] * y[2] * silu(cg[2]), cb[3] * y[3] * silu(cg[3]));
        w.z = cvtpk(cb[4] * y[4] * silu(cg[4]), cb[5] * y[5] * silu(cg[5])); w.w = cvtpk(cb[6] * y[6] * silu(cg[6]), cb[7] * y[7] * silu(cg[7]));
        *(uint4*)(MIX + (size_t)row * DM + 1024 + c0) = w;
    } }
    }
}
__device__ __forceinline__ void phase_rss(const Params& prm) {
    PH_COMMON
    const bf16_t* XB = (const bf16_t*)(ws + WS_XB); float* rss = (float*)(ws + WS_RSS) + M;
    for (int row = gwave; row < M; row += gwaves) {
        const uint4* xr = (const uint4*)(XB + (size_t)row * DM) + lane; float sq = 0.f;
#pragma unroll
        for (int j = 0; j < 4; ++j) { float f[8]; unpack8(xr[64 * j], f);
#pragma unroll
            for (int e = 0; e < 8; ++e) sq += f[e] * f[e]; }
        sq = wave_sum(sq);
        if (lane == 0) rss[row] = sq;
    }
}
__device__ __forceinline__ void phase_final(const Params& prm) {
    PH_COMMON
    const bf16_t* XB = (const bf16_t*)(ws + WS_XB);
    for (int row = gwave; row < M; row += gwaves) {
        const uint4* xr = (const uint4*)(XB + (size_t)row * DM) + lane; float sq = 0.f; float f[4][8];
#pragma unroll
        for (int j = 0; j < 4; ++j) { unpack8(ld_nt16(&xr[64 * j]), f[j]);
#pragma unroll
            for (int e = 0; e < 8; ++e) sq += f[j][e] * f[j][e]; }
        const float r = rsqrtf(wave_sum(sq) * (1.f / DM) + 1e-6f);
        float4* o = (float4*)(prm.out + (size_t)row * DM); const float4* w4 = (const float4*)prm.final_norm_w;
#pragma unroll
        for (int j = 0; j < 4; ++j) { const int c4 = (lane + 64 * j) * 2; const float4 wa = w4[c4], wb = w4[c4 + 1];
            typedef float f4v __attribute__((ext_vector_type(4)));
            __builtin_nontemporal_store((f4v){f[j][0] * r * wa.x, f[j][1] * r * wa.y, f[j][2] * r * wa.z, f[j][3] * r * wa.w}, (f4v*)&o[c4]);
            __builtin_nontemporal_store((f4v){f[j][4] * r * wb.x, f[j][5] * r * wb.y, f[j][6] * r * wb.z, f[j][7] * r * wb.w}, (f4v*)&o[c4 + 1]); }
    }
}

#ifndef REP_PRO
#define REP_PRO 1
#endif
#ifndef REP_INP
#define REP_INP 1
#endif
#ifndef REP_GAT
#define REP_GAT 1
#endif
#ifndef REP_CMP
#define REP_CMP 1
#endif
#ifndef REP_MAB
#define REP_MAB 1
#endif
#ifndef REP_MB
#define REP_MB 1
#endif
#ifndef REP_MD
#define REP_MD 1
#endif
#ifndef REP_CNV
#define REP_CNV 1
#endif
#ifndef REP_SYNC
#define REP_SYNC 1
#endif
#define REPEAT(n) _Pragma("unroll 1") for (int rep_ = 0; rep_ < (n); ++rep_)
__global__ void __launch_bounds__(NT, 2) fwd_kernel(Params prm) {
    extern __shared__ __attribute__((aligned(16))) unsigned char lds_raw[];
    LAS unsigned char* ldsb = (LAS unsigned char*)lds_raw;
    volatile LAS unsigned* MISC = (volatile LAS unsigned*)(ldsb + MISC_OFF);
    if (threadIdx.x < 32) MISC[threadIdx.x] = 0u;
    __syncthreads();
    const XcdBarrier bar = xcd_barrier_post((unsigned*)(prm.ws + WS_CTL) + CW_BAR, MISC + 8);
#define GRID_SYNC() do { TS_BEGIN(20) xcd_barrier(bar); TS_END(20) } while (0)
    { TS_BEGIN(8) phase_prologue(prm, ldsb, 0); __syncthreads();
      split_arrive((unsigned*)(prm.ws + WS_CTL) + CW_SPLIT + 64 * 4);
      phase_prologue(prm, ldsb, 1); __syncthreads();
      split_wait((unsigned*)(prm.ws + WS_CTL) + CW_SPLIT + 64 * 4, (unsigned*)(prm.ws + WS_CTL) + CW_BAR + XB_TMO); TS_END(8) }
#pragma unroll
    for (int layer = 0; layer < DEPTH; ++layer) {
        { TS_BEGIN(6) REPEAT(REP_INP) phase_inproj(prm, layer, ldsb); TS_END(6) }
        split_arrive((unsigned*)(prm.ws + WS_CTL) + CW_SPLIT + 64 * (2 * layer));
        REPEAT(REP_GAT) phase_gates(prm, layer, ldsb);
        split_wait((unsigned*)(prm.ws + WS_CTL) + CW_SPLIT + 64 * (2 * layer), (unsigned*)(prm.ws + WS_CTL) + CW_BAR + XB_TMO);
        { TS_BEGIN(21)
        REPEAT(REP_CMP) phase_compress(prm, layer, ldsb);
        split_arrive((unsigned*)(prm.ws + WS_CTL) + CW_SPLIT + 64 * (2 * layer + 1));
        REPEAT(REP_MD) { phase_mix_db(prm, layer, ldsb); __syncthreads(); }
        TS_END(21) }
        split_wait((unsigned*)(prm.ws + WS_CTL) + CW_SPLIT + 64 * (2 * layer + 1), (unsigned*)(prm.ws + WS_CTL) + CW_BAR + XB_TMO);
        { TS_BEGIN(22) REPEAT(REP_MAB) { phase_mix_a(prm, layer, ldsb); __syncthreads(); } TS_END(22) }
        phase_conv(prm, layer, MISC + 16);
        GRID_SYNC();
        { TS_BEGIN(7) phase_outproj(prm, layer, ldsb); TS_END(7) }
        GRID_SYNC();
    }
    phase_final(prm);
    if (TSEL != 0 && blockIdx.x == TSBLK && threadIdx.x == 0) {
        const unsigned long long want = (unsigned long long)TMUL * *TS_ACC_PTR, t0 = __builtin_amdgcn_s_memrealtime();
        while (__builtin_amdgcn_s_memrealtime() - t0 < want) __builtin_amdgcn_s_sleep(32);
    }
}

extern "C" void kernel_launch(void* const* d_in, const int* in_sizes, int n_in, void* d_out, int out_size, void* d_ws, size_t ws_size, hipStream_t stream) {
    static int grid_blocks = 0;
    if (!grid_blocks) {
        int dev = 0, cus = 0, per_cu = 0;
        (void)hipGetDevice(&dev);
        (void)hipDeviceGetAttribute(&cus, hipDeviceAttributeMultiprocessorCount, dev);
        if (hipFuncSetAttribute((const void*)fwd_kernel, hipFuncAttributeMaxDynamicSharedMemorySize, LDS_BYTES) != hipSuccess) fprintf(stderr, "kernel_launch: hipFuncSetAttribute failed\n");
        (void)hipOccupancyMaxActiveBlocksPerMultiprocessor(&per_cu, fwd_kernel, NT, LDS_BYTES);
        if (per_cu < 1) fprintf(stderr, "kernel_launch: occupancy query says %d blocks per CU\n", per_cu);
        grid_blocks = cus;
        if (ws_size < WS_END) fprintf(stderr, "kernel_launch: workspace too small: %zu < %zu\n", ws_size, (size_t)WS_END);
    }
    Params p{};
    p.x = (const float*)d_in[0]; p.norm_w = (const float*)d_in[1]; p.w_in = (const float*)d_in[2]; p.w_out = (const float*)d_in[3];
    p.conv_w = (const float*)d_in[4]; p.sinks = (const float*)d_in[5]; p.cmp_pos = (const float*)d_in[6]; p.cmp_w1 = (const float*)d_in[7];
    p.cmp_w2 = (const float*)d_in[8]; p.rel_bias = (const float*)d_in[9]; p.final_norm_w = (const float*)d_in[10];
    p.out = (float*)d_out; p.ws = (unsigned char*)d_ws;
    if (hipMemsetAsync((char*)d_ws + WS_CTL, 0, CTL_ZERO_BYTES, stream) != hipSuccess) { fprintf(stderr, "kernel_launch: memset of the control words failed\n"); return; }
    hipLaunchKernelGGL(fwd_kernel, dim3(grid_blocks), dim3(NT), LDS_BYTES, stream, p);
    hipError_t e = hipPeekAtLastError();
    if (e != hipSuccess) fprintf(stderr, "launch failed: %s (grid %d)\n", hipGetErrorString(e), grid_blocks);
}
```

```cpp
#define F_TB 1
#define F_RSEL 1
#define F_LAZY 1
#include <hip/hip_runtime.h>
#include <cstdio>
#include <cstdint>

namespace pg8 {
#define PG8_LAS __attribute__((address_space(3)))
typedef unsigned short bf16_t;
typedef short bf16x8 __attribute__((ext_vector_type(8)));
typedef float f32x4 __attribute__((ext_vector_type(4)));
typedef unsigned u32x4 __attribute__((ext_vector_type(4)));
constexpr int BM = 256, BK = 64, HALF = 128, HTB = HALF * BK * 2  , STAGE_BYTES = 8 * HTB, NXCD = 8, WGM = 2;

__host__ __device__ __forceinline__ int lds_byte(int r, int c) { const int st = (r >> 4) * 2 + (c >> 5), rr = r & 15, cc = c & 31, ob = rr * 64 + cc * 2; return st * 1024 + (ob ^ (((ob >> 9) & 1) << 5)); }
__host__ __device__ __forceinline__ void stage_rc(int b, int& R, int& C) { const int st = b / 1024, sb = b % 1024, swz = sb ^ (((sb >> 9) & 1) << 5); R = (st >> 1) * 16 + swz / 64; C = (st & 1) * 32 + (swz % 64) / 2; }
__host__ __device__ __forceinline__ int perm32(int rho) { const int n = rho >> 4, i = rho & 15; return 8 * (i >> 2) + 4 * n + (i & 3); }

struct Unit { int pm, pn; };
struct Gemm { const bf16_t* A; const bf16_t* Bt; int M, N, K; };

struct StaticOrder {
    int nM, nN, nwg, G, c;
    __host__ __device__ void init(int M, int N, int G_, int c_) { nM = M / BM; nN = N / BM; nwg = nM * nN; G = G_; c = c_; }
    __host__ __device__ bool next(int i, Unit& u) const {
        const long L = (long)i * G + c; if (L >= nwg) return false;
        int wgid = (int)L; { const int q = nwg / NXCD, r = nwg % NXCD, xcd = wgid % NXCD, off = wgid / NXCD; wgid = (xcd < r ? xcd * (q + 1) : r * (q + 1) + (xcd - r) * q) + off; }
        const int nig = WGM * nN, gid = wgid / nig, fm = gid * WGM, gsz = (nM - fm) < WGM ? (nM - fm) : WGM;
        u.pm = fm + ((wgid % nig) % gsz); u.pn = (wgid % nig) / gsz; return true;
    }
    __device__ __forceinline__ void a_ready(const Unit&) const {}
    __device__ __forceinline__ void done(const Unit&) const {}
};


struct VtOrder {
    StaticOrder so; bool grouped; int c;
    __host__ __device__ bool next(int i, Unit& u) const {
        if (!grouped) return so.next(i, u);
        if (i > 0) return false;
        const int g = c & 7, j = c >> 3; u.pm = j & 3; u.pn = 8 * g + (j >> 2); return true;
    }
    __device__ __forceinline__ void a_ready(const Unit&) const {}
    __device__ __forceinline__ void done(const Unit&) const {}
};
__device__ __forceinline__ unsigned cvt_pk_bf16(float lo, float hi) { unsigned r; asm volatile("v_cvt_pk_bf16_f32 %0, %1, %2" : "=v"(r) : "v"(lo), "v"(hi)); return r; }
struct EpiBf16 {
    static constexpr bool PERM = true, AFTER_DRAIN = false;
    bf16_t* O; int ldc;
    __device__ __forceinline__ void operator()(const f32x4 (&acc)[2][2][4][2], const Unit& u, int wr, int wc, int fr, int fq) const {
        const int row0 = u.pm * BM + wr * 64 + fr; const int col0 = u.pn * BM + wc * 32 + 8 * fq;
#pragma unroll
        for (int ai = 0; ai < 2; ++ai)
#pragma unroll
            for (int m = 0; m < 4; ++m) { bf16_t* rowp = O + (size_t)(row0 + ai * HALF + m * 16) * ldc + col0;
#pragma unroll
                for (int bj = 0; bj < 2; ++bj) { const f32x4 v0 = acc[ai][bj][m][0], v1 = acc[ai][bj][m][1];
                    u32x4 w; w.x = cvt_pk_bf16(v0[0], v0[1]); w.y = cvt_pk_bf16(v0[2], v0[3]); w.z = cvt_pk_bf16(v1[0], v1[1]); w.w = cvt_pk_bf16(v1[2], v1[3]);
                    *(u32x4*)(rowp + bj * HALF) = w; } }
    }
};
__host__ __device__ constexpr bool is_q_half(int hf) { return hf < 4 || (hf >= 11 && hf < 15) || (hf >= 36 && hf < 40); }
struct EpiBf16RowScale {
    static constexpr bool PERM = true, AFTER_DRAIN = false;
    bf16_t* O; int ldc; const float* rss; bf16_t* KCB;
    __device__ __forceinline__ void operator()(const f32x4 (&acc)[2][2][4][2], const Unit& u, int wr, int wc, int fr, int fq) const {
        const int row0 = u.pm * BM + wr * 64 + fr; const int col0 = u.pn * BM + wc * 32 + 8 * fq;
        float scv[2][4];
#pragma unroll
        for (int ai = 0; ai < 2; ++ai)
#pragma unroll
            for (int m = 0; m < 4; ++m) scv[ai][m] = rss[row0 + ai * HALF + m * 16];
#pragma unroll
        for (int ai = 0; ai < 2; ++ai)
#pragma unroll
            for (int m = 0; m < 4; ++m) { const int row = row0 + ai * HALF + m * 16; bf16_t* rowp = O + (size_t)row * ldc + col0;
                const float sc = rsqrtf(scv[ai][m] * (1.f / 2048.f) + 1e-6f);
                if (u.pn >= 12 && u.pn < 16) {
                    const float s2 = sc * sc;
                    const f32x4 v0 = acc[ai][0][m][0] * acc[ai][1][m][0] * s2, v1 = acc[ai][0][m][1] * acc[ai][1][m][1] * s2;
                    u32x4 w; w.x = cvt_pk_bf16(v0[0], v0[1]); w.y = cvt_pk_bf16(v0[2], v0[3]); w.z = cvt_pk_bf16(v1[0], v1[1]); w.w = cvt_pk_bf16(v1[2], v1[3]);
                    *(u32x4*)(O + (size_t)row * ldc + 3072 + 128 * (u.pn - 12) + wc * 32 + 8 * fq) = w;
                    continue; }
#pragma unroll
                for (int bj = 0; bj < 2; ++bj) { const float scq = is_q_half(u.pn * 2 + bj) ? sc * (0.125f * 1.4426950408889634f) : sc;
                    const f32x4 v0 = acc[ai][bj][m][0] * scq, v1 = acc[ai][bj][m][1] * scq;
                    u32x4 w; w.x = cvt_pk_bf16(v0[0], v0[1]); w.y = cvt_pk_bf16(v0[2], v0[3]); w.z = cvt_pk_bf16(v1[0], v1[1]); w.w = cvt_pk_bf16(v1[2], v1[3]);
                    if (u.pn * 2 + bj == 4) {
                        const int cin = wc * 32 + 8 * fq, gg = cin >> 6, s4 = (cin & 63) >> 4, hh = (cin >> 3) & 1, bb = row >> 11, t = row & 2047, cc = t >> 4, l = t & 15;
                        bf16_t* kb = KCB + (size_t)(bb * 2 + gg) * 4 * 128 * 2 * 32 * 8 + hh * 256;
                        *(u32x4*)(kb + ((size_t)((cc >> 5) * 128 + l * 4 + s4) * 64 + (cc & 31)) * 8) = w;
                        if (cc >= 1) *(u32x4*)(kb + ((size_t)(((cc - 1) >> 5) * 128 + (l + 16) * 4 + s4) * 64 + ((cc - 1) & 31)) * 8) = w; }
                    else *(u32x4*)(rowp + bj * HALF) = w; } }
    }
};
struct EpiBf16ColScale {
    static constexpr bool PERM = true, AFTER_DRAIN = false;
    bf16_t* O; int ldc; const float* rss;
    __device__ __forceinline__ void operator()(const f32x4 (&acc)[2][2][4][2], const Unit& u, int wr, int wc, int fr, int fq) const {
        const int row0 = u.pm * BM + wr * 64 + fr; const int col0 = u.pn * BM + wc * 32 + 8 * fq;
        f32x4 cs[2][2];
#pragma unroll
        for (int bj = 0; bj < 2; ++bj) { cs[bj][0] = *(const f32x4*)(rss + col0 + bj * HALF); cs[bj][1] = *(const f32x4*)(rss + col0 + bj * HALF + 4); }
#pragma unroll
        for (int bj = 0; bj < 2; ++bj) {
            f32x4 c0 = cs[bj][0], c1 = cs[bj][1];
#pragma unroll
            for (int i = 0; i < 4; ++i) { c0[i] = rsqrtf(c0[i] * (1.f / 2048.f) + 1e-6f); c1[i] = rsqrtf(c1[i] * (1.f / 2048.f) + 1e-6f); }
#pragma unroll
            for (int ai = 0; ai < 2; ++ai)
#pragma unroll
                for (int m = 0; m < 4; ++m) { const f32x4 v0 = acc[ai][bj][m][0] * c0, v1 = acc[ai][bj][m][1] * c1;
                    u32x4 w; w.x = cvt_pk_bf16(v0[0], v0[1]); w.y = cvt_pk_bf16(v0[2], v0[3]); w.z = cvt_pk_bf16(v1[0], v1[1]); w.w = cvt_pk_bf16(v1[2], v1[3]);
                    *(u32x4*)(O + (size_t)(row0 + ai * HALF + m * 16) * ldc + col0 + bj * HALF) = w; }
        }
    }
};
template <bool BASE_F32> struct EpiResidBf16 {
    static constexpr bool PERM = true, AFTER_DRAIN = false;
    const float* basef; bf16_t* O; int ldc; float* rss;
    __device__ __forceinline__ void operator()(const f32x4 (&acc)[2][2][4][2], const Unit& u, int wr, int wc, int fr, int fq) const {
        const int row0 = u.pm * BM + wr * 64 + fr; const int col0 = u.pn * BM + wc * 32 + 8 * fq;
        if (BASE_F32) {
#pragma unroll
            for (int ai = 0; ai < 2; ++ai)
#pragma unroll
                for (int m = 0; m < 4; ++m) { const size_t off = (size_t)(row0 + ai * HALF + m * 16) * ldc + col0; float sq = 0.f;
#pragma unroll
                    for (int bj = 0; bj < 2; ++bj) { const f32x4 b0 = *(const f32x4*)(basef + off + bj * HALF), b1 = *(const f32x4*)(basef + off + bj * HALF + 4);
                        const f32x4 v0 = b0 + acc[ai][bj][m][0], v1 = b1 + acc[ai][bj][m][1];
                        u32x4 o; o.x = cvt_pk_bf16(v0[0], v0[1]); o.y = cvt_pk_bf16(v0[2], v0[3]); o.z = cvt_pk_bf16(v1[0], v1[1]); o.w = cvt_pk_bf16(v1[2], v1[3]);
                        *(u32x4*)(O + off + bj * HALF) = o;
                        sq += (v0[0] * v0[0] + v0[1] * v0[1]) + (v0[2] * v0[2] + v0[3] * v0[3]) + (v1[0] * v1[0] + v1[1] * v1[1]) + (v1[2] * v1[2] + v1[3] * v1[3]); }
                    if (rss) { sq += __shfl_xor(sq, 16); sq += __shfl_xor(sq, 32); if (fq == 0) atomicAdd(rss + row0 + ai * HALF + m * 16, sq); } }
        } else {
            u32x4 wv[2][4][2];
#pragma unroll
            for (int ai = 0; ai < 2; ++ai)
#pragma unroll
                for (int m = 0; m < 4; ++m)
#pragma unroll
                    for (int bj = 0; bj < 2; ++bj) wv[ai][m][bj] = *(const u32x4*)(O + (size_t)(row0 + ai * HALF + m * 16) * ldc + col0 + bj * HALF);
#pragma unroll
            for (int ai = 0; ai < 2; ++ai) {
#pragma unroll
                for (int m = 0; m < 4; ++m) { const size_t off = (size_t)(row0 + ai * HALF + m * 16) * ldc + col0; float sq = 0.f;
#pragma unroll
                    for (int bj = 0; bj < 2; ++bj) { const u32x4 ww = wv[ai][m][bj];
                        const f32x4 b0 = (f32x4){__builtin_bit_cast(float, ww.x << 16), __builtin_bit_cast(float, ww.x & 0xffff0000u), __builtin_bit_cast(float, ww.y << 16), __builtin_bit_cast(float, ww.y & 0xffff0000u)};
                        const f32x4 b1 = (f32x4){__builtin_bit_cast(float, ww.z << 16), __builtin_bit_cast(float, ww.z & 0xffff0000u), __builtin_bit_cast(float, ww.w << 16), __builtin_bit_cast(float, ww.w & 0xffff0000u)};
                        const f32x4 v0 = b0 + acc[ai][bj][m][0], v1 = b1 + acc[ai][bj][m][1];
                        u32x4 o; o.x = cvt_pk_bf16(v0[0], v0[1]); o.y = cvt_pk_bf16(v0[2], v0[3]); o.z = cvt_pk_bf16(v1[0], v1[1]); o.w = cvt_pk_bf16(v1[2], v1[3]);
                        *(u32x4*)(O + off + bj * HALF) = o;
                        sq += (v0[0] * v0[0] + v0[1] * v0[1]) + (v0[2] * v0[2] + v0[3] * v0[3]) + (v1[0] * v1[0] + v1[1] * v1[1]) + (v1[2] * v1[2] + v1[3] * v1[3]); }
                    if (rss) { sq += __shfl_xor(sq, 16); sq += __shfl_xor(sq, 32); if (fq == 0) atomicAdd(rss + row0 + ai * HALF + m * 16, sq); } }
            }
        }
    }
};
struct EpiResid {
    static constexpr bool PERM = false, AFTER_DRAIN = false;
    const float* base; float* out; int ldc;
    __device__ __forceinline__ void operator()(const f32x4 (&acc)[2][2][4][2], const Unit& u, int wr, int wc, int fr, int fq) const {
        const int col0 = u.pn * BM + wc * 32 + 4 * fq;
#pragma unroll
        for (int ai = 0; ai < 2; ++ai)
#pragma unroll
            for (int m = 0; m < 4; ++m) { const size_t off = (size_t)(u.pm * BM + ai * HALF + wr * 64 + m * 16 + fr) * ldc + col0;
#pragma unroll
                for (int bj = 0; bj < 2; ++bj)
#pragma unroll
                    for (int n = 0; n < 2; ++n) { const f32x4 bs = *(const f32x4*)(base + off + bj * HALF + n * 16); *(f32x4*)(out + off + bj * HALF + n * 16) = bs + acc[ai][bj][m][n]; } }
    }
};

template <class Epi, class Sched, bool ALIGN_EPI = false, bool SP2 = false>
__device__ __forceinline__ void gemm_phase(PG8_LAS unsigned char* lds, const Gemm g, const Sched& S, const Epi& E) {
    int tid_ = threadIdx.x; asm volatile("" : "+v"(tid_));
    const int tid = tid_, wid = __builtin_amdgcn_readfirstlane(tid >> 6), lane = tid & 63, wr = wid >> 2, wc = wid & 3, fr = lane & 15, fq = lane >> 4;
    const int K = g.K, nt = K / BK;
    unsigned voffA[2], voffB[2];
#pragma unroll
    for (int i = 0; i < 2; ++i) { int R, C; stage_rc(tid * 16 + i * 8192, R, C); const int Rb = Epi::PERM ? ((R & ~31) + perm32(R & 31)) : R;
        voffA[i] = (unsigned)(R * K + C) * 2u; voffB[i] = (unsigned)(Rb * K + C) * 2u; }
    const size_t kstep = (size_t)(BK * 2);
    const size_t hstep = (size_t)HALF * K * 2;
    const size_t tstep = 2 * hstep;
    const unsigned ldsw = (unsigned)wid * 1024u;
    const unsigned ldsm0 = __builtin_amdgcn_readfirstlane((unsigned)(unsigned long long)lds + ldsw);
    const int aoff = lds_byte(wr * 64 + fr, fq * 8), boff = lds_byte(wc * 32 + fr, fq * 8);
#define PG8_SA(b, h) (((b) * 2 + (h)) * HTB)
#define PG8_SB(b, h) ((4 + (b) * 2 + (h)) * HTB)
#define PG8_STAGE(bufoff, gbase, voff) do { _Pragma("unroll") for (int _i = 0; _i < 2; ++_i) \
        asm volatile("s_mov_b32 m0, %0\n\ts_nop 0\n\tglobal_load_lds_dwordx4 %1, %2" :: "s"(ldsm0 + (unsigned)((bufoff) + _i * 8192)), "v"((voff)[_i]), "s"((const char*)(gbase)) : "m0", "memory"); } while (0)
#define PG8_LDA(dst, b, h) do { _Pragma("unroll") for (int m = 0; m < 4; ++m) _Pragma("unroll") for (int k = 0; k < 2; ++k) dst[m][k] = *(const PG8_LAS bf16x8*)(lds + PG8_SA(b, h) + aoff + m * 2048 + k * 1024); } while (0)
#define PG8_LDB(dst, b, h) do { _Pragma("unroll") for (int n = 0; n < 2; ++n) _Pragma("unroll") for (int k = 0; k < 2; ++k) dst[n][k] = *(const PG8_LAS bf16x8*)(lds + PG8_SB(b, h) + boff + n * 2048 + k * 1024); } while (0)
#define PG8_MMA(ai, bj, At, Bt) do { __builtin_amdgcn_s_setprio(1); _Pragma("unroll") for (int m = 0; m < 4; ++m) _Pragma("unroll") for (int n = 0; n < 2; ++n) _Pragma("unroll") for (int k = 0; k < 2; ++k) \
        acc[ai][bj][m][n] = __builtin_amdgcn_mfma_f32_16x16x32_bf16(Bt[n][k], At[m][k], acc[ai][bj][m][n], 0, 0, 0); __builtin_amdgcn_s_setprio(0); } while (0)
#define PG8_WAIT_V(n) asm volatile("s_waitcnt vmcnt(" #n ")" ::: "memory")
#define PG8_WAIT_L(n) asm volatile("s_waitcnt lgkmcnt(" #n ")" ::: "memory")
#define PG8_BAR __builtin_amdgcn_s_barrier()
#define PG8_SCHED __builtin_amdgcn_sched_barrier(0)
    Unit cur, nxt; int ui = 0;
    if (!S.next(0, cur)) return;
    f32x4 acc[2][2][4][2];
#pragma unroll
    for (int a = 0; a < 2; ++a)
#pragma unroll
        for (int b = 0; b < 2; ++b)
#pragma unroll
            for (int m = 0; m < 4; ++m)
#pragma unroll
                for (int n = 0; n < 2; ++n) acc[a][b][m][n] = (f32x4){0.f, 0.f, 0.f, 0.f};
    bf16x8 At[4][2], B0[2][2], B1[2][2];
    const char* cA = (const char*)g.A + (size_t)cur.pm * tstep; const char* cB = (const char*)g.Bt + (size_t)cur.pn * tstep;
    S.a_ready(cur);
    if constexpr (SP2) {
        PG8_STAGE(PG8_SB(0, 0), cB, voffB); PG8_STAGE(PG8_SB(0, 1), cB + hstep, voffB); PG8_STAGE(PG8_SA(0, 0), cA, voffA); PG8_STAGE(PG8_SA(0, 1), cA + hstep, voffA);
        if (wr == 1) PG8_BAR;
        PG8_WAIT_V(2); PG8_BAR;
        PG8_STAGE(PG8_SB(1, 0), cB + kstep, voffB); PG8_STAGE(PG8_SA(1, 0), cA + kstep, voffA); PG8_STAGE(PG8_SB(1, 1), cB + hstep + kstep, voffB);
        PG8_WAIT_V(6); PG8_BAR;
    } else {
        PG8_STAGE(PG8_SB(0, 0), cB, voffB); PG8_STAGE(PG8_SA(0, 0), cA, voffA); PG8_STAGE(PG8_SB(0, 1), cB + hstep, voffB); PG8_STAGE(PG8_SA(0, 1), cA + hstep, voffA);
        if (wr == 1) PG8_BAR;
        PG8_WAIT_V(4); PG8_BAR;
        PG8_STAGE(PG8_SB(1, 0), cB + kstep, voffB); PG8_STAGE(PG8_SA(1, 0), cA + kstep, voffA); PG8_STAGE(PG8_SB(1, 1), cB + hstep + kstep, voffB);
        PG8_WAIT_V(6); PG8_BAR;
    }
    for (;;) {
        const bool has_next = S.next(ui + 1, nxt);
        const char* nA = has_next ? (const char*)g.A + (size_t)nxt.pm * tstep : cA; const char* nB = has_next ? (const char*)g.Bt + (size_t)nxt.pn * tstep : cB;
        for (int t = 0; t < nt; t += 2) {
            const bool last = (t == nt - 2);
            const char* a1 = cA + (size_t)(t + 1) * kstep;
            const char* a2 = last ? nA : cA + (size_t)(t + 2) * kstep; const char* b2 = last ? nB : cB + (size_t)(t + 2) * kstep;
            const char* a3 = a2 + kstep; const char* b3 = b2 + kstep;
            if (last && has_next) S.a_ready(nxt);
            if constexpr (SP2) {
            PG8_LDB(B0, 0, 0); PG8_LDB(B1, 0, 1); PG8_SCHED; PG8_LDA(At, 0, 0); PG8_STAGE(PG8_SA(1, 1), a1 + hstep, voffA);
            PG8_WAIT_V(8); PG8_WAIT_L(0); PG8_BAR; PG8_MMA(0, 0, At, B0); PG8_MMA(0, 1, At, B1); PG8_BAR; PG8_SCHED;
            PG8_LDA(At, 0, 1); PG8_STAGE(PG8_SB(0, 0), b2, voffB); PG8_STAGE(PG8_SB(0, 1), b2 + hstep, voffB); PG8_STAGE(PG8_SA(0, 0), a2, voffA);
            PG8_WAIT_V(8); PG8_WAIT_L(0); PG8_BAR; PG8_MMA(1, 0, At, B0); PG8_MMA(1, 1, At, B1); PG8_BAR; PG8_SCHED;
            PG8_LDB(B0, 1, 0); PG8_LDB(B1, 1, 1); PG8_SCHED; PG8_LDA(At, 1, 0); PG8_STAGE(PG8_SA(0, 1), a2 + hstep, voffA);
            PG8_WAIT_V(8); PG8_WAIT_L(0); PG8_BAR; PG8_MMA(0, 0, At, B0); PG8_MMA(0, 1, At, B1); PG8_BAR; PG8_SCHED;
            PG8_LDA(At, 1, 1); PG8_STAGE(PG8_SB(1, 0), b3, voffB); PG8_STAGE(PG8_SB(1, 1), b3 + hstep, voffB); PG8_STAGE(PG8_SA(1, 0), a3, voffA);
            PG8_WAIT_V(8); PG8_WAIT_L(0); PG8_BAR; PG8_MMA(1, 0, At, B0); PG8_MMA(1, 1, At, B1); PG8_BAR; PG8_SCHED;
            } else {
            PG8_LDB(B0, 0, 0); PG8_SCHED; PG8_LDA(At, 0, 0); PG8_STAGE(PG8_SA(1, 1), a1 + hstep, voffA);
            PG8_WAIT_L(8); PG8_BAR; PG8_WAIT_L(0); PG8_MMA(0, 0, At, B0); PG8_BAR; PG8_SCHED;
            PG8_LDB(B1, 0, 1); PG8_STAGE(PG8_SB(0, 0), b2, voffB);
            PG8_BAR; PG8_WAIT_L(0); PG8_MMA(0, 1, At, B1); PG8_BAR;
            PG8_LDA(At, 0, 1); PG8_STAGE(PG8_SA(0, 0), a2, voffA);
            PG8_BAR; PG8_WAIT_L(0); PG8_MMA(1, 0, At, B0); PG8_BAR; PG8_SCHED;
            PG8_STAGE(PG8_SB(0, 1), b2 + hstep, voffB);
            PG8_WAIT_V(6); PG8_BAR; PG8_MMA(1, 1, At, B1); PG8_BAR;
            PG8_LDB(B0, 1, 0); PG8_SCHED; PG8_LDA(At, 1, 0); PG8_STAGE(PG8_SA(0, 1), a2 + hstep, voffA);
            PG8_WAIT_L(8); PG8_BAR; PG8_WAIT_L(0); PG8_MMA(0, 0, At, B0); PG8_BAR; PG8_SCHED;
            PG8_LDB(B1, 1, 1); PG8_STAGE(PG8_SB(1, 0), b3, voffB);
            PG8_BAR; PG8_WAIT_L(0); PG8_MMA(0, 1, At, B1); PG8_BAR;
            PG8_LDA(At, 1, 1); PG8_STAGE(PG8_SA(1, 0), a3, voffA);
            PG8_BAR; PG8_WAIT_L(0); PG8_MMA(1, 0, At, B0); PG8_BAR; PG8_SCHED;
            PG8_STAGE(PG8_SB(1, 1), b3 + hstep, voffB);
            PG8_WAIT_V(6); PG8_BAR; PG8_MMA(1, 1, At, B1); PG8_BAR;
            }
        }
        if constexpr (ALIGN_EPI) { if (wr == 0) PG8_BAR; }
        if constexpr (!Epi::AFTER_DRAIN) { E(acc, cur, wr, wc, fr, fq); S.done(cur); }
        if (!has_next) break;
#pragma unroll
        for (int a = 0; a < 2; ++a)
#pragma unroll
            for (int b = 0; b < 2; ++b)
#pragma unroll
                for (int m = 0; m < 4; ++m)
#pragma unroll
                    for (int n = 0; n < 2; ++n) acc[a][b][m][n] = (f32x4){0.f, 0.f, 0.f, 0.f};
        cur = nxt; cA = nA; cB = nB; ++ui;
        if constexpr (ALIGN_EPI) { if (wr == 1) PG8_BAR; }
    }
    PG8_WAIT_V(0);
    if constexpr (!ALIGN_EPI) { if (wr == 0) PG8_BAR; }
    PG8_BAR;
    if constexpr (Epi::AFTER_DRAIN) { E.fused(acc, cur, wr, wc, fr, fq, lds, wid, lane); S.done(cur); }
#undef PG8_SA
#undef PG8_SB
#undef PG8_STAGE
#undef PG8_LDA
#undef PG8_LDB
#undef PG8_MMA
#undef PG8_WAIT_V
#undef PG8_WAIT_L
#undef PG8_BAR
#undef PG8_SCHED
}
}

typedef unsigned short bf16_t;
#define LAS __attribute__((address_space(3)))
#ifndef TSEL
#define TSEL 0
#endif
#ifndef TMUL
#define TMUL 10
#endif
#define TS_ACC_PTR ((volatile LAS unsigned long long*)(147456 - 64))
#define TS_BEGIN(id) unsigned long long ts_##id = 0; if (TSEL == (id)) ts_##id = __builtin_amdgcn_s_memrealtime();
#ifndef TSBLK
#define TSBLK 0
#endif
#define TS_END(id) if (TSEL == (id) && blockIdx.x == TSBLK && threadIdx.x == 0) { *TS_ACC_PTR += __builtin_amdgcn_s_memrealtime() - ts_##id; }
constexpr int DM = 2048, NB = 8, S = 2048, M = NB * S, DIN = 7192, DEPTH = 2, LDP = 6144, NVT = 1024, NW_IN = LDP + NVT;
constexpr int NWAVES = 8, NT = NWAVES * 64;
constexpr int C_AQ = 0, C_AKC = 512, C_AKS = 640, C_AKW = 768, C_AGATE = 896;
constexpr int C_BQ = 1408, C_BK = 1920, C_BGATE = 2048;
constexpr int C_CB = 2560, C_CC = 3072, C_CH = 3584, C_CGATE = 4096;
constexpr int C_DQ = 4608, C_DK = 5120, C_DGATE = 5632;
constexpr int VR_AVC = 0, VR_AVS = 128, VR_AVW = 256, VR_BV = 384, VR_DV = 512;
__host__ __device__ __forceinline__ int src_col_of(int n) {
    if (n < 640) return n;
    if (n < 768) return n - 640 + 768;
    if (n < 896) return n - 768 + 1024;
    if (n < 1408) return n - 896 + 1304;
    if (n < 1920) return n - 1408 + 1816;
    if (n < 2048) return n - 1920 + 2328;
    if (n < 2560) return n - 2048 + 2584;
    if (n >= 3072 && n < 4096) { const int T = n >> 8, w = n & 255; return (w < 128 ? 3608 : 4120 - 128) + 128 * (T - 12) + w; }
    if (n < 4608) return n - 2560 + 3096;
    if (n < 5120) return n - 4608 + 5144;
    if (n < 5632) return n - 5120 + 5656;
    if (n < 6144) return n - 5632 + 6680;
    if (n < 6272) return n - 6144 + 640;
    if (n < 6400) return n - 6272 + 896;
    if (n < 6528) return n - 6400 + 1152;
    if (n < 6656) return n - 6528 + 2456;
    return n - 6656 + 6168;
}
constexpr int SRC_GATES = 1280;
constexpr int NCMP = 127;

constexpr size_t MiB = 1u << 20;
constexpr size_t WS_BIASD = 1 * MiB;
constexpr size_t WS_IMG = 1 * MiB + 512 * 1024;
constexpr size_t WS_G = 2 * MiB;
constexpr size_t WS_RSS = 3 * MiB + 768 * 1024;
constexpr size_t WS_WG = 4 * MiB;
constexpr size_t WS_PB = 4 * MiB + 512 * 1024;
constexpr size_t WS_W2T = 4 * MiB + 768 * 1024;
constexpr size_t WS_W1T = 6 * MiB;
constexpr size_t WS_CMP = 5 * MiB;
constexpr size_t WS_WIN = 8 * MiB;
constexpr size_t WS_WOUT = 64 * MiB;
constexpr size_t WS_XB = 80 * MiB;
constexpr size_t WS_MIX = 144 * MiB;
constexpr size_t WS_P = 208 * MiB;
constexpr size_t WS_VT = 400 * MiB;
constexpr size_t WS_KCB = 432 * MiB;
constexpr size_t WS_END = 440 * MiB;
constexpr int LDS_BYTES = 163840;

struct Params {
    const float* x; const float* norm_w; const float* w_in; const float* w_out; const float* conv_w; const float* sinks;
    const float* cmp_pos; const float* cmp_w1; const float* cmp_w2; const float* rel_bias; const float* final_norm_w;
    float* out; unsigned char* ws;
};

__device__ __forceinline__ float bf2f(bf16_t v) { return __uint_as_float(((unsigned)v) << 16); }
__device__ __forceinline__ unsigned f2bfu(float f) { unsigned u = __float_as_uint(f); return (u + 0x7fffu + ((u >> 16) & 1u)) >> 16; }
__device__ __forceinline__ bf16_t f2bf(float f) { return (bf16_t)f2bfu(f); }
typedef float pk2_f2_ __attribute__((ext_vector_type(2))); typedef __bf16 pk2_b2_ __attribute__((ext_vector_type(2)));
__device__ __forceinline__ unsigned pk2(float lo, float hi) { pk2_f2_ v = {lo, hi}; pk2_b2_ r = __builtin_convertvector(v, pk2_b2_); return __builtin_bit_cast(unsigned, r); }
__device__ __forceinline__ float wave_sum(float v) {
#pragma unroll
    for (int o = 32; o > 0; o >>= 1) v += __shfl_xor(v, o);
    return v;
}
__device__ __forceinline__ float wave_max(float v) {
#pragma unroll
    for (int o = 32; o > 0; o >>= 1) v = fmaxf(v, __shfl_xor(v, o));
    return v;
}
__device__ __forceinline__ float silu(float v) { return v / (1.f + __expf(-v)); }
__device__ __forceinline__ float sigmoidf(float v) { return 1.f / (1.f + __expf(-v)); }
__device__ __forceinline__ void unpack8(const uint4 w, float (&f)[8]) {
    f[0] = __uint_as_float(w.x << 16); f[1] = __uint_as_float(w.x & 0xffff0000u); f[2] = __uint_as_float(w.y << 16); f[3] = __uint_as_float(w.y & 0xffff0000u);
    f[4] = __uint_as_float(w.z << 16); f[5] = __uint_as_float(w.z & 0xffff0000u); f[6] = __uint_as_float(w.w << 16); f[7] = __uint_as_float(w.w & 0xffff0000u);
}
#define LDS_FENCE() asm volatile("s_waitcnt lgkmcnt(0)" ::: "memory")

__device__ __forceinline__ int t5_bucket(int d) {
    if (d < 16) return d < 0 ? 0 : d;
    int b = 16;
    b += (d >= 22); b += (d >= 30); b += (d >= 40); b += (d >= 54); b += (d >= 73); b += (d >= 99); b += (d >= 134); b += (d >= 182);
    b += (d >= 246); b += (d >= 332); b += (d >= 450); b += (d >= 609); b += (d >= 825); b += (d >= 1117); b += (d >= 1513);
    return b;
}

struct TrItem { const float* W; const LAS float* ksc; bf16_t* WT; int K, srcld, src_n0, kb, nb; };
__device__ __forceinline__ void tr_load(const TrItem& t, float (&wv)[32], int lane) {
    const int k0 = 64 * t.kb, n0 = 32 * t.nb;
#pragma unroll
    for (int i = 0; i < 32; ++i) wv[i] = __builtin_nontemporal_load(&t.W[(size_t)(k0 + 2 * i + (lane >> 5)) * t.srcld + t.src_n0 + n0 + (lane & 31)]);
}
__device__ __forceinline__ void tr_store(const TrItem& t, const float (&wv)[32], LAS float* scr, int lane) {
    const int k0 = 64 * t.kb, n0 = 32 * t.nb;
#pragma unroll
    for (int i = 0; i < 32; ++i) { const int kk = 2 * i + (lane >> 5); const float sc = t.ksc ? t.ksc[k0 + kk] : 1.f; scr[kk * 33 + (lane & 31)] = wv[i] * sc; }
    LDS_FENCE();
    const int c = lane & 7;
#pragma unroll
    for (int j = 0; j < 4; ++j) { const int n = (lane >> 3) + 8 * j; const LAS float* s = scr + (8 * c) * 33 + n;
        uint4 o; o.x = pk2(s[0 * 33], s[1 * 33]); o.y = pk2(s[2 * 33], s[3 * 33]); o.z = pk2(s[4 * 33], s[5 * 33]); o.w = pk2(s[6 * 33], s[7 * 33]);
        *(uint4*)(t.WT + (size_t)(n0 + n) * t.K + k0 + 8 * c) = o; }
    LDS_FENCE();
}
__device__ __forceinline__ void rms_row_to_bf16(const float* xrow, bf16_t* orow, int lane) {
    const float4* xr = (const float4*)xrow + lane;
    float4 v[8]; float s = 0.f;
#pragma unroll
    for (int j = 0; j < 8; ++j) { v[j] = xr[64 * j]; s += (v[j].x * v[j].x + v[j].y * v[j].y) + (v[j].z * v[j].z + v[j].w * v[j].w); }
    const float r = rsqrtf(wave_sum(s) * (1.f / DM) + 1e-6f);
    uint2* o8 = (uint2*)orow + lane;
#pragma unroll
    for (int j = 0; j < 8; ++j) o8[64 * j] = make_uint2(pk2(v[j].x * r, v[j].y * r), pk2(v[j].z * r, v[j].w * r));
}

typedef unsigned u32x4_t_ __attribute__((ext_vector_type(4)));
typedef short abf16x8 __attribute__((ext_vector_type(8)));
typedef float f32x16 __attribute__((ext_vector_type(16)));
constexpr float LOG2E = 1.4426950408889634f, SCL = 0.125f * 1.4426950408889634f;
constexpr int OFF_TA = 0, OFF_TB = 65536, OFF_OSC = 65536 + 8192, OFF_TD = 0;
__device__ __forceinline__ int pi32(int i) { return (i & 19) | ((i & 4) << 1) | ((i & 8) >> 1); }
typedef float f32x2_t_ __attribute__((ext_vector_type(2))); typedef __bf16 bf16x2_t_ __attribute__((ext_vector_type(2)));
__device__ __forceinline__ unsigned cvtpk(float lo, float hi) { f32x2_t_ v = {lo, hi}; bf16x2_t_ b = __builtin_convertvector(v, bf16x2_t_); return __builtin_bit_cast(unsigned, b); }
struct KVF { abf16x8 k[4]; abf16x8 v[4]; };
struct Soft { float m, l; f32x16 o[2]; int reb; };
#ifndef F_TB
#define F_TB 1
#endif
#ifndef F_RSEL
#define F_RSEL 1
#endif
#ifndef F_LAZY
#define F_LAZY 1
#endif
__device__ __forceinline__ void soft_init(Soft& st) {
    st.m = F_LAZY ? 0.f : -INFINITY; st.l = 0.f; st.reb = 0;
#pragma unroll
    for (int r = 0; r < 16; ++r) { st.o[0][r] = 0.f; st.o[1][r] = 0.f; }
}
__device__ __forceinline__ void store_rows(const f32x16 (&o)[2], float scale, const bf16_t* gp, bf16_t* op, int h) {
    uint2 gw[8];
#pragma unroll
    for (int q = 0; q < 8; ++q) gw[q] = *(const uint2*)(gp + 32 * (q >> 2) + 8 * (q & 3) + 4 * h);
#pragma unroll
    for (int dh = 0; dh < 2; ++dh)
#pragma unroll
        for (int rg = 0; rg < 4; ++rg) {
            const int dim0 = 32 * dh + 8 * rg + 4 * h;
            const uint2 g = gw[dh * 4 + rg];
            const float g0 = __uint_as_float(g.x << 16), g1 = __uint_as_float(g.x & 0xffff0000u), g2 = __uint_as_float(g.y << 16), g3 = __uint_as_float(g.y & 0xffff0000u);
            uint2 w; w.x = cvtpk(o[dh][4 * rg + 0] * scale * silu(g0), o[dh][4 * rg + 1] * scale * silu(g1)); w.y = cvtpk(o[dh][4 * rg + 2] * scale * silu(g2), o[dh][4 * rg + 3] * scale * silu(g3));
            *(uint2*)(op + dim0) = w;
        }
}
constexpr int KVB = 8192, KVROUND = 2 * KVB;
struct StageRegs { u32x4_t_ k, v; };
__device__ __forceinline__ void stage_load(StageRegs& sr, const bf16_t* kg, size_t krs, const bf16_t* vg, int R, int tid) {
    const int row = tid >> 3, ch = tid & 7;
    sr.k = *(const u32x4_t_*)(kg + (size_t)(64 * R + row) * krs + ch * 8);
    sr.v = *(const u32x4_t_*)(vg + (size_t)row * M + 64 * R + ch * 8);
}
__device__ __forceinline__ void stage_write(const StageRegs& sr, LAS unsigned char* kvb, int tid) {
    const int row = tid >> 3, ch = tid & 7;
    const int off = row * 128 + ((ch ^ ((row >> 1) & 7)) << 4);
    *(LAS u32x4_t_*)(kvb + off) = sr.k; *(LAS u32x4_t_*)(kvb + KVB + off) = sr.v;
}
__device__ __forceinline__ void kfrag_read64(abf16x8 (&k0)[4], abf16x8 (&k1)[4], const LAS unsigned char* kvb, int lane) {
    const int i = lane & 31, h = lane >> 5, rr = pi32(i), sw = (rr >> 1) & 7;
#pragma unroll
    for (int s = 0; s < 4; ++s) { const int off = rr * 128 + (((2 * s + h) ^ sw) << 4); k0[s] = *(const LAS abf16x8*)(kvb + off); k1[s] = *(const LAS abf16x8*)(kvb + 4096 + off); }
}
__device__ __forceinline__ void vfrag_read64(abf16x8 (&v)[8], const LAS unsigned char* kvb, int lane) {
    const int i = lane & 31, h = lane >> 5, swv = (i >> 1) & 7;
#pragma unroll
    for (int j = 0; j < 2; ++j)
#pragma unroll
        for (int s2 = 0; s2 < 2; ++s2) { const int off = KVB + i * 128 + (((4 * j + 2 * s2 + h) ^ swv) << 4); v[j * 4 + s2] = *(const LAS abf16x8*)(kvb + off); v[j * 4 + 2 + s2] = *(const LAS abf16x8*)(kvb + 4096 + off); }
}
__device__ __forceinline__ float xhalf_max(float m) {
    auto rr = __builtin_amdgcn_permlane32_swap(__float_as_uint(m), __float_as_uint(m), false, false);
    return fmaxf(__uint_as_float(rr[0]), __uint_as_float(rr[1]));
}
__device__ __forceinline__ abf16x8 pack8(const float* p) {
    u32x4_t_ w; w.x = cvtpk(p[0], p[1]); w.y = cvtpk(p[2], p[3]); w.z = cvtpk(p[4], p[5]); w.w = cvtpk(p[6], p[7]);
    return __builtin_bit_cast(abf16x8, w);
}
__device__ __forceinline__ float max3f(float a, float b, float c) { return fmaxf(fmaxf(a, b), c); }
constexpr float THR_HI = 64.f;
template <bool CAUSAL, bool WIN, bool ROWSEL>
__device__ __forceinline__ void tile64_step(Soft& st, const LAS unsigned char* kvb, const abf16x8 (&qf)[4], const LAS float* tabp, int key0, int D0, int W, bool rowsel, int lane) {
    f32x16 a0, a1;
#pragma unroll
    for (int r = 0; r < 16; ++r) { a0[r] = 0.f; a1[r] = 0.f; }
    const LAS float* tb = tabp + key0;
#if F_TB
    asm volatile("" : "+v"(tb));
#endif
    float tv[32];
    {
        abf16x8 k0[4], k1[4]; kfrag_read64(k0, k1, kvb, lane);
#pragma unroll
        for (int r = 0; r < 16; ++r) { const int ko = (r & 7) + 16 * (r >> 3); tv[r] = tb[ko]; tv[16 + r] = tb[32 + ko]; }
        asm volatile("" : "+v"(k0[0]), "+v"(k0[1]), "+v"(k0[2]), "+v"(k0[3]), "+v"(k1[0]), "+v"(k1[1]), "+v"(k1[2]), "+v"(k1[3]) :: "memory");
#pragma unroll
        for (int s = 0; s < 4; ++s) { a0 = __builtin_amdgcn_mfma_f32_32x32x16_bf16(k0[s], qf[s], a0, 0, 0, 0); a1 = __builtin_amdgcn_mfma_f32_32x32x16_bf16(k1[s], qf[s], a1, 0, 0, 0); }
    }
    constexpr bool MASKX = CAUSAL || WIN || (ROWSEL && !F_RSEL);
    float sv[32]; float tm = -INFINITY;
#pragma unroll
    for (int r = 0; r < 16; ++r) {
        const int ko = (r & 7) + 16 * (r >> 3);
        float x0 = fmaf(a0[r], SCL, tv[r]), x1 = fmaf(a1[r], SCL, tv[16 + r]);
        if (MASKX) {
            bool ok0 = true, ok1 = true;
            if (CAUSAL) { ok0 = ok0 && (ko <= D0); ok1 = ok1 && (ko + 32 <= D0); }
            if (WIN) { ok0 = ok0 && (ko >= D0 - W); ok1 = ok1 && (ko + 32 >= D0 - W); }
            if (ROWSEL && !F_RSEL) { ok0 = ok0 && rowsel; ok1 = ok1 && rowsel; }
            x0 = ok0 ? x0 : -INFINITY; x1 = ok1 ? x1 : -INFINITY;
        }
        sv[r] = x0; sv[16 + r] = x1;
#if F_TB
        tm = max3f(tm, x0, x1);
#else
        tm = fmaxf(tm, fmaxf(x0, x1));
#endif
    }
    asm volatile("" ::: "memory");
    if (ROWSEL && F_RSEL) tm = rowsel ? tm : -INFINITY;
#if F_LAZY
    bool slow = st.reb != 0;
    if (CAUSAL) { const float tmx = xhalf_max(tm); slow = slow || __any(!(fabsf(tmx) <= THR_HI)); }
    else slow = slow || __any(tm > THR_HI);
    if (slow) {
        const float tmx = xhalf_max(tm);
        const float mn = CAUSAL ? tmx : fmaxf(st.m, tmx);
        const float alpha = CAUSAL ? 1.f : __builtin_amdgcn_exp2f(st.m - mn);
#pragma unroll
        for (int r = 0; r < 16; ++r) { st.o[0][r] *= alpha; st.o[1][r] *= alpha; }
        st.l *= alpha; st.m = mn; st.reb = 1;
#pragma unroll
        for (int r = 0; r < 32; ++r) sv[r] -= mn;
    }
#else
    {
        tm = xhalf_max(tm);
        const float mn = fmaxf(st.m, tm);
        const float alpha = __builtin_amdgcn_exp2f(st.m - mn);
        if (__any(alpha != 1.f)) {
#pragma unroll
            for (int r = 0; r < 16; ++r) { st.o[0][r] *= alpha; st.o[1][r] *= alpha; }
        }
        st.l *= alpha; st.m = mn;
#pragma unroll
        for (int r = 0; r < 32; ++r) sv[r] -= mn;
    }
#endif
    float rs = 0.f;
    const int i = lane & 31, h = lane >> 5, swv = (i >> 1) & 7;
#pragma unroll
    for (int j = 0; j < 2; ++j) {
        abf16x8 vf[4];
#pragma unroll
        for (int s2 = 0; s2 < 2; ++s2) { const int off = KVB + i * 128 + (((4 * j + 2 * s2 + h) ^ swv) << 4); vf[s2] = *(const LAS abf16x8*)(kvb + off); vf[2 + s2] = *(const LAS abf16x8*)(kvb + 4096 + off); }
#pragma unroll
        for (int r = 0; r < 16; ++r) { sv[16 * j + r] = __builtin_amdgcn_exp2f(sv[16 * j + r]); rs += sv[16 * j + r]; }
#pragma unroll
        for (int s2 = 0; s2 < 2; ++s2) {
            u32x4_t_ w; const float* p = sv + 16 * j + 8 * s2;
            w.x = cvtpk(p[0], p[1]); w.y = cvtpk(p[2], p[3]); w.z = cvtpk(p[4], p[5]); w.w = cvtpk(p[6], p[7]);
            if (ROWSEL && F_RSEL) { w.x = rowsel ? w.x : 0u; w.y = rowsel ? w.y : 0u; w.z = rowsel ? w.z : 0u; w.w = rowsel ? w.w : 0u; }
            const abf16x8 pf = __builtin_bit_cast(abf16x8, w);
            st.o[0] = __builtin_amdgcn_mfma_f32_32x32x16_bf16(vf[s2], pf, st.o[0], 0, 0, 0);
            st.o[1] = __builtin_amdgcn_mfma_f32_32x32x16_bf16(vf[2 + s2], pf, st.o[1], 0, 0, 0); }
    }
    if (ROWSEL && F_RSEL) rs = rowsel ? rs : 0.f;
    st.l += rs;
}
#define ROUND_LOOP64(rm_, kg_, krs_, vg_, kvbase_, tid_, ...) do { \
    unsigned rm__ = (rm_); int R__ = 31 - __builtin_clz(rm__); int bs__ = 0; StageRegs sr__; \
    stage_load(sr__, kg_, krs_, vg_, R__, tid_); stage_write(sr__, (kvbase_), tid_); \
    asm volatile("" :: "v"(qf[0]), "v"(qf[1]), "v"(qf[2]), "v"(qf[3]));     \
    __syncthreads(); \
    for (;;) { rm__ &= ~(1u << R__); const int Rn__ = rm__ ? 31 - __builtin_clz(rm__) : -1; \
        if (Rn__ >= 0) stage_load(sr__, kg_, krs_, vg_, Rn__, tid_); \
        { const LAS unsigned char* kvb__ = (kvbase_) + bs__ * KVROUND; const int R = R__; __VA_ARGS__ } \
        if (Rn__ < 0) break; \
        { TS_BEGIN(5) stage_write(sr__, (kvbase_) + (bs__ ^ 1) * KVROUND, tid_); __syncthreads(); TS_END(5) } bs__ ^= 1; R__ = Rn__; } \
    __syncthreads(); } while (0)
__device__ __forceinline__ void bunit_D(const bf16_t* P, const bf16_t* VT, bf16_t* MIX, const LAS float* tabD1  , LAS unsigned char* kvbase, int b, int head, int qb, int tid, int wib) {
    asm volatile("" : "+v"(tid));
    int lane = tid & 63; asm volatile("" : "+v"(lane));
    const int c = lane & 31, h = lane >> 5, qt = 8 * qb + wib, tc = qt * 32 + c;
    const size_t rowq = (size_t)b * S + tc;
    abf16x8 qf[4];
#pragma unroll
    for (int s = 0; s < 4; ++s) qf[s] = *(const abf16x8*)(P + rowq * LDP + C_DQ + head * 64 + 16 * s + 8 * h);
    const bf16_t* kg = P + (size_t)b * S * LDP + C_DK + head * 64;
    const bf16_t* vg = VT + (size_t)(VR_DV + head * 64) * M + (size_t)b * S;
    const LAS float* tabp = tabD1 + (2047 - tc + 8 * h);
    Soft st; soft_init(st);
    const unsigned rm = 0xffffffffu >> (31 - (4 * qb + 3));
    const int Rw = qt >> 1;
    ROUND_LOOP64(rm, kg, (size_t)LDP, vg, kvbase, tid,
        if (R <= Rw) { const int D0 = tc - 64 * R - 8 * h;
            if (R == Rw) tile64_step<true, false, false>(st, kvb__, qf, tabp, 64 * R, D0, 0, true, lane);
            else tile64_step<false, false, false>(st, kvb__, qf, tabp, 64 * R, D0, 0, true, lane); }
    );
    const float l = st.l + __shfl_xor(st.l, 32);
    store_rows(st.o, 1.f / l, P + rowq * LDP + C_DGATE + head * 64, MIX + rowq * DM + 1536 + head * 64, h);
}

__device__ __forceinline__ void bunit_B(const bf16_t* P, const bf16_t* VT, bf16_t* MIX, const LAS float* tabB, const float* sinks, LAS unsigned char* kvbase, int b, int g, int q64, int tid, int wib) {
    asm volatile("" : "+v"(tid));
    int lane = tid & 63; asm volatile("" : "+v"(lane));
    const int c = lane & 31, h = lane >> 5, hh = c >> 3, qi = c & 7, t0 = 64 * q64 + 8 * wib, tc = t0 + qi, head = g * 4 + hh;
    const size_t rowq = (size_t)b * S + tc;
    abf16x8 qf[4];
#pragma unroll
    for (int s = 0; s < 4; ++s) qf[s] = *(const abf16x8*)(P + rowq * LDP + C_BQ + head * 64 + 16 * s + 8 * h);
    const bf16_t* kg = P + (size_t)b * S * LDP + C_BK + g * 64;
    const bf16_t* vg = VT + (size_t)(VR_BV + g * 64) * M + (size_t)b * S;
    const LAS float* tabp = tabB + head * 264 + (255 - tc + 8 * h);
    Soft st; soft_init(st);
    const int ktd = t0 >> 5, ktlo = (t0 - 127 > 0 ? t0 - 127 : 0) >> 5;
    const int Rlo = (64 * q64 - 127 > 0 ? 64 * q64 - 127 : 0) >> 6;
    const unsigned rm = (0xffffffffu >> (31 - q64)) & (0xffffffffu << Rlo);
    (void)ktd;
    ROUND_LOOP64(rm, kg, (size_t)LDP, vg, kvbase, tid,
        if (2 * R + 1 >= ktlo) { const int D0 = tc - 64 * R - 8 * h;
            if (R == q64) tile64_step<true, false, false>(st, kvb__, qf, tabp, 64 * R, D0, 0, true, lane);
            else tile64_step<false, true, false>(st, kvb__, qf, tabp, 64 * R, D0, 127, true, lane); }
    );
    const float l = st.l + __shfl_xor(st.l, 32) + __builtin_amdgcn_exp2f(sinks[head] * LOG2E - st.m);
    store_rows(st.o, 1.f / l, P + rowq * LDP + C_BGATE + head * 64, MIX + rowq * DM + 512 + head * 64, h);
}

constexpr int D6_SLOT = 8192, D6_K = 0, D6_V = 3 * D6_SLOT, D6_WS = 6 * D6_SLOT, D6_OST = D6_WS + 8 * 256, D6_TD = D6_OST + 8 * 4096, D6_TDN = 2304, D6_END = D6_TD + D6_TDN * 4;
constexpr float D6_THR = 8.f;
#define D6_SBAR() __builtin_amdgcn_sched_barrier(0)
#define D6_PIN(x) asm volatile("" : "+v"(x))
#define D6_MFMA(a, b, c) __builtin_amdgcn_mfma_f32_32x32x16_bf16(a, b, c, 0, 0, 0)
#define D6_WAIT_BAR(N) asm volatile("s_waitcnt vmcnt(" #N ") lgkmcnt(0)\n\ts_barrier" ::: "memory")
__device__ __forceinline__ int d6_crow(int r, int hi) { return (r & 3) + 8 * (r >> 2) + 4 * hi; }
__device__ __forceinline__ void d6_glds16(const void* g, unsigned lds_base) {
    unsigned sv; asm volatile("s_mov_b32 %0, m0\n\ts_mov_b32 m0, %2\n\ts_nop 0\n\tglobal_load_lds_dwordx4 %1, off\n\ts_mov_b32 m0, %0" : "=&s"(sv) : "v"(g), "s"(lds_base) : "memory"); }
typedef const LAS unsigned char* d6_lptr;
__device__ __forceinline__ void d6_kload2(abf16x8* kf, d6_lptr kp, int d0) { kf[2 * d0] = *(const LAS abf16x8*)(kp + d0 * 2048); kf[2 * d0 + 1] = *(const LAS abf16x8*)(kp + d0 * 2048 + 512); }
#define D6_MX3(a, b, c) __builtin_fmaxf(__builtin_fmaxf((a), (b)), (c))
__device__ __forceinline__ float d6_rowmax(const f32x16& p0, const f32x16& p1) {
    float a = D6_MX3(p0[0], p0[1], p1[0]), b = D6_MX3(p0[2], p0[3], p1[1]); a = D6_MX3(a, p1[2], p1[3]);
#pragma unroll
    for (int r = 4; r < 16; r += 4) { a = D6_MX3(a, p0[r], p0[r + 1]); b = D6_MX3(b, p0[r + 2], p0[r + 3]); a = D6_MX3(a, p1[r], p1[r + 1]); b = D6_MX3(b, p1[r + 2], p1[r + 3]); }
    float m = __builtin_fmaxf(a, b); auto rr = __builtin_amdgcn_permlane32_swap(__float_as_uint(m), __float_as_uint(m), false, false);
    return __builtin_fmaxf(__uint_as_float(rr[0]), __uint_as_float(rr[1])); }
#define D6_TLOAD(X0, X1, tq, tt, r0, r1) do { _Pragma("unroll") for (int r_ = (r0); r_ < (r1); ++r_) { const int ko_ = (r_ & 7) + 16 * (r_ >> 3); X0[r_] = (tq)[64 * (tt) + ko_]; X1[r_] = (tq)[64 * (tt) + 32 + ko_]; } } while (0)
__device__ __forceinline__ void dunit64(const bf16_t* P, const bf16_t* VT, bf16_t* MIX, LAS unsigned char* lds, int b, int head, int qb, int tid_in) {
    int tid = tid_in; asm volatile("" : "+v"(tid));
    const int lane = tid & 63, r32 = lane & 31, hi = lane >> 5; const int wid = __builtin_amdgcn_readfirstlane(tid >> 6);
    const size_t rowbase = (size_t)b * S; const int q0 = qb * 256, NT_ = (q0 + 256) / 64;
    const bf16_t* Qw = P + (rowbase + q0 + wid * 32) * LDP + C_DQ + head * 64;
    const unsigned lds0 = (unsigned)(uintptr_t)lds; LAS float* wsf = (LAS float*)(lds + D6_WS) + wid * 64;
    const bf16_t* ksrc = P + rowbase * LDP + C_DK + head * 64 + (size_t)lane * LDP + wid * 8;
    const bf16_t* vsrc = VT + (size_t)(VR_DV + head * 64 + lane) * M + rowbase + wid * 8;
    const unsigned kdst = lds0 + D6_K + wid * 1024, vdst = lds0 + D6_V + wid * 1024;
#define D6_DMA_K(t, slot) d6_glds16(ksrc + (size_t)(t) * 64 * LDP, (unsigned)__builtin_amdgcn_readfirstlane(kdst + (slot)))
#define D6_DMA_V(t, slot) d6_glds16(vsrc + (size_t)(t) * 64, (unsigned)__builtin_amdgcn_readfirstlane(vdst + (slot)))
    const d6_lptr vp0 = (d6_lptr)lds + D6_V + hi * 1024 + r32 * 16;
    const d6_lptr kp0 = (d6_lptr)lds + D6_K + hi * 1024 + pi32(r32) * 16;
    D6_DMA_K(0, 0); D6_DMA_V(0, 0); D6_DMA_K(1, D6_SLOT);
    abf16x8 qr[4];
#pragma unroll
    for (int d0 = 0; d0 < 4; ++d0) qr[d0] = *(const abf16x8*)(Qw + (size_t)r32 * LDP + d0 * 16 + hi * 8);
    float mhat = 0.f, l_reg = 0.f; f32x16 o[2];
#pragma unroll
    for (int r = 0; r < 16; ++r) { o[0][r] = 0.f; o[1][r] = 0.f; }
    const int tc = q0 + wid * 32 + r32; bool resc = false;
    const LAS float* tq = (const LAS float*)(lds + D6_TD) + (2047 - tc + 8 * hi);
    f32x16 pA0, pA1, pB0, pB1; abf16x8 kf[8]; abf16x8 vf[8]; u32x4_t_ pw0, pw1, pw2, pw3;
    int sl_prev = 0, sl_cur = 0, sl_next = D6_SLOT;
#define D6_ROT() do { sl_prev = sl_cur; sl_cur = sl_next; sl_next = (sl_next == 2 * D6_SLOT) ? 0 : sl_next + D6_SLOT; } while (0)
#define D6_EX(v) __builtin_amdgcn_exp2f(__builtin_fmaf((v), SCL, nmh))
#define D6_RESC() do { if (resc) { _Pragma("unroll") for (int d_ = 0; d_ < 2; ++d_) _Pragma("unroll") for (int r = 0; r < 16; ++r) o[d_][r] *= wsf[d6_crow(r, hi)]; } } while (0)
    D6_DMA_K(2, 2 * D6_SLOT);
    D6_TLOAD(pA0, pA1, tq, 0, 0, 16);
    D6_WAIT_BAR(3);
    _Pragma("unroll") for (int d0 = 0; d0 < 4; ++d0) d6_kload2(kf, kp0, d0);
    pA0 = D6_MFMA(kf[0], qr[0], pA0); pA1 = D6_MFMA(kf[1], qr[0], pA1); pA0 = D6_MFMA(kf[2], qr[1], pA0); pA1 = D6_MFMA(kf[3], qr[1], pA1);
    pA0 = D6_MFMA(kf[4], qr[2], pA0); pA1 = D6_MFMA(kf[5], qr[2], pA1); pA0 = D6_MFMA(kf[6], qr[3], pA0); pA1 = D6_MFMA(kf[7], qr[3], pA1);
    D6_TLOAD(pB0, pB1, tq, 1, 0, 16);
    { const float rm = d6_rowmax(pA0, pA1) * SCL;
      if (__any(rm > D6_THR)) mhat = __builtin_fmaxf(rm, 0.f);
      const float nmh = -mhat;
#pragma unroll
      for (int r = 0; r < 16; ++r) { pA0[r] = D6_EX(pA0[r]); pA1[r] = D6_EX(pA1[r]); } }
    D6_WAIT_BAR(0);
    D6_DMA_K(3, 0); D6_DMA_V(1, D6_SLOT); D6_ROT();
    _Pragma("unroll") for (int d0 = 0; d0 < 4; ++d0) d6_kload2(kf, kp0 + sl_cur, d0);
    D6_WAIT_BAR(2);
#define D6_PKW(P_, i) cvtpk(P_[i], P_[i + 1])
#define D6_PAF(k) __builtin_bit_cast(abf16x8, pw##k)
#define D6_VRD(i) do { vf[i] = *(const LAS abf16x8*)(vp_ + (((i) & 3) * 2048 + ((i) >> 2) * 512)); } while (0)
#define D6_KRD(G_, d0) do { if (G_) { d6_kload2(kf, kp0 + sl_next, d0); D6_SBAR(); } } while (0)
#define D6_TRD(G_, X0, X1, tt, r0, r1) do { if (G_) { D6_TLOAD(X0, X1, tq, tt, r0, r1); D6_SBAR(); } } while (0)
#define D6_GAPA(MF, a0, a1, a2, a3, W0, W1, PW) do { MF; sacc += a0; sacc += a1; sacc += a2; sacc += a3; W0; W1; D6_PIN(PW); D6_PIN(sacc); D6_SBAR(); } while (0)
#define D6_GAPB(MF, X, i) do { MF; X[i] = D6_EX(X[i]); X[i + 1] = D6_EX(X[i + 1]); X[i + 2] = D6_EX(X[i + 2]); X[i + 3] = D6_EX(X[i + 3]); D6_PIN(X); D6_SBAR(); } while (0)
#define D6_STEP(C0, C1, P0, P1, t, GK, GV, GL) do { D6_SBAR(); \
    const d6_lptr vp_ = vp0 + sl_prev; \
    D6_VRD(0); D6_SBAR(); float sacc = P0[0] + P0[1]; \
                       D6_GAPA(C0 = D6_MFMA(kf[0], qr[0], C0), P0[2], P0[3], P0[4], P0[5],     pw0[0] = D6_PKW(P0, 0),  pw0[1] = D6_PKW(P0, 2),  pw0); \
    D6_VRD(4); D6_SBAR(); D6_GAPA(C1 = D6_MFMA(kf[1], qr[0], C1), P0[6], P0[7], P0[8], P0[9],     pw0[2] = D6_PKW(P0, 4),  pw0[3] = D6_PKW(P0, 6),  pw0); \
    D6_VRD(1); D6_SBAR(); D6_GAPA(C0 = D6_MFMA(kf[2], qr[1], C0),    P0[10], P0[11], P0[12], P0[13], pw1[0] = D6_PKW(P0, 8),  pw1[1] = D6_PKW(P0, 10), pw1); \
    D6_VRD(5); D6_SBAR(); D6_GAPA(C1 = D6_MFMA(kf[3], qr[1], C1),    P0[14], P0[15], P1[0], P1[1],   pw1[2] = D6_PKW(P0, 12), pw1[3] = D6_PKW(P0, 14), pw1); \
    D6_VRD(2); D6_SBAR(); D6_GAPA(C0 = D6_MFMA(kf[4], qr[2], C0),    P1[2], P1[3], P1[4], P1[5],     pw2[0] = D6_PKW(P1, 0),  pw2[1] = D6_PKW(P1, 2),  pw2); \
    D6_VRD(6); D6_SBAR(); D6_GAPA(C1 = D6_MFMA(kf[5], qr[2], C1),    P1[6], P1[7], P1[8], P1[9],     pw2[2] = D6_PKW(P1, 4),  pw2[3] = D6_PKW(P1, 6),  pw2); \
    D6_VRD(3); D6_SBAR(); D6_GAPA(C0 = D6_MFMA(kf[6], qr[3], C0),    P1[10], P1[11], P1[12], P1[13], pw3[0] = D6_PKW(P1, 8),  pw3[1] = D6_PKW(P1, 10), pw3); \
    D6_VRD(7); D6_SBAR(); D6_GAPA(C1 = D6_MFMA(kf[7], qr[3], C1),    P1[14], P1[15], 0.f, 0.f,       pw3[2] = D6_PKW(P1, 12), pw3[3] = D6_PKW(P1, 14), pw3); \
    l_reg += sacc; \
    if (GK) D6_DMA_K((t) + 3, sl_cur); if (GV) D6_DMA_V((t) + 1, sl_next); \
    { const float rm = __builtin_fmaf(d6_rowmax(C0, C1), SCL, -mhat); resc = false; \
      if (__builtin_expect(__any(rm > D6_THR), 0)) { const float dl = __builtin_fmaxf(rm, 0.f); mhat += dl; \
          const float f = __builtin_amdgcn_exp2f(-dl); l_reg *= f; if (hi == 0) wsf[r32] = f; resc = true; } } \
    const float nmh = -mhat; D6_SBAR(); \
    D6_TRD(GL, P0, P1, (t) + 1, 0, 4);  D6_GAPB(o[0] = D6_MFMA(D6_PAF(0), vf[0], o[0]), C0, 0);  D6_TRD(GL, P0, P1, (t) + 1, 4, 8);  D6_GAPB(o[1] = D6_MFMA(D6_PAF(0), vf[4], o[1]), C0, 4); \
    D6_KRD(GL, 0); D6_GAPB(o[0] = D6_MFMA(D6_PAF(1), vf[1], o[0]), C0, 8);  D6_KRD(GL, 1); D6_GAPB(o[1] = D6_MFMA(D6_PAF(1), vf[5], o[1]), C0, 12); \
    D6_KRD(GL, 2); D6_GAPB(o[0] = D6_MFMA(D6_PAF(2), vf[2], o[0]), C1, 0);  D6_KRD(GL, 3); D6_GAPB(o[1] = D6_MFMA(D6_PAF(2), vf[6], o[1]), C1, 4); \
    D6_TRD(GL, P0, P1, (t) + 1, 8, 12); D6_GAPB(o[0] = D6_MFMA(D6_PAF(3), vf[3], o[0]), C1, 8);  D6_TRD(GL, P0, P1, (t) + 1, 12, 16); D6_GAPB(o[1] = D6_MFMA(D6_PAF(3), vf[7], o[1]), C1, 12); \
    } while (0)
    int t = 1;
    for (; t + 5 < NT_; t += 2) {
        D6_STEP(pB0, pB1, pA0, pA1, t, true, true, true);     D6_WAIT_BAR(2); D6_RESC(); D6_ROT();
        D6_STEP(pA0, pA1, pB0, pB1, t + 1, true, true, true); D6_WAIT_BAR(2); D6_RESC(); D6_ROT();
    }
#define D6_ENDW(tt) do { if ((tt) + 3 < NT_) { D6_WAIT_BAR(2); } else if ((tt) + 2 < NT_) { D6_WAIT_BAR(1); } else { D6_WAIT_BAR(0); } } while (0)
    for (; t + 1 < NT_; t += 2) {
        D6_STEP(pB0, pB1, pA0, pA1, t, (t + 3 < NT_), (t + 1 < NT_), (t + 1 < NT_));         D6_ENDW(t);     D6_RESC(); D6_ROT();
        D6_STEP(pA0, pA1, pB0, pB1, t + 1, (t + 4 < NT_), (t + 2 < NT_), (t + 2 < NT_));     D6_ENDW(t + 1); D6_RESC(); D6_ROT();
    }
    D6_STEP(pB0, pB1, pA0, pA1, NT_ - 1, false, false, false); D6_RESC();
    { float sacc = pB0[0] + pB0[1];
#pragma unroll
      for (int r = 2; r < 16; ++r) sacc += pB0[r];
#pragma unroll
      for (int r = 0; r < 16; ++r) sacc += pB1[r];
      l_reg += sacc;
      pw0 = (u32x4_t_){D6_PKW(pB0, 0), D6_PKW(pB0, 2), D6_PKW(pB0, 4), D6_PKW(pB0, 6)}; pw1 = (u32x4_t_){D6_PKW(pB0, 8), D6_PKW(pB0, 10), D6_PKW(pB0, 12), D6_PKW(pB0, 14)};
      pw2 = (u32x4_t_){D6_PKW(pB1, 0), D6_PKW(pB1, 2), D6_PKW(pB1, 4), D6_PKW(pB1, 6)}; pw3 = (u32x4_t_){D6_PKW(pB1, 8), D6_PKW(pB1, 10), D6_PKW(pB1, 12), D6_PKW(pB1, 14)};
      const d6_lptr vp_ = vp0 + sl_cur; _Pragma("unroll") for (int i = 0; i < 8; ++i) D6_VRD(i);
      o[0] = D6_MFMA(D6_PAF(0), vf[0], o[0]); o[1] = D6_MFMA(D6_PAF(0), vf[4], o[1]); o[0] = D6_MFMA(D6_PAF(1), vf[1], o[0]); o[1] = D6_MFMA(D6_PAF(1), vf[5], o[1]);
      o[0] = D6_MFMA(D6_PAF(2), vf[2], o[0]); o[1] = D6_MFMA(D6_PAF(2), vf[6], o[1]); o[0] = D6_MFMA(D6_PAF(3), vf[3], o[0]); o[1] = D6_MFMA(D6_PAF(3), vf[7], o[1]); }
    const size_t row0 = rowbase + q0 + wid * 32;
    uint4 gv[4];
#pragma unroll
    for (int i = 0; i < 4; ++i) { const int row = i * 8 + (lane >> 3), ch = lane & 7; gv[i] = *(const uint4*)(P + (row0 + row) * LDP + C_DGATE + head * 64 + ch * 8); }
    { auto rr = __builtin_amdgcn_permlane32_swap(__float_as_uint(l_reg), __float_as_uint(l_reg), false, false); l_reg = __uint_as_float(rr[0]) + __uint_as_float(rr[1]); }
    if (hi == 0) wsf[32 + r32] = l_reg; asm volatile("s_waitcnt lgkmcnt(0)" ::: "memory");
    float rli[16];
#pragma unroll
    for (int r = 0; r < 16; ++r) rli[r] = __builtin_amdgcn_rcpf(wsf[32 + d6_crow(r, hi)]);
    LAS bf16_t* stg = (LAS bf16_t*)(lds + D6_OST) + wid * 2048;
#pragma unroll
    for (int r = 0; r < 16; ++r) { const int orow = d6_crow(r, hi);
#pragma unroll
        for (int d0 = 0; d0 < 2; ++d0) stg[orow * 64 + d0 * 32 + r32] = (bf16_t)(cvtpk(o[d0][r] * rli[r], 0.f) & 0xffffu); }
    asm volatile("s_waitcnt lgkmcnt(0)" ::: "memory");
    {
#pragma unroll
        for (int i = 0; i < 4; ++i) { const int row = i * 8 + (lane >> 3), ch = lane & 7;
            const u32x4_t_ ovv = *(const LAS u32x4_t_*)(stg + row * 64 + ch * 8); const uint4 ov = make_uint4(ovv.x, ovv.y, ovv.z, ovv.w);
            float fo[8], fg[8]; unpack8(ov, fo); unpack8(gv[i], fg);
            uint4 w; w.x = cvtpk(fo[0] * silu(fg[0]), fo[1] * silu(fg[1])); w.y = cvtpk(fo[2] * silu(fg[2]), fo[3] * silu(fg[3]));
            w.z = cvtpk(fo[4] * silu(fg[4]), fo[5] * silu(fg[5])); w.w = cvtpk(fo[6] * silu(fg[6]), fo[7] * silu(fg[7]));
            *(uint4*)(MIX + (row0 + row) * DM + 1536 + head * 64 + ch * 8) = w; }
    }
    asm volatile("s_waitcnt vmcnt(0) lgkmcnt(0)\n\ts_barrier" ::: "memory");
}
#define A6_POP(seq, R_, real_) do { real_ = seq##_m != 0u; if (real_) { seq##_last = __builtin_ctz(seq##_m); seq##_m &= seq##_m - 1u; } R_ = seq##_last; } while (0)
#define A6_TLOAD(X0, X1, tp_, r0, r1) do { _Pragma("unroll") for (int r_ = (r0); r_ < (r1); ++r_) { const int ko_ = (r_ & 7) + 16 * (r_ >> 3); X0[r_] = (tp_)[ko_]; X1[r_] = (tp_)[32 + ko_]; } } while (0)
#define A6_NS(x) ((x) == 2 * D6_SLOT ? 0 : (x) + D6_SLOT)
__device__ __forceinline__ void a_prime(const bf16_t* kbase, const bf16_t* vbase, LAS unsigned char* lds, unsigned tmask, int base, int tid_in) {
    int tid = tid_in; asm volatile("" : "+v"(tid));
    const int lane = tid & 63; const int wid = __builtin_amdgcn_readfirstlane(tid >> 6);
    const unsigned lds0 = (unsigned)(uintptr_t)lds;
    const bf16_t* ksrc = kbase + (size_t)lane * LDP + wid * 8;
    const bf16_t* vsrc = vbase + (size_t)lane * M + wid * 8;
    const unsigned kdst = lds0 + wid * 1024, vdst = lds0 + 3 * D6_SLOT + wid * 1024;
    unsigned m = tmask; const int R0 = __builtin_ctz(m); m &= m - 1u; const int R1 = m ? __builtin_ctz(m) : R0; if (m) m &= m - 1u; const int R2 = m ? __builtin_ctz(m) : R1;
    const int s0 = base, s1 = A6_NS(s0), s2 = A6_NS(s1);
    d6_glds16(ksrc + (size_t)R0 * 64 * LDP, (unsigned)__builtin_amdgcn_readfirstlane(kdst + s0)); d6_glds16(vsrc + (size_t)R0 * 64, (unsigned)__builtin_amdgcn_readfirstlane(vdst + s0));
    d6_glds16(ksrc + (size_t)R1 * 64 * LDP, (unsigned)__builtin_amdgcn_readfirstlane(kdst + s1)); d6_glds16(ksrc + (size_t)R2 * 64 * LDP, (unsigned)__builtin_amdgcn_readfirstlane(kdst + s2));
}
template <bool SEL>
__device__ __forceinline__ void a_sweep64(const bf16_t* kbase  , const bf16_t* vbase  ,
                                          LAS unsigned char* lds  , LAS float* wsf, unsigned tmask, unsigned selmask, const LAS float* tabq, const LAS float* ninfp,
                                          const abf16x8 (&qr)[4], f32x16 (&o)[2], float& l_out, float& m_out, int tid_in, bool primed, int base, const bf16_t* nkb, const bf16_t* nvb, unsigned ntmask, int& nbase) {
    int tid = tid_in; asm volatile("" : "+v"(tid));
    const int lane = tid & 63, r32 = lane & 31, hi = lane >> 5; const int wid = __builtin_amdgcn_readfirstlane(tid >> 6);
    const int NT_ = __builtin_popcount(tmask);
    const unsigned lds0 = (unsigned)(uintptr_t)lds;
    const bf16_t* ksrc = kbase + (size_t)lane * LDP + wid * 8;
    const bf16_t* vsrc = vbase + (size_t)lane * M + wid * 8;
    const unsigned kdst = lds0 + wid * 1024, vdst = lds0 + 3 * D6_SLOT + wid * 1024;
#define A6_DMA_K(R_, slot) d6_glds16(ksrc + (size_t)(R_) * 64 * LDP, (unsigned)__builtin_amdgcn_readfirstlane(kdst + (slot)))
#define A6_DMA_V(R_, slot) d6_glds16(vsrc + (size_t)(R_) * 64, (unsigned)__builtin_amdgcn_readfirstlane(vdst + (slot)))
#define A6_TPTR(R_, real_) (((real_) && (!SEL || ((selmask >> (R_)) & 1u))) ? tabq + 64 * (R_) : ninfp)
    const d6_lptr vp0 = (d6_lptr)lds + 3 * D6_SLOT + hi * 1024 + r32 * 16;
    const d6_lptr kp0 = (d6_lptr)lds + hi * 1024 + pi32(r32) * 16;
    unsigned sK_m = tmask, sV_m = tmask, sT_m = tmask; int sK_last = __builtin_ctz(tmask), sV_last = sK_last, sT_last = sK_last;
    int Rk, Rv, Rt; bool rk, rv, rt; (void)rk; (void)rv;
    asm volatile("s_waitcnt vmcnt(0)" ::: "memory");
    const int s0 = base, s1 = A6_NS(s0), s2 = A6_NS(s1);
    A6_POP(sK, Rk, rk); if (!primed) A6_DMA_K(Rk, s0); A6_POP(sV, Rv, rv); if (!primed) A6_DMA_V(Rv, s0); A6_POP(sK, Rk, rk); if (!primed) A6_DMA_K(Rk, s1); A6_POP(sK, Rk, rk); if (!primed) A6_DMA_K(Rk, s2);
    float mhat = 0.f, l_reg = 0.f;
#pragma unroll
    for (int r = 0; r < 16; ++r) { o[0][r] = 0.f; o[1][r] = 0.f; }
    bool resc = false, wmoved = false;
    f32x16 pA0, pA1, pB0, pB1; abf16x8 kf[8]; abf16x8 vf[8]; u32x4_t_ pw0, pw1, pw2, pw3;
    int sl_prev = s0, sl_cur = s0, sl_next = s1;
    { A6_POP(sT, Rt, rt); const LAS float* tp = A6_TPTR(Rt, rt); A6_TLOAD(pA0, pA1, tp, 0, 16); }
    D6_WAIT_BAR(3);
    _Pragma("unroll") for (int d0 = 0; d0 < 4; ++d0) d6_kload2(kf, kp0 + s0, d0);
    pA0 = D6_MFMA(kf[0], qr[0], pA0); pA1 = D6_MFMA(kf[1], qr[0], pA1); pA0 = D6_MFMA(kf[2], qr[1], pA0); pA1 = D6_MFMA(kf[3], qr[1], pA1);
    pA0 = D6_MFMA(kf[4], qr[2], pA0); pA1 = D6_MFMA(kf[5], qr[2], pA1); pA0 = D6_MFMA(kf[6], qr[3], pA0); pA1 = D6_MFMA(kf[7], qr[3], pA1);
    { A6_POP(sT, Rt, rt); const LAS float* tp = A6_TPTR(Rt, rt); A6_TLOAD(pB0, pB1, tp, 0, 16); }
    { const float rm = d6_rowmax(pA0, pA1);
      if (__builtin_expect(__any(rm > D6_THR), 0)) { mhat = __builtin_fmaxf(rm, 0.f); wmoved = true;
#pragma unroll
          for (int r = 0; r < 16; ++r) { pA0[r] -= mhat; pA1[r] -= mhat; } }
#pragma unroll
      for (int r = 0; r < 16; ++r) { pA0[r] = __builtin_amdgcn_exp2f(pA0[r]); pA1[r] = __builtin_amdgcn_exp2f(pA1[r]); } }
    D6_WAIT_BAR(0);
    if (3 < NT_) { A6_POP(sK, Rk, rk); A6_DMA_K(Rk, s0); } if (1 < NT_) { A6_POP(sV, Rv, rv); A6_DMA_V(Rv, s1); } D6_ROT();
    _Pragma("unroll") for (int d0 = 0; d0 < 4; ++d0) d6_kload2(kf, kp0 + sl_cur, d0);
    D6_ENDW(0);
#define A6_TRD(G_, X0, X1, r0, r1) do { if (G_) { A6_TLOAD(X0, X1, tpn, r0, r1); D6_SBAR(); } } while (0)
#define A6_GAPB(MF, X, i) do { MF; X[i] = __builtin_amdgcn_exp2f(X[i]); X[i + 1] = __builtin_amdgcn_exp2f(X[i + 1]); X[i + 2] = __builtin_amdgcn_exp2f(X[i + 2]); X[i + 3] = __builtin_amdgcn_exp2f(X[i + 3]); D6_PIN(X); D6_SBAR(); } while (0)
#define A6_STEP(C0, C1, P0, P1, GK, GV, GL) do { D6_SBAR(); \
    if (__builtin_expect(wmoved, 0)) { _Pragma("unroll") for (int r = 0; r < 16; ++r) { C0[r] -= mhat; C1[r] -= mhat; } } \
    const d6_lptr vp_ = vp0 + sl_prev; \
    D6_VRD(0); D6_SBAR(); float sacc = P0[0] + P0[1]; \
                       D6_GAPA(C0 = D6_MFMA(kf[0], qr[0], C0), P0[2], P0[3], P0[4], P0[5],     pw0[0] = D6_PKW(P0, 0),  pw0[1] = D6_PKW(P0, 2),  pw0); \
    D6_VRD(4); D6_SBAR(); D6_GAPA(C1 = D6_MFMA(kf[1], qr[0], C1), P0[6], P0[7], P0[8], P0[9],     pw0[2] = D6_PKW(P0, 4),  pw0[3] = D6_PKW(P0, 6),  pw0); \
    D6_VRD(1); D6_SBAR(); D6_GAPA(C0 = D6_MFMA(kf[2], qr[1], C0),    P0[10], P0[11], P0[12], P0[13], pw1[0] = D6_PKW(P0, 8),  pw1[1] = D6_PKW(P0, 10), pw1); \
    D6_VRD(5); D6_SBAR(); D6_GAPA(C1 = D6_MFMA(kf[3], qr[1], C1),    P0[14], P0[15], P1[0], P1[1],   pw1[2] = D6_PKW(P0, 12), pw1[3] = D6_PKW(P0, 14), pw1); \
    D6_VRD(2); D6_SBAR(); D6_GAPA(C0 = D6_MFMA(kf[4], qr[2], C0),    P1[2], P1[3], P1[4], P1[5],     pw2[0] = D6_PKW(P1, 0),  pw2[1] = D6_PKW(P1, 2),  pw2); \
    D6_VRD(6); D6_SBAR(); D6_GAPA(C1 = D6_MFMA(kf[5], qr[2], C1),    P1[6], P1[7], P1[8], P1[9],     pw2[2] = D6_PKW(P1, 4),  pw2[3] = D6_PKW(P1, 6),  pw2); \
    D6_VRD(3); D6_SBAR(); D6_GAPA(C0 = D6_MFMA(kf[6], qr[3], C0),    P1[10], P1[11], P1[12], P1[13], pw3[0] = D6_PKW(P1, 8),  pw3[1] = D6_PKW(P1, 10), pw3); \
    D6_VRD(7); D6_SBAR(); D6_GAPA(C1 = D6_MFMA(kf[7], qr[3], C1),    P1[14], P1[15], 0.f, 0.f,       pw3[2] = D6_PKW(P1, 12), pw3[3] = D6_PKW(P1, 14), pw3); \
    l_reg += sacc; \
    if (GK) { A6_POP(sK, Rk, rk); A6_DMA_K(Rk, sl_cur); } if (GV) { A6_POP(sV, Rv, rv); A6_DMA_V(Rv, sl_next); } \
    const LAS float* tpn = ninfp; if (GL) { A6_POP(sT, Rt, rt); tpn = A6_TPTR(Rt, rt); } \
    { const float rm = d6_rowmax(C0, C1); resc = false; \
      if (__builtin_expect(__any(rm > D6_THR), 0)) { const float dl = __builtin_fmaxf(rm, 0.f); mhat += dl; wmoved = true; \
          const float f = __builtin_amdgcn_exp2f(-dl); l_reg *= f; if (hi == 0) wsf[r32] = f; resc = true; \
          _Pragma("unroll") for (int r = 0; r < 16; ++r) { C0[r] -= dl; C1[r] -= dl; } } } \
    D6_SBAR(); \
    A6_TRD(GL, P0, P1, 0, 4);  A6_GAPB(o[0] = D6_MFMA(D6_PAF(0), vf[0], o[0]), C0, 0);  A6_TRD(GL, P0, P1, 4, 8);  A6_GAPB(o[1] = D6_MFMA(D6_PAF(0), vf[4], o[1]), C0, 4); \
    D6_KRD(GL, 0); A6_GAPB(o[0] = D6_MFMA(D6_PAF(1), vf[1], o[0]), C0, 8);  D6_KRD(GL, 1); A6_GAPB(o[1] = D6_MFMA(D6_PAF(1), vf[5], o[1]), C0, 12); \
    D6_KRD(GL, 2); A6_GAPB(o[0] = D6_MFMA(D6_PAF(2), vf[2], o[0]), C1, 0);  D6_KRD(GL, 3); A6_GAPB(o[1] = D6_MFMA(D6_PAF(2), vf[6], o[1]), C1, 4); \
    A6_TRD(GL, P0, P1, 8, 12); A6_GAPB(o[0] = D6_MFMA(D6_PAF(3), vf[3], o[0]), C1, 8);  A6_TRD(GL, P0, P1, 12, 16); A6_GAPB(o[1] = D6_MFMA(D6_PAF(3), vf[7], o[1]), C1, 12); \
    } while (0)
    int t = 1;
    for (; t + 5 < NT_; t += 2) {
        A6_STEP(pB0, pB1, pA0, pA1, true, true, true); D6_WAIT_BAR(2); D6_RESC(); D6_ROT();
        A6_STEP(pA0, pA1, pB0, pB1, true, true, true); D6_WAIT_BAR(2); D6_RESC(); D6_ROT();
    }
#define A6_DRAIN(Q0, Q1, slot_) do { float sacc = Q0[0] + Q0[1]; \
      _Pragma("unroll") for (int r = 2; r < 16; ++r) sacc += Q0[r]; \
      _Pragma("unroll") for (int r = 0; r < 16; ++r) sacc += Q1[r]; \
      l_reg += sacc; \
      pw0 = (u32x4_t_){D6_PKW(Q0, 0), D6_PKW(Q0, 2), D6_PKW(Q0, 4), D6_PKW(Q0, 6)}; pw1 = (u32x4_t_){D6_PKW(Q0, 8), D6_PKW(Q0, 10), D6_PKW(Q0, 12), D6_PKW(Q0, 14)}; \
      pw2 = (u32x4_t_){D6_PKW(Q1, 0), D6_PKW(Q1, 2), D6_PKW(Q1, 4), D6_PKW(Q1, 6)}; pw3 = (u32x4_t_){D6_PKW(Q1, 8), D6_PKW(Q1, 10), D6_PKW(Q1, 12), D6_PKW(Q1, 14)}; \
      const d6_lptr vp_ = vp0 + (slot_); _Pragma("unroll") for (int i = 0; i < 8; ++i) D6_VRD(i); \
      o[0] = D6_MFMA(D6_PAF(0), vf[0], o[0]); o[1] = D6_MFMA(D6_PAF(0), vf[4], o[1]); o[0] = D6_MFMA(D6_PAF(1), vf[1], o[0]); o[1] = D6_MFMA(D6_PAF(1), vf[5], o[1]); \
      o[0] = D6_MFMA(D6_PAF(2), vf[2], o[0]); o[1] = D6_MFMA(D6_PAF(2), vf[6], o[1]); o[0] = D6_MFMA(D6_PAF(3), vf[3], o[0]); o[1] = D6_MFMA(D6_PAF(3), vf[7], o[1]); } while (0)
    for (; t + 1 < NT_; t += 2) {
        A6_STEP(pB0, pB1, pA0, pA1, (t + 3 < NT_), (t + 1 < NT_), (t + 1 < NT_));         D6_ENDW(t);     D6_RESC(); D6_ROT();
        if (t + 2 == NT_) { nbase = sl_next; if (ntmask) a_prime(nkb, nvb, lds, ntmask, nbase, tid); }
        A6_STEP(pA0, pA1, pB0, pB1, (t + 4 < NT_), (t + 2 < NT_), (t + 2 < NT_));         D6_ENDW(t + 1); D6_RESC(); D6_ROT();
    }
    if (NT_ & 1) {
        if (NT_ == 1) { nbase = sl_next; if (ntmask) a_prime(nkb, nvb, lds, ntmask, nbase, tid); }
        A6_DRAIN(pA0, pA1, sl_prev);
    } else {
        nbase = sl_next;
        if (ntmask) a_prime(nkb, nvb, lds, ntmask, nbase, tid);
        A6_STEP(pB0, pB1, pA0, pA1, false, false, false); D6_RESC();
        A6_DRAIN(pB0, pB1, sl_cur);
    }
    l_out = l_reg; m_out = mhat;
    asm volatile("s_waitcnt vmcnt(0) lgkmcnt(0)\n\ts_barrier" ::: "memory");
}
typedef float f32x4_t_ __attribute__((ext_vector_type(4)));
constexpr int TA_HS = 2048 + 128 + 8;
constexpr int TW_N = 648, TW_HS = 680;
__device__ __forceinline__ void bunit_A(const bf16_t* P, const bf16_t* VT, const bf16_t* KCMP, const bf16_t* VCMPT, const float* GT, bf16_t* MIX, const LAS float* tabA4, const LAS float* tabW4, LAS float* osc  ,
                                        LAS float* wsf  , volatile LAS unsigned* um  , LAS unsigned char* ring, int b, int g, int q64, int tid, int wib,
                                        int& wbase  , int q64n  ) {
    asm volatile("" : "+v"(tid));
    int lane = tid & 63; asm volatile("" : "+v"(lane));
    const int c = lane & 31, h = lane >> 5, hh = c >> 3, qi = c & 7, t0 = 64 * q64 + 8 * wib, tc = t0 + qi, head = g * 4 + hh;
    const size_t rowq = (size_t)b * S + tc;
    abf16x8 qf[4];
#pragma unroll
    for (int s = 0; s < 4; ++s) qf[s] = *(const abf16x8*)(P + rowq * LDP + C_AQ + head * 64 + 16 * s + 8 * h);
    const LAS float* tabh = tabA4 + hh * TA_HS;
    const float gt0 = GT[rowq * 24 + 0 * 8 + head], gt1 = GT[rowq * 24 + 1 * 8 + head], gt2 = GT[rowq * 24 + 2 * 8 + head];
    unsigned selmask = 0u;
    TS_BEGIN(1)
    {
        const int ncv = tc >= 31 ? ((tc - 31) >> 4) + 1 : 0;
        const bf16_t* kp = KCMP + (size_t)(b * 2 + g) * 8192 + (h * 32 + c) * 8;
        const bf16_t* vp = VCMPT + (size_t)(b * 2 + g) * 8192 + (h * 32 + c) * 8;
        const LAS float* tabp = tabh + (2047 - tc + 31 + 128 * h);
        float sc[4][16]; float mx = -INFINITY;
        const int ntile = (4 * q64 + 34) >> 5;
        abf16x8 kcf[4][4];
#pragma unroll
        for (int kt = 0; kt < 4; ++kt) if (kt < ntile) {
#pragma unroll
            for (int s = 0; s < 4; ++s) kcf[kt][s] = *(const abf16x8*)(kp + (kt * 4 + s) * 512); }
#pragma unroll
        for (int kt = 0; kt < 4; ++kt) if (kt < ntile) {
            f32x16 acc;
#pragma unroll
            for (int r = 0; r < 16; ++r) acc[r] = tabp[512 * kt + 16 * ((r & 7) + 16 * (r >> 3))];
#pragma unroll
            for (int s = 0; s < 4; ++s) acc = __builtin_amdgcn_mfma_f32_32x32x16_bf16(kcf[kt][s], qf[s], acc, 0, 0, 0);
#pragma unroll
            for (int r = 0; r < 16; ++r) {
                const int ko = (r & 7) + 16 * (r >> 3);
                const bool ok = 32 * kt + 8 * h + ko < ncv;
                const float x = ok ? acc[r] : -INFINITY;
                sc[kt][r] = x; mx = fmaxf(mx, x);
            }
        }
        abf16x8 vcf[4][4];
#pragma unroll
        for (int kt = 0; kt < 4; ++kt) if (kt < ntile) {
#pragma unroll
            for (int dh = 0; dh < 2; ++dh)
#pragma unroll
                for (int s2 = 0; s2 < 2; ++s2) vcf[kt][dh * 2 + s2] = *(const abf16x8*)(vp + ((kt * 2 + dh) * 2 + s2) * 512); }
        mx = fmaxf(mx, __shfl_xor(mx, 32)); mx = fmaxf(mx, -1e30f);
        float sum = 0.f; const float nmx = -mx;
#pragma unroll
        for (int kt = 0; kt < 4; ++kt) {
            if (kt < ntile) {
#pragma unroll
                for (int r = 0; r < 16; ++r) { sc[kt][r] = __builtin_amdgcn_exp2f(sc[kt][r] + nmx); sum += sc[kt][r]; }
            } else {
#pragma unroll
                for (int r = 0; r < 16; ++r) sc[kt][r] = 0.f;
            }
        }
        sum += __shfl_xor(sum, 32);
        const float inv = 1.f / fmaxf(sum, 1e-30f);
        f32x16 oc[2];
#pragma unroll
        for (int r = 0; r < 16; ++r) { oc[0][r] = 0.f; oc[1][r] = 0.f; }
#pragma unroll
        for (int kt = 0; kt < 4; ++kt) if (kt < ntile) {
            abf16x8 pf[2];
#pragma unroll
            for (int s2 = 0; s2 < 2; ++s2) {
                u32x4_t_ w; w.x = cvtpk(sc[kt][8 * s2 + 0], sc[kt][8 * s2 + 1]); w.y = cvtpk(sc[kt][8 * s2 + 2], sc[kt][8 * s2 + 3]); w.z = cvtpk(sc[kt][8 * s2 + 4], sc[kt][8 * s2 + 5]); w.w = cvtpk(sc[kt][8 * s2 + 6], sc[kt][8 * s2 + 7]);
                pf[s2] = __builtin_bit_cast(abf16x8, w);
            }
#pragma unroll
            for (int dh = 0; dh < 2; ++dh)
#pragma unroll
                for (int s2 = 0; s2 < 2; ++s2) oc[dh] = __builtin_amdgcn_mfma_f32_32x32x16_bf16(pf[s2], vcf[kt][dh * 2 + s2], oc[dh], 0, 0, 0);
        }
        const int cur = q64;
        if (cur <= 7) selmask = 0xffffffffu >> (31 - cur);
        else {
            float x7[4], x15[4];
#pragma unroll
            for (int kt = 0; kt < 4; ++kt) { x7[kt] = 0.f; x15[kt] = 0.f; if (kt < ntile) { x7[kt] = __shfl_xor(sc[kt][7], 32); x15[kt] = __shfl_xor(sc[kt][15], 32); } }
            unsigned key[16];
#pragma unroll
            for (int kt = 0; kt < 4; ++kt) {
                if (kt < ntile) {
#pragma unroll
                    for (int gb = 0; gb < 2; ++gb) {
                        const float pl0 = gb == 0 ? (kt > 0 ? x15[kt > 0 ? kt - 1 : 0] : 0.f) : x7[kt];
                        const float pl1 = gb == 0 ? x7[kt] : x15[kt];
                        const float prevlast = h ? pl1 : pl0;
                        float ie = prevlast + sc[kt][8 * gb + 0] + sc[kt][8 * gb + 1] + sc[kt][8 * gb + 2] + sc[kt][8 * gb + 3];
                        float io = sc[kt][8 * gb + 3] + sc[kt][8 * gb + 4] + sc[kt][8 * gb + 5] + sc[kt][8 * gb + 6] + sc[kt][8 * gb + 7];
                        ie *= inv; io *= inv;
                        ie += __shfl_xor(ie, 8); ie += __shfl_xor(ie, 16);
                        io += __shfl_xor(io, 8); io += __shfl_xor(io, 16);
#pragma unroll
                        for (int eo = 0; eo < 2; ++eo) {
                            const int n = 8 * kt + 2 * h + 4 * gb + eo;
                            const bool forced = n == 0 || n == cur || n == cur - 1;
                            const float v = eo ? io : ie;
                            key[(kt * 2 + gb) * 2 + eo] = forced ? 0u : (n > cur ? (unsigned)(31 - n) : ((((__float_as_uint(v) >> 5) + 1u) << 5) | (unsigned)(31 - n)));
                        }
                    }
                } else {
#pragma unroll
                    for (int e = 0; e < 4; ++e) key[kt * 4 + e] = 0u;
                }
            }
            selmask = 1u | (1u << cur) | (1u << (cur - 1));
#pragma unroll 1
            for (int round = 0; round < 5; ++round) {
                unsigned lm = key[0];
#pragma unroll
                for (int i = 1; i < 16; ++i) lm = lm > key[i] ? lm : key[i];
                const unsigned pm = (unsigned)__shfl_xor((int)lm, 32);
                const unsigned best = lm > pm ? lm : pm;
                selmask |= 1u << (31 - (best & 31u));
#pragma unroll
                for (int i = 0; i < 16; ++i) key[i] = key[i] == best ? 0u : key[i];
            }
        }
        if (h == 0) wsf[32 + c] = sigmoidf(gt0) * inv;
        asm volatile("s_waitcnt lgkmcnt(0)" ::: "memory");
#pragma unroll
        for (int r = 0; r < 16; ++r) { const int row = d6_crow(r, h); const float g0 = wsf[32 + row]; osc[row * 64 + c] = oc[0][r] * g0; osc[row * 64 + 32 + c] = oc[1][r] * g0; }
    }
    TS_END(1)
    unsigned umask = selmask;
#pragma unroll
    for (int o = 1; o < 64; o <<= 1) umask |= (unsigned)__shfl_xor((int)umask, o);
    umask = __builtin_amdgcn_readfirstlane(umask) & (0xffffffffu >> (31 - q64));
    if (lane == 0) um[wib] = umask;
    __syncthreads();
    unsigned bmask = 0u;
#pragma unroll
    for (int w = 0; w < 8; ++w) bmask |= um[w];
    bmask = __builtin_amdgcn_readfirstlane(bmask);
    int sbase = 0;
    {
        int h2 = lane >> 5; asm volatile("" : "+v"(h2));
        int c2 = lane & 31; asm volatile("" : "+v"(c2));
        const LAS float* tabw = tabW4 + (c2 >> 3) * TW_HS;
        const int Rlo = (64 * q64 - 511 > 0 ? 64 * q64 - 511 : 0) >> 6;
        const unsigned rm = (0xffffffffu >> (31 - q64)) & (0xffffffffu << Rlo);
        f32x16 o[2]; float l, mref; (void)mref;
        TS_BEGIN(3)
        a_sweep64<false>(P + (size_t)b * S * LDP + C_AKW + g * 64, VT + (size_t)(VR_AVW + g * 64) * M + (size_t)b * S, ring, wsf, rm, 0u, tabw + (575 - tc + 8 * h2), tabw + 576, qf, o, l, mref, tid,
                         true, wbase, P + (size_t)b * S * LDP + C_AKS + g * 64, VT + (size_t)(VR_AVS + g * 64) * M + (size_t)b * S, bmask, sbase);
        TS_END(3)
        { auto rr = __builtin_amdgcn_permlane32_swap(__float_as_uint(l), __float_as_uint(l), false, false); l = __uint_as_float(rr[0]) + __uint_as_float(rr[1]); }
        if (h2 == 0) wsf[32 + c2] = sigmoidf(gt2) / l;
        asm volatile("s_waitcnt lgkmcnt(0)" ::: "memory");
#pragma unroll
        for (int r = 0; r < 16; ++r) { const int row = d6_crow(r, h2); const float g2 = wsf[32 + row]; osc[row * 64 + c2] += o[0][r] * g2; osc[row * 64 + 32 + c2] += o[1][r] * g2; }
    }
    {
        int h2 = lane >> 5; asm volatile("" : "+v"(h2));
        int c2 = lane & 31; asm volatile("" : "+v"(c2));
        unsigned rmn = 0u;
        if (q64n >= 0) { const int Rlon = (64 * q64n - 511 > 0 ? 64 * q64n - 511 : 0) >> 6; rmn = (0xffffffffu >> (31 - q64n)) & (0xffffffffu << Rlon); }
        f32x16 o[2]; float l, mref; (void)mref;
        TS_BEGIN(2)
        a_sweep64<true>(P + (size_t)b * S * LDP + C_AKS + g * 64, VT + (size_t)(VR_AVS + g * 64) * M + (size_t)b * S, ring, wsf, bmask, selmask, tabh + (2047 - tc + 8 * h2), tabh + 2112, qf, o, l, mref, tid,
                        true, sbase, P + (size_t)b * S * LDP + C_AKW + g * 64, VT + (size_t)(VR_AVW + g * 64) * M + (size_t)b * S, rmn, wbase);
        TS_END(2)
        int ln = lane; asm volatile("" : "+v"(ln));
        uint4 gv[4];
#pragma unroll
        for (int i = 0; i < 4; ++i) { const int row = i * 8 + (ln >> 3), ch = ln & 7; gv[i] = *(const uint4*)(P + ((size_t)b * S + t0 + (row & 7)) * LDP + C_AGATE + (g * 4 + (row >> 3)) * 64 + ch * 8); }
        { auto rr = __builtin_amdgcn_permlane32_swap(__float_as_uint(l), __float_as_uint(l), false, false); l = __uint_as_float(rr[0]) + __uint_as_float(rr[1]); }
        if (h2 == 0) wsf[32 + c2] = sigmoidf(gt1) / l;
        asm volatile("s_waitcnt lgkmcnt(0)" ::: "memory");
#pragma unroll
        for (int r = 0; r < 16; ++r) { const int row = d6_crow(r, h2); const float g1 = wsf[32 + row]; osc[row * 64 + c2] += o[0][r] * g1; osc[row * 64 + 32 + c2] += o[1][r] * g1; }
        asm volatile("s_waitcnt lgkmcnt(0)" ::: "memory");
#pragma unroll
        for (int i = 0; i < 4; ++i) { const int row = i * 8 + (ln >> 3), ch = ln & 7;
            const f32x4_t_ oa = *(const LAS f32x4_t_*)(osc + row * 64 + ch * 8), ob = *(const LAS f32x4_t_*)(osc + row * 64 + ch * 8 + 4);
            float fg[8]; unpack8(gv[i], fg);
            uint4 w; w.x = cvtpk(oa.x * silu(fg[0]), oa.y * silu(fg[1])); w.y = cvtpk(oa.z * silu(fg[2]), oa.w * silu(fg[3]));
            w.z = cvtpk(ob.x * silu(fg[4]), ob.y * silu(fg[5])); w.w = cvtpk(ob.z * silu(fg[6]), ob.w * silu(fg[7]));
            *(uint4*)(MIX + ((size_t)b * S + t0 + (row & 7)) * DM + (g * 4 + (row >> 3)) * 64 + ch * 8) = w; }
    }
}

typedef __attribute__((address_space(1))) unsigned gu32;
constexpr size_t WS_CTL = 0; constexpr size_t CTL_ZERO_BYTES = 64 * 1024; constexpr int CW_BAR = 1024;
constexpr int MISC_OFF = LDS_BYTES - 128;
#define XB_TMO      128
#define XB_XCNT(j)  (256  + 64 * (j))
#define XB_XSUB(j)  (1280 + 64 * (j))
#define XB_XGEN(j)  (2304 + 64 * (j))
#define XB_TOP      3328
#define XB_TOPGEN   3392
#define XCD_BAR_WORDS 3456
#define XB_SPIN_CAP (1u << 18)

__device__ __forceinline__ unsigned xb_ld(unsigned* p)              { return __hip_atomic_load(p, __ATOMIC_RELAXED, __HIP_MEMORY_SCOPE_AGENT); }
__device__ __forceinline__ unsigned xb_add(unsigned* p, unsigned v) { return __hip_atomic_fetch_add(p, v, __ATOMIC_RELAXED, __HIP_MEMORY_SCOPE_AGENT); }
__device__ __forceinline__ unsigned xb_xcc_id() { return (unsigned)__builtin_amdgcn_s_getreg((3 << 11) | 20) & 0xFu; }
#define XB_SPIN(cond, bar) do { unsigned _sp = 0; while (cond) { __builtin_amdgcn_s_sleep(1); \
    if ((++_sp & 255u) == 0u) { if (xb_ld(&(bar)[XB_TMO])) break; if (_sp > XB_SPIN_CAP) { atomicAdd(&(bar)[XB_TMO], 1u); break; } } } } while (0)

struct XcdBarrier {
    unsigned* bar; unsigned x;
    volatile LAS unsigned* st;
};

__device__ __forceinline__ XcdBarrier xcd_barrier_post(unsigned* bar, volatile LAS unsigned* st) {
    XcdBarrier b; b.bar = bar; b.x = xb_xcc_id(); b.st = st;
    if (threadIdx.x == 0) (void)xb_add(&bar[XB_XCNT(b.x)], 1u);
    return b;
}
__device__ __forceinline__ void xcd_barrier_complete(unsigned* bar, unsigned x, unsigned& nloc, unsigned& nx) {
    const unsigned G = gridDim.x * gridDim.y * gridDim.z;
    unsigned sum, cnt, mine, sp = 0u;
    for (;;) {
        sum = 0u; cnt = 0u; mine = 0u;
#pragma unroll
        for (unsigned j = 0; j < 16; ++j) { const unsigned c = xb_ld(&bar[XB_XCNT(j)]); sum += c; cnt += (c > 0u) ? 1u : 0u; mine = (j == x) ? c : mine; }
        if (sum == G) break;
        __builtin_amdgcn_s_sleep(1);
        if ((++sp & 255u) == 0u) { if (xb_ld(&bar[XB_TMO])) break; if (sp > XB_SPIN_CAP) { atomicAdd(&bar[XB_TMO], 1u); break; } }
    }
    nloc = mine > 0u ? mine : 1u; nx = cnt > 0u ? cnt : 1u;
}

__device__ __forceinline__ void xcd_barrier(const XcdBarrier& b) {
    asm volatile("s_waitcnt vmcnt(0)" ::: "memory");
    __syncthreads();
    if (threadIdx.x == 0) {
        unsigned* bar = b.bar;
        __builtin_amdgcn_s_waitcnt(0);
        unsigned nloc = b.st[0], nx = b.st[1];
        if (nloc == 0u) { xcd_barrier_complete(bar, b.x, nloc, nx); b.st[0] = nloc; b.st[1] = nx; }
        const unsigned old = xb_add(&bar[XB_XSUB(b.x)], 1u);
        const unsigned gen = old / nloc;
        if (old + 1u == (gen + 1u) * nloc) {
            __builtin_amdgcn_fence(__ATOMIC_RELEASE, "agent");
            asm volatile("s_waitcnt vmcnt(0)" ::: "memory");
            const unsigned og = xb_add(&bar[XB_TOP], 1u);
            const unsigned tg = og / nx;
            if (og + 1u == (tg + 1u) * nx) xb_add(&bar[XB_TOPGEN], 1u);
            else XB_SPIN(xb_ld(&bar[XB_TOPGEN]) == tg, bar);
            __builtin_amdgcn_fence(__ATOMIC_ACQUIRE, "agent");
            xb_add(&bar[XB_XGEN(b.x)], 1u);
            asm volatile("s_waitcnt vmcnt(0)" ::: "memory");
        } else {
            XB_SPIN(xb_ld(&bar[XB_XGEN(b.x)]) == gen, bar);
            __builtin_amdgcn_fence(__ATOMIC_ACQUIRE, "agent");
            asm volatile("s_waitcnt vmcnt(0)" ::: "memory");
        }
    }
    __syncthreads();
}


typedef unsigned u4v_nt __attribute__((ext_vector_type(4)));
__device__ __forceinline__ uint4 ld_nt16(const void* p) { const u4v_nt t = __builtin_nontemporal_load((const u4v_nt*)p); return make_uint4(t.x, t.y, t.z, t.w); }
constexpr int CW_SPLIT = 8192;
__device__ __forceinline__ void split_arrive(unsigned* cnt) {
    asm volatile("s_waitcnt vmcnt(0)" ::: "memory");
    __syncthreads();
    if (threadIdx.x == 0) {
        __builtin_amdgcn_fence(__ATOMIC_RELEASE, "agent");
        asm volatile("s_waitcnt vmcnt(0)" ::: "memory");
        (void)__hip_atomic_fetch_add(cnt, 1u, __ATOMIC_RELAXED, __HIP_MEMORY_SCOPE_AGENT);
    }
}
constexpr int CW_GRP = 8192 + 64 * 16;
__device__ __forceinline__ void split_arrive2(unsigned* cnt, unsigned* cnt2) {
    asm volatile("s_waitcnt vmcnt(0)" ::: "memory");
    __syncthreads();
    if (threadIdx.x == 0) {
        __builtin_amdgcn_fence(__ATOMIC_RELEASE, "agent");
        asm volatile("s_waitcnt vmcnt(0)" ::: "memory");
        (void)__hip_atomic_fetch_add(cnt, 1u, __ATOMIC_RELAXED, __HIP_MEMORY_SCOPE_AGENT);
        if (cnt2) (void)__hip_atomic_fetch_add(cnt2, 1u, __ATOMIC_RELAXED, __HIP_MEMORY_SCOPE_AGENT);
    }
}
__device__ __forceinline__ void split_wait(unsigned* cnt, unsigned* tmo);
__device__ __forceinline__ void split_wait_n(unsigned* cnt, unsigned target, unsigned* tmo) {
    if (threadIdx.x == 0) {
        unsigned sp = 0u;
        while (__hip_atomic_load(cnt, __ATOMIC_RELAXED, __HIP_MEMORY_SCOPE_AGENT) < target) {
            __builtin_amdgcn_s_sleep(1);
            if ((++sp & 255u) == 0u) { if (__hip_atomic_load(tmo, __ATOMIC_RELAXED, __HIP_MEMORY_SCOPE_AGENT)) break; if (sp > XB_SPIN_CAP) { atomicAdd(tmo, 1u); break; } }
        }
        __builtin_amdgcn_fence(__ATOMIC_ACQUIRE, "agent");
        asm volatile("s_waitcnt vmcnt(0)" ::: "memory");
    }
    __syncthreads();
}
__device__ __forceinline__ void split_wait(unsigned* cnt, unsigned* tmo) {
    if (threadIdx.x == 0) {
        const unsigned G = gridDim.x; unsigned sp = 0u;
        while (__hip_atomic_load(cnt, __ATOMIC_RELAXED, __HIP_MEMORY_SCOPE_AGENT) < G) {
            __builtin_amdgcn_s_sleep(1);
            if ((++sp & 255u) == 0u) { if (__hip_atomic_load(tmo, __ATOMIC_RELAXED, __HIP_MEMORY_SCOPE_AGENT)) break; if (sp > XB_SPIN_CAP) { atomicAdd(tmo, 1u); break; } }
        }
        __builtin_amdgcn_fence(__ATOMIC_ACQUIRE, "agent");
        asm volatile("s_waitcnt vmcnt(0)" ::: "memory");
    }
    __syncthreads();
}

#define LAUNDER_S(x)
#define PH_COMMON \
    int tid_ = threadIdx.x; asm volatile("" : "+v"(tid_)); const int tid = tid_, lane = tid & 63, wib = __builtin_amdgcn_readfirstlane(tid >> 6); \
    const int G = gridDim.x; const int vblk = (G & 7) == 0 ? (int)(blockIdx.x & 7) * (G >> 3) + (int)(blockIdx.x >> 3) : (int)blockIdx.x;     \
    const int gthreads = G * NT, gtid = vblk * NT + tid; const int gwaves = G * NWAVES, gwave = vblk * NWAVES + wib; \
    size_t wsz_ = 0; asm volatile("" : "+s"(wsz_)); unsigned char* ws = prm.ws + wsz_;        (void)lane; (void)gthreads; (void)gtid; (void)gwaves; (void)gwave; (void)ws;

__device__ __forceinline__ void phase_prologue(const Params& prm, LAS unsigned char* ldsb, int part) {
    PH_COMMON
    float* biasd = (float*)(ws + WS_BIASD); bf16_t* WG = (bf16_t*)(ws + WS_WG);
    bf16_t* WINT = (bf16_t*)(ws + WS_WIN); bf16_t* WOUTT = (bf16_t*)(ws + WS_WOUT); bf16_t* XB = (bf16_t*)(ws + WS_XB);
    if (part == 1) for (int i = gtid; i < 24 * 2048; i += gthreads) { const int h = i >> 11, d = i & 2047; biasd[i] = prm.rel_bias[t5_bucket(d) * 24 + h]; }
    if (part == 1) {
        float* img = (float*)(ws + WS_IMG);
        for (int i = gtid; i < 8 * 2048; i += gthreads) { const int h = i >> 11, d = 2047 - (i & 2047);
            img[i] = prm.rel_bias[t5_bucket(d) * 24 + h] * LOG2E;
            const int mult = (d <= 128 ? 1 : 0) + (((d & 3) == 0 && d <= 512) ? 1 : 0) + ((d & 15) == 0 ? 1 : 0);
            img[8 * 2048 + i] = mult == 0 ? -INFINITY : prm.rel_bias[t5_bucket(d) * 24 + 16 + h] * LOG2E + (mult == 1 ? 0.f : (mult == 2 ? 1.f : 1.5849625007211562f)); }
        for (int i = gtid; i < 8 * 256; i += gthreads) { const int h = i >> 8, d = 255 - (i & 255); img[16 * 2048 + i] = prm.rel_bias[t5_bucket(d) * 24 + 8 + h] * LOG2E; }
    }
    if (part == 0) for (int i = gtid; i < DEPTH * 256 * 32; i += gthreads) { const int j = i & 31, k8 = (i >> 5) & 255, l = i >> 13;
        uint4 o = make_uint4(0u, 0u, 0u, 0u);
        if (j < 24) { float v[8];
#pragma unroll
            for (int e = 0; e < 8; ++e) { const int k = 8 * k8 + e; v[e] = prm.w_in[(size_t)l * DM * DIN + (size_t)k * DIN + SRC_GATES + j] * prm.norm_w[l * DM + k]; }
            o = make_uint4(pk2(v[0], v[1]), pk2(v[2], v[3]), pk2(v[4], v[5]), pk2(v[6], v[7])); }
        *(uint4*)(WG + (size_t)i * 8) = o; }
    if (part == 1) {
        bf16_t* W1T = (bf16_t*)(ws + WS_W1T); bf16_t* W2T = (bf16_t*)(ws + WS_W2T); bf16_t* POSB = (bf16_t*)(ws + WS_PB);
        for (int i = gtid; i < 4 * 256 * 128; i += gthreads) { const int j = i & 127, g8 = (i >> 7) & 255, lw = i >> 15;
            float v[8];
#pragma unroll
            for (int e = 0; e < 8; ++e) { const int kk = 8 * g8 + e; const int k = (lw & 1) ? ((kk & 31) * 64 + (kk >> 5)) : kk;
                v[e] = prm.cmp_w1[((size_t)lw * 2048 + k) * 128 + j]; }
            *(uint4*)(W1T + ((((((size_t)lw * 4 + (j >> 5)) * 2 + (g8 >> 7)) * 64 + ((g8 >> 1) & 63)) * 2 + (g8 & 1)) * 32 + (j & 31)) * 8) = make_uint4(pk2(v[0], v[1]), pk2(v[2], v[3]), pk2(v[4], v[5]), pk2(v[6], v[7])); }
        for (int i = gtid; i < 4 * 2048; i += gthreads) { const int kk = i & 2047, lw = i >> 11; const int k = (lw & 1) ? ((kk & 31) * 64 + (kk >> 5)) : kk;
            POSB[i] = f2bf(prm.cmp_pos[(size_t)lw * 2048 + k]); }
        for (int i = gtid; i < 4 * 128 * 64; i += gthreads) { const int e = i & 63, j = (i >> 6) & 127, lw = i >> 13; W2T[((size_t)lw * 64 + e) * 128 + j] = f2bf(prm.cmp_w2[((size_t)lw * 128 + j) * 64 + e]); }
    }
    {
        LAS float* scr = (LAS float*)(ldsb + wib * 8448);
        LAS float* nwl = (LAS float*)(ldsb + 8 * 8448);
        for (int i = tid; i < DEPTH * DM; i += NT) nwl[i] = prm.norm_w[i];
        __syncthreads();
        constexpr int I_IN = 32 * (NW_IN / 32), I_OUT = 32 * (DM / 32), NIT = DEPTH * (I_IN + I_OUT);
        auto decode = [&](int it) -> TrItem {
            const int l = it / (I_IN + I_OUT); int r = it % (I_IN + I_OUT); TrItem t;
            if (r < I_IN) { t.nb = r % (NW_IN / 32); t.kb = r / (NW_IN / 32); t.W = prm.w_in + (size_t)l * DM * DIN; t.K = DM; t.srcld = DIN; t.src_n0 = src_col_of(32 * t.nb) - 32 * t.nb; t.ksc = nwl + l * DM; t.WT = WINT + (size_t)l * NW_IN * DM; }
            else { r -= I_IN; t.nb = r % (DM / 32); t.kb = r / (DM / 32); t.W = prm.w_out + (size_t)l * DM * DM; t.K = DM; t.srcld = DM; t.src_n0 = 0; t.ksc = nullptr; t.WT = WOUTT + (size_t)l * DM * DM; }
            return t; };
        float wa[32], wb[32]; TrItem ta, tb;
        const int itend = part == 0 ? I_IN : NIT;
        int it = (part == 0 ? 0 : I_IN) + gwave;
        if (it < itend) { ta = decode(it); tr_load(ta, wa, lane); }
        while (it < itend) {
            const int it2 = it + gwaves;
            if (it2 < itend) { tb = decode(it2); tr_load(tb, wb, lane); }
            tr_store(ta, wa, scr, lane);
            const int it3 = it2 + gwaves;
            if (it3 < itend) { ta = decode(it3); tr_load(ta, wa, lane); }
            if (it2 < itend) tr_store(tb, wb, scr, lane);
            it = it3;
        }
    }
    if (part == 0) {
        float* rss = (float*)(ws + WS_RSS);
        for (int i = gtid; i < M; i += gthreads) rss[M + i] = 0.f;
        auto rload = [&](int row, float4 (&v)[8]) { const float4* xr = (const float4*)(prm.x + (size_t)row * DM) + lane;
#pragma unroll
            for (int j = 0; j < 8; ++j) { typedef float f4v __attribute__((ext_vector_type(4))); const f4v t4 = __builtin_nontemporal_load((const f4v*)&xr[64 * j]); v[j] = make_float4(t4.x, t4.y, t4.z, t4.w); } };
        auto rstore = [&](int row, const float4 (&v)[8]) { uint2* o8 = (uint2*)(XB + (size_t)row * DM) + lane; float sq = 0.f;
#pragma unroll
            for (int j = 0; j < 8; ++j) { sq += (v[j].x * v[j].x + v[j].y * v[j].y) + (v[j].z * v[j].z + v[j].w * v[j].w); o8[64 * j] = make_uint2(pk2(v[j].x, v[j].y), pk2(v[j].z, v[j].w)); }
            sq = wave_sum(sq);
            if (lane == 0) rss[row] = sq; };
        float4 va[8], vb[8];
        int row = gwave;
        if (row < M) rload(row, va);
        while (row < M) {
            const int r2 = row + gwaves;
            if (r2 < M) rload(r2, vb);
            rstore(row, va);
            const int r3 = r2 + gwaves;
            if (r3 < M) rload(r3, va);
            if (r2 < M) rstore(r2, vb);
            row = r3;
        }
    }
}

__device__ __forceinline__ void phase_inproj(const Params& prm, int layer, LAS unsigned char* ldsb) {
    LAUNDER_S(layer);
    size_t wsz_ = 0; asm volatile("" : "+s"(wsz_)); unsigned char* ws = prm.ws + wsz_;
    const bf16_t* W = (const bf16_t*)(ws + WS_WIN) + (size_t)layer * NW_IN * DM;
    {
        pg8::Gemm g{(const bf16_t*)(ws + WS_XB), W, M, LDP, DM}; pg8::StaticOrder So; So.init(M, LDP, (int)gridDim.x, (int)blockIdx.x);
        pg8::EpiBf16RowScale E{(bf16_t*)(ws + WS_P), LDP, (const float*)(ws + WS_RSS) + (size_t)layer * M, (bf16_t*)(ws + WS_KCB)};
        pg8::gemm_phase<pg8::EpiBf16RowScale, pg8::StaticOrder, false, true>(ldsb, g, So, E);
    }
    {
        pg8::Gemm g{W + (size_t)LDP * DM, (const bf16_t*)(ws + WS_XB), NVT, M, DM}; pg8::VtOrder So; So.so.init(NVT, M, (int)gridDim.x, (int)blockIdx.x); So.grouped = gridDim.x == 256; So.c = (int)blockIdx.x;
        pg8::EpiBf16ColScale E{(bf16_t*)(ws + WS_VT), M, (const float*)(ws + WS_RSS) + (size_t)layer * M};
        pg8::gemm_phase<pg8::EpiBf16ColScale, pg8::VtOrder, false, true>(ldsb, g, So, E);
    }
}
__device__ __forceinline__ void phase_outproj(const Params& prm, int layer, LAS unsigned char* ldsb) {
    LAUNDER_S(layer);
    size_t wsz_ = 0; asm volatile("" : "+s"(wsz_)); unsigned char* ws = prm.ws + wsz_;
    pg8::Gemm g{(const bf16_t*)(ws + WS_MIX), (const bf16_t*)(ws + WS_WOUT) + (size_t)layer * DM * DM, M, DM, DM}; pg8::StaticOrder So; So.init(M, DM, (int)gridDim.x, (int)blockIdx.x);
    pg8::EpiResidBf16<false> E{nullptr, (bf16_t*)(ws + WS_XB), DM, layer == 0 ? (float*)(ws + WS_RSS) + M : nullptr};
    pg8::gemm_phase<pg8::EpiResidBf16<false>, pg8::StaticOrder, false, true>(ldsb, g, So, E);
}
__device__ __forceinline__ void phase_gates(const Params& prm, int layer, LAS unsigned char* ldsb) {
    LAUNDER_S(layer);
    PH_COMMON
    const bf16_t* XB = (const bf16_t*)(ws + WS_XB); float* GT = (float*)(ws + WS_G);
    const bf16_t* wg = (const bf16_t*)(ws + WS_WG) + (size_t)layer * 32 * 2048;
    const float* rss = (const float*)(ws + WS_RSS) + (size_t)layer * M;
    const int c = lane & 31, h = lane >> 5, kq = wib & 3, half = wib >> 2;
    LAS float* red = (LAS float*)ldsb + wib * 1024;
    const unsigned lds0 = (unsigned)(uintptr_t)ldsb;
    for (int blk = vblk; blk < M / 64; blk += G) {
        const int rowb = blk * 64, row0 = rowb + half * 32;
        f32x16 acc;
#pragma unroll
        for (int r = 0; r < 16; ++r) acc[r] = 0.f;
#pragma unroll 1
        for (int kh = 0; kh < 2; ++kh) {
            __syncthreads();
#pragma unroll
            for (int r = 0; r < 8; ++r)
#pragma unroll
                for (int p = 0; p < 2; ++p) { const int rho = 8 * wib + r; const int q = (p * 64 + lane) ^ (rho & 15);
                    d6_glds16(XB + (size_t)(rowb + rho) * DM + kh * 1024 + q * 8, (unsigned)__builtin_amdgcn_readfirstlane(lds0 + rho * 2048 + p * 1024)); }
            abf16x8 bfr[16];
#pragma unroll
            for (int s = 0; s < 16; ++s) bfr[s] = *(const abf16x8*)(wg + ((size_t)(kh * 128 + kq * 32 + 2 * s + h) * 32 + c) * 8);
            asm volatile("s_waitcnt vmcnt(0)" ::: "memory");
            __syncthreads();
            const int rho = half * 32 + c; const LAS unsigned char* arow = ldsb + rho * 2048;
#pragma unroll
            for (int s = 0; s < 16; ++s) { const int q = kq * 32 + 2 * s + h;
                acc = __builtin_amdgcn_mfma_f32_32x32x16_bf16(*(const LAS abf16x8*)(arow + ((q ^ (rho & 15)) << 4)), bfr[s], acc, 0, 0, 0); }
        }
        __syncthreads();
#pragma unroll
        for (int r = 0; r < 16; ++r) red[r * 64 + lane] = acc[r];
        __syncthreads();
        if (kq == 0 && c < 24) {
            float rv[16];
#pragma unroll
            for (int r = 0; r < 16; ++r) rv[r] = rss[row0 + (r & 3) + 8 * (r >> 2) + 4 * h];
#pragma unroll
            for (int r = 0; r < 16; ++r) { const float v = (red[r * 64 + lane] + red[1024 + r * 64 + lane]) + (red[2048 + r * 64 + lane] + red[3072 + r * 64 + lane]);
                const int row = row0 + (r & 3) + 8 * (r >> 2) + 4 * h;
                GT[(size_t)row * 24 + c] = v * rsqrtf(rv[r] * (1.f / 2048.f) + 1e-6f); }
        }
        __syncthreads();
    }
}
__device__ __forceinline__ void phase_compress(const Params& prm, int layer, LAS unsigned char* ldsb) {
    LAUNDER_S(layer);
    PH_COMMON
    const bf16_t* P = (const bf16_t*)(ws + WS_P); const bf16_t* VT = (const bf16_t*)(ws + WS_VT);
    bf16_t* KCMP = (bf16_t*)(ws + WS_CMP); bf16_t* VCMPT = KCMP + (size_t)NB * 2 * 128 * 64;
    const int c = lane & 31, h = lane >> 5, jt = wib & 3, kh = wib >> 2;
    LAS float* red = (LAS float*)ldsb;
    LAS float* hid = (LAS float*)(ldsb + 32768);
    const int cj = (int)blockIdx.x >> 3, cgp = (int)blockIdx.x & 7;
    const int cu0 = G == 256 ? (cj < 16 ? (cj >> 3) * 64 + cgp * 8 + (cj & 7) : 2 * NB * 2 * 4) : (int)blockIdx.x;
    for (int u = cu0; u < 2 * NB * 2 * 4; u += G) {
        const int ct = u & 3, g = (u >> 2) & 1, b = (u >> 3) & 7, which = u >> 6;
        const int lw = layer * 2 + which;
        const bf16_t* w1 = (const bf16_t*)(ws + WS_W1T) + ((((size_t)lw * 4 + jt) * 2 + kh) * 64) * 512 + (h * 32 + c) * 8;
        const bf16_t* posb = (const bf16_t*)(ws + WS_PB) + (size_t)lw * 2048 + kh * 1024 + 8 * h;
        int cc = ct * 32 + c; if (cc > NCMP - 1) cc = NCMP - 1;
        f32x16 acc;
#pragma unroll
        for (int r = 0; r < 16; ++r) acc[r] = 0.f;
        if (which == 0) {
            const bf16_t* src = (const bf16_t*)(ws + WS_KCB) + ((size_t)((b * 2 + g) * 4 + ct) * 128) * 512 + (h * 32 + c) * 8;
#pragma unroll 8
            for (int s = 0; s < 64; ++s) { const int ks = kh * 64 + s;
                const abf16x8 wf = *(const abf16x8*)(w1 + 512 * s);
                acc = __builtin_amdgcn_mfma_f32_32x32x16_bf16(wf, *(const abf16x8*)(src + (size_t)ks * 512), acc, 0, 0, 0);
                acc = __builtin_amdgcn_mfma_f32_32x32x16_bf16(wf, *(const abf16x8*)(posb + 16 * s), acc, 0, 0, 0); }
        } else {
            const bf16_t* src = VT + (size_t)(VR_AVC + g * 64) * M + (size_t)(b * S + 16 * cc) + 8 * h;
#pragma unroll 8
            for (int s = 0; s < 64; ++s) { const int ks = kh * 64 + s;
                const abf16x8 wf = *(const abf16x8*)(w1 + 512 * s);
                acc = __builtin_amdgcn_mfma_f32_32x32x16_bf16(wf, *(const abf16x8*)(src + (size_t)(ks >> 1) * M + (ks & 1) * 16), acc, 0, 0, 0);
                acc = __builtin_amdgcn_mfma_f32_32x32x16_bf16(wf, *(const abf16x8*)(posb + 16 * s), acc, 0, 0, 0); }
        }
#pragma unroll
        for (int r = 0; r < 16; ++r) red[wib * 1024 + r * 64 + lane] = acc[r];
        __syncthreads();
        if (wib < 4) {
#pragma unroll
            for (int r = 0; r < 16; ++r) { const int j = jt * 32 + (r & 3) + 8 * (r >> 2) + 4 * h;
                hid[j * 32 + c] = silu(red[wib * 1024 + r * 64 + lane] + red[(wib + 4) * 1024 + r * 64 + lane]); }
        }
        __syncthreads();
        if (wib < 2) {
            const bf16_t* w2 = (const bf16_t*)(ws + WS_W2T) + ((size_t)lw * 64 + wib * 32 + c) * 128 + 8 * h;
            f32x16 o;
#pragma unroll
            for (int r = 0; r < 16; ++r) o[r] = 0.f;
#pragma unroll
            for (int s = 0; s < 8; ++s) {
                u32x4_t_ w; const LAS float* hp = hid + (16 * s + 8 * h) * 32 + c;
                w.x = cvtpk(hp[0], hp[32]); w.y = cvtpk(hp[64], hp[96]); w.z = cvtpk(hp[128], hp[160]); w.w = cvtpk(hp[192], hp[224]);
                o = __builtin_amdgcn_mfma_f32_32x32x16_bf16(*(const abf16x8*)(w2 + 16 * s), __builtin_bit_cast(abf16x8, w), o, 0, 0, 0);
            }
            const int cw = ct * 32 + c;
            if (which == 0) {
                bf16_t* dst = KCMP + (size_t)(b * 2 + g) * 8192 + pi32(c) * 8 + 4 * h;
#pragma unroll
                for (int rg = 0; rg < 4; ++rg) { uint2 w; w.x = cvtpk(o[4 * rg], o[4 * rg + 1]); w.y = cvtpk(o[4 * rg + 2], o[4 * rg + 3]);
                    *(uint2*)(dst + (((ct * 4 + wib * 2 + (rg >> 1)) * 2 + (rg & 1)) * 32) * 8) = w; }
            } else {
                bf16_t* dst = VCMPT + (size_t)(b * 2 + g) * 8192 + ((((ct * 2 + wib) * 2 + (c >> 4)) * 2 + ((c >> 3) & 1)) * 32) * 8 + (c & 7);
#pragma unroll
                for (int r = 0; r < 16; ++r) dst[(4 * h + (r & 3) + 8 * (r >> 2)) * 8] = f2bf(o[r]);
            }
        }
        __syncthreads();
    }
}
__device__ __forceinline__ void dunit64b(const bf16_t* P, const bf16_t* VT, bf16_t* MIX, LAS unsigned char* lds, int b, int head, int qb, int tid_in, int& base, int qbn  ) {
    int tid = tid_in; asm volatile("" : "+v"(tid));
    const int lane = tid & 63, r32 = lane & 31, hi = lane >> 5; const int wid = __builtin_amdgcn_readfirstlane(tid >> 6);
    const size_t rowbase = (size_t)b * S; const int q0 = qb * 256, NT_ = (q0 + 256) / 64;
    const bf16_t* Qw = P + (rowbase + q0 + wid * 32) * LDP + C_DQ + head * 64;
    LAS float* wsf = (LAS float*)(lds + D6_WS) + wid * 64;
    abf16x8 qr[4];
#pragma unroll
    for (int d0 = 0; d0 < 4; ++d0) qr[d0] = *(const abf16x8*)(Qw + (size_t)r32 * LDP + d0 * 16 + hi * 8);
    const int tc = q0 + wid * 32 + r32;
    const LAS float* td = (const LAS float*)(lds + D6_TD);
    const bf16_t* kb = P + rowbase * LDP + C_DK + head * 64; const bf16_t* vb = VT + (size_t)(VR_DV + head * 64) * M + rowbase;
    const unsigned tm = NT_ >= 32 ? 0xffffffffu : (1u << NT_) - 1u;
    const int NTn = qbn < 0 ? 0 : 4 * qbn + 4; const unsigned tmn = qbn < 0 ? 0u : (NTn >= 32 ? 0xffffffffu : (1u << NTn) - 1u);
    f32x16 o[2]; float l_reg, mref; int nbase = 0; (void)mref;
    a_sweep64<false>(kb, vb, lds, wsf, tm, 0u, td + (2047 - tc + 8 * hi), td + 2112, qr, o, l_reg, mref, tid, true, base, kb, vb, tmn, nbase);
    base = nbase;
    const size_t row0 = rowbase + q0 + wid * 32;
    uint4 gv[4];
#pragma unroll
    for (int i = 0; i < 4; ++i) { const int row = i * 8 + (lane >> 3), ch = lane & 7; gv[i] = *(const uint4*)(P + (row0 + row) * LDP + C_DGATE + head * 64 + ch * 8); }
    { auto rr = __builtin_amdgcn_permlane32_swap(__float_as_uint(l_reg), __float_as_uint(l_reg), false, false); l_reg = __uint_as_float(rr[0]) + __uint_as_float(rr[1]); }
    if (hi == 0) wsf[32 + r32] = l_reg; asm volatile("s_waitcnt lgkmcnt(0)" ::: "memory");
    float rli[16];
#pragma unroll
    for (int r = 0; r < 16; ++r) rli[r] = __builtin_amdgcn_rcpf(wsf[32 + d6_crow(r, hi)]);
    LAS bf16_t* stg = (LAS bf16_t*)(lds + D6_OST) + wid * 2048;
#pragma unroll
    for (int r = 0; r < 16; ++r) { const int orow = d6_crow(r, hi);
#pragma unroll
        for (int d0 = 0; d0 < 2; ++d0) stg[orow * 64 + d0 * 32 + r32] = (bf16_t)(cvtpk(o[d0][r] * rli[r], 0.f) & 0xffffu); }
    asm volatile("s_waitcnt lgkmcnt(0)" ::: "memory");
#pragma unroll
    for (int i = 0; i < 4; ++i) { const int row = i * 8 + (lane >> 3), ch = lane & 7;
        const u32x4_t_ ovv = *(const LAS u32x4_t_*)(stg + row * 64 + ch * 8); const uint4 ov = make_uint4(ovv.x, ovv.y, ovv.z, ovv.w);
        float fo[8], fg[8]; unpack8(ov, fo); unpack8(gv[i], fg);
        uint4 w; w.x = cvtpk(fo[0] * silu(fg[0]), fo[1] * silu(fg[1])); w.y = cvtpk(fo[2] * silu(fg[2]), fo[3] * silu(fg[3]));
        w.z = cvtpk(fo[4] * silu(fg[4]), fo[5] * silu(fg[5])); w.w = cvtpk(fo[6] * silu(fg[6]), fo[7] * silu(fg[7]));
        *(uint4*)(MIX + (row0 + row) * DM + 1536 + head * 64 + ch * 8) = w; }
}
constexpr int TBW_N = 264, TBW_HS = 296;
__device__ __forceinline__ void bunit_B2(const bf16_t* P, const bf16_t* VT, bf16_t* MIX, const LAS float* tbw4, const float* sinks, LAS unsigned char* ring, LAS float* wsf, LAS bf16_t* stg  ,
                                         int b, int g, int q64, int tid, int wib, int& base  , int bn  ) {
    asm volatile("" : "+v"(tid));
    int lane = tid & 63; asm volatile("" : "+v"(lane));
    const int c = lane & 31, h = lane >> 5, hh = c >> 3, qi = c & 7, t0 = 64 * q64 + 8 * wib, tc = t0 + qi, head = g * 4 + hh;
    const size_t rowq = (size_t)b * S + tc;
    abf16x8 qf[4];
#pragma unroll
    for (int s = 0; s < 4; ++s) qf[s] = *(const abf16x8*)(P + rowq * LDP + C_BQ + head * 64 + 16 * s + 8 * h);
    const LAS float* tbh = tbw4 + hh * TBW_HS;
    const float sinkv = sinks[head];
    const int Rlo = (64 * q64 - 127 > 0 ? 64 * q64 - 127 : 0) >> 6;
    const unsigned rm = (0xffffffffu >> (31 - q64)) & (0xffffffffu << Rlo);
    f32x16 o[2]; float l, mref; int nbase = 0;
    a_sweep64<false>(P + (size_t)b * S * LDP + C_BK + g * 64, VT + (size_t)(VR_BV + g * 64) * M + (size_t)b * S, ring, wsf, rm, 0u, tbh + (191 - tc + 8 * h), tbh + 192, qf, o, l, mref, tid,
                     true, base, P + (size_t)(bn < 0 ? 0 : bn) * S * LDP + C_BK + g * 64, VT + (size_t)(VR_BV + g * 64) * M + (size_t)(bn < 0 ? 0 : bn) * S, bn < 0 ? 0u : rm, nbase);
    base = nbase;
    int h2 = lane >> 5; asm volatile("" : "+v"(h2));
    int c2 = lane & 31; asm volatile("" : "+v"(c2));
    int ln = lane; asm volatile("" : "+v"(ln));
    uint4 gv[4];
#pragma unroll
    for (int i = 0; i < 4; ++i) { const int row = i * 8 + (ln >> 3), ch = ln & 7; gv[i] = *(const uint4*)(P + ((size_t)b * S + t0 + (row & 7)) * LDP + C_BGATE + (g * 4 + (row >> 3)) * 64 + ch * 8); }
    { auto rr = __builtin_amdgcn_permlane32_swap(__float_as_uint(l), __float_as_uint(l), false, false); l = __uint_as_float(rr[0]) + __uint_as_float(rr[1]); }
    l += __builtin_amdgcn_exp2f(sinkv * LOG2E - mref);
    if (h2 == 0) wsf[32 + c2] = 1.f / l;
    asm volatile("s_waitcnt lgkmcnt(0)" ::: "memory");
#pragma unroll
    for (int r = 0; r < 16; ++r) { const int row = d6_crow(r, h2); const float il = wsf[32 + row];
        stg[row * 64 + c2] = (bf16_t)(cvtpk(o[0][r] * il, 0.f) & 0xffffu); stg[row * 64 + 32 + c2] = (bf16_t)(cvtpk(o[1][r] * il, 0.f) & 0xffffu); }
    asm volatile("s_waitcnt lgkmcnt(0)" ::: "memory");
#pragma unroll
    for (int i = 0; i < 4; ++i) { const int row = i * 8 + (ln >> 3), ch = ln & 7;
        const u32x4_t_ ovv = *(const LAS u32x4_t_*)(stg + row * 64 + ch * 8); const uint4 ov = make_uint4(ovv.x, ovv.y, ovv.z, ovv.w);
        float fo[8], fg[8]; unpack8(ov, fo); unpack8(gv[i], fg);
        uint4 w; w.x = cvtpk(fo[0] * silu(fg[0]), fo[1] * silu(fg[1])); w.y = cvtpk(fo[2] * silu(fg[2]), fo[3] * silu(fg[3]));
        w.z = cvtpk(fo[4] * silu(fg[4]), fo[5] * silu(fg[5])); w.w = cvtpk(fo[6] * silu(fg[6]), fo[7] * silu(fg[7]));
        *(uint4*)(MIX + ((size_t)b * S + t0 + (row & 7)) * DM + 512 + (g * 4 + (row >> 3)) * 64 + ch * 8) = w; }
}

typedef unsigned u32x4_t __attribute__((ext_vector_type(4)));
constexpr int LY_TA = 0, LY_OSC = 4 * TA_HS * 4, LY_UM = LY_OSC + 65536, LY_RING = LY_UM + 256, LY_TW = LY_RING + 6 * D6_SLOT, LY_WSF = LY_TW + 4 * TW_HS * 4, LY_END = LY_WSF + 2048;
static_assert(LY_END <= LDS_BYTES - 128, "phase Y LDS map");
__device__ __forceinline__ void phase_mix_a(const Params& prm, int layer, LAS unsigned char* ldsb) {
    LAUNDER_S(layer);
    PH_COMMON
    const float* GT = (const float*)(ws + WS_G); const bf16_t* KCMP = (const bf16_t*)(ws + WS_CMP); const bf16_t* VCMPT = KCMP + (size_t)NB * 2 * 128 * 64;
    const bf16_t* P = (const bf16_t*)(ws + WS_P); bf16_t* MIX = (bf16_t*)(ws + WS_MIX); const bf16_t* VT = (const bf16_t*)(ws + WS_VT);
    for (int pair = vblk; pair < 256; pair += G) {
        const int bg = pair >> 4, qa = pair & 15;
        __syncthreads();
        {
            const f32x4_t_* src4 = (const f32x4_t_*)(ws + WS_IMG + (size_t)(bg & 1) * 32768);
            LAS float* ta = (LAS float*)(ldsb + LY_TA); LAS float* tw = (LAS float*)(ldsb + LY_TW);
            const f32x4_t_ v0 = src4[tid], v1 = src4[tid + NT], v2 = src4[tid + 2 * NT], v3 = src4[tid + 3 * NT];
            const f32x4_t_ vw = src4[(tid >> 7) * 512 + 384 + (tid & 127)];
            *(LAS f32x4_t_*)(ta + 4 * tid) = v0; *(LAS f32x4_t_*)(ta + TA_HS + 4 * tid) = v1;
            *(LAS f32x4_t_*)(ta + 2 * TA_HS + 4 * tid) = v2; *(LAS f32x4_t_*)(ta + 3 * TA_HS + 4 * tid) = v3;
            ta[(tid >> 7) * TA_HS + 2048 + (tid & 127)] = -INFINITY;
            *(LAS f32x4_t_*)(tw + (tid >> 7) * TW_HS + 64 + 4 * (tid & 127)) = vw;
            for (int i = tid; i < 4 * 136; i += NT) { const int hh = i / 136, e = i - hh * 136; tw[hh * TW_HS + (e < 64 ? e : 512 + e)] = -INFINITY; }
        }
        __syncthreads();
        int wbase = 0;
        {
            const int b_ = bg >> 1, g_ = bg & 1; const int Rlo = (64 * qa - 511 > 0 ? 64 * qa - 511 : 0) >> 6;
            a_prime(P + (size_t)b_ * S * LDP + C_AKW + g_ * 64, VT + (size_t)(VR_AVW + g_ * 64) * M + (size_t)b_ * S, ldsb + LY_RING, (0xffffffffu >> (31 - qa)) & (0xffffffffu << Rlo), 0, tid);
        }
#pragma unroll 1
        for (int k = 0; k < 2; ++k)
            bunit_A(P, VT, KCMP, VCMPT, GT, MIX, (const LAS float*)(ldsb + LY_TA), (const LAS float*)(ldsb + LY_TW), (LAS float*)(ldsb + LY_OSC + wib * 8192), (LAS float*)(ldsb + LY_WSF) + wib * 64,
                    (volatile LAS unsigned*)(ldsb + LY_UM), ldsb + LY_RING, bg >> 1, bg & 1, k ? 31 - qa : qa, tid, wib, wbase, k ? -1 : 31 - qa);
    }
}
constexpr int LX_KV = 0, LX_TB = D6_END;
__device__ __forceinline__ void phase_mix_db(const Params& prm, int layer, LAS unsigned char* ldsb) {
    LAUNDER_S(layer);
    PH_COMMON
    const bf16_t* P = (const bf16_t*)(ws + WS_P); bf16_t* MIX = (bf16_t*)(ws + WS_MIX); const bf16_t* VT = (const bf16_t*)(ws + WS_VT);
    const float* sinks = prm.sinks + layer * 8;
    for (int pair = vblk; pair < 256; pair += G) {
        const int bh = pair >> 2, qa = pair & 3;
        __syncthreads();
        int dbase = 0;
        {
            const int b_ = bh >> 3, hd = bh & 7; const int nt0 = 4 * qa + 4;
            a_prime(P + (size_t)b_ * S * LDP + C_DK + hd * 64, VT + (size_t)(VR_DV + hd * 64) * M + (size_t)b_ * S, ldsb, nt0 >= 32 ? 0xffffffffu : (1u << nt0) - 1u, 0, tid);
        }
        {
            const f32x4_t_* src4 = (const f32x4_t_*)(ws + WS_IMG + 65536 + (size_t)(bh & 7) * 8192); LAS float* dst = (LAS float*)(ldsb + D6_TD);
            *(LAS f32x4_t_*)(dst + 4 * tid) = src4[tid];
            if (tid < 256) dst[2048 + tid] = -INFINITY;
        }
        __syncthreads();
#pragma unroll 1
        for (int k = 0; k < 2; ++k) dunit64b(P, VT, MIX, ldsb, bh >> 3, bh & 7, k ? 7 - qa : qa, tid, dbase, k ? -1 : 7 - qa);
    }
}
constexpr int CW_BST = 8192 + 64 * 10;
__device__ __forceinline__ void phase_b_steal(const Params& prm, int layer, LAS unsigned char* ldsb, volatile LAS unsigned* slot) {
    LAUNDER_S(layer);
    PH_COMMON
    const bf16_t* P = (const bf16_t*)(ws + WS_P); bf16_t* MIX = (bf16_t*)(ws + WS_MIX); const bf16_t* VT = (const bf16_t*)(ws + WS_VT);
    const float* sinks = prm.sinks + layer * 8;
    unsigned* ctr = (unsigned*)(ws + WS_CTL) + CW_BST + 64 * layer;
    unsigned nxt = 0u;
    if (tid == 0) nxt = __hip_atomic_fetch_add(ctr, 1u, __ATOMIC_RELAXED, __HIP_MEMORY_SCOPE_AGENT);
#pragma unroll 1
    for (;;) {
        __syncthreads();
        if (tid == 0) *slot = nxt;
        __syncthreads();
        const int u = (int)*slot;
        if (u >= 512) break;
        if (tid == 0) nxt = __hip_atomic_fetch_add(ctr, 1u, __ATOMIC_RELAXED, __HIP_MEMORY_SCOPE_AGENT);
        const int b_ = u >> 6, g_ = (u >> 5) & 1, q_ = u & 31;
        {
            const f32x4_t_* src4 = (const f32x4_t_*)((const float*)(ws + WS_IMG + 131072) + (size_t)g_ * 4 * 256);
            LAS float* tb = (LAS float*)(ldsb + LX_TB);
            if (tid < 128) *(LAS f32x4_t_*)(tb + (tid >> 5) * TBW_HS + 64 + 4 * (tid & 31)) = src4[(tid >> 5) * 64 + 32 + (tid & 31)];
            for (int i = tid; i < 4 * 136; i += NT) { const int hh = i / 136, e = i - hh * 136; tb[hh * TBW_HS + (e < 64 ? e : 128 + e)] = -INFINITY; }
        }
        {
            const int Rlo = (64 * q_ - 127 > 0 ? 64 * q_ - 127 : 0) >> 6;
            a_prime(P + (size_t)b_ * S * LDP + C_BK + g_ * 64, VT + (size_t)(VR_BV + g_ * 64) * M + (size_t)b_ * S, ldsb + LX_KV, (0xffffffffu >> (31 - q_)) & (0xffffffffu << Rlo), 0, tid);
        }
        __syncthreads();
        int bbase = 0;
        bunit_B2(P, VT, MIX, (const LAS float*)(ldsb + LX_TB), sinks, ldsb + LX_KV, (LAS float*)(ldsb + D6_WS) + wib * 64, (LAS bf16_t*)(ldsb + D6_OST) + wib * 2048, b_, g_, q_, tid, wib, bbase, -1);
    }
}
constexpr int CW_CONV = 8192 + 64 * 8;
__device__ __forceinline__ void phase_conv(const Params& prm, int layer, volatile LAS unsigned* slot  ) {
    LAUNDER_S(layer);
    PH_COMMON
    const bf16_t* P = (const bf16_t*)(ws + WS_P); bf16_t* MIX = (bf16_t*)(ws + WS_MIX);
    const float* convw = prm.conv_w + layer * 3 * 512;
    unsigned* ctr = (unsigned*)(ws + WS_CTL) + CW_CONV + 64 * layer;
    constexpr unsigned NCH = M / 16;
    const int c0 = (tid & 63) * 8;
    float cw[3][8];
#pragma unroll
    for (int k = 0; k < 3; ++k)
#pragma unroll
        for (int j = 0; j < 8; ++j) cw[k][j] = convw[k * 512 + c0 + j];
    unsigned nxt = 0u;
    if (tid == 0) nxt = __hip_atomic_fetch_add(ctr, 1u, __ATOMIC_RELAXED, __HIP_MEMORY_SCOPE_AGENT);
    for (;;) {
        __syncthreads();
        if (tid == 0) *slot = nxt;
        __syncthreads();
        const unsigned ch = *slot;
        if (ch >= NCH) break;
        if (tid == 0) nxt = __hip_atomic_fetch_add(ctr, 1u, __ATOMIC_RELAXED, __HIP_MEMORY_SCOPE_AGENT);
        uint4 L[2][5]; bool ok1[2], ok2[2];
#pragma unroll
        for (int q = 0; q < 2; ++q) { const int i = (int)ch * 1024 + q * NT + tid; const int row = i >> 6, t = row & (S - 1);
            const bf16_t* pr = P + (size_t)row * LDP; ok1[q] = t >= 1; ok2[q] = t >= 2;
            const bf16_t* p1 = ok1[q] ? pr - LDP : pr; const bf16_t* p2 = ok2[q] ? pr - 2 * LDP : pr;
            L[q][0] = ld_nt16(pr + C_CB + c0); L[q][1] = ld_nt16(pr + C_CGATE + c0);
            L[q][2] = *(const uint4*)(pr + C_CC + c0); L[q][3] = *(const uint4*)(p1 + C_CC + c0); L[q][4] = *(const uint4*)(p2 + C_CC + c0); }
#pragma unroll
        for (int q = 0; q < 2; ++q) { const int i = (int)ch * 1024 + q * NT + tid; const int row = i >> 6;
            float cb[8], cg[8], a[8], y[8];
            unpack8(L[q][0], cb); unpack8(L[q][1], cg); unpack8(L[q][2], a);
#pragma unroll
            for (int j = 0; j < 8; ++j) y[j] = cw[2][j] * a[j];
            unpack8(L[q][3], a);
#pragma unroll
            for (int j = 0; j < 8; ++j) y[j] += (ok1[q] ? cw[1][j] : 0.f) * a[j];
            unpack8(L[q][4], a);
#pragma unroll
            for (int j = 0; j < 8; ++j) y[j] += (ok2[q] ? cw[0][j] : 0.f) * a[j];
            uint4 w;
            w.x = cvtpk(cb[0] * y[0] * silu(cg[0]), cb[1] * y[1] * silu(cg[1])); w.y = cvtpk(cb[2] * y[2] * silu(cg[2]), cb[3] * y[3] * silu(cg[3]));
            w.z = cvtpk(cb[4] * y[4] * silu(cg[4]), cb[5] * y[5] * silu(cg[5])); w.w = cvtpk(cb[6] * y[6] * silu(cg[6]), cb[7] * y[7] * silu(cg[7]));
            *(uint4*)(MIX + (size_t)row * DM + 1024 + c0) = w; }
    }
}
__device__ __forceinline__ void phase_rss(const Params& prm) {
    PH_COMMON
    const bf16_t* XB = (const bf16_t*)(ws + WS_XB); float* rss = (float*)(ws + WS_RSS) + M;
    for (int row = gwave; row < M; row += gwaves) {
        const uint4* xr = (const uint4*)(XB + (size_t)row * DM) + lane; float sq = 0.f;
#pragma unroll
        for (int j = 0; j < 4; ++j) { float f[8]; unpack8(xr[64 * j], f);
#pragma unroll
            for (int e = 0; e < 8; ++e) sq += f[e] * f[e]; }
        sq = wave_sum(sq);
        if (lane == 0) rss[row] = sq;
    }
}
__device__ __forceinline__ void phase_final(const Params& prm) {
    PH_COMMON
    const bf16_t* XB = (const bf16_t*)(ws + WS_XB);
    const bool grouped = G == 256;
    for (int it = 0, row = grouped ? (vblk >> 5) * S + (vblk & 31) * NWAVES + wib : gwave; grouped ? it < S / 256 : row < M; ++it, row += grouped ? 256 : gwaves) {
        const uint4* xr = (const uint4*)(XB + (size_t)row * DM) + lane; float sq = 0.f; float f[4][8];
#pragma unroll
        for (int j = 0; j < 4; ++j) { unpack8(ld_nt16(&xr[64 * j]), f[j]);
#pragma unroll
            for (int e = 0; e < 8; ++e) sq += f[j][e] * f[j][e]; }
        const float r = rsqrtf(wave_sum(sq) * (1.f / DM) + 1e-6f);
        float4* o = (float4*)(prm.out + (size_t)row * DM); const float4* w4 = (const float4*)prm.final_norm_w;
#pragma unroll
        for (int j = 0; j < 4; ++j) { const int c4 = (lane + 64 * j) * 2; const float4 wa = w4[c4], wb = w4[c4 + 1];
            typedef float f4v __attribute__((ext_vector_type(4)));
            __builtin_nontemporal_store((f4v){f[j][0] * r * wa.x, f[j][1] * r * wa.y, f[j][2] * r * wa.z, f[j][3] * r * wa.w}, (f4v*)&o[c4]);
            __builtin_nontemporal_store((f4v){f[j][4] * r * wb.x, f[j][5] * r * wb.y, f[j][6] * r * wb.z, f[j][7] * r * wb.w}, (f4v*)&o[c4 + 1]); }
    }
}

#ifndef REP_PRO
#define REP_PRO 1
#endif
#ifndef REP_INP
#define REP_INP 1
#endif
#ifndef REP_GAT
#define REP_GAT 1
#endif
#ifndef REP_CMP
#define REP_CMP 1
#endif
#ifndef REP_MAB
#define REP_MAB 1
#endif
#ifndef REP_MB
#define REP_MB 1
#endif
#ifndef REP_MD
#define REP_MD 1
#endif
#ifndef REP_CNV
#define REP_CNV 1
#endif
#ifndef REP_SYNC
#define REP_SYNC 1
#endif
#define REPEAT(n) _Pragma("unroll 1") for (int rep_ = 0; rep_ < (n); ++rep_)
__global__ void __launch_bounds__(NT, 2) fwd_kernel(Params prm) {
    extern __shared__ __attribute__((aligned(16))) unsigned char lds_raw[];
    LAS unsigned char* ldsb = (LAS unsigned char*)lds_raw;
    volatile LAS unsigned* MISC = (volatile LAS unsigned*)(ldsb + MISC_OFF);
    if (threadIdx.x < 32) MISC[threadIdx.x] = 0u;
    __syncthreads();
    const XcdBarrier bar = xcd_barrier_post((unsigned*)(prm.ws + WS_CTL) + CW_BAR, MISC + 8);
#define GRID_SYNC() do { TS_BEGIN(20) xcd_barrier(bar); TS_END(20) } while (0)
    { TS_BEGIN(8) phase_prologue(prm, ldsb, 0); __syncthreads();
      split_arrive((unsigned*)(prm.ws + WS_CTL) + CW_SPLIT + 64 * 4);
      phase_prologue(prm, ldsb, 1); __syncthreads();
      split_wait((unsigned*)(prm.ws + WS_CTL) + CW_SPLIT + 64 * 4, (unsigned*)(prm.ws + WS_CTL) + CW_BAR + XB_TMO); TS_END(8) }
#pragma unroll
    for (int layer = 0; layer < DEPTH; ++layer) {
        { TS_BEGIN(6) REPEAT(REP_INP) phase_inproj(prm, layer, ldsb); TS_END(6) }
        unsigned* const ctlw = (unsigned*)(prm.ws + WS_CTL);
        unsigned* const tmow = ctlw + CW_BAR + XB_TMO;
        const bool grouped = gridDim.x == 256;
        const int grp = (int)blockIdx.x & 7;
        unsigned* const gA = ctlw + CW_GRP + 64 * (8 * (3 * layer + 0) + grp);
        unsigned* const gB = ctlw + CW_GRP + 64 * (8 * (3 * layer + 1) + grp);
        unsigned* const gC = ctlw + CW_GRP + 64 * (8 * (3 * layer + 2) + grp);
        const unsigned gtarget = gridDim.x >> 3;
        split_arrive2(ctlw + CW_SPLIT + 64 * (2 * layer), grouped ? gA : nullptr);
        REPEAT(REP_GAT) phase_gates(prm, layer, ldsb);
        if (grouped) split_wait_n(gA, gtarget, tmow);
        else split_wait(ctlw + CW_SPLIT + 64 * (2 * layer), tmow);
        { TS_BEGIN(21)
        REPEAT(REP_CMP) phase_compress(prm, layer, ldsb);
        split_arrive(grouped ? gB : ctlw + CW_SPLIT + 64 * (2 * layer + 1));
        REPEAT(REP_MD) { phase_mix_db(prm, layer, ldsb); __syncthreads(); }
        TS_END(21) }
        if (grouped) split_wait_n(gB, gtarget, tmow);
        else split_wait(ctlw + CW_SPLIT + 64 * (2 * layer + 1), tmow);
        { TS_BEGIN(22) REPEAT(REP_MAB) { phase_mix_a(prm, layer, ldsb); __syncthreads(); } TS_END(22) }
        if (grouped) split_wait(ctlw + CW_SPLIT + 64 * (2 * layer), tmow);
        phase_b_steal(prm, layer, ldsb, MISC + 17);
        phase_conv(prm, layer, MISC + 16);
        GRID_SYNC();
        { TS_BEGIN(7) phase_outproj(prm, layer, ldsb); TS_END(7) }
        if (grouped) { split_arrive(gC); split_wait_n(gC, gtarget, tmow); }
        else GRID_SYNC();
    }
    phase_final(prm);
    if (TSEL != 0 && blockIdx.x == TSBLK && threadIdx.x == 0) {
        const unsigned long long want = (unsigned long long)TMUL * *TS_ACC_PTR, t0 = __builtin_amdgcn_s_memrealtime();
        while (__builtin_amdgcn_s_memrealtime() - t0 < want) __builtin_amdgcn_s_sleep(32);
    }
}

extern "C" void kernel_launch(void* const* d_in, const int* in_sizes, int n_in, void* d_out, int out_size, void* d_ws, size_t ws_size, hipStream_t stream) {
    static int grid_blocks = 0;
    if (!grid_blocks) {
        int dev = 0, cus = 0, per_cu = 0;
        (void)hipGetDevice(&dev);
        (void)hipDeviceGetAttribute(&cus, hipDeviceAttributeMultiprocessorCount, dev);
        if (hipFuncSetAttribute((const void*)fwd_kernel, hipFuncAttributeMaxDynamicSharedMemorySize, LDS_BYTES) != hipSuccess) fprintf(stderr, "kernel_launch: hipFuncSetAttribute failed\n");
        (void)hipOccupancyMaxActiveBlocksPerMultiprocessor(&per_cu, fwd_kernel, NT, LDS_BYTES);
        if (per_cu < 1) fprintf(stderr, "kernel_launch: occupancy query says %d blocks per CU\n", per_cu);
        grid_blocks = cus;
        if (ws_size < WS_END) fprintf(stderr, "kernel_launch: workspace too small: %zu < %zu\n", ws_size, (size_t)WS_END);
    }
    Params p{};
    p.x = (const float*)d_in[0]; p.norm_w = (const float*)d_in[1]; p.w_in = (const float*)d_in[2]; p.w_out = (const float*)d_in[3];
    p.conv_w = (const float*)d_in[4]; p.sinks = (const float*)d_in[5]; p.cmp_pos = (const float*)d_in[6]; p.cmp_w1 = (const float*)d_in[7];
    p.cmp_w2 = (const float*)d_in[8]; p.rel_bias = (const float*)d_in[9]; p.final_norm_w = (const float*)d_in[10];
    p.out = (float*)d_out; p.ws = (unsigned char*)d_ws;
    if (hipMemsetAsync((char*)d_ws + WS_CTL, 0, CTL_ZERO_BYTES, stream) != hipSuccess) { fprintf(stderr, "kernel_launch: memset of the control words failed\n"); return; }
    hipLaunchKernelGGL(fwd_kernel, dim3(grid_blocks), dim3(NT), LDS_BYTES, stream, p);
    hipError_t e = hipPeekAtLastError();
    if (e != hipSuccess) fprintf(stderr, "launch failed: %s (grid %d)\n", hipGetErrorString(e), grid_blocks);
}
```
